# Optimizing an MI355X kernel written in HIP

```python
import math
import jax, jax.numpy as jnp
from jax import lax
import numpy as np

D_MODEL = 1024
BATCH = 8
SEQ = 2048
DEPTH = 2

CHUNK = 64
Q_BLOCK = 128
HEAD_DIM = 64
MEM_LEN = 256
MEM_HEADS = 4
MEM_W = MEM_HEADS * HEAD_DIM
MIX_W = D_MODEL
BR_W = MIX_W - MEM_W
A_HEADS = BR_W // HEAD_DIM
B_HEADS = BR_W // (2 * HEAD_DIM)
LORA_W = 64
LORA_A = 64
N_A = DEPTH // 2
N_B = DEPTH - N_A
A_SHIFT = 3 * BR_W + LORA_W + LORA_A
A_IN = A_SHIFT + BR_W + 2 * MEM_W
B_IN = 2 * BR_W + 2 * MEM_W
NORM_EPS = 1e-6
LNX_EPS = 64e-5

kernel_name = 'hybrid_rwkv7_diffattn_yoco'


def rms_norm(x, g):
    xf = x.astype(jnp.float32)
    y = xf * lax.rsqrt(jnp.mean(xf * xf, axis=-1, keepdims=True) + NORM_EPS)
    return (y * g.astype(jnp.float32)).astype(x.dtype)


def token_shift(z):
    return jnp.pad(z, ((0, 0), (1, 0), (0, 0)))[:, :-1]


def alibi_slopes(n):
    def pow2(m):
        start = 2.0 ** (-8.0 / m)
        return [start ** (i + 1) for i in range(m)]
    if math.log2(n).is_integer():
        s = pow2(n)
    else:
        c = 2 ** int(math.floor(math.log2(n)))
        s = pow2(c) + pow2(2 * c)[0::2][: n - c]
    return jnp.asarray(np.array(s, dtype=np.float32))


def rwkv7_time_mix(z, mu, w0, w2, a0, a2, k_k, k_a, r_k, lnx_w, lnx_b):
    B, S, _ = z.shape
    z = z.astype(jnp.float32)
    z = z + (token_shift(z) - z) * mu
    r, k, v, wd, ad = jnp.split(z, [BR_W, 2 * BR_W, 3 * BR_W, 3 * BR_W + LORA_W], axis=-1)
    w = -jax.nn.softplus(-(w0 + jnp.tanh(wd) @ w2)) - 0.5
    decay = jnp.exp(-jnp.exp(w))
    a = jax.nn.sigmoid(a0 + ad @ a2)
    heads = lambda t: t.reshape(B, S, A_HEADS, HEAD_DIM)
    kk = heads(k * k_k)
    kk = kk * lax.rsqrt(jnp.maximum(jnp.sum(kk * kk, axis=-1, keepdims=True), 1e-12))
    k = k * (1.0 + (a - 1.0) * k_a)
    r, k, v, decay, a = heads(r), heads(k), heads(v), heads(decay), heads(a)

    def step(state, inp):
        r_t, w_t, k_t, v_t, kk_t, a_t = inp
        sa = jnp.einsum('bhvk,bhk->bhv', state, -kk_t)
        state = (state * w_t[:, :, None, :]
                 + sa[..., None] * (kk_t * a_t)[:, :, None, :]
                 + v_t[..., None] * k_t[:, :, None, :])
        y_t = jnp.einsum('bhvk,bhk->bhv', state, r_t)
        return state, y_t

    tm = lambda t: jnp.moveaxis(t, 1, 0)
    state0 = jnp.zeros((B, A_HEADS, HEAD_DIM, HEAD_DIM), jnp.float32)
    _, y = lax.scan(step, state0, (tm(r), tm(decay), tm(k), tm(v), tm(kk), tm(a)))
    y = jnp.moveaxis(y, 0, 1)
    mean = jnp.mean(y, axis=-1, keepdims=True)
    var = jnp.mean(jnp.square(y - mean), axis=-1, keepdims=True)
    y = ((y - mean) * lax.rsqrt(var + LNX_EPS)).reshape(B, S, BR_W) * lnx_w + lnx_b
    bonus = jnp.sum(r * k * r_k, axis=-1, keepdims=True) * v
    return y + bonus.reshape(B, S, BR_W)


def diff_attention(q, k_sh, v_sh, lq1, lk1, lq2, lk2, subln, lam_init):
    B, S, _ = q.shape
    q = q.reshape(B, S, B_HEADS, 2, HEAD_DIM) * (HEAD_DIM ** -0.5)
    k = k_sh.reshape(B, S, B_HEADS, 2, HEAD_DIM)
    v = v_sh.reshape(B, S, B_HEADS, 2 * HEAD_DIM)
    lq1f, lk1f = lq1.astype(jnp.float32), lk1.astype(jnp.float32)
    lq2f, lk2f = lq2.astype(jnp.float32), lk2.astype(jnp.float32)
    lam = jnp.exp(jnp.sum(lq1f * lk1f)) - jnp.exp(jnp.sum(lq2f * lk2f)) + lam_init
    slopes = alibi_slopes(B_HEADS)
    pos = jnp.arange(S)
    nb = S // Q_BLOCK
    qb = jnp.moveaxis(q.reshape(B, nb, Q_BLOCK, B_HEADS, 2, HEAD_DIM), 1, 0)

    def block(args):
        q_blk, i = args
        t = i * Q_BLOCK + jnp.arange(Q_BLOCK)
        s = jnp.einsum('bqhcd,bkhcd->bhcqk', q_blk, k, preferred_element_type=jnp.float32)
        dist = jnp.abs(t[:, None] - pos[None, :]).astype(jnp.float32)
        bias = -slopes[:, None, None] * dist
        allowed = (pos[None, :] // CHUNK) <= (t[:, None] // CHUNK)
        s = jnp.where(allowed, s + bias[None, :, None], -jnp.inf)
        p = jax.nn.softmax(s, axis=-1)
        attn = (p[:, :, 0] - lam * p[:, :, 1]).astype(v.dtype)
        return jnp.einsum('bhqk,bkhe->bqhe', attn, v)

    o = lax.map(block, (qb, jnp.arange(nb)))
    o = jnp.moveaxis(o, 0, 1).reshape(B, S, B_HEADS, 2 * HEAD_DIM)
    o = rms_norm(o, subln) * (1.0 - lam_init)
    return o.reshape(B, S, BR_W)


def memory_cross_attention(q, mem_n, w_mem_kv):
    B, S, _ = q.shape
    k, v = jnp.split(mem_n @ w_mem_kv, 2, axis=-1)
    k = k.reshape(B, -1, MEM_HEADS, HEAD_DIM)
    v = v.reshape(B, -1, MEM_HEADS, HEAD_DIM)
    q = q.reshape(B, S, MEM_HEADS, HEAD_DIM)
    s = jnp.einsum('bshd,bmhd->bhsm', q, k, preferred_element_type=jnp.float32) * (HEAD_DIM ** -0.5)
    p = jax.nn.softmax(s, axis=-1).astype(v.dtype)
    o = jnp.einsum('bhsm,bmhd->bshd', p, v)
    return o.reshape(B, S, MEM_W)


def setup_inputs(seed: int = 0) -> dict:
    key = jax.random.key(seed)
    ks = jax.random.split(key, 32)
    nrm = lambda k, shape, scale: scale * jax.random.normal(k, shape, jnp.float32)
    gain = lambda k, shape: 1.0 + 0.05 * jax.random.normal(k, shape, jnp.float32)
    return {
        'x': jax.random.normal(ks[0], (BATCH, SEQ, D_MODEL), jnp.float32),
        'mem': jax.random.normal(ks[1], (BATCH, MEM_LEN, D_MODEL), jnp.float32),
        'pre_norm': gain(ks[2], (DEPTH, D_MODEL)),
        'post_norm': gain(ks[3], (DEPTH, D_MODEL)),
        'w_out': nrm(ks[4], (DEPTH, MIX_W, D_MODEL), MIX_W ** -0.5),
        'mem_norm': gain(ks[5], (DEPTH, D_MODEL)),
        'w_mem_kv': nrm(ks[6], (DEPTH, D_MODEL, 2 * MEM_W), D_MODEL ** -0.5),
        'a_w_in': nrm(ks[7], (N_A, D_MODEL, A_IN), D_MODEL ** -0.5),
        'a_shift_mu': jax.random.uniform(ks[8], (N_A, A_SHIFT), jnp.float32),
        'a_w0': jax.random.uniform(ks[9], (N_A, BR_W), jnp.float32, minval=-6.0, maxval=0.0),
        'a_w2': nrm(ks[10], (N_A, LORA_W, BR_W), 0.5 * LORA_W ** -0.5),
        'a_a0': nrm(ks[11], (N_A, BR_W), 0.1),
        'a_a2': nrm(ks[12], (N_A, LORA_A, BR_W), 0.5 * LORA_A ** -0.5),
        'a_k_k': 0.85 + 0.05 * jax.random.normal(ks[13], (N_A, BR_W), jnp.float32),
        'a_k_a': gain(ks[14], (N_A, BR_W)),
        'a_r_k': nrm(ks[15], (N_A, A_HEADS, HEAD_DIM), 0.1),
        'a_lnx_w': gain(ks[16], (N_A, BR_W)),
        'a_lnx_b': nrm(ks[17], (N_A, BR_W), 0.02),
        'kv_norm': gain(ks[18], (D_MODEL,)),
        'w_kv': nrm(ks[19], (D_MODEL, 2 * BR_W), D_MODEL ** -0.5),
        'b_w_in': nrm(ks[20], (N_B, D_MODEL, B_IN), D_MODEL ** -0.5),
        'b_lam_q1': nrm(ks[21], (N_B, HEAD_DIM), 0.1),
        'b_lam_k1': nrm(ks[22], (N_B, HEAD_DIM), 0.1),
        'b_lam_q2': nrm(ks[23], (N_B, HEAD_DIM), 0.1),
        'b_lam_k2': nrm(ks[24], (N_B, HEAD_DIM), 0.1),
        'b_subln': gain(ks[25], (N_B, 2 * HEAD_DIM)),
    }


def reference(x, mem, pre_norm, post_norm, w_out, mem_norm, w_mem_kv,
              a_w_in, a_shift_mu, a_w0, a_w2, a_a0, a_a2, a_k_k, a_k_a, a_r_k, a_lnx_w, a_lnx_b,
              kv_norm, w_kv,
              b_w_in, b_lam_q1, b_lam_k1, b_lam_q2, b_lam_k2, b_subln):
    k_sh = None
    v_sh = None
    for l in range(DEPTH):
        h = rms_norm(x, pre_norm[l])
        mem_n = rms_norm(mem, mem_norm[l])
        if l < N_A:
            i = l
            proj = h @ a_w_in[i]
            z, gate, q_mem, g_mem = jnp.split(
                proj, [A_SHIFT, A_SHIFT + BR_W, A_SHIFT + BR_W + MEM_W], axis=-1)
            y_br = rwkv7_time_mix(z, a_shift_mu[i], a_w0[i], a_w2[i], a_a0[i], a_a2[i],
                                  a_k_k[i], a_k_a[i], a_r_k[i], a_lnx_w[i], a_lnx_b[i])
        else:
            if l == N_A:
                k_sh, v_sh = jnp.split(rms_norm(x, kv_norm) @ w_kv, 2, axis=-1)
            i = l - N_A
            proj = h @ b_w_in[i]
            q, gate, q_mem, g_mem = jnp.split(
                proj, [BR_W, 2 * BR_W, 2 * BR_W + MEM_W], axis=-1)
            lam_init = 0.8 - 0.6 * math.exp(-0.3 * l)
            y_br = diff_attention(q, k_sh, v_sh, b_lam_q1[i], b_lam_k1[i], b_lam_q2[i],
                                  b_lam_k2[i], b_subln[i], lam_init)
        y_mem = memory_cross_attention(q_mem, mem_n, w_mem_kv[l])
        y = jnp.concatenate([(y_br * jax.nn.silu(gate.astype(jnp.float32))).astype(x.dtype),
                             y_mem * jax.nn.silu(g_mem)], axis=-1) @ w_out[l]
        x = x + rms_norm(y, post_norm[l])
    return x
```

```cpp
#include <hip/hip_runtime.h>
#include <hip/hip_cooperative_groups.h>
#include <cstdio>
#include <cstdint>
namespace cg = cooperative_groups;

#ifndef MK_COOP
#define MK_COOP 1
#endif

#define LAS __attribute__((address_space(3)))
typedef unsigned short bf16;
typedef short bf16x8 __attribute__((ext_vector_type(8)));
typedef float f32x4 __attribute__((ext_vector_type(4)));
typedef float f32x2 __attribute__((ext_vector_type(2)));
typedef unsigned u32x4 __attribute__((ext_vector_type(4)));
typedef unsigned u32x2 __attribute__((ext_vector_type(2)));

constexpr int DM = 1024, NBATCH = 8, SEQ = 2048, MTOK = NBATCH * SEQ;
constexpr int MEML = 256, MROWS = NBATCH * MEML;
constexpr int BRW = 768, AH = 12, BH = 6;
constexpr int LDP0 = 3840;
constexpr int LDP1 = 2816;
constexpr int C_R = 0, C_K = 768, C_V = 1536, C_WD = 2304, C_AD = 2368, C_GATE0 = 2432, C_QM0 = 3200, C_GM0 = 3456;
constexpr int C_Q1 = 0, C_GATE1 = 768, C_QM1 = 1536, C_GM1 = 1792, C_KSH = 2048;
constexpr float NORM_EPS = 1e-6f, LNX_EPS = 64e-5f;
constexpr float LOG2E = 1.4426950408889634f;

constexpr size_t MiB = 1u << 20;
constexpr size_t WS_WA = 1 * MiB;
constexpr size_t WS_WB = 9 * MiB;
constexpr size_t WS_WO = 16 * MiB;
constexpr size_t WS_WM = 20 * MiB;
constexpr size_t WS_MEMN = 22 * MiB;
constexpr size_t WS_MK = 26 * MiB;
constexpr size_t WS_MVT = 28 * MiB;
constexpr size_t WS_XN = 30 * MiB;
constexpr size_t WS_CAT = 62 * MiB;
constexpr size_t WS_VT = 94 * MiB;
constexpr size_t WS_PROJ = 118 * MiB;
constexpr size_t WS_Y = 118 * MiB;
constexpr size_t WS_W2T = 0 * MiB + 65536;
constexpr size_t WS_BS = 238 * MiB;
constexpr size_t WS_END = 240 * MiB;

__device__ __forceinline__ unsigned f2bf(float f) { unsigned u = __builtin_bit_cast(unsigned, f); return (u + 0x7fffu + ((u >> 16) & 1u)) >> 16; }
__device__ __forceinline__ unsigned pk2(float lo, float hi) { return f2bf(lo) | (f2bf(hi) << 16); }
__device__ __forceinline__ float bflo(unsigned u) { return __builtin_bit_cast(float, u << 16); }
__device__ __forceinline__ float bfhi(unsigned u) { return __builtin_bit_cast(float, u & 0xffff0000u); }
__device__ __forceinline__ float wave_sum(float v) {
#pragma unroll
    for (int o = 1; o < 64; o <<= 1) v += __shfl_xor(v, o);
    return v;
}
template <int CTRL> __device__ __forceinline__ float dppf(float x) { return __builtin_bit_cast(float, __builtin_amdgcn_update_dpp(0, __builtin_bit_cast(int, x), CTRL, 0xf, 0xf, false)); }
__device__ __forceinline__ float sum8(float x) { x += dppf<0xB1>(x); x += dppf<0x4E>(x); x += dppf<0x141>(x); return x; }
__device__ __forceinline__ float sum16(float x) { x += dppf<0xB1>(x); x += dppf<0x4E>(x); x += dppf<0x141>(x); x += dppf<0x140>(x); return x; }
__device__ __forceinline__ float sigmoidf_(float x) { return 1.f / (1.f + __expf(-x)); }
__device__ __forceinline__ float siluf_(float x) { return x / (1.f + __expf(-x)); }

namespace pg8 {
constexpr int BM = 256, BK = 64, HALF = 128, HTB = HALF * BK * 2, STAGE_BYTES = 8 * HTB, NXCD = 8, WGM = 8;
__device__ __forceinline__ int lds_byte(int r, int c) { const int st = (r >> 4) * 2 + (c >> 5), rr = r & 15, cc = c & 31, ob = rr * 64 + cc * 2; return st * 1024 + (ob ^ (((ob >> 9) & 1) << 5)); }
__device__ __forceinline__ void stage_rc(int b, int& R, int& C) { const int st = b / 1024, sb = b % 1024, swz = sb ^ (((sb >> 9) & 1) << 5); R = (st >> 1) * 16 + swz / 64; C = (st & 1) * 32 + (swz % 64) / 2; }
__device__ __forceinline__ int perm32(int rho) { const int n = rho >> 4, i = rho & 15; return 8 * (i >> 2) + 4 * n + (i & 3); }
struct Unit { int pm, pn; };
struct Gemm { const bf16* A; const bf16* Bt; int M, N, K; };
struct StaticOrder {
    int nM, nN, nwg, G, c;
    __device__ void init(int M, int N, int G_, int c_) { nM = M / BM; nN = N / BM; nwg = nM * nN; G = G_; c = c_; }
    __device__ bool next(int i, Unit& u) const {
        const long L = (long)i * G + c; if (L >= nwg) return false;
        int wgid = (int)L; { const int q = nwg / NXCD, r = nwg % NXCD, xcd = wgid % NXCD, off = wgid / NXCD; wgid = (xcd < r ? xcd * (q + 1) : r * (q + 1) + (xcd - r) * q) + off; }
        const int nig = WGM * nN, gid = wgid / nig, fm = gid * WGM, gsz = (nM - fm) < WGM ? (nM - fm) : WGM;
        u.pm = fm + ((wgid % nig) % gsz); u.pn = (wgid % nig) / gsz; return true;
    }
};
__device__ __forceinline__ unsigned cvt_pk_bf16(float lo, float hi) { unsigned r; asm volatile("v_cvt_pk_bf16_f32 %0, %1, %2" : "=v"(r) : "v"(lo), "v"(hi)); return r; }

struct EpiStore {
    void* O; int ldc; int f32out;
    __device__ __forceinline__ void operator()(const f32x4 (&acc)[2][2][4][2], const Unit& u, int wr, int wc, int fr, int fq) const {
        const int row0 = u.pm * BM + wr * 64 + fr, col0 = u.pn * BM + wc * 32 + 8 * fq;
        if (f32out) {
#pragma unroll
            for (int ai = 0; ai < 2; ++ai)
#pragma unroll
                for (int m = 0; m < 4; ++m) { float* rowp = (float*)O + (size_t)(row0 + ai * HALF + m * 16) * ldc + col0;
#pragma unroll
                    for (int bj = 0; bj < 2; ++bj) { *(f32x4*)(rowp + bj * HALF) = acc[ai][bj][m][0]; *(f32x4*)(rowp + bj * HALF + 4) = acc[ai][bj][m][1]; } }
        } else {
#pragma unroll
            for (int ai = 0; ai < 2; ++ai)
#pragma unroll
                for (int m = 0; m < 4; ++m) { bf16* rowp = (bf16*)O + (size_t)(row0 + ai * HALF + m * 16) * ldc + col0;
#pragma unroll
                    for (int bj = 0; bj < 2; ++bj) { const f32x4 v0 = acc[ai][bj][m][0], v1 = acc[ai][bj][m][1];
                        u32x4 w; w.x = cvt_pk_bf16(v0[0], v0[1]); w.y = cvt_pk_bf16(v0[2], v0[3]); w.z = cvt_pk_bf16(v1[0], v1[1]); w.w = cvt_pk_bf16(v1[2], v1[3]);
                        *(u32x4*)(rowp + bj * HALF) = w; } }
        }
    }
};

template <class Epi, class Sched>
__device__ __forceinline__ void gemm_phase(LAS unsigned char* lds, const Gemm g, const Sched& S, const Epi& E) {
    const int tid = threadIdx.x, wid = __builtin_amdgcn_readfirstlane(tid >> 6), lane = tid & 63, wr = wid >> 2, wc = wid & 3, fr = lane & 15, fq = lane >> 4;
    const int K = g.K, nt = K / BK;
    unsigned voffA[2], voffB[2];
#pragma unroll
    for (int i = 0; i < 2; ++i) { int R, C; stage_rc(tid * 16 + i * 8192, R, C); const int Rb = (R & ~31) + perm32(R & 31);
        voffA[i] = (unsigned)(R * K + C) * 2u; voffB[i] = (unsigned)(Rb * K + C) * 2u; }
    const size_t kstep = (size_t)(BK * 2);
    const size_t hstep = (size_t)HALF * K * 2;
    const size_t tstep = 2 * hstep;
    const unsigned ldsw = (unsigned)wid * 1024u;
    const int aoff = lds_byte(wr * 64 + fr, fq * 8), boff = lds_byte(wc * 32 + fr, fq * 8);
#define PG8_SA(b, h) (((b) * 2 + (h)) * HTB)
#define PG8_SB(b, h) ((4 + (b) * 2 + (h)) * HTB)
#define PG8_STAGE(bufoff, gbase, voff) do { _Pragma("unroll") for (int _i = 0; _i < 2; ++_i) \
        __builtin_amdgcn_global_load_lds((const unsigned*)((const char*)(gbase) + (voff)[_i]), (LAS unsigned*)(lds + (bufoff) + ldsw + _i * 8192), 16, 0, 0); } while (0)
#define PG8_LDA(dst, b, h) do { _Pragma("unroll") for (int m = 0; m < 4; ++m) _Pragma("unroll") for (int k = 0; k < 2; ++k) dst[m][k] = *(const LAS bf16x8*)(lds + PG8_SA(b, h) + aoff + m * 2048 + k * 1024); } while (0)
#define PG8_LDB(dst, b, h) do { _Pragma("unroll") for (int n = 0; n < 2; ++n) _Pragma("unroll") for (int k = 0; k < 2; ++k) dst[n][k] = *(const LAS bf16x8*)(lds + PG8_SB(b, h) + boff + n * 2048 + k * 1024); } while (0)
#define PG8_MMA(ai, bj, At, Bt) do { __builtin_amdgcn_s_setprio(1); _Pragma("unroll") for (int m = 0; m < 4; ++m) _Pragma("unroll") for (int n = 0; n < 2; ++n) _Pragma("unroll") for (int k = 0; k < 2; ++k) \
        acc[ai][bj][m][n] = __builtin_amdgcn_mfma_f32_16x16x32_bf16(Bt[n][k], At[m][k], acc[ai][bj][m][n], 0, 0, 0); __builtin_amdgcn_s_setprio(0); } while (0)
#define PG8_WAIT_V(n) asm volatile("s_waitcnt vmcnt(" #n ")" ::: "memory")
#define PG8_WAIT_L(n) asm volatile("s_waitcnt lgkmcnt(" #n ")" ::: "memory")
#define PG8_BAR __builtin_amdgcn_s_barrier()
#define PG8_SCHED __builtin_amdgcn_sched_barrier(0)
    Unit cur, nxt; int ui = 0;
    if (!S.next(0, cur)) return;
    f32x4 acc[2][2][4][2];
#pragma unroll
    for (int a = 0; a < 2; ++a)
#pragma unroll
        for (int b = 0; b < 2; ++b)
#pragma unroll
            for (int m = 0; m < 4; ++m)
#pragma unroll
                for (int n = 0; n < 2; ++n) acc[a][b][m][n] = (f32x4){0.f, 0.f, 0.f, 0.f};
    bf16x8 At[4][2], B0[2][2], B1[2][2];
    const char* cA = (const char*)g.A + (size_t)cur.pm * tstep; const char* cB = (const char*)g.Bt + (size_t)cur.pn * tstep;
    PG8_STAGE(PG8_SB(0, 0), cB, voffB); PG8_STAGE(PG8_SB(0, 1), cB + hstep, voffB); PG8_STAGE(PG8_SA(0, 0), cA, voffA); PG8_STAGE(PG8_SA(0, 1), cA + hstep, voffA);
    if (wr == 1) PG8_BAR;
    PG8_WAIT_V(2); PG8_BAR;
    PG8_STAGE(PG8_SB(1, 0), cB + kstep, voffB); PG8_STAGE(PG8_SA(1, 0), cA + kstep, voffA); PG8_STAGE(PG8_SB(1, 1), cB + hstep + kstep, voffB);
    PG8_WAIT_V(6); PG8_BAR;
    for (;;) {
        const bool has_next = S.next(ui + 1, nxt);
        const char* nA = has_next ? (const char*)g.A + (size_t)nxt.pm * tstep : cA; const char* nB = has_next ? (const char*)g.Bt + (size_t)nxt.pn * tstep : cB;
        for (int t = 0; t < nt; t += 2) {
            const bool last = (t == nt - 2);
            const char* a1 = cA + (size_t)(t + 1) * kstep;
            const char* a2 = last ? nA : cA + (size_t)(t + 2) * kstep; const char* b2 = last ? nB : cB + (size_t)(t + 2) * kstep;
            const char* a3 = a2 + kstep; const char* b3 = b2 + kstep;
            PG8_LDB(B0, 0, 0); PG8_LDB(B1, 0, 1); PG8_SCHED; PG8_LDA(At, 0, 0); PG8_STAGE(PG8_SA(1, 1), a1 + hstep, voffA);
            PG8_WAIT_V(8); PG8_WAIT_L(0); PG8_BAR; PG8_MMA(0, 0, At, B0); PG8_MMA(0, 1, At, B1); PG8_BAR; PG8_SCHED;
            PG8_LDA(At, 0, 1); PG8_STAGE(PG8_SB(0, 0), b2, voffB); PG8_STAGE(PG8_SB(0, 1), b2 + hstep, voffB); PG8_STAGE(PG8_SA(0, 0), a2, voffA);
            PG8_WAIT_V(8); PG8_WAIT_L(0); PG8_BAR; PG8_MMA(1, 0, At, B0); PG8_MMA(1, 1, At, B1); PG8_BAR; PG8_SCHED;
            PG8_LDB(B0, 1, 0); PG8_LDB(B1, 1, 1); PG8_SCHED; PG8_LDA(At, 1, 0); PG8_STAGE(PG8_SA(0, 1), a2 + hstep, voffA);
            PG8_WAIT_V(8); PG8_WAIT_L(0); PG8_BAR; PG8_MMA(0, 0, At, B0); PG8_MMA(0, 1, At, B1); PG8_BAR; PG8_SCHED;
            PG8_LDA(At, 1, 1); PG8_STAGE(PG8_SB(1, 0), b3, voffB); PG8_STAGE(PG8_SB(1, 1), b3 + hstep, voffB); PG8_STAGE(PG8_SA(1, 0), a3, voffA);
            PG8_WAIT_V(8); PG8_WAIT_L(0); PG8_BAR; PG8_MMA(1, 0, At, B0); PG8_MMA(1, 1, At, B1); PG8_BAR; PG8_SCHED;
        }
        if (wr == 0) PG8_BAR;
        E(acc, cur, wr, wc, fr, fq);
        if (!has_next) break;
#pragma unroll
        for (int a = 0; a < 2; ++a)
#pragma unroll
            for (int b = 0; b < 2; ++b)
#pragma unroll
                for (int m = 0; m < 4; ++m)
#pragma unroll
                    for (int n = 0; n < 2; ++n) acc[a][b][m][n] = (f32x4){0.f, 0.f, 0.f, 0.f};
        cur = nxt; cA = nA; cB = nB; ++ui;
        if (wr == 1) PG8_BAR;
    }
    PG8_WAIT_V(0);
    PG8_BAR;
#undef PG8_SA
#undef PG8_SB
#undef PG8_STAGE
#undef PG8_LDA
#undef PG8_LDB
#undef PG8_MMA
#undef PG8_WAIT_V
#undef PG8_WAIT_L
#undef PG8_BAR
#undef PG8_SCHED
}
}

struct Args { const float* in[26]; float* out; unsigned char* ws; int ph_lo, ph_hi; };
enum { I_X = 0, I_MEM, I_PRE, I_POST, I_WOUT, I_MEMNORM, I_WMEMKV, I_AWIN, I_AMU, I_AW0, I_AW2, I_AA0, I_AA2, I_AKK, I_AKA, I_ARK, I_ALNW, I_ALNB,
       I_KVNORM, I_WKV, I_BWIN, I_LQ1, I_LK1, I_LQ2, I_LK2, I_SUBLN };

constexpr int LDS_BYTES = 147456;

__device__ __forceinline__ void p0_transpose_item(const float* W, int ldw, int c0, int nc, const float* gain, bf16* WT, int row0, LAS float* scr, int item, int lane, int ldo = 1024) {
    const int nblk = nc / 32, kb = item / nblk, nb = item % nblk, k0 = 64 * kb, n0 = 32 * nb;
#pragma unroll 8
    for (int i = 0; i < 32; ++i) { const int kk = 2 * i + (lane >> 5);
        float v = W[(size_t)(k0 + kk) * ldw + c0 + n0 + (lane & 31)]; if (gain) v *= gain[k0 + kk];
        scr[kk * 33 + (lane & 31)] = v; }
    asm volatile("s_waitcnt lgkmcnt(0)" ::: "memory");
    const int c = lane & 7;
#pragma unroll
    for (int j = 0; j < 4; ++j) { const int n = (lane >> 3) + 8 * j; const LAS float* s = scr + (8 * c) * 33 + n;
        u32x4 o; o.x = pk2(s[0 * 33], s[1 * 33]); o.y = pk2(s[2 * 33], s[3 * 33]); o.z = pk2(s[4 * 33], s[5 * 33]); o.w = pk2(s[6 * 33], s[7 * 33]);
        *(u32x4*)(WT + (size_t)(row0 + n0 + n) * ldo + k0 + 8 * c) = o; }
    asm volatile("s_waitcnt lgkmcnt(0)" ::: "memory");
}
__device__ __forceinline__ void rms_row_to_bf16(const float* xrow, bf16* orow, int lane) {
    const f32x4* xr = (const f32x4*)xrow + lane;
    f32x4 v[4]; float s = 0.f;
#pragma unroll
    for (int j = 0; j < 4; ++j) { v[j] = xr[64 * j]; s += (v[j].x * v[j].x + v[j].y * v[j].y) + (v[j].z * v[j].z + v[j].w * v[j].w); }
    const float rs = 1.f / sqrtf(wave_sum(s) * (1.f / DM) + NORM_EPS);
    unsigned long long* o8 = (unsigned long long*)orow + lane;
#pragma unroll
    for (int j = 0; j < 4; ++j) o8[64 * j] = (unsigned long long)pk2(v[j].x * rs, v[j].y * rs) | ((unsigned long long)pk2(v[j].z * rs, v[j].w * rs) << 32);
}
__device__ __forceinline__ void phase_prologue(const Args& a, LAS unsigned char* lds) {
    const int tid = threadIdx.x, lane = tid & 63, wave = __builtin_amdgcn_readfirstlane(tid >> 6);
    const int G = gridDim.x, gw = blockIdx.x * 8 + wave, NGW = G * 8;
    unsigned char* ws = a.ws;
    LAS float* scr = (LAS float*)(lds + wave * 16384);
    bf16* WA = (bf16*)(ws + WS_WA); bf16* WB = (bf16*)(ws + WS_WB); bf16* WO = (bf16*)(ws + WS_WO); bf16* WM = (bf16*)(ws + WS_WM);
    constexpr int I0 = 16 * (3712 / 32), I1 = 16 * (2048 / 32), I2 = 16 * (1536 / 32), I3 = 16 * (1024 / 32), I5 = 16 * (256 / 32);
    constexpr int I6 = 768 / 32;
    constexpr int NITEMS = I0 + I1 + I2 + 2 * I3 + 4 * I5 + 2 * I6;
    bf16* W2T = (bf16*)(ws + WS_W2T); bf16* A2T = W2T + 768 * 64;
    for (int it = gw; it < NITEMS; it += NGW) {
        int r = it;
        if (r < I0) { p0_transpose_item(a.in[I_AWIN], 3712, 0, 3712, a.in[I_PRE], WA, 0, scr, r, lane); continue; } r -= I0;
        if (r < I1) { p0_transpose_item(a.in[I_BWIN], 2048, 0, 2048, a.in[I_PRE] + 1024, WB, 0, scr, r, lane); continue; } r -= I1;
        if (r < I2) { p0_transpose_item(a.in[I_WKV], 1536, 0, 1536, a.in[I_KVNORM], WB, 2048, scr, r, lane); continue; } r -= I2;
        if (r < I3) { p0_transpose_item(a.in[I_WOUT], 1024, 0, 1024, nullptr, WO, 0, scr, r, lane); continue; } r -= I3;
        if (r < I3) { p0_transpose_item(a.in[I_WOUT] + 1024 * 1024, 1024, 0, 1024, nullptr, WO + 1024 * 1024, 0, scr, r, lane); continue; } r -= I3;
        if (r < I5) { p0_transpose_item(a.in[I_WMEMKV], 512, 0, 256, a.in[I_MEMNORM], WM, 0, scr, r, lane); continue; } r -= I5;
        if (r < I5) { p0_transpose_item(a.in[I_WMEMKV], 512, 256, 256, a.in[I_MEMNORM], WM, 512, scr, r, lane); continue; } r -= I5;
        if (r < I5) { p0_transpose_item(a.in[I_WMEMKV] + 1024 * 512, 512, 0, 256, a.in[I_MEMNORM] + 1024, WM, 256, scr, r, lane); continue; } r -= I5;
        if (r < I5) { p0_transpose_item(a.in[I_WMEMKV] + 1024 * 512, 512, 256, 256, a.in[I_MEMNORM] + 1024, WM, 768, scr, r, lane); continue; } r -= I5;
        if (r < I6) { p0_transpose_item(a.in[I_AW2], 768, 0, 768, nullptr, W2T, 0, scr, r, lane, 64); continue; } r -= I6;
        p0_transpose_item(a.in[I_AA2], 768, 0, 768, nullptr, A2T, 0, scr, r, lane, 64);
    }
    { u32x4* z = (u32x4*)(WA + (size_t)3712 * 1024); const int nz = 128 * 1024 * 2 / 16;
      for (int i = blockIdx.x * 512 + tid; i < nz; i += G * 512) z[i] = (u32x4){0u, 0u, 0u, 0u}; }
    bf16* XN = (bf16*)(ws + WS_XN); bf16* MEMN = (bf16*)(ws + WS_MEMN);
    for (int m = gw; m < MTOK + MROWS; m += NGW) {
        if (m < MTOK) rms_row_to_bf16(a.in[I_X] + (size_t)m * DM, XN + (size_t)m * DM, lane);
        else rms_row_to_bf16(a.in[I_MEM] + (size_t)(m - MTOK) * DM, MEMN + (size_t)(m - MTOK) * DM, lane);
    }
}

__device__ __forceinline__ void run_gemm(LAS unsigned char* lds, const bf16* A, const bf16* Bt, int M, int N, void* O, int ldc, int f32out, int shift) {
    const int G = gridDim.x;
    pg8::Gemm g{A, Bt, M, N, 1024};
    pg8::StaticOrder S; S.init(M, N, G, (int)((blockIdx.x + G - shift) % G));
    pg8::EpiStore E{O, ldc, f32out};
    pg8::gemm_phase<pg8::EpiStore, pg8::StaticOrder>(lds, g, S, E);
}
__device__ __forceinline__ void phase_gemm(const Args& a, LAS unsigned char* lds, int first, int count) {
    unsigned char* ws = a.ws;
    for (int j = first; j < first + count; ++j) {
        const bf16* A; const bf16* Bt; int M, N, ldc, f32o, shift; void* O;
        switch (j) {
        case 0: A = (const bf16*)(ws + WS_XN); Bt = (const bf16*)(ws + WS_WA); M = MTOK; N = 3840; O = ws + WS_PROJ; ldc = LDP0; f32o = 0; shift = 0; break;
        case 1: A = (const bf16*)(ws + WS_MEMN); Bt = (const bf16*)(ws + WS_WM); M = MROWS; N = 512; O = ws + WS_MK; ldc = 512; f32o = 0; shift = 192; break;
        case 2: A = (const bf16*)(ws + WS_WM) + 512 * 1024; Bt = (const bf16*)(ws + WS_MEMN); M = 512; N = MROWS; O = ws + WS_MVT; ldc = MROWS; f32o = 0; shift = 208; break;
        case 3: A = (const bf16*)(ws + WS_CAT); Bt = (const bf16*)(ws + WS_WO); M = MTOK; N = 1024; O = ws + WS_Y; ldc = 1024; f32o = 1; shift = 0; break;
        case 4: A = (const bf16*)(ws + WS_XN); Bt = (const bf16*)(ws + WS_WB); M = MTOK; N = 2816; O = ws + WS_PROJ; ldc = LDP1; f32o = 0; shift = 0; break;
        case 5: A = (const bf16*)(ws + WS_WB) + 2816 * 1024; Bt = (const bf16*)(ws + WS_XN); M = 768; N = MTOK; O = ws + WS_VT; ldc = MTOK; f32o = 0; shift = 192; break;
        default: A = (const bf16*)(ws + WS_CAT); Bt = (const bf16*)(ws + WS_WO) + 1024 * 1024; M = MTOK; N = 1024; O = ws + WS_Y; ldc = 1024; f32o = 1; shift = 0; break;
        }
        run_gemm(lds, A, Bt, M, N, O, ldc, f32o, shift);
    }
}

constexpr int AT_PITCH = 72;
template <int NMAP>
__device__ __forceinline__ void attn_unit(LAS unsigned char* lds, const bf16* Qp, int ldq, const bf16* Kp, int ldk, const bf16* VTp, int ldvt,
                                          int nkt_lo, int nkt_hi, float slope2, int tq0,
                                          const bf16* Gp, int ldg, bf16* Op, int ldo, const float* subln, float lam, float oscale) {
    constexpr int EV = 64 * NMAP, NET = EV / 16;
    const int tid = threadIdx.x, lane = tid & 63, wave = __builtin_amdgcn_readfirstlane(tid >> 6), g = lane >> 4, c = lane & 15;
    LAS bf16* Ks = (LAS bf16*)lds;
    LAS bf16* Vs = (LAS bf16*)(lds + NMAP * 64 * AT_PITCH * 2);
    const int nkt = (wave < 4) ? nkt_lo : nkt_hi;
    const int qrow = 16 * wave + c;
    bf16x8 qf[NMAP][2];
#pragma unroll
    for (int mp = 0; mp < NMAP; ++mp)
#pragma unroll
        for (int ks = 0; ks < 2; ++ks) qf[mp][ks] = *(const bf16x8*)(Qp + (size_t)qrow * ldq + mp * 64 + 32 * ks + 8 * g);
    f32x4 o[NMAP][NET];
#pragma unroll
    for (int mp = 0; mp < NMAP; ++mp)
#pragma unroll
        for (int et = 0; et < NET; ++et) o[mp][et] = (f32x4){0.f, 0.f, 0.f, 0.f};
    float mrun[NMAP], lrun[NMAP];
#pragma unroll
    for (int mp = 0; mp < NMAP; ++mp) { mrun[mp] = -1e30f; lrun[mp] = 0.f; }
    const float sc2 = 0.125f * LOG2E;
    const float tq = (float)(tq0 + qrow);
    u32x4 kreg[NMAP], vreg[NMAP];
#define AT_LOAD(kt) do { _Pragma("unroll") for (int i = 0; i < NMAP; ++i) { const int id = tid + 512 * i; \
        { const int mp = id >> 9, n = (id >> 3) & 63, ch = id & 7; kreg[i] = *(const u32x4*)(Kp + (size_t)((kt) * 64 + n) * ldk + mp * 64 + 8 * ch); } \
        { const int e = id >> 3, ch = id & 7; vreg[i] = *(const u32x4*)(VTp + (size_t)e * ldvt + (kt) * 64 + 8 * ch); } } } while (0)
    AT_LOAD(0);
    for (int kt = 0; kt < nkt_hi; ++kt) {
        __syncthreads();
#pragma unroll
        for (int i = 0; i < NMAP; ++i) { const int id = tid + 512 * i;
            { const int mp = id >> 9, n = (id >> 3) & 63, ch = id & 7; *(LAS u32x4*)(Ks + (mp * 64 + n) * AT_PITCH + 8 * ch) = kreg[i]; }
            { const int e = id >> 3, ch = id & 7; *(LAS u32x4*)(Vs + e * AT_PITCH + 8 * ch) = vreg[i]; } }
        __syncthreads();
        if (kt + 1 < nkt_hi) AT_LOAD(kt + 1);
        if (kt < nkt) {
            bf16x8 pf[NMAP][2];
#pragma unroll
            for (int mp = 0; mp < NMAP; ++mp) {
                f32x4 st[4];
#pragma unroll
                for (int k16 = 0; k16 < 4; ++k16) {
                    st[k16] = (f32x4){0.f, 0.f, 0.f, 0.f};
#pragma unroll
                    for (int ks = 0; ks < 2; ++ks) { const bf16x8 ka = *(const LAS bf16x8*)(Ks + (mp * 64 + 16 * k16 + c) * AT_PITCH + 32 * ks + 8 * g);
                        st[k16] = __builtin_amdgcn_mfma_f32_16x16x32_bf16(ka, qf[mp][ks], st[k16], 0, 0, 0); }
                }
                float mx = -1e30f;
#pragma unroll
                for (int k16 = 0; k16 < 4; ++k16)
#pragma unroll
                    for (int j = 0; j < 4; ++j) { const float tk = (float)(kt * 64 + 16 * k16 + 4 * g + j);
                        const float x = st[k16][j] * sc2 - slope2 * fabsf(tq - tk); st[k16][j] = x; mx = fmaxf(mx, x); }
                mx = fmaxf(mx, __shfl_xor(mx, 16)); mx = fmaxf(mx, __shfl_xor(mx, 32));
                const float mnew = fmaxf(mrun[mp], mx), alpha = __builtin_amdgcn_exp2f(mrun[mp] - mnew);
                mrun[mp] = mnew;
                float ps = 0.f;
#pragma unroll
                for (int k16 = 0; k16 < 4; ++k16)
#pragma unroll
                    for (int j = 0; j < 4; ++j) { const float p = __builtin_amdgcn_exp2f(st[k16][j] - mnew); st[k16][j] = p; ps += p; }
                lrun[mp] = lrun[mp] * alpha + ps;
#pragma unroll
                for (int et = 0; et < NET; ++et) o[mp][et] = o[mp][et] * alpha;
#pragma unroll
                for (int i = 0; i < 2; ++i) { u32x4 w; w.x = pk2(st[2 * i][0], st[2 * i][1]); w.y = pk2(st[2 * i][2], st[2 * i][3]); w.z = pk2(st[2 * i + 1][0], st[2 * i + 1][1]); w.w = pk2(st[2 * i + 1][2], st[2 * i + 1][3]);
                    pf[mp][i] = __builtin_bit_cast(bf16x8, w); }
            }
#pragma unroll
            for (int et = 0; et < NET; ++et)
#pragma unroll
                for (int i = 0; i < 2; ++i) {
                    const u32x2 lo = *(const LAS u32x2*)(Vs + (16 * et + c) * AT_PITCH + 32 * i + 4 * g);
                    const u32x2 hi = *(const LAS u32x2*)(Vs + (16 * et + c) * AT_PITCH + 32 * i + 16 + 4 * g);
                    const bf16x8 va = __builtin_bit_cast(bf16x8, (u32x4){lo.x, lo.y, hi.x, hi.y});
#pragma unroll
                    for (int mp = 0; mp < NMAP; ++mp) o[mp][et] = __builtin_amdgcn_mfma_f32_16x16x32_bf16(va, pf[mp][i], o[mp][et], 0, 0, 0);
                }
        }
    }
#undef AT_LOAD
    float inv[NMAP];
#pragma unroll
    for (int mp = 0; mp < NMAP; ++mp) { float l = lrun[mp]; l += __shfl_xor(l, 16); l += __shfl_xor(l, 32); inv[mp] = 1.f / l; }
    f32x4 r[NET]; float ss = 0.f;
#pragma unroll
    for (int et = 0; et < NET; ++et) {
        if (NMAP == 2) r[et] = o[0][et] * inv[0] - o[NMAP - 1][et] * (lam * inv[NMAP - 1]);
        else r[et] = o[0][et] * inv[0];
        ss += (r[et].x * r[et].x + r[et].y * r[et].y) + (r[et].z * r[et].z + r[et].w * r[et].w);
    }
    float rs = 1.f;
    if (NMAP == 2) { ss += __shfl_xor(ss, 16); ss += __shfl_xor(ss, 32); rs = oscale / sqrtf(ss * (1.f / EV) + NORM_EPS); }
#pragma unroll
    for (int et = 0; et < NET; ++et) {
        const int e = 16 * et + 4 * g;
        const u32x2 gv = *(const u32x2*)(Gp + (size_t)qrow * ldg + e);
        f32x4 v = r[et] * rs;
        if (NMAP == 2) v = v * *(const f32x4*)(subln + e);
        v.x *= siluf_(bflo(gv.x)); v.y *= siluf_(bfhi(gv.x)); v.z *= siluf_(bflo(gv.y)); v.w *= siluf_(bfhi(gv.y));
        u32x2 w; w.x = pk2(v.x, v.y); w.y = pk2(v.z, v.w);
        *(u32x2*)(Op + (size_t)qrow * ldo + e) = w;
    }
    __syncthreads();
}

__device__ __forceinline__ void mem_attn_unit(const Args& a, LAS unsigned char* lds, int l, int u) {
    unsigned char* ws = a.ws;
    const int b = u >> 6, h = (u >> 4) & 3, qb = u & 15;
    const bf16* PROJ = (const bf16*)(ws + WS_PROJ);
    const int ldp = l ? LDP1 : LDP0, cq = l ? C_QM1 : C_QM0, cg_ = l ? C_GM1 : C_GM0;
    const size_t row0 = (size_t)b * SEQ + qb * 128;
    attn_unit<1>(lds, PROJ + row0 * ldp + cq + h * 64, ldp,
                 (const bf16*)(ws + WS_MK) + (size_t)b * MEML * 512 + l * 256 + h * 64, 512,
                 (const bf16*)(ws + WS_MVT) + (size_t)(l * 256 + h * 64) * MROWS + b * MEML, MROWS,
                 4, 4, 0.f, 0,
                 PROJ + row0 * ldp + cg_ + h * 64, ldp, (bf16*)(ws + WS_CAT) + row0 * DM + BRW + h * 64, DM, nullptr, 0.f, 1.f);
}

constexpr int SC_TB = 16, SC_STRIDE = 360, SC_BUF = SC_TB * SC_STRIDE;
__device__ __forceinline__ void scan_unit(const Args& a, LAS unsigned char* lds, int b, int h, int half) {
    const int tid = threadIdx.x, lane = tid & 63, wave = __builtin_amdgcn_readfirstlane(tid >> 6);
    unsigned char* ws = a.ws;
    LAS float* ops = (LAS float*)lds;
    const bf16* PROJ = (const bf16*)(ws + WS_PROJ);
    bf16* CAT = (bf16*)(ws + WS_CAT);
    const size_t mb = (size_t)b * SEQ;
    constexpr int NBLK = SEQ / SC_TB;
    if (wave < 4) {
        const int rg = lane >> 3, kg = lane & 7;
        const int rowl = 8 * wave + rg;
        f32x2 S[4];
#pragma unroll
        for (int i = 0; i < 4; ++i) S[i] = (f32x2){0.f, 0.f};
        for (int q = 0; q < 4; ++q) __syncthreads();
        for (int blk = 0; blk < NBLK; ++blk) {
            const LAS float* ob = ops + (blk % 3) * SC_BUF;
            float yk0 = 0.f, yk1 = 0.f;
#pragma unroll 2
            for (int s = 0; s < SC_TB; ++s) {
                const LAS float* o = ob + s * SC_STRIDE + 8 * kg;
                const f32x4 w0 = *(const LAS f32x4*)(o), w1 = *(const LAS f32x4*)(o + 4);
                const f32x4 b0 = *(const LAS f32x4*)(o + 64), b1 = *(const LAS f32x4*)(o + 68);
                const f32x4 k0 = *(const LAS f32x4*)(o + 128), k1 = *(const LAS f32x4*)(o + 132);
                const f32x4 n0 = *(const LAS f32x4*)(o + 192), n1 = *(const LAS f32x4*)(o + 196);
                const f32x4 r0 = *(const LAS f32x4*)(o + 256), r1 = *(const LAS f32x4*)(o + 260);
                const float vv = ob[s * SC_STRIDE + 320 + rowl];
                const f32x2 sc = *(const LAS f32x2*)(ob + s * SC_STRIDE + 352);
                f32x2 d1 = S[0] * (f32x2){n0.x, n0.y}; d1 = S[1] * (f32x2){n0.z, n0.w} + d1; d1 = S[2] * (f32x2){n1.x, n1.y} + d1; d1 = S[3] * (f32x2){n1.z, n1.w} + d1;
                f32x2 d2 = S[0] * (f32x2){r0.x, r0.y}; d2 = S[1] * (f32x2){r0.z, r0.w} + d2; d2 = S[2] * (f32x2){r1.x, r1.y} + d2; d2 = S[3] * (f32x2){r1.z, r1.w} + d2;
                const float sa = sum8(d1.x + d1.y), yd = sum8(d2.x + d2.y);
                const f32x2 sa2 = {sa, sa}, v2 = {vv, vv};
                S[0] = S[0] * (f32x2){w0.x, w0.y} + (sa2 * (f32x2){b0.x, b0.y} + v2 * (f32x2){k0.x, k0.y});
                S[1] = S[1] * (f32x2){w0.z, w0.w} + (sa2 * (f32x2){b0.z, b0.w} + v2 * (f32x2){k0.z, k0.w});
                S[2] = S[2] * (f32x2){w1.x, w1.y} + (sa2 * (f32x2){b1.x, b1.y} + v2 * (f32x2){k1.x, k1.y});
                S[3] = S[3] * (f32x2){w1.z, w1.w} + (sa2 * (f32x2){b1.z, b1.w} + v2 * (f32x2){k1.z, k1.w});
                const float y = yd + sa * sc.x + vv * sc.y;
                if ((s & 7) == kg) { if (s < 8) yk0 = y; else yk1 = y; }
            }
            bf16* yp = CAT + (mb + (size_t)blk * SC_TB + kg) * DM + h * 64 + 32 * half + rowl;
            yp[0] = (bf16)f2bf(yk0); yp[(size_t)8 * DM] = (bf16)f2bf(yk1);
            __syncthreads();
        }
    } else {
        const int pw = wave - 4, g = lane >> 4, c = lane & 15;
        const float* mu = a.in[I_AMU];
        const int kc = h * 64 + 4 * c;
        const f32x4 p_w0 = *(const f32x4*)(a.in[I_AW0] + kc), p_a0 = *(const f32x4*)(a.in[I_AA0] + kc), p_kk = *(const f32x4*)(a.in[I_AKK] + kc),
                    p_ka = *(const f32x4*)(a.in[I_AKA] + kc), p_rk = *(const f32x4*)(a.in[I_ARK] + kc),
                    mu_r = *(const f32x4*)(mu + C_R + kc), mu_k = *(const f32x4*)(mu + C_K + kc);
        const bf16* W2T = (const bf16*)(ws + WS_W2T); const bf16* A2T = W2T + 768 * 64;
        for (int q = 0; q < pw; ++q) __syncthreads();
        for (int n = 0; n < NBLK / 4; ++n) {
            const int blk = 4 * n + pw, t0 = blk * SC_TB;
            u32x4 zwd[2], zwdp[2], zad[2], zadp[2], zv, zvp; u32x2 zr[4], zrp[4], zk[4], zkp[4];
            {
                const bf16* cur = PROJ + (mb + t0 + c) * LDP0; const bf16* prv = (t0 + c == 0) ? cur : cur - LDP0;
#pragma unroll
                for (int ks = 0; ks < 2; ++ks) { zwd[ks] = *(const u32x4*)(cur + C_WD + 32 * ks + 8 * g); zwdp[ks] = *(const u32x4*)(prv + C_WD + 32 * ks + 8 * g);
                    zad[ks] = *(const u32x4*)(cur + C_AD + 32 * ks + 8 * g); zadp[ks] = *(const u32x4*)(prv + C_AD + 32 * ks + 8 * g); }
#pragma unroll
                for (int jj = 0; jj < 4; ++jj) { const int s = 4 * g + jj; const bf16* cs = PROJ + (mb + t0 + s) * LDP0; const bf16* ps = (t0 + s == 0) ? cs : cs - LDP0;
                    zr[jj] = *(const u32x2*)(cs + C_R + kc); zrp[jj] = *(const u32x2*)(ps + C_R + kc); zk[jj] = *(const u32x2*)(cs + C_K + kc); zkp[jj] = *(const u32x2*)(ps + C_K + kc); }
                const int sv = lane >> 2, cv = lane & 3; const bf16* cs = PROJ + (mb + t0 + sv) * LDP0; const bf16* ps = (t0 + sv == 0) ? cs : cs - LDP0;
                zv = *(const u32x4*)(cs + C_V + h * 64 + 32 * half + 8 * cv); zvp = *(const u32x4*)(ps + C_V + h * 64 + 32 * half + 8 * cv);
            }
            __syncthreads();
            const float pz_c = (t0 + c == 0) ? 0.f : 1.f;
            f32x4 accw[4], acca[4];
            {
                bf16x8 Aw[2], Aa[2];
#pragma unroll
                for (int ks = 0; ks < 2; ++ks) {
                    const f32x4 m0 = *(const f32x4*)(mu + C_WD + 32 * ks + 8 * g), m1 = *(const f32x4*)(mu + C_WD + 32 * ks + 8 * g + 4);
                    const f32x4 n0 = *(const f32x4*)(mu + C_AD + 32 * ks + 8 * g), n1 = *(const f32x4*)(mu + C_AD + 32 * ks + 8 * g + 4);
                    float xw[8], xa[8];
#pragma unroll
                    for (int e = 0; e < 4; ++e) {
                        const unsigned uw = zwd[ks][e], up = zwdp[ks][e], ua = zad[ks][e], uq = zadp[ks][e];
                        const float muw0 = (e < 2) ? m0[2 * e] : m1[2 * e - 4], muw1 = (e < 2) ? m0[2 * e + 1] : m1[2 * e - 3];
                        const float mua0 = (e < 2) ? n0[2 * e] : n1[2 * e - 4], mua1 = (e < 2) ? n0[2 * e + 1] : n1[2 * e - 3];
                        float z0 = bflo(uw), z1 = bfhi(uw);
                        z0 = z0 + (bflo(up) * pz_c - z0) * muw0; z1 = z1 + (bfhi(up) * pz_c - z1) * muw1;
                        xw[2 * e] = 1.f - 2.f / (1.f + __expf(2.f * z0)); xw[2 * e + 1] = 1.f - 2.f / (1.f + __expf(2.f * z1));
                        float y0 = bflo(ua), y1 = bfhi(ua);
                        xa[2 * e] = y0 + (bflo(uq) * pz_c - y0) * mua0; xa[2 * e + 1] = y1 + (bfhi(uq) * pz_c - y1) * mua1;
                    }
                    u32x4 w; w.x = pk2(xw[0], xw[1]); w.y = pk2(xw[2], xw[3]); w.z = pk2(xw[4], xw[5]); w.w = pk2(xw[6], xw[7]); Aw[ks] = __builtin_bit_cast(bf16x8, w);
                    u32x4 x; x.x = pk2(xa[0], xa[1]); x.y = pk2(xa[2], xa[3]); x.z = pk2(xa[4], xa[5]); x.w = pk2(xa[6], xa[7]); Aa[ks] = __builtin_bit_cast(bf16x8, x);
                }
#pragma unroll
                for (int nt = 0; nt < 4; ++nt) {
                    const bf16x8 wf0 = *(const bf16x8*)(W2T + (size_t)(kc + nt) * 64 + 8 * g), wf1 = *(const bf16x8*)(W2T + (size_t)(kc + nt) * 64 + 32 + 8 * g);
                    const bf16x8 af0 = *(const bf16x8*)(A2T + (size_t)(kc + nt) * 64 + 8 * g), af1 = *(const bf16x8*)(A2T + (size_t)(kc + nt) * 64 + 32 + 8 * g);
                    accw[nt] = __builtin_amdgcn_mfma_f32_16x16x32_bf16(Aw[0], wf0, (f32x4){0.f, 0.f, 0.f, 0.f}, 0, 0, 0);
                    accw[nt] = __builtin_amdgcn_mfma_f32_16x16x32_bf16(Aw[1], wf1, accw[nt], 0, 0, 0);
                    acca[nt] = __builtin_amdgcn_mfma_f32_16x16x32_bf16(Aa[0], af0, (f32x4){0.f, 0.f, 0.f, 0.f}, 0, 0, 0);
                    acca[nt] = __builtin_amdgcn_mfma_f32_16x16x32_bf16(Aa[1], af1, acca[nt], 0, 0, 0);
                }
            }
            __syncthreads();
            LAS float* ob = ops + (blk % 3) * SC_BUF;
#pragma unroll
            for (int jj = 0; jj < 4; ++jj) {
                if (jj == 2) __syncthreads();
                const int s = 4 * g + jj;
                const float pz = (t0 + s == 0) ? 0.f : 1.f;
                float rr[4], aa[4], ku[4];
                const unsigned ur[2] = {zr[jj].x, zr[jj].y}, urp[2] = {zrp[jj].x, zrp[jj].y}, uk[2] = {zk[jj].x, zk[jj].y}, ukp[2] = {zkp[jj].x, zkp[jj].y};
                f32x4 e_dec, e_b, e_kp, e_nk, e_wr;
                float ssq = 0.f;
#pragma unroll
                for (int nt = 0; nt < 4; ++nt) {
                    const float zc = (nt & 1) ? bfhi(ur[nt >> 1]) : bflo(ur[nt >> 1]), zp = ((nt & 1) ? bfhi(urp[nt >> 1]) : bflo(urp[nt >> 1])) * pz;
                    const float kc_ = (nt & 1) ? bfhi(uk[nt >> 1]) : bflo(uk[nt >> 1]), kp_ = ((nt & 1) ? bfhi(ukp[nt >> 1]) : bflo(ukp[nt >> 1])) * pz;
                    rr[nt] = zc + (zp - zc) * mu_r[nt];
                    const float kk = kc_ + (kp_ - kc_) * mu_k[nt];
                    const float sg = sigmoidf_(p_w0[nt] + accw[nt][jj]);
                    e_dec[nt] = __expf(-0.6065306597126334f * sg);
                    aa[nt] = sigmoidf_(p_a0[nt] + acca[nt][jj]);
                    ku[nt] = kk * p_kk[nt];
                    ssq += ku[nt] * ku[nt];
                    e_kp[nt] = kk * (1.f + (aa[nt] - 1.f) * p_ka[nt]);
                }
                ssq = sum16(ssq);
                const float rn = 1.f / sqrtf(fmaxf(ssq, 1e-12f));
                float br = 0.f, kr = 0.f, bs = 0.f;
#pragma unroll
                for (int nt = 0; nt < 4; ++nt) {
                    const float kn = ku[nt] * rn;
                    e_nk[nt] = -kn; e_b[nt] = kn * aa[nt]; e_wr[nt] = e_dec[nt] * rr[nt];
                    br += e_b[nt] * rr[nt]; kr += e_kp[nt] * rr[nt]; bs += rr[nt] * e_kp[nt] * p_rk[nt];
                }
                br = sum16(br); kr = sum16(kr); bs = sum16(bs);
                LAS float* o = ob + s * SC_STRIDE + 4 * c;
                *(LAS f32x4*)(o) = e_dec; *(LAS f32x4*)(o + 64) = e_b; *(LAS f32x4*)(o + 128) = e_kp; *(LAS f32x4*)(o + 192) = e_nk; *(LAS f32x4*)(o + 256) = e_wr;
                if (c == 0) { *(LAS f32x2*)(ob + s * SC_STRIDE + 352) = (f32x2){br, kr};
                    if (half == 0) ((float*)(ws + WS_BS))[(mb + t0 + s) * AH + h] = bs; }
            }
            {
                const int sv = lane >> 2, cv = lane & 3; const float pz = (t0 + sv == 0) ? 0.f : 1.f;
                const float* mv = mu + C_V + h * 64 + 32 * half + 8 * cv;
                const f32x4 m0 = *(const f32x4*)mv, m1 = *(const f32x4*)(mv + 4);
                f32x4 v0, v1;
                { float z; z = bflo(zv.x); v0.x = z + (bflo(zvp.x) * pz - z) * m0.x; z = bfhi(zv.x); v0.y = z + (bfhi(zvp.x) * pz - z) * m0.y;
                  z = bflo(zv.y); v0.z = z + (bflo(zvp.y) * pz - z) * m0.z; z = bfhi(zv.y); v0.w = z + (bfhi(zvp.y) * pz - z) * m0.w;
                  z = bflo(zv.z); v1.x = z + (bflo(zvp.z) * pz - z) * m1.x; z = bfhi(zv.z); v1.y = z + (bfhi(zvp.z) * pz - z) * m1.y;
                  z = bflo(zv.w); v1.z = z + (bflo(zvp.w) * pz - z) * m1.z; z = bfhi(zv.w); v1.w = z + (bfhi(zvp.w) * pz - z) * m1.w; }
                *(LAS f32x4*)(ob + sv * SC_STRIDE + 320 + 8 * cv) = v0; *(LAS f32x4*)(ob + sv * SC_STRIDE + 324 + 8 * cv) = v1;
            }
            __syncthreads();
        }
        for (int q = 0; q < 4 - pw; ++q) __syncthreads();
    }
}

__device__ __forceinline__ void phase_scan(const Args& a, LAS unsigned char* lds) {
    const int G = gridDim.x, bx = blockIdx.x;
    if (bx < 192) { scan_unit(a, lds, bx / 24, (bx % 24) >> 1, bx & 1); }
    else { for (int u = bx - 192; u < 512; u += G - 192) mem_attn_unit(a, lds, 0, u); }
}

__device__ __forceinline__ void phase_rwkv_post(const Args& a) {
    const int tid = threadIdx.x, lane = tid & 63, wave = tid >> 6, G = gridDim.x;
    unsigned char* ws = a.ws;
    const bf16* PROJ = (const bf16*)(ws + WS_PROJ); bf16* CAT = (bf16*)(ws + WS_CAT); const float* BS = (const float*)(ws + WS_BS);
    const float* mu = a.in[I_AMU];
    for (int m = blockIdx.x * 8 + wave; m < MTOK; m += G * 8) {
        const int t = m & (SEQ - 1);
        const bf16* pc = PROJ + (size_t)m * LDP0; const bf16* pp = (t == 0) ? pc : pc - LDP0; const float pz = (t == 0) ? 0.f : 1.f;
#pragma unroll
        for (int i = 0; i < 3; ++i) {
            const int col = 256 * i + 4 * lane, hh = col >> 6;
            const u32x2 yv = *(const u32x2*)(CAT + (size_t)m * DM + col);
            float y[4] = {bflo(yv.x), bfhi(yv.x), bflo(yv.y), bfhi(yv.y)};
            const float mean = sum16((y[0] + y[1]) + (y[2] + y[3])) * (1.f / 64.f);
            float d[4], vs = 0.f;
#pragma unroll
            for (int j = 0; j < 4; ++j) { d[j] = y[j] - mean; vs += d[j] * d[j]; }
            const float rstd = 1.f / sqrtf(sum16(vs) * (1.f / 64.f) + LNX_EPS);
            const f32x4 lw = *(const f32x4*)(a.in[I_ALNW] + col), lb = *(const f32x4*)(a.in[I_ALNB] + col), mv = *(const f32x4*)(mu + C_V + col);
            const u32x2 vc = *(const u32x2*)(pc + C_V + col), vp = *(const u32x2*)(pp + C_V + col), gt = *(const u32x2*)(pc + C_GATE0 + col);
            const float vcur[4] = {bflo(vc.x), bfhi(vc.x), bflo(vc.y), bfhi(vc.y)}, vprv[4] = {bflo(vp.x) * pz, bfhi(vp.x) * pz, bflo(vp.y) * pz, bfhi(vp.y) * pz};
            const float gg[4] = {bflo(gt.x), bfhi(gt.x), bflo(gt.y), bfhi(gt.y)};
            const float bs = BS[(size_t)m * AH + hh];
            float o[4];
#pragma unroll
            for (int j = 0; j < 4; ++j) { const float v = vcur[j] + (vprv[j] - vcur[j]) * mv[j];
                o[j] = (d[j] * rstd * lw[j] + lb[j] + bs * v) * siluf_(gg[j]); }
            u32x2 w; w.x = pk2(o[0], o[1]); w.y = pk2(o[2], o[3]);
            *(u32x2*)(CAT + (size_t)m * DM + col) = w;
        }
    }
}

template <int LAYER>
__device__ __forceinline__ void phase_rows(const Args& a) {
    const int tid = threadIdx.x, lane = tid & 63, wave = tid >> 6, G = gridDim.x;
    unsigned char* ws = a.ws;
    const float* Y = (const float*)(ws + WS_Y); const float* gpost = a.in[I_POST] + LAYER * DM;
    const float* xin = LAYER ? (const float*)a.out : a.in[I_X];
    bf16* XN = (bf16*)(ws + WS_XN);
    for (int m = blockIdx.x * 8 + wave; m < MTOK; m += G * 8) {
        const f32x4* yr = (const f32x4*)(Y + (size_t)m * DM) + lane; const f32x4* xr = (const f32x4*)(xin + (size_t)m * DM) + lane;
        f32x4 y[4], x[4]; float s = 0.f;
#pragma unroll
        for (int j = 0; j < 4; ++j) { y[j] = yr[64 * j]; x[j] = xr[64 * j]; s += (y[j].x * y[j].x + y[j].y * y[j].y) + (y[j].z * y[j].z + y[j].w * y[j].w); }
        const float rs = 1.f / sqrtf(wave_sum(s) * (1.f / DM) + NORM_EPS);
        float s1 = 0.f;
        f32x4* orow = (f32x4*)(a.out + (size_t)m * DM) + lane;
#pragma unroll
        for (int j = 0; j < 4; ++j) { const f32x4 gp = *((const f32x4*)gpost + lane + 64 * j);
            x[j] = x[j] + y[j] * rs * gp; orow[64 * j] = x[j];
            s1 += (x[j].x * x[j].x + x[j].y * x[j].y) + (x[j].z * x[j].z + x[j].w * x[j].w); }
        if (LAYER == 0) {
            const float r1 = 1.f / sqrtf(wave_sum(s1) * (1.f / DM) + NORM_EPS);
            unsigned long long* o8 = (unsigned long long*)(XN + (size_t)m * DM) + lane;
#pragma unroll
            for (int j = 0; j < 4; ++j) o8[64 * j] = (unsigned long long)pk2(x[j].x * r1, x[j].y * r1) | ((unsigned long long)pk2(x[j].z * r1, x[j].w * r1) << 32);
        }
    }
}

__device__ __forceinline__ void phase_attn1(const Args& a, LAS unsigned char* lds) {
    const int G = gridDim.x, bx = blockIdx.x, lane = threadIdx.x & 63;
    unsigned char* ws = a.ws;
    const float s1 = wave_sum(a.in[I_LQ1][lane] * a.in[I_LK1][lane]), s2 = wave_sum(a.in[I_LQ2][lane] * a.in[I_LK2][lane]);
    const float lam_init = 0.8f - 0.6f * 0.7408182206817179f;
    const float lam = __expf(s1) - __expf(s2) + lam_init;
    const bf16* PROJ = (const bf16*)(ws + WS_PROJ); const bf16* VT = (const bf16*)(ws + WS_VT); bf16* CAT = (bf16*)(ws + WS_CAT);
    const float slopes[6] = {0.25f, 0.0625f, 0.015625f, 0.00390625f, 0.5f, 0.125f};
    for (int i = 0;; ++i) {
        const int n = (i & 1) ? (i * G + (G - 1 - bx)) : (i * G + bx);
        if (i * G >= 768) break;
        if (n >= 768) continue;
        const int qb = 15 - n / 48, bh = n % 48, b = bh / 6, h = bh % 6;
        const size_t row0 = (size_t)b * SEQ + qb * 128;
        float slope = slopes[0];
#pragma unroll
        for (int k = 1; k < 6; ++k) slope = (h == k) ? slopes[k] : slope;
        attn_unit<2>(lds, PROJ + row0 * LDP1 + C_Q1 + h * 128, LDP1,
                     PROJ + (size_t)b * SEQ * LDP1 + C_KSH + h * 128, LDP1,
                     VT + (size_t)(h * 128) * MTOK + (size_t)b * SEQ, MTOK,
                     2 * qb + 1, 2 * qb + 2, slope * LOG2E, qb * 128,
                     PROJ + row0 * LDP1 + C_GATE1 + h * 128, LDP1, CAT + row0 * DM + h * 128, DM, a.in[I_SUBLN], lam, 1.f - lam_init);
    }
    for (int u = bx; u < 512; u += G) mem_attn_unit(a, lds, 1, u);
}

constexpr int N_PHASES = 10;
__global__ void __launch_bounds__(512, 2) yoco_fwd(Args args) {
    extern __shared__ __attribute__((aligned(16))) unsigned char lds_raw[];
    LAS unsigned char* lds = (LAS unsigned char*)lds_raw;
    const int lo = args.ph_lo, hi = args.ph_hi;
#define IN(k) (lo <= (k) && (k) < hi)
#define SEAM(k) do { if (IN(k) && IN((k) + 1)) { __syncthreads(); cg::this_grid().sync(); } } while (0)
    if (IN(0)) phase_prologue(args, lds);
    SEAM(0);
    if (IN(1)) phase_gemm(args, lds, 0, 3);
    SEAM(1);
    if (IN(2)) phase_scan(args, lds);
    SEAM(2);
    if (IN(3)) phase_rwkv_post(args);
    SEAM(3);
    if (IN(4)) phase_gemm(args, lds, 3, 1);
    SEAM(4);
    if (IN(5)) phase_rows<0>(args);
    SEAM(5);
    if (IN(6)) phase_gemm(args, lds, 4, 2);
    SEAM(6);
    if (IN(7)) phase_attn1(args, lds);
    SEAM(7);
    if (IN(8)) phase_gemm(args, lds, 6, 1);
    SEAM(8);
    if (IN(9)) phase_rows<1>(args);
#undef IN
#undef SEAM
}

extern "C" void kernel_launch(void* const* d_in, const int* in_sizes, int n_in, void* d_out, int out_size, void* d_ws, size_t ws_size, hipStream_t stream) {
    static int ready = 0;
    if (ready == 0) {
        if (n_in != 26 || out_size != MTOK * DM || ws_size < WS_END) { fprintf(stderr, "kernel_launch: unexpected problem shape (n_in %d out %d ws %zu)\n", n_in, out_size, ws_size); ready = -1; return; }
        if (hipFuncSetAttribute((const void*)yoco_fwd, hipFuncAttributeMaxDynamicSharedMemorySize, LDS_BYTES) != hipSuccess) { fprintf(stderr, "kernel_launch: hipFuncSetAttribute failed\n"); ready = -1; return; }
        int per_cu = 0;
        if (hipOccupancyMaxActiveBlocksPerMultiprocessor(&per_cu, (const void*)yoco_fwd, 512, LDS_BYTES) != hipSuccess || per_cu < 1) fprintf(stderr, "kernel_launch: occupancy query says %d\n", per_cu);
        (void)hipGetLastError();
        ready = 1;
    }
    if (ready < 0) return;
    Args a{};
    for (int i = 0; i < 26; ++i) a.in[i] = (const float*)d_in[i];
    a.out = (float*)d_out; a.ws = (unsigned char*)d_ws;
#if MK_COOP
    a.ph_lo = 0; a.ph_hi = N_PHASES;
    void* params[] = {&a};
    hipError_t e = hipLaunchCooperativeKernel((const void*)yoco_fwd, dim3(256), dim3(512), params, LDS_BYTES, stream);
    if (e != hipSuccess) fprintf(stderr, "kernel_launch: cooperative launch failed: %s\n", hipGetErrorString(e));
#else
    for (int ph = 0; ph < N_PHASES; ++ph) { a.ph_lo = ph; a.ph_hi = ph + 1; hipLaunchKernelGGL(yoco_fwd, dim3(256), dim3(512), LDS_BYTES, stream, a); }
#endif
}
```

```cpp
#include <hip/hip_runtime.h>
#include <hip/hip_cooperative_groups.h>
#include <cstdio>
#include <cstdint>
namespace cg = cooperative_groups;

#ifndef PROBE_DUP
#define PROBE_DUP -1
#endif
#ifndef MK_COOP
#define MK_COOP 1
#endif

#define LAS __attribute__((address_space(3)))
typedef unsigned short bf16;
typedef short bf16x8 __attribute__((ext_vector_type(8)));
typedef float f32x4 __attribute__((ext_vector_type(4)));
typedef float f32x2 __attribute__((ext_vector_type(2)));
typedef unsigned u32x4 __attribute__((ext_vector_type(4)));
typedef unsigned u32x2 __attribute__((ext_vector_type(2)));

constexpr int DM = 1024, NBATCH = 8, SEQ = 2048, MTOK = NBATCH * SEQ;
constexpr int MEML = 256, MROWS = NBATCH * MEML;
constexpr int BRW = 768, AH = 12, BH = 6;
constexpr int LDP0 = 3840;
constexpr int LDP1 = 2816;
constexpr int C_R = 0, C_K = 768, C_V = 1536, C_WD = 2304, C_AD = 2368, C_GATE0 = 2432, C_QM0 = 3200, C_GM0 = 3456;
constexpr int C_Q1 = 0, C_GATE1 = 768, C_QM1 = 1536, C_GM1 = 1792, C_KSH = 2048;
constexpr float NORM_EPS = 1e-6f, LNX_EPS = 64e-5f;
constexpr float LOG2E = 1.4426950408889634f;

constexpr size_t MiB = 1u << 20;
constexpr size_t WS_WA = 1 * MiB;
constexpr size_t WS_WB = 9 * MiB;
constexpr size_t WS_WO = 16 * MiB;
constexpr size_t WS_WM = 20 * MiB;
constexpr size_t WS_MEMN = 22 * MiB;
constexpr size_t WS_MK = 26 * MiB;
constexpr size_t WS_MVT = 28 * MiB;
constexpr size_t WS_XN = 30 * MiB;
constexpr size_t WS_CAT = 62 * MiB;
constexpr size_t WS_VT = 94 * MiB;
constexpr size_t WS_PROJ = 118 * MiB;
constexpr size_t WS_Y = 118 * MiB;
constexpr size_t WS_W2T = 0 * MiB + 65536;
constexpr size_t WS_BS = 238 * MiB;
constexpr size_t WS_END = 240 * MiB;

__device__ __forceinline__ unsigned f2bf(float f) { unsigned u = __builtin_bit_cast(unsigned, f); return (u + 0x7fffu + ((u >> 16) & 1u)) >> 16; }
typedef __bf16 bf16x2_t __attribute__((ext_vector_type(2)));
__device__ __forceinline__ unsigned pk2(float lo, float hi) { f32x2 v = {lo, hi}; bf16x2_t b = __builtin_convertvector(v, bf16x2_t); return __builtin_bit_cast(unsigned, b); }
__device__ __forceinline__ float bflo(unsigned u) { return __builtin_bit_cast(float, u << 16); }
__device__ __forceinline__ float bfhi(unsigned u) { return __builtin_bit_cast(float, u & 0xffff0000u); }
__device__ __forceinline__ float wave_sum(float v) {
#pragma unroll
    for (int o = 1; o < 64; o <<= 1) v += __shfl_xor(v, o);
    return v;
}
template <int CTRL> __device__ __forceinline__ float dppf(float x) { return __builtin_bit_cast(float, __builtin_amdgcn_update_dpp(0, __builtin_bit_cast(int, x), CTRL, 0xf, 0xf, false)); }
__device__ __forceinline__ float sum8(float x) { x += dppf<0xB1>(x); x += dppf<0x4E>(x); x += dppf<0x141>(x); return x; }
__device__ __forceinline__ float sum16(float x) { x += dppf<0xB1>(x); x += dppf<0x4E>(x); x += dppf<0x141>(x); x += dppf<0x140>(x); return x; }
__device__ __forceinline__ float sigmoidf_(float x) { return __builtin_amdgcn_rcpf(1.f + __builtin_amdgcn_exp2f(-1.4426950408889634f * x)); }
__device__ __forceinline__ float siluf_(float x) { return x * __builtin_amdgcn_rcpf(1.f + __builtin_amdgcn_exp2f(-1.4426950408889634f * x)); }

namespace pg8 {
constexpr int BM = 256, BK = 64, HALF = 128, HTB = HALF * BK * 2, STAGE_BYTES = 8 * HTB, NXCD = 8, WGM = 8;
__device__ __forceinline__ int lds_byte(int r, int c) { const int st = (r >> 4) * 2 + (c >> 5), rr = r & 15, cc = c & 31, ob = rr * 64 + cc * 2; return st * 1024 + (ob ^ (((ob >> 9) & 1) << 5)); }
__device__ __forceinline__ void stage_rc(int b, int& R, int& C) { const int st = b / 1024, sb = b % 1024, swz = sb ^ (((sb >> 9) & 1) << 5); R = (st >> 1) * 16 + swz / 64; C = (st & 1) * 32 + (swz % 64) / 2; }
__device__ __forceinline__ int perm32(int rho) { const int n = rho >> 4, i = rho & 15; return 8 * (i >> 2) + 4 * n + (i & 3); }
struct Unit { int pm, pn; };
struct Gemm { const bf16* A; const bf16* Bt; int M, N, K; };
struct StaticOrder {
    int nM, nN, nwg, G, c;
    __device__ void init(int M, int N, int G_, int c_) { nM = M / BM; nN = N / BM; nwg = nM * nN; G = G_; c = c_; }
    __device__ bool next(int i, Unit& u) const {
        const long L = (long)i * G + c; if (L >= nwg) return false;
        int wgid = (int)L; { const int q = nwg / NXCD, r = nwg % NXCD, xcd = wgid % NXCD, off = wgid / NXCD; wgid = (xcd < r ? xcd * (q + 1) : r * (q + 1) + (xcd - r) * q) + off; }
        const int nig = WGM * nN, gid = wgid / nig, fm = gid * WGM, gsz = (nM - fm) < WGM ? (nM - fm) : WGM;
        u.pm = fm + ((wgid % nig) % gsz); u.pn = (wgid % nig) / gsz; return true;
    }
};
__device__ __forceinline__ unsigned cvt_pk_bf16(float lo, float hi) { unsigned r; asm volatile("v_cvt_pk_bf16_f32 %0, %1, %2" : "=v"(r) : "v"(lo), "v"(hi)); return r; }

struct EpiStore {
    void* O; int ldc; int f32out;
    __device__ __forceinline__ void operator()(const f32x4 (&acc)[2][2][4][2], const Unit& u, int wr, int wc, int fr, int fq) const {
        const int row0 = u.pm * BM + wr * 64 + fr, col0 = u.pn * BM + wc * 32 + 8 * fq;
        if (f32out) {
#pragma unroll
            for (int ai = 0; ai < 2; ++ai)
#pragma unroll
                for (int m = 0; m < 4; ++m) { float* rowp = (float*)O + (size_t)(row0 + ai * HALF + m * 16) * ldc + col0;
#pragma unroll
                    for (int bj = 0; bj < 2; ++bj) { *(f32x4*)(rowp + bj * HALF) = acc[ai][bj][m][0]; *(f32x4*)(rowp + bj * HALF + 4) = acc[ai][bj][m][1]; } }
        } else {
#pragma unroll
            for (int ai = 0; ai < 2; ++ai)
#pragma unroll
                for (int m = 0; m < 4; ++m) { bf16* rowp = (bf16*)O + (size_t)(row0 + ai * HALF + m * 16) * ldc + col0;
#pragma unroll
                    for (int bj = 0; bj < 2; ++bj) { const f32x4 v0 = acc[ai][bj][m][0], v1 = acc[ai][bj][m][1];
                        u32x4 w; w.x = cvt_pk_bf16(v0[0], v0[1]); w.y = cvt_pk_bf16(v0[2], v0[3]); w.z = cvt_pk_bf16(v1[0], v1[1]); w.w = cvt_pk_bf16(v1[2], v1[3]);
                        *(u32x4*)(rowp + bj * HALF) = w; } }
        }
    }
};

template <class Epi, class Sched>
__device__ __forceinline__ void gemm_phase(LAS unsigned char* lds, const Gemm g, const Sched& S, const Epi& E) {
    const int tid = threadIdx.x, wid = __builtin_amdgcn_readfirstlane(tid >> 6), lane = tid & 63, wr = wid >> 2, wc = wid & 3, fr = lane & 15, fq = lane >> 4;
    const int K = g.K, nt = K / BK;
    unsigned voffA[2], voffB[2];
#pragma unroll
    for (int i = 0; i < 2; ++i) { int R, C; stage_rc(tid * 16 + i * 8192, R, C); const int Rb = (R & ~31) + perm32(R & 31);
        voffA[i] = (unsigned)(R * K + C) * 2u; voffB[i] = (unsigned)(Rb * K + C) * 2u; }
    const size_t kstep = (size_t)(BK * 2);
    const size_t hstep = (size_t)HALF * K * 2;
    const size_t tstep = 2 * hstep;
    const unsigned ldsw = (unsigned)wid * 1024u;
    const int aoff = lds_byte(wr * 64 + fr, fq * 8), boff = lds_byte(wc * 32 + fr, fq * 8);
#define PG8_SA(b, h) (((b) * 2 + (h)) * HTB)
#define PG8_SB(b, h) ((4 + (b) * 2 + (h)) * HTB)
#define PG8_STAGE(bufoff, gbase, voff) do { _Pragma("unroll") for (int _i = 0; _i < 2; ++_i) \
        __builtin_amdgcn_global_load_lds((const unsigned*)((const char*)(gbase) + (voff)[_i]), (LAS unsigned*)(lds + (bufoff) + ldsw + _i * 8192), 16, 0, 0); } while (0)
#define PG8_LDA(dst, b, h) do { _Pragma("unroll") for (int m = 0; m < 4; ++m) _Pragma("unroll") for (int k = 0; k < 2; ++k) dst[m][k] = *(const LAS bf16x8*)(lds + PG8_SA(b, h) + aoff + m * 2048 + k * 1024); } while (0)
#define PG8_LDB(dst, b, h) do { _Pragma("unroll") for (int n = 0; n < 2; ++n) _Pragma("unroll") for (int k = 0; k < 2; ++k) dst[n][k] = *(const LAS bf16x8*)(lds + PG8_SB(b, h) + boff + n * 2048 + k * 1024); } while (0)
#define PG8_MMA(ai, bj, At, Bt) do { __builtin_amdgcn_s_setprio(1); _Pragma("unroll") for (int m = 0; m < 4; ++m) _Pragma("unroll") for (int n = 0; n < 2; ++n) _Pragma("unroll") for (int k = 0; k < 2; ++k) \
        acc[ai][bj][m][n] = __builtin_amdgcn_mfma_f32_16x16x32_bf16(Bt[n][k], At[m][k], acc[ai][bj][m][n], 0, 0, 0); __builtin_amdgcn_s_setprio(0); } while (0)
#define PG8_WAIT_V(n) asm volatile("s_waitcnt vmcnt(" #n ")" ::: "memory")
#define PG8_WAIT_L(n) asm volatile("s_waitcnt lgkmcnt(" #n ")" ::: "memory")
#define PG8_BAR __builtin_amdgcn_s_barrier()
#define PG8_SCHED __builtin_amdgcn_sched_barrier(0)
    Unit cur, nxt; int ui = 0;
    if (!S.next(0, cur)) return;
    f32x4 acc[2][2][4][2];
#pragma unroll
    for (int a = 0; a < 2; ++a)
#pragma unroll
        for (int b = 0; b < 2; ++b)
#pragma unroll
            for (int m = 0; m < 4; ++m)
#pragma unroll
                for (int n = 0; n < 2; ++n) acc[a][b][m][n] = (f32x4){0.f, 0.f, 0.f, 0.f};
    bf16x8 At[4][2], B0[2][2], B1[2][2];
    const char* cA = (const char*)g.A + (size_t)cur.pm * tstep; const char* cB = (const char*)g.Bt + (size_t)cur.pn * tstep;
    PG8_STAGE(PG8_SB(0, 0), cB, voffB); PG8_STAGE(PG8_SB(0, 1), cB + hstep, voffB); PG8_STAGE(PG8_SA(0, 0), cA, voffA); PG8_STAGE(PG8_SA(0, 1), cA + hstep, voffA);
    if (wr == 1) PG8_BAR;
    PG8_WAIT_V(2); PG8_BAR;
    PG8_STAGE(PG8_SB(1, 0), cB + kstep, voffB); PG8_STAGE(PG8_SA(1, 0), cA + kstep, voffA); PG8_STAGE(PG8_SB(1, 1), cB + hstep + kstep, voffB);
    PG8_WAIT_V(6); PG8_BAR;
    for (;;) {
        const bool has_next = S.next(ui + 1, nxt);
        const char* nA = has_next ? (const char*)g.A + (size_t)nxt.pm * tstep : cA; const char* nB = has_next ? (const char*)g.Bt + (size_t)nxt.pn * tstep : cB;
        for (int t = 0; t < nt; t += 2) {
            const bool last = (t == nt - 2);
            const char* a1 = cA + (size_t)(t + 1) * kstep;
            const char* a2 = last ? nA : cA + (size_t)(t + 2) * kstep; const char* b2 = last ? nB : cB + (size_t)(t + 2) * kstep;
            const char* a3 = a2 + kstep; const char* b3 = b2 + kstep;
            PG8_LDB(B0, 0, 0); PG8_LDB(B1, 0, 1); PG8_SCHED; PG8_LDA(At, 0, 0); PG8_STAGE(PG8_SA(1, 1), a1 + hstep, voffA);
            PG8_WAIT_V(8); PG8_WAIT_L(0); PG8_BAR; PG8_MMA(0, 0, At, B0); PG8_MMA(0, 1, At, B1); PG8_BAR; PG8_SCHED;
            PG8_LDA(At, 0, 1); PG8_STAGE(PG8_SB(0, 0), b2, voffB); PG8_STAGE(PG8_SB(0, 1), b2 + hstep, voffB); PG8_STAGE(PG8_SA(0, 0), a2, voffA);
            PG8_WAIT_V(8); PG8_WAIT_L(0); PG8_BAR; PG8_MMA(1, 0, At, B0); PG8_MMA(1, 1, At, B1); PG8_BAR; PG8_SCHED;
            PG8_LDB(B0, 1, 0); PG8_LDB(B1, 1, 1); PG8_SCHED; PG8_LDA(At, 1, 0); PG8_STAGE(PG8_SA(0, 1), a2 + hstep, voffA);
            PG8_WAIT_V(8); PG8_WAIT_L(0); PG8_BAR; PG8_MMA(0, 0, At, B0); PG8_MMA(0, 1, At, B1); PG8_BAR; PG8_SCHED;
            PG8_LDA(At, 1, 1); PG8_STAGE(PG8_SB(1, 0), b3, voffB); PG8_STAGE(PG8_SB(1, 1), b3 + hstep, voffB); PG8_STAGE(PG8_SA(1, 0), a3, voffA);
            PG8_WAIT_V(8); PG8_WAIT_L(0); PG8_BAR; PG8_MMA(1, 0, At, B0); PG8_MMA(1, 1, At, B1); PG8_BAR; PG8_SCHED;
        }
        if (wr == 0) PG8_BAR;
        E(acc, cur, wr, wc, fr, fq);
        if (!has_next) break;
#pragma unroll
        for (int a = 0; a < 2; ++a)
#pragma unroll
            for (int b = 0; b < 2; ++b)
#pragma unroll
                for (int m = 0; m < 4; ++m)
#pragma unroll
                    for (int n = 0; n < 2; ++n) acc[a][b][m][n] = (f32x4){0.f, 0.f, 0.f, 0.f};
        cur = nxt; cA = nA; cB = nB; ++ui;
        if (wr == 1) PG8_BAR;
    }
    PG8_WAIT_V(0);
    PG8_BAR;
#undef PG8_SA
#undef PG8_SB
#undef PG8_STAGE
#undef PG8_LDA
#undef PG8_LDB
#undef PG8_MMA
#undef PG8_WAIT_V
#undef PG8_WAIT_L
#undef PG8_BAR
#undef PG8_SCHED
}
}

struct Args { const float* in[26]; float* out; unsigned char* ws; int ph_lo, ph_hi; };
enum { I_X = 0, I_MEM, I_PRE, I_POST, I_WOUT, I_MEMNORM, I_WMEMKV, I_AWIN, I_AMU, I_AW0, I_AW2, I_AA0, I_AA2, I_AKK, I_AKA, I_ARK, I_ALNW, I_ALNB,
       I_KVNORM, I_WKV, I_BWIN, I_LQ1, I_LK1, I_LQ2, I_LK2, I_SUBLN };

constexpr int LDS_BYTES = 147456;

__device__ __forceinline__ void p0_transpose_item(const float* W, int ldw, int c0, int nc, const float* gain, bf16* WT, int row0, LAS float* scr, int item, int lane, int ldo = 1024) {
    const int nblk = nc / 32, kb = item / nblk, nb = item % nblk, k0 = 64 * kb, n0 = 32 * nb;
#pragma unroll 8
    for (int i = 0; i < 32; ++i) { const int kk = 2 * i + (lane >> 5);
        float v = W[(size_t)(k0 + kk) * ldw + c0 + n0 + (lane & 31)]; if (gain) v *= gain[k0 + kk];
        scr[kk * 33 + (lane & 31)] = v; }
    asm volatile("s_waitcnt lgkmcnt(0)" ::: "memory");
    const int c = lane & 7;
#pragma unroll
    for (int j = 0; j < 4; ++j) { const int n = (lane >> 3) + 8 * j; const LAS float* s = scr + (8 * c) * 33 + n;
        u32x4 o; o.x = pk2(s[0 * 33], s[1 * 33]); o.y = pk2(s[2 * 33], s[3 * 33]); o.z = pk2(s[4 * 33], s[5 * 33]); o.w = pk2(s[6 * 33], s[7 * 33]);
        *(u32x4*)(WT + (size_t)(row0 + n0 + n) * ldo + k0 + 8 * c) = o; }
    asm volatile("s_waitcnt lgkmcnt(0)" ::: "memory");
}
__device__ __forceinline__ void rms_row_to_bf16(const float* xrow, bf16* orow, int lane) {
    const f32x4* xr = (const f32x4*)xrow + lane;
    f32x4 v[4]; float s = 0.f;
#pragma unroll
    for (int j = 0; j < 4; ++j) { v[j] = xr[64 * j]; s += (v[j].x * v[j].x + v[j].y * v[j].y) + (v[j].z * v[j].z + v[j].w * v[j].w); }
    const float rs = 1.f / sqrtf(wave_sum(s) * (1.f / DM) + NORM_EPS);
    unsigned long long* o8 = (unsigned long long*)orow + lane;
#pragma unroll
    for (int j = 0; j < 4; ++j) o8[64 * j] = (unsigned long long)pk2(v[j].x * rs, v[j].y * rs) | ((unsigned long long)pk2(v[j].z * rs, v[j].w * rs) << 32);
}
template <int GROUP>
__device__ __forceinline__ void transpose_group(const Args& a, LAS unsigned char* lds, int gw, int NGW) {
    const int lane = threadIdx.x & 63, wave = __builtin_amdgcn_readfirstlane(threadIdx.x >> 6);
    unsigned char* ws = a.ws;
    LAS float* scr = (LAS float*)(lds + wave * 16384);
    bf16* WA = (bf16*)(ws + WS_WA); bf16* WB = (bf16*)(ws + WS_WB); bf16* WO = (bf16*)(ws + WS_WO); bf16* WM = (bf16*)(ws + WS_WM);
    constexpr int I0 = 16 * (3712 / 32), I1 = 16 * (2048 / 32), I2 = 16 * (1536 / 32), I3 = 16 * (1024 / 32), I5 = 16 * (256 / 32), I6 = 768 / 32;
    bf16* W2T = (bf16*)(ws + WS_W2T); bf16* A2T = W2T + 768 * 64;
    if (GROUP == 0) {
        constexpr int NITEMS = I0 + 4 * I5 + 2 * I6;
        for (int it = gw; it < NITEMS; it += NGW) {
            int r = it;
            if (r < I0) { p0_transpose_item(a.in[I_AWIN], 3712, 0, 3712, a.in[I_PRE], WA, 0, scr, r, lane); continue; } r -= I0;
            if (r < I5) { p0_transpose_item(a.in[I_WMEMKV], 512, 0, 256, a.in[I_MEMNORM], WM, 0, scr, r, lane); continue; } r -= I5;
            if (r < I5) { p0_transpose_item(a.in[I_WMEMKV], 512, 256, 256, a.in[I_MEMNORM], WM, 512, scr, r, lane); continue; } r -= I5;
            if (r < I5) { p0_transpose_item(a.in[I_WMEMKV] + 1024 * 512, 512, 0, 256, a.in[I_MEMNORM] + 1024, WM, 256, scr, r, lane); continue; } r -= I5;
            if (r < I5) { p0_transpose_item(a.in[I_WMEMKV] + 1024 * 512, 512, 256, 256, a.in[I_MEMNORM] + 1024, WM, 768, scr, r, lane); continue; } r -= I5;
            if (r < I6) { p0_transpose_item(a.in[I_AW2], 768, 0, 768, nullptr, W2T, 0, scr, r, lane, 64); continue; } r -= I6;
            p0_transpose_item(a.in[I_AA2], 768, 0, 768, nullptr, A2T, 0, scr, r, lane, 64);
        }
    } else {
        constexpr int NITEMS = I1 + I2 + 2 * I3;
        for (int it = gw; it < NITEMS; it += NGW) {
            int r = it;
            if (r < I1) { p0_transpose_item(a.in[I_BWIN], 2048, 0, 2048, a.in[I_PRE] + 1024, WB, 0, scr, r, lane); continue; } r -= I1;
            if (r < I2) { p0_transpose_item(a.in[I_WKV], 1536, 0, 1536, a.in[I_KVNORM], WB, 2048, scr, r, lane); continue; } r -= I2;
            if (r < I3) { p0_transpose_item(a.in[I_WOUT], 1024, 0, 1024, nullptr, WO, 0, scr, r, lane); continue; } r -= I3;
            p0_transpose_item(a.in[I_WOUT] + 1024 * 1024, 1024, 0, 1024, nullptr, WO + 1024 * 1024, 0, scr, r, lane);
        }
    }
}
__device__ __forceinline__ void phase_prologue(const Args& a, LAS unsigned char* lds) {
    const int tid = threadIdx.x, lane = tid & 63, wave = __builtin_amdgcn_readfirstlane(tid >> 6);
    const int G = gridDim.x, gw = blockIdx.x * 8 + wave, NGW = G * 8;
    unsigned char* ws = a.ws;
    bf16* WA = (bf16*)(ws + WS_WA);
    transpose_group<0>(a, lds, gw, NGW);
    { u32x4* z = (u32x4*)(WA + (size_t)3712 * 1024); const int nz = 128 * 1024 * 2 / 16;
      for (int i = blockIdx.x * 512 + tid; i < nz; i += G * 512) z[i] = (u32x4){0u, 0u, 0u, 0u}; }
    bf16* XN = (bf16*)(ws + WS_XN); bf16* MEMN = (bf16*)(ws + WS_MEMN);
    for (int m = gw; m < MTOK + MROWS; m += NGW) {
        if (m < MTOK) rms_row_to_bf16(a.in[I_X] + (size_t)m * DM, XN + (size_t)m * DM, lane);
        else rms_row_to_bf16(a.in[I_MEM] + (size_t)(m - MTOK) * DM, MEMN + (size_t)(m - MTOK) * DM, lane);
    }
}

__device__ __forceinline__ void run_gemm(LAS unsigned char* lds, const bf16* A, const bf16* Bt, int M, int N, void* O, int ldc, int f32out, int shift) {
    const int G = gridDim.x;
    pg8::Gemm g{A, Bt, M, N, 1024};
    pg8::StaticOrder S; S.init(M, N, G, (int)((blockIdx.x + G - shift) % G));
    pg8::EpiStore E{O, ldc, f32out};
    pg8::gemm_phase<pg8::EpiStore, pg8::StaticOrder>(lds, g, S, E);
}
__device__ __forceinline__ void phase_gemm(const Args& a, LAS unsigned char* lds, int first, int count) {
    unsigned char* ws = a.ws;
    for (int j = first; j < first + count; ++j) {
        const bf16* A; const bf16* Bt; int M, N, ldc, f32o, shift; void* O;
        switch (j) {
        case 0: A = (const bf16*)(ws + WS_XN); Bt = (const bf16*)(ws + WS_WA); M = MTOK; N = 3840; O = ws + WS_PROJ; ldc = LDP0; f32o = 0; shift = 0; break;
        case 1: A = (const bf16*)(ws + WS_MEMN); Bt = (const bf16*)(ws + WS_WM); M = MROWS; N = 512; O = ws + WS_MK; ldc = 512; f32o = 0; shift = 192; break;
        case 2: A = (const bf16*)(ws + WS_WM) + 512 * 1024; Bt = (const bf16*)(ws + WS_MEMN); M = 512; N = MROWS; O = ws + WS_MVT; ldc = MROWS; f32o = 0; shift = 208; break;
        case 3: A = (const bf16*)(ws + WS_CAT); Bt = (const bf16*)(ws + WS_WO); M = MTOK; N = 1024; O = ws + WS_Y; ldc = 1024; f32o = 1; shift = 0; break;
        case 4: A = (const bf16*)(ws + WS_XN); Bt = (const bf16*)(ws + WS_WB); M = MTOK; N = 2816; O = ws + WS_PROJ; ldc = LDP1; f32o = 0; shift = 0; break;
        case 5: A = (const bf16*)(ws + WS_WB) + 2816 * 1024; Bt = (const bf16*)(ws + WS_XN); M = 768; N = MTOK; O = ws + WS_VT; ldc = MTOK; f32o = 0; shift = 192; break;
        default: A = (const bf16*)(ws + WS_CAT); Bt = (const bf16*)(ws + WS_WO) + 1024 * 1024; M = MTOK; N = 1024; O = ws + WS_Y; ldc = 1024; f32o = 1; shift = 0; break;
        }
        run_gemm(lds, A, Bt, M, N, O, ldc, f32o, shift);
    }
}

constexpr int AT_PITCH = 72;
template <int NMAP>
__device__ __forceinline__ void attn_unit(LAS unsigned char* lds, const bf16* Qp, int ldq, const bf16* Kp, int ldk, const bf16* VTp, int ldvt,
                                          int nkt_lo, int nkt_hi, float slope2, int tq0,
                                          const bf16* Gp, int ldg, bf16* Op, int ldo, const float* subln, float lam, float oscale) {
    constexpr int EV = 64 * NMAP, NET = EV / 16;
    const int tid = threadIdx.x, lane = tid & 63, wave = __builtin_amdgcn_readfirstlane(tid >> 6), g = lane >> 4, c = lane & 15;
    LAS bf16* Ks = (LAS bf16*)lds;
    LAS bf16* Vs = (LAS bf16*)(lds + NMAP * 64 * AT_PITCH * 2);
    const int nkt = (wave < 4) ? nkt_lo : nkt_hi;
    const int qrow = 16 * wave + c;
    bf16x8 qf[NMAP][2];
#pragma unroll
    for (int mp = 0; mp < NMAP; ++mp)
#pragma unroll
        for (int ks = 0; ks < 2; ++ks) qf[mp][ks] = *(const bf16x8*)(Qp + (size_t)qrow * ldq + mp * 64 + 32 * ks + 8 * g);
    f32x4 o[NMAP][NET];
#pragma unroll
    for (int mp = 0; mp < NMAP; ++mp)
#pragma unroll
        for (int et = 0; et < NET; ++et) o[mp][et] = (f32x4){0.f, 0.f, 0.f, 0.f};
    float mrun[NMAP], lrun[NMAP];
#pragma unroll
    for (int mp = 0; mp < NMAP; ++mp) { mrun[mp] = -1e30f; lrun[mp] = 0.f; }
    const float sc2 = 0.125f * LOG2E;
    const float tq = (float)(tq0 + qrow);
    u32x4 kreg[NMAP], vreg[NMAP];
#define AT_LOAD(kt) do { _Pragma("unroll") for (int i = 0; i < NMAP; ++i) { const int id = tid + 512 * i; \
        { const int mp = id >> 9, n = (id >> 3) & 63, ch = id & 7; kreg[i] = *(const u32x4*)(Kp + (size_t)((kt) * 64 + n) * ldk + mp * 64 + 8 * ch); } \
        { const int e = id >> 3, ch = id & 7; vreg[i] = *(const u32x4*)(VTp + (size_t)e * ldvt + (kt) * 64 + 8 * ch); } } } while (0)
    AT_LOAD(0);
    for (int kt = 0; kt < nkt_hi; ++kt) {
        __syncthreads();
#pragma unroll
        for (int i = 0; i < NMAP; ++i) { const int id = tid + 512 * i;
            { const int mp = id >> 9, n = (id >> 3) & 63, ch = id & 7; *(LAS u32x4*)(Ks + (mp * 64 + n) * AT_PITCH + 8 * ch) = kreg[i]; }
            { const int e = id >> 3, ch = id & 7; *(LAS u32x4*)(Vs + e * AT_PITCH + 8 * ch) = vreg[i]; } }
        __syncthreads();
        if (kt + 1 < nkt_hi) AT_LOAD(kt + 1);
        if (kt < nkt) {
            bf16x8 pf[NMAP][2];
#pragma unroll
            for (int mp = 0; mp < NMAP; ++mp) {
                f32x4 st[4];
#pragma unroll
                for (int k16 = 0; k16 < 4; ++k16) {
                    st[k16] = (f32x4){0.f, 0.f, 0.f, 0.f};
#pragma unroll
                    for (int ks = 0; ks < 2; ++ks) { const bf16x8 ka = *(const LAS bf16x8*)(Ks + (mp * 64 + 16 * k16 + c) * AT_PITCH + 32 * ks + 8 * g);
                        st[k16] = __builtin_amdgcn_mfma_f32_16x16x32_bf16(ka, qf[mp][ks], st[k16], 0, 0, 0); }
                }
                float mx = -1e30f;
#pragma unroll
                for (int k16 = 0; k16 < 4; ++k16)
#pragma unroll
                    for (int j = 0; j < 4; ++j) { const float tk = (float)(kt * 64 + 16 * k16 + 4 * g + j);
                        const float x = st[k16][j] * sc2 - slope2 * fabsf(tq - tk); st[k16][j] = x; mx = fmaxf(mx, x); }
                mx = fmaxf(mx, __shfl_xor(mx, 16)); mx = fmaxf(mx, __shfl_xor(mx, 32));
                const float mnew = fmaxf(mrun[mp], mx), alpha = __builtin_amdgcn_exp2f(mrun[mp] - mnew);
                mrun[mp] = mnew;
                float ps = 0.f;
#pragma unroll
                for (int k16 = 0; k16 < 4; ++k16)
#pragma unroll
                    for (int j = 0; j < 4; ++j) { const float p = __builtin_amdgcn_exp2f(st[k16][j] - mnew); st[k16][j] = p; ps += p; }
                lrun[mp] = lrun[mp] * alpha + ps;
#pragma unroll
                for (int et = 0; et < NET; ++et) o[mp][et] = o[mp][et] * alpha;
#pragma unroll
                for (int i = 0; i < 2; ++i) { u32x4 w; w.x = pk2(st[2 * i][0], st[2 * i][1]); w.y = pk2(st[2 * i][2], st[2 * i][3]); w.z = pk2(st[2 * i + 1][0], st[2 * i + 1][1]); w.w = pk2(st[2 * i + 1][2], st[2 * i + 1][3]);
                    pf[mp][i] = __builtin_bit_cast(bf16x8, w); }
            }
#pragma unroll
            for (int et = 0; et < NET; ++et)
#pragma unroll
                for (int i = 0; i < 2; ++i) {
                    const u32x2 lo = *(const LAS u32x2*)(Vs + (16 * et + c) * AT_PITCH + 32 * i + 4 * g);
                    const u32x2 hi = *(const LAS u32x2*)(Vs + (16 * et + c) * AT_PITCH + 32 * i + 16 + 4 * g);
                    const bf16x8 va = __builtin_bit_cast(bf16x8, (u32x4){lo.x, lo.y, hi.x, hi.y});
#pragma unroll
                    for (int mp = 0; mp < NMAP; ++mp) o[mp][et] = __builtin_amdgcn_mfma_f32_16x16x32_bf16(va, pf[mp][i], o[mp][et], 0, 0, 0);
                }
        }
    }
#undef AT_LOAD
    float inv[NMAP];
#pragma unroll
    for (int mp = 0; mp < NMAP; ++mp) { float l = lrun[mp]; l += __shfl_xor(l, 16); l += __shfl_xor(l, 32); inv[mp] = 1.f / l; }
    f32x4 r[NET]; float ss = 0.f;
#pragma unroll
    for (int et = 0; et < NET; ++et) {
        if (NMAP == 2) r[et] = o[0][et] * inv[0] - o[NMAP - 1][et] * (lam * inv[NMAP - 1]);
        else r[et] = o[0][et] * inv[0];
        ss += (r[et].x * r[et].x + r[et].y * r[et].y) + (r[et].z * r[et].z + r[et].w * r[et].w);
    }
    float rs = 1.f;
    if (NMAP == 2) { ss += __shfl_xor(ss, 16); ss += __shfl_xor(ss, 32); rs = oscale / sqrtf(ss * (1.f / EV) + NORM_EPS); }
#pragma unroll
    for (int et = 0; et < NET; ++et) {
        const int e = 16 * et + 4 * g;
        const u32x2 gv = *(const u32x2*)(Gp + (size_t)qrow * ldg + e);
        f32x4 v = r[et] * rs;
        if (NMAP == 2) v = v * *(const f32x4*)(subln + e);
        v.x *= siluf_(bflo(gv.x)); v.y *= siluf_(bfhi(gv.x)); v.z *= siluf_(bflo(gv.y)); v.w *= siluf_(bfhi(gv.y));
        u32x2 w; w.x = pk2(v.x, v.y); w.y = pk2(v.z, v.w);
        *(u32x2*)(Op + (size_t)qrow * ldo + e) = w;
    }
    __syncthreads();
}

__device__ __forceinline__ void mem_attn_unit(const Args& a, LAS unsigned char* lds, int l, int u) {
    unsigned char* ws = a.ws;
    const int b = u >> 6, h = (u >> 4) & 3, qb = u & 15;
    const bf16* PROJ = (const bf16*)(ws + WS_PROJ);
    const int ldp = l ? LDP1 : LDP0, cq = l ? C_QM1 : C_QM0, cg_ = l ? C_GM1 : C_GM0;
    const size_t row0 = (size_t)b * SEQ + qb * 128;
    attn_unit<1>(lds, PROJ + row0 * ldp + cq + h * 64, ldp,
                 (const bf16*)(ws + WS_MK) + (size_t)b * MEML * 512 + l * 256 + h * 64, 512,
                 (const bf16*)(ws + WS_MVT) + (size_t)(l * 256 + h * 64) * MROWS + b * MEML, MROWS,
                 4, 4, 0.f, 0,
                 PROJ + row0 * ldp + cg_ + h * 64, ldp, (bf16*)(ws + WS_CAT) + row0 * DM + BRW + h * 64, DM, nullptr, 0.f, 1.f);
}

constexpr int SK_SLOT = 15360, SK_NT = 0, SK_RT = 2304, SK_BP = 4608, SK_KP = 7168, SK_VT = 9728, SK_PC = 12288, SK_LK = 12544, SK_TT = 13184, SK_MB = 13824, SK_MK = 14464;
constexpr int SK_SCR = 3 * SK_SLOT, SK_SCRW = 5632, SK_BS = 0, SK_KS = 2304, SK_LB = 4608;
constexpr int SK_P72 = 72, SK_P20 = 20;
constexpr int SK_PRM = SK_SCR + 4 * SK_SCRW, SK_W2L = SK_PRM, SK_A2L = SK_PRM + 9216, SK_PF = SK_PRM + 18432;
enum { PF_W0 = 0, PF_A0, PF_KK, PF_KA, PF_RK, PF_MUR, PF_MUK, PF_MUWD, PF_MUAD, PF_MUV };
__device__ __forceinline__ bf16x8 lds2x8(const LAS bf16* p, int offa, int offb) { const u32x2 a = *(const LAS u32x2*)(p + offa), b = *(const LAS u32x2*)(p + offb); return __builtin_bit_cast(bf16x8, (u32x4){a.x, a.y, b.x, b.y}); }
__device__ __forceinline__ bf16x8 lds8z(const LAS bf16* p, int offa) { const u32x2 a = *(const LAS u32x2*)(p + offa); return __builtin_bit_cast(bf16x8, (u32x4){a.x, a.y, 0u, 0u}); }
__device__ __forceinline__ void scan_unit(const Args& a, LAS unsigned char* lds, int b, int h) {
    const int tid = threadIdx.x, lane = tid & 63, wave = __builtin_amdgcn_readfirstlane(tid >> 6), g = lane >> 4, c = lane & 15;
    unsigned char* ws = a.ws;
    const bf16* PROJ = (const bf16*)(ws + WS_PROJ);
    bf16* CAT = (bf16*)(ws + WS_CAT);
    const size_t mb = (size_t)b * SEQ;
    constexpr int NBLK = SEQ / 16;
    const f32x4 Z4 = {0.f, 0.f, 0.f, 0.f};
    {
        const bf16* W2T = (const bf16*)(ws + WS_W2T);
        for (int i = tid; i < 2 * 64 * 8; i += 512) { const int m = i >> 9, key = (i >> 3) & 63, ch = i & 7;
            const u32x4 v = *(const u32x4*)(W2T + (size_t)m * 768 * 64 + (size_t)(h * 64 + key) * 64 + 8 * ch);
            *(LAS u32x4*)(lds + (m ? SK_A2L : SK_W2L) + (((key & 3) * 16 + (key >> 2)) * SK_P72 + 8 * ch) * 2) = v; }
        for (int i = tid; i < 10 * 64; i += 512) { const int w = i >> 6, k = i & 63; float v;
            switch (w) { case PF_W0: v = a.in[I_AW0][h * 64 + k]; break; case PF_A0: v = a.in[I_AA0][h * 64 + k]; break; case PF_KK: v = a.in[I_AKK][h * 64 + k]; break;
                         case PF_KA: v = a.in[I_AKA][h * 64 + k]; break; case PF_RK: v = a.in[I_ARK][h * 64 + k]; break; case PF_MUR: v = a.in[I_AMU][C_R + h * 64 + k]; break;
                         case PF_MUK: v = a.in[I_AMU][C_K + h * 64 + k]; break; case PF_MUWD: v = a.in[I_AMU][C_WD + k]; break; case PF_MUAD: v = a.in[I_AMU][C_AD + k]; break;
                         default: v = a.in[I_AMU][C_V + h * 64 + k]; break; }
            ((LAS float*)(lds + SK_PF))[i] = v; }
        __syncthreads();
    }
    if (wave < 4) {
        f32x4 St[4] = {Z4, Z4, Z4, Z4};
        for (int q = 0; q < 4; ++q) __syncthreads();
        for (int blk = 0; blk < NBLK; ++blk) {
            const LAS unsigned char* sl = lds + (blk % 3) * SK_SLOT;
            const LAS bf16* NT = (const LAS bf16*)(sl + SK_NT); const LAS bf16* RT = (const LAS bf16*)(sl + SK_RT);
            const LAS bf16* BP = (const LAS bf16*)(sl + SK_BP); const LAS bf16* KP = (const LAS bf16*)(sl + SK_KP);
            const LAS bf16* VT = (const LAS bf16*)(sl + SK_VT); const LAS float* PC = (const LAS float*)(sl + SK_PC);
            const LAS bf16* LK = (const LAS bf16*)(sl + SK_LK); const LAS bf16* TT = (const LAS bf16*)(sl + SK_TT);
            const LAS bf16* MB = (const LAS bf16*)(sl + SK_MB); const LAS bf16* MK = (const LAS bf16*)(sl + SK_MK);
            bf16x8 sbh[2], sbl[2];
#pragma unroll
            for (int ks = 0; ks < 2; ++ks) {
                const f32x4 x = St[2 * ks], y = St[2 * ks + 1];
                u32x4 hh; hh.x = pk2(x.x, x.y); hh.y = pk2(x.z, x.w); hh.z = pk2(y.x, y.y); hh.w = pk2(y.z, y.w);
                u32x4 ll; ll.x = pk2(x.x - bflo(hh.x), x.y - bfhi(hh.x)); ll.y = pk2(x.z - bflo(hh.y), x.w - bfhi(hh.y));
                ll.z = pk2(y.x - bflo(hh.z), y.y - bfhi(hh.z)); ll.w = pk2(y.z - bflo(hh.w), y.w - bfhi(hh.w));
                sbh[ks] = __builtin_bit_cast(bf16x8, hh); sbl[ks] = __builtin_bit_cast(bf16x8, ll);
            }
            const bf16x8 An0 = lds2x8(NT, c * SK_P72 + 4 * g, c * SK_P72 + 16 + 4 * g), An1 = lds2x8(NT, c * SK_P72 + 32 + 4 * g, c * SK_P72 + 48 + 4 * g);
            const bf16x8 Ar0 = lds2x8(RT, c * SK_P72 + 4 * g, c * SK_P72 + 16 + 4 * g), Ar1 = lds2x8(RT, c * SK_P72 + 32 + 4 * g, c * SK_P72 + 48 + 4 * g);
            const u32x2 vq = *(const LAS u32x2*)(VT + (16 * wave + c) * SK_P20 + 4 * g);
            const bf16x8 vlo = __builtin_bit_cast(bf16x8, (u32x4){vq.x, vq.y, 0u, 0u});
            const bf16x8 Alk = lds8z(LK, c * SK_P20 + 4 * g), At = lds8z(TT, c * SK_P20 + 4 * g);
            const bf16x8 Amk = lds2x8(MB, c * SK_P20 + 4 * g, (int)((SK_MK - SK_MB) / 2) + c * SK_P20 + 4 * g);
            f32x4 X = __builtin_amdgcn_mfma_f32_16x16x32_bf16(An0, sbh[0], Z4, 0, 0, 0);
            X = __builtin_amdgcn_mfma_f32_16x16x32_bf16(An1, sbh[1], X, 0, 0, 0);
            X = __builtin_amdgcn_mfma_f32_16x16x32_bf16(An0, sbl[0], X, 0, 0, 0);
            X = __builtin_amdgcn_mfma_f32_16x16x32_bf16(An1, sbl[1], X, 0, 0, 0);
            X = __builtin_amdgcn_mfma_f32_16x16x32_bf16(Alk, vlo, X, 0, 0, 0);
            f32x4 Y = __builtin_amdgcn_mfma_f32_16x16x32_bf16(Ar0, sbh[0], Z4, 0, 0, 0);
            Y = __builtin_amdgcn_mfma_f32_16x16x32_bf16(Ar1, sbh[1], Y, 0, 0, 0);
            Y = __builtin_amdgcn_mfma_f32_16x16x32_bf16(Ar0, sbl[0], Y, 0, 0, 0);
            Y = __builtin_amdgcn_mfma_f32_16x16x32_bf16(Ar1, sbl[1], Y, 0, 0, 0);
            const bf16x8 xb = __builtin_bit_cast(bf16x8, (u32x4){pk2(X.x, X.y), pk2(X.z, X.w), 0u, 0u});
            const f32x4 U = __builtin_amdgcn_mfma_f32_16x16x32_bf16(At, xb, Z4, 0, 0, 0);
            const bf16x8 ub = __builtin_bit_cast(bf16x8, (u32x4){pk2(U.x, U.y), pk2(U.z, U.w), vq.x, vq.y});
            Y = __builtin_amdgcn_mfma_f32_16x16x32_bf16(Amk, ub, Y, 0, 0, 0);
#pragma unroll
            for (int kt = 0; kt < 4; ++kt) {
                const f32x4 pc4 = *(const LAS f32x4*)(PC + 16 * kt + 4 * g);
                const bf16x8 Abk = lds2x8(BP, (16 * kt + c) * SK_P20 + 4 * g, (int)((SK_KP - SK_BP) / 2) + (16 * kt + c) * SK_P20 + 4 * g);
                St[kt] = __builtin_amdgcn_mfma_f32_16x16x32_bf16(Abk, ub, St[kt] * pc4, 0, 0, 0);
            }
            bf16* yp = CAT + (mb + (size_t)blk * 16 + 4 * g) * DM + h * 64 + 16 * wave + c;
            yp[0] = (bf16)f2bf(Y.x); yp[DM] = (bf16)f2bf(Y.y); yp[2 * DM] = (bf16)f2bf(Y.z); yp[3 * DM] = (bf16)f2bf(Y.w);
            __syncthreads();
        }
    } else {
        const int pw = wave - 4;
        const int kc = h * 64 + 4 * c;
        const LAS float* PF = (const LAS float*)(lds + SK_PF); const LAS bf16* W2L = (const LAS bf16*)(lds + SK_W2L); const LAS bf16* A2L = (const LAS bf16*)(lds + SK_A2L);
        LAS unsigned char* scr = lds + SK_SCR + pw * SK_SCRW;
        LAS bf16* BSs = (LAS bf16*)(scr + SK_BS); LAS bf16* KSs = (LAS bf16*)(scr + SK_KS); LAS float* LBs = (LAS float*)(scr + SK_LB);
        u32x4 zwd[2], zwdp[2], zad[2], zadp[2], zv[2], zvp[2]; u32x2 zr[4], zrp[4], zk[4], zkp[4];
#define SK_LOAD_A(T0) do { const bf16* cur = PROJ + (mb + (T0) + c) * LDP0; const bf16* prv = ((T0) + c == 0) ? cur : cur - LDP0; \
        _Pragma("unroll") for (int ks = 0; ks < 2; ++ks) { zwd[ks] = *(const u32x4*)(cur + C_WD + 32 * ks + 8 * g); zwdp[ks] = *(const u32x4*)(prv + C_WD + 32 * ks + 8 * g); \
            zad[ks] = *(const u32x4*)(cur + C_AD + 32 * ks + 8 * g); zadp[ks] = *(const u32x4*)(prv + C_AD + 32 * ks + 8 * g); } } while (0)
#define SK_LOAD_V(T0) do { \
        { const int sv_ = lane >> 2, cv_ = lane & 3; const bf16* cs = PROJ + (mb + (T0) + sv_) * LDP0; const bf16* ps = ((T0) + sv_ == 0) ? cs : cs - LDP0; \
          _Pragma("unroll") for (int i = 0; i < 2; ++i) { zv[i] = *(const u32x4*)(cs + C_V + h * 64 + 16 * cv_ + 8 * i); zvp[i] = *(const u32x4*)(ps + C_V + h * 64 + 16 * cv_ + 8 * i); } } } while (0)
#define SK_LOAD_B(T0) do { _Pragma("unroll") for (int jj = 0; jj < 4; ++jj) { const int s_ = 4 * g + jj; const bf16* cs = PROJ + (mb + (T0) + s_) * LDP0; const bf16* ps = ((T0) + s_ == 0) ? cs : cs - LDP0; \
            zr[jj] = *(const u32x2*)(cs + C_R + kc); zrp[jj] = *(const u32x2*)(ps + C_R + kc); zk[jj] = *(const u32x2*)(cs + C_K + kc); zkp[jj] = *(const u32x2*)(ps + C_K + kc); } } while (0)
        SK_LOAD_A(pw * 16); SK_LOAD_V(pw * 16); SK_LOAD_B(pw * 16);
        for (int q = 0; q < pw; ++q) __syncthreads();
        for (int n = 0; n < NBLK / 4; ++n) {
            const int blk = 4 * n + pw, t0 = blk * 16, t0n = (blk + 4 < NBLK) ? t0 + 64 : t0;
            LAS unsigned char* sl = lds + (blk % 3) * SK_SLOT;
            int c_o = c; asm volatile("" : "+v"(c_o));
            const float pz_c = (t0 + c == 0) ? 0.f : 1.f;
            f32x4 accw[4], acca[4]; unsigned vm[8];
            {
                bf16x8 Aw[2], Aa[2];
#pragma unroll
                for (int ks = 0; ks < 2; ++ks) {
                    const f32x4 m0 = *(const LAS f32x4*)(PF + PF_MUWD * 64 + 32 * ks + 8 * g), m1 = *(const LAS f32x4*)(PF + PF_MUWD * 64 + 32 * ks + 8 * g + 4);
                    const f32x4 n0 = *(const LAS f32x4*)(PF + PF_MUAD * 64 + 32 * ks + 8 * g), n1 = *(const LAS f32x4*)(PF + PF_MUAD * 64 + 32 * ks + 8 * g + 4);
                    float xw[8], xa[8];
#pragma unroll
                    for (int e = 0; e < 4; ++e) {
                        const unsigned uw = zwd[ks][e], up = zwdp[ks][e], ua = zad[ks][e], uq = zadp[ks][e];
                        const float muw0 = (e < 2) ? m0[2 * e] : m1[2 * e - 4], muw1 = (e < 2) ? m0[2 * e + 1] : m1[2 * e - 3];
                        const float mua0 = (e < 2) ? n0[2 * e] : n1[2 * e - 4], mua1 = (e < 2) ? n0[2 * e + 1] : n1[2 * e - 3];
                        float z0 = bflo(uw), z1 = bfhi(uw);
                        z0 = z0 + (bflo(up) * pz_c - z0) * muw0; z1 = z1 + (bfhi(up) * pz_c - z1) * muw1;
                        xw[2 * e] = 1.f - 2.f * __builtin_amdgcn_rcpf(1.f + __builtin_amdgcn_exp2f(2.8853900817779268f * z0));
                        xw[2 * e + 1] = 1.f - 2.f * __builtin_amdgcn_rcpf(1.f + __builtin_amdgcn_exp2f(2.8853900817779268f * z1));
                        float y0 = bflo(ua), y1 = bfhi(ua);
                        xa[2 * e] = y0 + (bflo(uq) * pz_c - y0) * mua0; xa[2 * e + 1] = y1 + (bfhi(uq) * pz_c - y1) * mua1;
                    }
                    u32x4 w; w.x = pk2(xw[0], xw[1]); w.y = pk2(xw[2], xw[3]); w.z = pk2(xw[4], xw[5]); w.w = pk2(xw[6], xw[7]); Aw[ks] = __builtin_bit_cast(bf16x8, w);
                    u32x4 x; x.x = pk2(xa[0], xa[1]); x.y = pk2(xa[2], xa[3]); x.z = pk2(xa[4], xa[5]); x.w = pk2(xa[6], xa[7]); Aa[ks] = __builtin_bit_cast(bf16x8, x);
                }
                {
                    const int sv = lane >> 2, cv = lane & 3; const float pz = (t0 + sv == 0) ? 0.f : 1.f;
#pragma unroll
                    for (int i = 0; i < 2; ++i) {
                        const LAS float* mv = PF + PF_MUV * 64 + 16 * cv + 8 * i;
                        const f32x4 m0 = *(const LAS f32x4*)mv, m1 = *(const LAS f32x4*)(mv + 4);
#pragma unroll
                        for (int e = 0; e < 4; ++e) {
                            const unsigned uc = zv[i][e], up = zvp[i][e];
                            const float ma = (e < 2) ? m0[2 * e] : m1[2 * e - 4], mb_ = (e < 2) ? m0[2 * e + 1] : m1[2 * e - 3];
                            float z0 = bflo(uc), z1 = bfhi(uc);
                            z0 = z0 + (bflo(up) * pz - z0) * ma; z1 = z1 + (bfhi(up) * pz - z1) * mb_;
                            vm[4 * i + e] = pk2(z0, z1);
                        }
                    }
                }
                SK_LOAD_A(t0n);
#pragma unroll
                for (int nt = 0; nt < 4; ++nt) {
                    const bf16x8 wf0 = *(const LAS bf16x8*)(W2L + (nt * 16 + c) * SK_P72 + 8 * g), wf1 = *(const LAS bf16x8*)(W2L + (nt * 16 + c) * SK_P72 + 32 + 8 * g);
                    const bf16x8 af0 = *(const LAS bf16x8*)(A2L + (nt * 16 + c) * SK_P72 + 8 * g), af1 = *(const LAS bf16x8*)(A2L + (nt * 16 + c) * SK_P72 + 32 + 8 * g);
                    accw[nt] = __builtin_amdgcn_mfma_f32_16x16x32_bf16(Aw[0], wf0, Z4, 0, 0, 0);
                    accw[nt] = __builtin_amdgcn_mfma_f32_16x16x32_bf16(Aw[1], wf1, accw[nt], 0, 0, 0);
                    acca[nt] = __builtin_amdgcn_mfma_f32_16x16x32_bf16(Aa[0], af0, Z4, 0, 0, 0);
                    acca[nt] = __builtin_amdgcn_mfma_f32_16x16x32_bf16(Aa[1], af1, acca[nt], 0, 0, 0);
                }
            }
            __syncthreads();
            u32x2 ntp[4], rtp[4], bpp[4], kpp[4]; f32x4 pcv;
            {
                f32x4 dec[4], E4;
                const f32x4 p_w0 = *(const LAS f32x4*)(PF + PF_W0 * 64 + 4 * c);
#pragma unroll
                for (int jj = 0; jj < 4; ++jj)
#pragma unroll
                    for (int nt = 0; nt < 4; ++nt) dec[jj][nt] = __builtin_amdgcn_exp2f(-0.8750322163622201f * sigmoidf_(p_w0[nt] + accw[nt][jj]));
#pragma unroll
                for (int nt = 0; nt < 4; ++nt) {
                    const float p3 = (dec[0][nt] * dec[1][nt]) * (dec[2][nt] * dec[3][nt]);
                    const float q0 = __shfl(p3, c), q1 = __shfl(p3, c + 16), q2 = __shfl(p3, c + 32), q3 = __shfl(p3, c + 48);
                    E4[nt] = ((g > 0) ? q0 : 1.f) * ((g > 1) ? q1 : 1.f) * ((g > 2) ? q2 : 1.f);
                    pcv[nt] = (q0 * q1) * (q2 * q3);
                }
                const f32x4 p_a0 = *(const LAS f32x4*)(PF + PF_A0 * 64 + 4 * c), p_kk = *(const LAS f32x4*)(PF + PF_KK * 64 + 4 * c), p_ka = *(const LAS f32x4*)(PF + PF_KA * 64 + 4 * c),
                            p_rk = *(const LAS f32x4*)(PF + PF_RK * 64 + 4 * c), mu_r = *(const LAS f32x4*)(PF + PF_MUR * 64 + 4 * c), mu_k = *(const LAS f32x4*)(PF + PF_MUK * 64 + 4 * c);
                f32x4 pex = E4, bprev, kprev;
#pragma unroll
                for (int jj = 0; jj < 4; ++jj) {
                    if (jj == 2) __syncthreads();
                    const int s = 4 * g + jj;
                    const float pz = (t0 + s == 0) ? 0.f : 1.f;
                    const f32x4 pin = pex * dec[jj];
                    f32x4 rr, kp4, ku, aa;
                    const unsigned ur[2] = {zr[jj].x, zr[jj].y}, urp[2] = {zrp[jj].x, zrp[jj].y}, uk[2] = {zk[jj].x, zk[jj].y}, ukp[2] = {zkp[jj].x, zkp[jj].y};
                    float ssq = 0.f, bs = 0.f;
#pragma unroll
                    for (int nt = 0; nt < 4; ++nt) {
                        const float zc = (nt & 1) ? bfhi(ur[nt >> 1]) : bflo(ur[nt >> 1]), zp = ((nt & 1) ? bfhi(urp[nt >> 1]) : bflo(urp[nt >> 1])) * pz;
                        const float kc_ = (nt & 1) ? bfhi(uk[nt >> 1]) : bflo(uk[nt >> 1]), kp_ = ((nt & 1) ? bfhi(ukp[nt >> 1]) : bflo(ukp[nt >> 1])) * pz;
                        rr[nt] = zc + (zp - zc) * mu_r[nt];
                        const float kk = kc_ + (kp_ - kc_) * mu_k[nt];
                        aa[nt] = sigmoidf_(p_a0[nt] + acca[nt][jj]);
                        ku[nt] = kk * p_kk[nt];
                        ssq += ku[nt] * ku[nt];
                        kp4[nt] = kk * (1.f + (aa[nt] - 1.f) * p_ka[nt]);
                        bs += rr[nt] * kp4[nt] * p_rk[nt];
                    }
                    ssq = sum16(ssq); bs = sum16(bs);
                    if (c == 0) ((float*)(ws + WS_BS))[(mb + t0 + s) * AH + h] = bs;
                    const float rn = __builtin_amdgcn_rsqf(fmaxf(ssq, 1e-12f));
                    f32x4 rp; rp.x = __builtin_amdgcn_rcpf(pin.x); rp.y = __builtin_amdgcn_rcpf(pin.y); rp.z = __builtin_amdgcn_rcpf(pin.z); rp.w = __builtin_amdgcn_rcpf(pin.w);
                    const f32x4 kn = ku * rn;
                    const f32x4 nt_ = pex * (-kn), bt = kn * aa * rp, kt_ = kp4 * rp, rt = pin * rr;
                    const f32x4 bpc = bt * pcv, kpc = kt_ * pcv;
                    ntp[jj] = (u32x2){pk2(nt_.x, nt_.y), pk2(nt_.z, nt_.w)};
                    rtp[jj] = (u32x2){pk2(rt.x, rt.y), pk2(rt.z, rt.w)};
                    *(LAS u32x2*)(BSs + s * SK_P72 + 4 * c) = (u32x2){pk2(bt.x, bt.y), pk2(bt.z, bt.w)};
                    *(LAS u32x2*)(KSs + s * SK_P72 + 4 * c) = (u32x2){pk2(kt_.x, kt_.y), pk2(kt_.z, kt_.w)};
                    if (jj & 1) {
#pragma unroll
                        for (int nt = 0; nt < 4; ++nt) { if (jj == 1) { bpp[nt].x = pk2(bprev[nt], bpc[nt]); kpp[nt].x = pk2(kprev[nt], kpc[nt]); } else { bpp[nt].y = pk2(bprev[nt], bpc[nt]); kpp[nt].y = pk2(kprev[nt], kpc[nt]); } }
                    } else { bprev = bpc; kprev = kpc; }
                    pex = pin;
                }
                SK_LOAD_B(t0n);
            }
            SK_LOAD_V(t0n);
            {
                LAS bf16* NT = (LAS bf16*)(sl + SK_NT); LAS bf16* RT = (LAS bf16*)(sl + SK_RT);
                LAS bf16* BP = (LAS bf16*)(sl + SK_BP); LAS bf16* KP = (LAS bf16*)(sl + SK_KP);
#pragma unroll
                for (int jj = 0; jj < 4; ++jj) { const int s = 4 * g + jj;
                    *(LAS u32x2*)(NT + s * SK_P72 + 4 * c) = ntp[jj]; *(LAS u32x2*)(RT + s * SK_P72 + 4 * c) = rtp[jj]; }
#pragma unroll
                for (int nt = 0; nt < 4; ++nt) { *(LAS u32x2*)(BP + (4 * c + nt) * SK_P20 + 4 * g) = bpp[nt]; *(LAS u32x2*)(KP + (4 * c + nt) * SK_P20 + 4 * g) = kpp[nt]; }
                if (g == 0) *(LAS f32x4*)((LAS float*)(sl + SK_PC) + 4 * c) = pcv;
                { const int sv = lane >> 2, cv = lane & 3; LAS bf16* VT = (LAS bf16*)(sl + SK_VT);
#pragma unroll
                  for (int i = 0; i < 8; ++i) { VT[(16 * cv + 2 * i) * SK_P20 + sv] = (bf16)(vm[i] & 0xffffu); VT[(16 * cv + 2 * i + 1) * SK_P20 + sv] = (bf16)(vm[i] >> 16); } }
                asm volatile("s_waitcnt lgkmcnt(0)" ::: "memory");
                f32x4 Lb = Z4, Lk = Z4, Mb = Z4, Mk = Z4;
#pragma unroll
                for (int ks = 0; ks < 2; ++ks) {
                    const bf16x8 ab = *(const LAS bf16x8*)(BSs + c * SK_P72 + 32 * ks + 8 * g), ak = *(const LAS bf16x8*)(KSs + c * SK_P72 + 32 * ks + 8 * g);
                    const bf16x8 bn = *(const LAS bf16x8*)(NT + c * SK_P72 + 32 * ks + 8 * g), br = *(const LAS bf16x8*)(RT + c * SK_P72 + 32 * ks + 8 * g);
                    Lb = __builtin_amdgcn_mfma_f32_16x16x32_bf16(ab, bn, Lb, 0, 0, 0);
                    Lk = __builtin_amdgcn_mfma_f32_16x16x32_bf16(ak, bn, Lk, 0, 0, 0);
                    Mb = __builtin_amdgcn_mfma_f32_16x16x32_bf16(ab, br, Mb, 0, 0, 0);
                    Mk = __builtin_amdgcn_mfma_f32_16x16x32_bf16(ak, br, Mk, 0, 0, 0);
                }
#pragma unroll
                for (int j = 0; j < 4; ++j) { const int s = 4 * g + j; if (!(s < c)) { Lb[j] = 0.f; Lk[j] = 0.f; } if (!(s <= c)) { Mb[j] = 0.f; Mk[j] = 0.f; } }
                *(LAS u32x2*)((LAS bf16*)(sl + SK_LK) + c * SK_P20 + 4 * g) = (u32x2){pk2(Lk[0], Lk[1]), pk2(Lk[2], Lk[3])};
                *(LAS u32x2*)((LAS bf16*)(sl + SK_MB) + c * SK_P20 + 4 * g) = (u32x2){pk2(Mb[0], Mb[1]), pk2(Mb[2], Mb[3])};
                *(LAS u32x2*)((LAS bf16*)(sl + SK_MK) + c * SK_P20 + 4 * g) = (u32x2){pk2(Mk[0], Mk[1]), pk2(Mk[2], Mk[3])};
                *(LAS f32x4*)(LBs + c * 16 + 4 * g) = Lb;
            }
            __syncthreads();
            {
                float Ti[16];
#pragma unroll
                for (int t = 0; t < 16; ++t) {
                    float acc = (c_o == t) ? 1.f : 0.f;
                    if ((t & 3) == 0) asm volatile("" ::: "memory");
#pragma unroll
                    for (int s4 = 0; s4 < (t + 3) / 4; ++s4) {
                        const f32x4 l4 = *(const LAS f32x4*)(LBs + t * 16 + 4 * s4);
#pragma unroll
                        for (int e = 0; e < 4; ++e) if (4 * s4 + e < t) acc += Ti[4 * s4 + e] * l4[e];
                    }
                    Ti[t] = acc;
                }
                if (g == 0) {
                    LAS bf16* TT = (LAS bf16*)(sl + SK_TT);
#pragma unroll
                    for (int t = 0; t < 16; ++t) TT[t * SK_P20 + c] = (bf16)f2bf(Ti[t]);
                }
            }
            __syncthreads();
        }
#undef SK_LOAD_A
#undef SK_LOAD_V
#undef SK_LOAD_B
        for (int q = 0; q < 4 - pw; ++q) __syncthreads();
    }
}

__device__ __forceinline__ void phase_scan(const Args& a, LAS unsigned char* lds) {
    const int G = gridDim.x, bx = blockIdx.x;
    if (bx < 96) { scan_unit(a, lds, bx / 12, bx % 12); }
    else { for (int u = bx - 96; u < 512; u += G - 96) mem_attn_unit(a, lds, 0, u);
           const int wave = __builtin_amdgcn_readfirstlane(threadIdx.x >> 6);
           transpose_group<1>(a, lds, (bx - 96) * 8 + wave, (G - 96) * 8); }
}

__device__ __forceinline__ void phase_rwkv_post(const Args& a) {
    const int tid = threadIdx.x, lane = tid & 63, wave = tid >> 6, G = gridDim.x;
    unsigned char* ws = a.ws;
    const bf16* PROJ = (const bf16*)(ws + WS_PROJ); bf16* CAT = (bf16*)(ws + WS_CAT); const float* BS = (const float*)(ws + WS_BS);
    const float* mu = a.in[I_AMU];
    for (int m = blockIdx.x * 8 + wave; m < MTOK; m += G * 8) {
        const int t = m & (SEQ - 1);
        const bf16* pc = PROJ + (size_t)m * LDP0; const bf16* pp = (t == 0) ? pc : pc - LDP0; const float pz = (t == 0) ? 0.f : 1.f;
#pragma unroll
        for (int i = 0; i < 3; ++i) {
            const int col = 256 * i + 4 * lane, hh = col >> 6;
            const u32x2 yv = *(const u32x2*)(CAT + (size_t)m * DM + col);
            float y[4] = {bflo(yv.x), bfhi(yv.x), bflo(yv.y), bfhi(yv.y)};
            const float mean = sum16((y[0] + y[1]) + (y[2] + y[3])) * (1.f / 64.f);
            float d[4], vs = 0.f;
#pragma unroll
            for (int j = 0; j < 4; ++j) { d[j] = y[j] - mean; vs += d[j] * d[j]; }
            const float rstd = 1.f / sqrtf(sum16(vs) * (1.f / 64.f) + LNX_EPS);
            const f32x4 lw = *(const f32x4*)(a.in[I_ALNW] + col), lb = *(const f32x4*)(a.in[I_ALNB] + col), mv = *(const f32x4*)(mu + C_V + col);
            const u32x2 vc = *(const u32x2*)(pc + C_V + col), vp = *(const u32x2*)(pp + C_V + col), gt = *(const u32x2*)(pc + C_GATE0 + col);
            const float vcur[4] = {bflo(vc.x), bfhi(vc.x), bflo(vc.y), bfhi(vc.y)}, vprv[4] = {bflo(vp.x) * pz, bfhi(vp.x) * pz, bflo(vp.y) * pz, bfhi(vp.y) * pz};
            const float gg[4] = {bflo(gt.x), bfhi(gt.x), bflo(gt.y), bfhi(gt.y)};
            const float bs = BS[(size_t)m * AH + hh];
            float o[4];
#pragma unroll
            for (int j = 0; j < 4; ++j) { const float v = vcur[j] + (vprv[j] - vcur[j]) * mv[j];
                o[j] = (d[j] * rstd * lw[j] + lb[j] + bs * v) * siluf_(gg[j]); }
            u32x2 w; w.x = pk2(o[0], o[1]); w.y = pk2(o[2], o[3]);
            *(u32x2*)(CAT + (size_t)m * DM + col) = w;
        }
    }
}

template <int LAYER>
__device__ __forceinline__ void phase_rows(const Args& a) {
    const int tid = threadIdx.x, lane = tid & 63, wave = tid >> 6, G = gridDim.x;
    unsigned char* ws = a.ws;
    const float* Y = (const float*)(ws + WS_Y); const float* gpost = a.in[I_POST] + LAYER * DM;
    const float* xin = LAYER ? (const float*)a.out : a.in[I_X];
    bf16* XN = (bf16*)(ws + WS_XN);
    for (int m = blockIdx.x * 8 + wave; m < MTOK; m += G * 8) {
        const f32x4* yr = (const f32x4*)(Y + (size_t)m * DM) + lane; const f32x4* xr = (const f32x4*)(xin + (size_t)m * DM) + lane;
        f32x4 y[4], x[4]; float s = 0.f;
#pragma unroll
        for (int j = 0; j < 4; ++j) { y[j] = yr[64 * j]; x[j] = xr[64 * j]; s += (y[j].x * y[j].x + y[j].y * y[j].y) + (y[j].z * y[j].z + y[j].w * y[j].w); }
        const float rs = 1.f / sqrtf(wave_sum(s) * (1.f / DM) + NORM_EPS);
        float s1 = 0.f;
        f32x4* orow = (f32x4*)(a.out + (size_t)m * DM) + lane;
#pragma unroll
        for (int j = 0; j < 4; ++j) { const f32x4 gp = *((const f32x4*)gpost + lane + 64 * j);
            x[j] = x[j] + y[j] * rs * gp; orow[64 * j] = x[j];
            s1 += (x[j].x * x[j].x + x[j].y * x[j].y) + (x[j].z * x[j].z + x[j].w * x[j].w); }
        if (LAYER == 0) {
            const float r1 = 1.f / sqrtf(wave_sum(s1) * (1.f / DM) + NORM_EPS);
            unsigned long long* o8 = (unsigned long long*)(XN + (size_t)m * DM) + lane;
#pragma unroll
            for (int j = 0; j < 4; ++j) o8[64 * j] = (unsigned long long)pk2(x[j].x * r1, x[j].y * r1) | ((unsigned long long)pk2(x[j].z * r1, x[j].w * r1) << 32);
        }
    }
}

__device__ __forceinline__ void phase_attn1(const Args& a, LAS unsigned char* lds) {
    const int G = gridDim.x, bx = blockIdx.x, lane = threadIdx.x & 63;
    unsigned char* ws = a.ws;
    const float s1 = wave_sum(a.in[I_LQ1][lane] * a.in[I_LK1][lane]), s2 = wave_sum(a.in[I_LQ2][lane] * a.in[I_LK2][lane]);
    const float lam_init = 0.8f - 0.6f * 0.7408182206817179f;
    const float lam = __expf(s1) - __expf(s2) + lam_init;
    const bf16* PROJ = (const bf16*)(ws + WS_PROJ); const bf16* VT = (const bf16*)(ws + WS_VT); bf16* CAT = (bf16*)(ws + WS_CAT);
    const float slopes[6] = {0.25f, 0.0625f, 0.015625f, 0.00390625f, 0.5f, 0.125f};
    for (int i = 0;; ++i) {
        const int n = (i & 1) ? (i * G + (G - 1 - bx)) : (i * G + bx);
        if (i * G >= 768) break;
        if (n >= 768) continue;
        const int qb = 15 - n / 48, bh = n % 48, b = bh / 6, h = bh % 6;
        const size_t row0 = (size_t)b * SEQ + qb * 128;
        float slope = slopes[0];
#pragma unroll
        for (int k = 1; k < 6; ++k) slope = (h == k) ? slopes[k] : slope;
        attn_unit<2>(lds, PROJ + row0 * LDP1 + C_Q1 + h * 128, LDP1,
                     PROJ + (size_t)b * SEQ * LDP1 + C_KSH + h * 128, LDP1,
                     VT + (size_t)(h * 128) * MTOK + (size_t)b * SEQ, MTOK,
                     2 * qb + 1, 2 * qb + 2, slope * LOG2E, qb * 128,
                     PROJ + row0 * LDP1 + C_GATE1 + h * 128, LDP1, CAT + row0 * DM + h * 128, DM, a.in[I_SUBLN], lam, 1.f - lam_init);
    }
    for (int u = bx; u < 512; u += G) mem_attn_unit(a, lds, 1, u);
}

constexpr int N_PHASES = 10;
__global__ void __launch_bounds__(512, 2) yoco_fwd(Args args) {
    extern __shared__ __attribute__((aligned(16))) unsigned char lds_raw[];
    LAS unsigned char* lds = (LAS unsigned char*)lds_raw;
    const int lo = args.ph_lo, hi = args.ph_hi;
#ifndef ONLY_PHASE
#define ONLY_PHASE -1
#endif
#define IN(k) ((ONLY_PHASE < 0 || ONLY_PHASE == (k)) && lo <= (k) && (k) < hi)
#define SEAM(k) do { if (IN(k) && IN((k) + 1)) { __syncthreads(); cg::this_grid().sync(); } } while (0)
    if (IN(0)) { phase_prologue(args, lds); if (PROBE_DUP == 0) { __syncthreads(); phase_prologue(args, lds); } }
    SEAM(0);
    if (IN(1)) { phase_gemm(args, lds, 0, 3); if (PROBE_DUP == 1) { __syncthreads(); phase_gemm(args, lds, 0, 3); } }
    SEAM(1);
    if (IN(2)) { phase_scan(args, lds); if (PROBE_DUP == 2) { __syncthreads(); phase_scan(args, lds); } }
    SEAM(2);
    if (IN(3)) { phase_rwkv_post(args); if (PROBE_DUP == 3) { __syncthreads(); phase_rwkv_post(args); } }
    SEAM(3);
    if (IN(4)) { phase_gemm(args, lds, 3, 1); if (PROBE_DUP == 4) { __syncthreads(); phase_gemm(args, lds, 3, 1); } }
    SEAM(4);
    if (IN(5)) { phase_rows<0>(args); if (PROBE_DUP == 5) { __syncthreads(); phase_rows<0>(args); } }
    SEAM(5);
    if (IN(6)) { phase_gemm(args, lds, 4, 2); if (PROBE_DUP == 6) { __syncthreads(); phase_gemm(args, lds, 4, 2); } }
    SEAM(6);
    if (IN(7)) { phase_attn1(args, lds); if (PROBE_DUP == 7) { __syncthreads(); phase_attn1(args, lds); } }
    SEAM(7);
    if (IN(8)) { phase_gemm(args, lds, 6, 1); if (PROBE_DUP == 8) { __syncthreads(); phase_gemm(args, lds, 6, 1); } }
    SEAM(8);
    if (IN(9)) { phase_rows<1>(args); if (PROBE_DUP == 9) { __syncthreads(); phase_rows<1>(args); } }
#undef IN
#undef SEAM
}

extern "C" void kernel_launch(void* const* d_in, const int* in_sizes, int n_in, void* d_out, int out_size, void* d_ws, size_t ws_size, hipStream_t stream) {
    static int ready = 0;
    if (ready == 0) {
        if (n_in != 26 || out_size != MTOK * DM || ws_size < WS_END) { fprintf(stderr, "kernel_launch: unexpected problem shape (n_in %d out %d ws %zu)\n", n_in, out_size, ws_size); ready = -1; return; }
        if (hipFuncSetAttribute((const void*)yoco_fwd, hipFuncAttributeMaxDynamicSharedMemorySize, LDS_BYTES) != hipSuccess) { fprintf(stderr, "kernel_launch: hipFuncSetAttribute failed\n"); ready = -1; return; }
        int per_cu = 0;
        if (hipOccupancyMaxActiveBlocksPerMultiprocessor(&per_cu, (const void*)yoco_fwd, 512, LDS_BYTES) != hipSuccess || per_cu < 1) fprintf(stderr, "kernel_launch: occupancy query says %d\n", per_cu);
        (void)hipGetLastError();
        ready = 1;
    }
    if (ready < 0) return;
    Args a{};
    for (int i = 0; i < 26; ++i) a.in[i] = (const float*)d_in[i];
    a.out = (float*)d_out; a.ws = (unsigned char*)d_ws;
#if MK_COOP
    a.ph_lo = 0; a.ph_hi = N_PHASES;
    void* params[] = {&a};
    hipError_t e = hipLaunchCooperativeKernel((const void*)yoco_fwd, dim3(256), dim3(512), params, LDS_BYTES, stream);
    if (e != hipSuccess) fprintf(stderr, "kernel_launch: cooperative launch failed: %s\n", hipGetErrorString(e));
#else
    for (int ph = 0; ph < N_PHASES; ++ph) { a.ph_lo = ph; a.ph_hi = ph + 1; hipLaunchKernelGGL(yoco_fwd, dim3(256), dim3(512), LDS_BYTES, stream, a); }
#endif
}
```

```cpp
#include <hip/hip_runtime.h>
#include <hip/hip_cooperative_groups.h>
#include <cstdio>
#include <cstdint>
namespace cg = cooperative_groups;

#ifndef PROBE_DUP
#define PROBE_DUP -1
#endif
#ifndef MK_COOP
#define MK_COOP 1
#endif

#define LAS __attribute__((address_space(3)))
typedef unsigned short bf16;
typedef short bf16x8 __attribute__((ext_vector_type(8)));
typedef float f32x4 __attribute__((ext_vector_type(4)));
typedef float f32x2 __attribute__((ext_vector_type(2)));
typedef unsigned u32x4 __attribute__((ext_vector_type(4)));
typedef unsigned u32x2 __attribute__((ext_vector_type(2)));

constexpr int DM = 1024, NBATCH = 8, SEQ = 2048, MTOK = NBATCH * SEQ;
constexpr int MEML = 256, MROWS = NBATCH * MEML;
constexpr int BRW = 768, AH = 12, BH = 6;
constexpr int LDP0 = 3840;
constexpr int LDP1 = 2816;
constexpr int C_R = 0, C_K = 768, C_V = 1536, C_WD = 2304, C_AD = 2368, C_GATE0 = 2432, C_QM0 = 3200, C_GM0 = 3456;
constexpr int C_Q1 = 0, C_GATE1 = 768, C_QM1 = 1536, C_GM1 = 1792, C_KSH = 2048;
constexpr float NORM_EPS = 1e-6f, LNX_EPS = 64e-5f;
constexpr float LOG2E = 1.4426950408889634f;

constexpr size_t MiB = 1u << 20;
constexpr size_t WS_WA = 1 * MiB;
constexpr size_t WS_WB = 9 * MiB;
constexpr size_t WS_WO = 16 * MiB;
constexpr size_t WS_WM = 20 * MiB;
constexpr size_t WS_MEMN = 22 * MiB;
constexpr size_t WS_MK = 26 * MiB;
constexpr size_t WS_MVT = 28 * MiB;
constexpr size_t WS_XN = 30 * MiB;
constexpr size_t WS_CAT = 62 * MiB;
constexpr size_t WS_VT = 94 * MiB;
constexpr size_t WS_PROJ = 118 * MiB;
constexpr size_t WS_Y = 118 * MiB;
constexpr size_t WS_W2T = 0 * MiB + 65536;
constexpr size_t WS_BS = 238 * MiB;
constexpr size_t WS_END = 240 * MiB;

__device__ __forceinline__ unsigned f2bf(float f) { unsigned u = __builtin_bit_cast(unsigned, f); return (u + 0x7fffu + ((u >> 16) & 1u)) >> 16; }
typedef __bf16 bf16x2_t __attribute__((ext_vector_type(2)));
__device__ __forceinline__ unsigned pk2(float lo, float hi) { f32x2 v = {lo, hi}; bf16x2_t b = __builtin_convertvector(v, bf16x2_t); return __builtin_bit_cast(unsigned, b); }
__device__ __forceinline__ float bflo(unsigned u) { return __builtin_bit_cast(float, u << 16); }
__device__ __forceinline__ float bfhi(unsigned u) { return __builtin_bit_cast(float, u & 0xffff0000u); }
__device__ __forceinline__ float wave_sum(float v) {
#pragma unroll
    for (int o = 1; o < 64; o <<= 1) v += __shfl_xor(v, o);
    return v;
}
template <int CTRL> __device__ __forceinline__ float dppf(float x) { return __builtin_bit_cast(float, __builtin_amdgcn_update_dpp(0, __builtin_bit_cast(int, x), CTRL, 0xf, 0xf, false)); }
__device__ __forceinline__ float sum8(float x) { x += dppf<0xB1>(x); x += dppf<0x4E>(x); x += dppf<0x141>(x); return x; }
__device__ __forceinline__ float sum16(float x) { x += dppf<0xB1>(x); x += dppf<0x4E>(x); x += dppf<0x141>(x); x += dppf<0x140>(x); return x; }
__device__ __forceinline__ float sigmoidf_(float x) { return __builtin_amdgcn_rcpf(1.f + __builtin_amdgcn_exp2f(-1.4426950408889634f * x)); }
__device__ __forceinline__ float siluf_(float x) { return x * __builtin_amdgcn_rcpf(1.f + __builtin_amdgcn_exp2f(-1.4426950408889634f * x)); }

namespace pg8 {
constexpr int BM = 256, BK = 64, HALF = 128, HTB = HALF * BK * 2, STAGE_BYTES = 8 * HTB, NXCD = 8, WGM = 8;
__device__ __forceinline__ int lds_byte(int r, int c) { const int st = (r >> 4) * 2 + (c >> 5), rr = r & 15, cc = c & 31, ob = rr * 64 + cc * 2; return st * 1024 + (ob ^ (((ob >> 9) & 1) << 5)); }
__device__ __forceinline__ void stage_rc(int b, int& R, int& C) { const int st = b / 1024, sb = b % 1024, swz = sb ^ (((sb >> 9) & 1) << 5); R = (st >> 1) * 16 + swz / 64; C = (st & 1) * 32 + (swz % 64) / 2; }
__device__ __forceinline__ int perm32(int rho) { const int n = rho >> 4, i = rho & 15; return 8 * (i >> 2) + 4 * n + (i & 3); }
struct Unit { int pm, pn; };
struct Gemm { const bf16* A; const bf16* Bt; int M, N, K; };
struct StaticOrder {
    int nM, nN, nwg, G, c;
    __device__ void init(int M, int N, int G_, int c_) { nM = M / BM; nN = N / BM; nwg = nM * nN; G = G_; c = c_; }
    __device__ bool next(int i, Unit& u) const {
        const long L = (long)i * G + c; if (L >= nwg) return false;
        int wgid = (int)L; { const int q = nwg / NXCD, r = nwg % NXCD, xcd = wgid % NXCD, off = wgid / NXCD; wgid = (xcd < r ? xcd * (q + 1) : r * (q + 1) + (xcd - r) * q) + off; }
        const int nig = WGM * nN, gid = wgid / nig, fm = gid * WGM, gsz = (nM - fm) < WGM ? (nM - fm) : WGM;
        u.pm = fm + ((wgid % nig) % gsz); u.pn = (wgid % nig) / gsz; return true;
    }
};
__device__ __forceinline__ unsigned cvt_pk_bf16(float lo, float hi) { unsigned r; asm volatile("v_cvt_pk_bf16_f32 %0, %1, %2" : "=v"(r) : "v"(lo), "v"(hi)); return r; }

struct EpiStore {
    void* O; int ldc; int f32out;
    __device__ __forceinline__ void operator()(const f32x4 (&acc)[2][2][4][2], const Unit& u, int wr, int wc, int fr, int fq) const {
        const int row0 = u.pm * BM + wr * 64 + fr, col0 = u.pn * BM + wc * 32 + 8 * fq;
        if (f32out) {
#pragma unroll
            for (int ai = 0; ai < 2; ++ai)
#pragma unroll
                for (int m = 0; m < 4; ++m) { float* rowp = (float*)O + (size_t)(row0 + ai * HALF + m * 16) * ldc + col0;
#pragma unroll
                    for (int bj = 0; bj < 2; ++bj) { *(f32x4*)(rowp + bj * HALF) = acc[ai][bj][m][0]; *(f32x4*)(rowp + bj * HALF + 4) = acc[ai][bj][m][1]; } }
        } else {
#pragma unroll
            for (int ai = 0; ai < 2; ++ai)
#pragma unroll
                for (int m = 0; m < 4; ++m) { bf16* rowp = (bf16*)O + (size_t)(row0 + ai * HALF + m * 16) * ldc + col0;
#pragma unroll
                    for (int bj = 0; bj < 2; ++bj) { const f32x4 v0 = acc[ai][bj][m][0], v1 = acc[ai][bj][m][1];
                        u32x4 w; w.x = cvt_pk_bf16(v0[0], v0[1]); w.y = cvt_pk_bf16(v0[2], v0[3]); w.z = cvt_pk_bf16(v1[0], v1[1]); w.w = cvt_pk_bf16(v1[2], v1[3]);
                        *(u32x4*)(rowp + bj * HALF) = w; } }
        }
    }
};

template <class Epi, class Sched>
__device__ __forceinline__ void gemm_phase(LAS unsigned char* lds, const Gemm g, const Sched& S, const Epi& E) {
    const int tid = threadIdx.x, wid = __builtin_amdgcn_readfirstlane(tid >> 6), lane = tid & 63, wr = wid >> 2, wc = wid & 3, fr = lane & 15, fq = lane >> 4;
    const int K = g.K, nt = K / BK;
    unsigned voffA[2], voffB[2];
#pragma unroll
    for (int i = 0; i < 2; ++i) { int R, C; stage_rc(tid * 16 + i * 8192, R, C); const int Rb = (R & ~31) + perm32(R & 31);
        voffA[i] = (unsigned)(R * K + C) * 2u; voffB[i] = (unsigned)(Rb * K + C) * 2u; }
    const size_t kstep = (size_t)(BK * 2);
    const size_t hstep = (size_t)HALF * K * 2;
    const size_t tstep = 2 * hstep;
    const unsigned ldsw = (unsigned)wid * 1024u;
    const int aoff = lds_byte(wr * 64 + fr, fq * 8), boff = lds_byte(wc * 32 + fr, fq * 8);
#define PG8_SA(b, h) (((b) * 2 + (h)) * HTB)
#define PG8_SB(b, h) ((4 + (b) * 2 + (h)) * HTB)
#define PG8_STAGE(bufoff, gbase, voff) do { _Pragma("unroll") for (int _i = 0; _i < 2; ++_i) \
        __builtin_amdgcn_global_load_lds((const unsigned*)((const char*)(gbase) + (voff)[_i]), (LAS unsigned*)(lds + (bufoff) + ldsw + _i * 8192), 16, 0, 0); } while (0)
#define PG8_LDA(dst, b, h) do { _Pragma("unroll") for (int m = 0; m < 4; ++m) _Pragma("unroll") for (int k = 0; k < 2; ++k) dst[m][k] = *(const LAS bf16x8*)(lds + PG8_SA(b, h) + aoff + m * 2048 + k * 1024); } while (0)
#define PG8_LDB(dst, b, h) do { _Pragma("unroll") for (int n = 0; n < 2; ++n) _Pragma("unroll") for (int k = 0; k < 2; ++k) dst[n][k] = *(const LAS bf16x8*)(lds + PG8_SB(b, h) + boff + n * 2048 + k * 1024); } while (0)
#define PG8_MMA(ai, bj, At, Bt) do { __builtin_amdgcn_s_setprio(1); _Pragma("unroll") for (int m = 0; m < 4; ++m) _Pragma("unroll") for (int n = 0; n < 2; ++n) _Pragma("unroll") for (int k = 0; k < 2; ++k) \
        acc[ai][bj][m][n] = __builtin_amdgcn_mfma_f32_16x16x32_bf16(Bt[n][k], At[m][k], acc[ai][bj][m][n], 0, 0, 0); __builtin_amdgcn_s_setprio(0); } while (0)
#define PG8_WAIT_V(n) asm volatile("s_waitcnt vmcnt(" #n ")" ::: "memory")
#define PG8_WAIT_L(n) asm volatile("s_waitcnt lgkmcnt(" #n ")" ::: "memory")
#define PG8_BAR __builtin_amdgcn_s_barrier()
#define PG8_SCHED __builtin_amdgcn_sched_barrier(0)
    Unit cur, nxt; int ui = 0;
    if (!S.next(0, cur)) return;
    f32x4 acc[2][2][4][2];
#pragma unroll
    for (int a = 0; a < 2; ++a)
#pragma unroll
        for (int b = 0; b < 2; ++b)
#pragma unroll
            for (int m = 0; m < 4; ++m)
#pragma unroll
                for (int n = 0; n < 2; ++n) acc[a][b][m][n] = (f32x4){0.f, 0.f, 0.f, 0.f};
    bf16x8 At[4][2], B0[2][2], B1[2][2];
    const char* cA = (const char*)g.A + (size_t)cur.pm * tstep; const char* cB = (const char*)g.Bt + (size_t)cur.pn * tstep;
    PG8_STAGE(PG8_SB(0, 0), cB, voffB); PG8_STAGE(PG8_SB(0, 1), cB + hstep, voffB); PG8_STAGE(PG8_SA(0, 0), cA, voffA); PG8_STAGE(PG8_SA(0, 1), cA + hstep, voffA);
    if (wr == 1) PG8_BAR;
    PG8_WAIT_V(2); PG8_BAR;
    PG8_STAGE(PG8_SB(1, 0), cB + kstep, voffB); PG8_STAGE(PG8_SA(1, 0), cA + kstep, voffA); PG8_STAGE(PG8_SB(1, 1), cB + hstep + kstep, voffB);
    PG8_WAIT_V(6); PG8_BAR;
    for (;;) {
        const bool has_next = S.next(ui + 1, nxt);
        const char* nA = has_next ? (const char*)g.A + (size_t)nxt.pm * tstep : cA; const char* nB = has_next ? (const char*)g.Bt + (size_t)nxt.pn * tstep : cB;
        for (int t = 0; t < nt; t += 2) {
            const bool last = (t == nt - 2);
            const char* a1 = cA + (size_t)(t + 1) * kstep;
            const char* a2 = last ? nA : cA + (size_t)(t + 2) * kstep; const char* b2 = last ? nB : cB + (size_t)(t + 2) * kstep;
            const char* a3 = a2 + kstep; const char* b3 = b2 + kstep;
            PG8_LDB(B0, 0, 0); PG8_LDB(B1, 0, 1); PG8_SCHED; PG8_LDA(At, 0, 0); PG8_STAGE(PG8_SA(1, 1), a1 + hstep, voffA);
            PG8_WAIT_V(8); PG8_WAIT_L(0); PG8_BAR; PG8_MMA(0, 0, At, B0); PG8_MMA(0, 1, At, B1); PG8_BAR; PG8_SCHED;
            PG8_LDA(At, 0, 1); PG8_STAGE(PG8_SB(0, 0), b2, voffB); PG8_STAGE(PG8_SB(0, 1), b2 + hstep, voffB); PG8_STAGE(PG8_SA(0, 0), a2, voffA);
            PG8_WAIT_V(8); PG8_WAIT_L(0); PG8_BAR; PG8_MMA(1, 0, At, B0); PG8_MMA(1, 1, At, B1); PG8_BAR; PG8_SCHED;
            PG8_LDB(B0, 1, 0); PG8_LDB(B1, 1, 1); PG8_SCHED; PG8_LDA(At, 1, 0); PG8_STAGE(PG8_SA(0, 1), a2 + hstep, voffA);
            PG8_WAIT_V(8); PG8_WAIT_L(0); PG8_BAR; PG8_MMA(0, 0, At, B0); PG8_MMA(0, 1, At, B1); PG8_BAR; PG8_SCHED;
            PG8_LDA(At, 1, 1); PG8_STAGE(PG8_SB(1, 0), b3, voffB); PG8_STAGE(PG8_SB(1, 1), b3 + hstep, voffB); PG8_STAGE(PG8_SA(1, 0), a3, voffA);
            PG8_WAIT_V(8); PG8_WAIT_L(0); PG8_BAR; PG8_MMA(1, 0, At, B0); PG8_MMA(1, 1, At, B1); PG8_BAR; PG8_SCHED;
        }
        if (wr == 0) PG8_BAR;
        E(acc, cur, wr, wc, fr, fq);
        if (!has_next) break;
#pragma unroll
        for (int a = 0; a < 2; ++a)
#pragma unroll
            for (int b = 0; b < 2; ++b)
#pragma unroll
                for (int m = 0; m < 4; ++m)
#pragma unroll
                    for (int n = 0; n < 2; ++n) acc[a][b][m][n] = (f32x4){0.f, 0.f, 0.f, 0.f};
        cur = nxt; cA = nA; cB = nB; ++ui;
        if (wr == 1) PG8_BAR;
    }
    PG8_WAIT_V(0);
    PG8_BAR;
#undef PG8_SA
#undef PG8_SB
#undef PG8_STAGE
#undef PG8_LDA
#undef PG8_LDB
#undef PG8_MMA
#undef PG8_WAIT_V
#undef PG8_WAIT_L
#undef PG8_BAR
#undef PG8_SCHED
}
}

struct Args { const float* in[26]; float* out; unsigned char* ws; int ph_lo, ph_hi; };
enum { I_X = 0, I_MEM, I_PRE, I_POST, I_WOUT, I_MEMNORM, I_WMEMKV, I_AWIN, I_AMU, I_AW0, I_AW2, I_AA0, I_AA2, I_AKK, I_AKA, I_ARK, I_ALNW, I_ALNB,
       I_KVNORM, I_WKV, I_BWIN, I_LQ1, I_LK1, I_LQ2, I_LK2, I_SUBLN };

constexpr int LDS_BYTES = 147456;

__device__ __forceinline__ void p0_transpose_item(const float* W, int ldw, int c0, int nc, const float* gain, bf16* WT, int row0, LAS float* scr, int item, int lane, int ldo = 1024) {
    const int nblk = nc / 32, kb = item / nblk, nb = item % nblk, k0 = 64 * kb, n0 = 32 * nb;
#pragma unroll 8
    for (int i = 0; i < 32; ++i) { const int kk = 2 * i + (lane >> 5);
        float v = W[(size_t)(k0 + kk) * ldw + c0 + n0 + (lane & 31)]; if (gain) v *= gain[k0 + kk];
        scr[kk * 33 + (lane & 31)] = v; }
    asm volatile("s_waitcnt lgkmcnt(0)" ::: "memory");
    const int c = lane & 7;
#pragma unroll
    for (int j = 0; j < 4; ++j) { const int n = (lane >> 3) + 8 * j; const LAS float* s = scr + (8 * c) * 33 + n;
        u32x4 o; o.x = pk2(s[0 * 33], s[1 * 33]); o.y = pk2(s[2 * 33], s[3 * 33]); o.z = pk2(s[4 * 33], s[5 * 33]); o.w = pk2(s[6 * 33], s[7 * 33]);
        *(u32x4*)(WT + (size_t)(row0 + n0 + n) * ldo + k0 + 8 * c) = o; }
    asm volatile("s_waitcnt lgkmcnt(0)" ::: "memory");
}
__device__ __forceinline__ void rms_row_to_bf16(const float* xrow, bf16* orow, int lane) {
    const f32x4* xr = (const f32x4*)xrow + lane;
    f32x4 v[4]; float s = 0.f;
#pragma unroll
    for (int j = 0; j < 4; ++j) { v[j] = xr[64 * j]; s += (v[j].x * v[j].x + v[j].y * v[j].y) + (v[j].z * v[j].z + v[j].w * v[j].w); }
    const float rs = 1.f / sqrtf(wave_sum(s) * (1.f / DM) + NORM_EPS);
    unsigned long long* o8 = (unsigned long long*)orow + lane;
#pragma unroll
    for (int j = 0; j < 4; ++j) o8[64 * j] = (unsigned long long)pk2(v[j].x * rs, v[j].y * rs) | ((unsigned long long)pk2(v[j].z * rs, v[j].w * rs) << 32);
}
template <int GROUP>
__device__ __forceinline__ void transpose_group(const Args& a, LAS unsigned char* lds, int gw, int NGW) {
    const int lane = threadIdx.x & 63, wave = __builtin_amdgcn_readfirstlane(threadIdx.x >> 6);
    unsigned char* ws = a.ws;
    LAS float* scr = (LAS float*)(lds + wave * 16384);
    bf16* WA = (bf16*)(ws + WS_WA); bf16* WB = (bf16*)(ws + WS_WB); bf16* WO = (bf16*)(ws + WS_WO); bf16* WM = (bf16*)(ws + WS_WM);
    constexpr int I0 = 16 * (3712 / 32), I1 = 16 * (2048 / 32), I2 = 16 * (1536 / 32), I3 = 16 * (1024 / 32), I5 = 16 * (256 / 32), I6 = 768 / 32;
    bf16* W2T = (bf16*)(ws + WS_W2T); bf16* A2T = W2T + 768 * 64;
    if (GROUP == 0) {
        constexpr int NITEMS = I0 + 4 * I5 + 2 * I6;
        for (int it = gw; it < NITEMS; it += NGW) {
            int r = it;
            if (r < I0) { p0_transpose_item(a.in[I_AWIN], 3712, 0, 3712, a.in[I_PRE], WA, 0, scr, r, lane); continue; } r -= I0;
            if (r < I5) { p0_transpose_item(a.in[I_WMEMKV], 512, 0, 256, a.in[I_MEMNORM], WM, 0, scr, r, lane); continue; } r -= I5;
            if (r < I5) { p0_transpose_item(a.in[I_WMEMKV], 512, 256, 256, a.in[I_MEMNORM], WM, 512, scr, r, lane); continue; } r -= I5;
            if (r < I5) { p0_transpose_item(a.in[I_WMEMKV] + 1024 * 512, 512, 0, 256, a.in[I_MEMNORM] + 1024, WM, 256, scr, r, lane); continue; } r -= I5;
            if (r < I5) { p0_transpose_item(a.in[I_WMEMKV] + 1024 * 512, 512, 256, 256, a.in[I_MEMNORM] + 1024, WM, 768, scr, r, lane); continue; } r -= I5;
            if (r < I6) { p0_transpose_item(a.in[I_AW2], 768, 0, 768, nullptr, W2T, 0, scr, r, lane, 64); continue; } r -= I6;
            p0_transpose_item(a.in[I_AA2], 768, 0, 768, nullptr, A2T, 0, scr, r, lane, 64);
        }
    } else {
        constexpr int NITEMS = I1 + I2 + 2 * I3;
        for (int it = gw; it < NITEMS; it += NGW) {
            int r = it;
            if (r < I1) { p0_transpose_item(a.in[I_BWIN], 2048, 0, 2048, a.in[I_PRE] + 1024, WB, 0, scr, r, lane); continue; } r -= I1;
            if (r < I2) { p0_transpose_item(a.in[I_WKV], 1536, 0, 1536, a.in[I_KVNORM], WB, 2048, scr, r, lane); continue; } r -= I2;
            if (r < I3) { p0_transpose_item(a.in[I_WOUT], 1024, 0, 1024, nullptr, WO, 0, scr, r, lane); continue; } r -= I3;
            p0_transpose_item(a.in[I_WOUT] + 1024 * 1024, 1024, 0, 1024, nullptr, WO + 1024 * 1024, 0, scr, r, lane);
        }
    }
}
__device__ __forceinline__ void phase_prologue(const Args& a, LAS unsigned char* lds) {
    const int tid = threadIdx.x, lane = tid & 63, wave = __builtin_amdgcn_readfirstlane(tid >> 6);
    const int G = gridDim.x, gw = blockIdx.x * 8 + wave, NGW = G * 8;
    unsigned char* ws = a.ws;
    bf16* WA = (bf16*)(ws + WS_WA);
    transpose_group<0>(a, lds, gw, NGW);
    { u32x4* z = (u32x4*)(WA + (size_t)3712 * 1024); const int nz = 128 * 1024 * 2 / 16;
      for (int i = blockIdx.x * 512 + tid; i < nz; i += G * 512) z[i] = (u32x4){0u, 0u, 0u, 0u}; }
    bf16* XN = (bf16*)(ws + WS_XN); bf16* MEMN = (bf16*)(ws + WS_MEMN);
    for (int m = gw; m < MTOK + MROWS; m += NGW) {
        if (m < MTOK) rms_row_to_bf16(a.in[I_X] + (size_t)m * DM, XN + (size_t)m * DM, lane);
        else rms_row_to_bf16(a.in[I_MEM] + (size_t)(m - MTOK) * DM, MEMN + (size_t)(m - MTOK) * DM, lane);
    }
}

__device__ __forceinline__ void run_gemm(LAS unsigned char* lds, const bf16* A, const bf16* Bt, int M, int N, void* O, int ldc, int f32out, int shift) {
    const int G = gridDim.x;
    pg8::Gemm g{A, Bt, M, N, 1024};
    pg8::StaticOrder S; S.init(M, N, G, (int)((blockIdx.x + G - shift) % G));
    pg8::EpiStore E{O, ldc, f32out};
    pg8::gemm_phase<pg8::EpiStore, pg8::StaticOrder>(lds, g, S, E);
}
__device__ __forceinline__ void phase_gemm(const Args& a, LAS unsigned char* lds, int first, int count) {
    unsigned char* ws = a.ws;
    for (int j = first; j < first + count; ++j) {
        const bf16* A; const bf16* Bt; int M, N, ldc, f32o, shift; void* O;
        switch (j) {
        case 0: A = (const bf16*)(ws + WS_XN); Bt = (const bf16*)(ws + WS_WA); M = MTOK; N = 3840; O = ws + WS_PROJ; ldc = LDP0; f32o = 0; shift = 0; break;
        case 1: A = (const bf16*)(ws + WS_MEMN); Bt = (const bf16*)(ws + WS_WM); M = MROWS; N = 512; O = ws + WS_MK; ldc = 512; f32o = 0; shift = 192; break;
        case 2: A = (const bf16*)(ws + WS_WM) + 512 * 1024; Bt = (const bf16*)(ws + WS_MEMN); M = 512; N = MROWS; O = ws + WS_MVT; ldc = MROWS; f32o = 0; shift = 208; break;
        case 3: A = (const bf16*)(ws + WS_CAT); Bt = (const bf16*)(ws + WS_WO); M = MTOK; N = 1024; O = ws + WS_Y; ldc = 1024; f32o = 1; shift = 0; break;
        case 4: A = (const bf16*)(ws + WS_XN); Bt = (const bf16*)(ws + WS_WB); M = MTOK; N = 2816; O = ws + WS_PROJ; ldc = LDP1; f32o = 0; shift = 0; break;
        case 5: A = (const bf16*)(ws + WS_WB) + 2816 * 1024; Bt = (const bf16*)(ws + WS_XN); M = 768; N = MTOK; O = ws + WS_VT; ldc = MTOK; f32o = 0; shift = 192; break;
        default: A = (const bf16*)(ws + WS_CAT); Bt = (const bf16*)(ws + WS_WO) + 1024 * 1024; M = MTOK; N = 1024; O = ws + WS_Y; ldc = 1024; f32o = 1; shift = 0; break;
        }
        run_gemm(lds, A, Bt, M, N, O, ldc, f32o, shift);
    }
}

constexpr int AT_PITCH = 72;
template <int NMAP>
__device__ __forceinline__ void attn_unit(LAS unsigned char* lds, const bf16* Qp, int ldq, const bf16* Kp, int ldk, const bf16* VTp, int ldvt,
                                          int nkt_lo, int nkt_hi, float slope2, int tq0,
                                          const bf16* Gp, int ldg, bf16* Op, int ldo, const float* subln, float lam, float oscale) {
    constexpr int EV = 64 * NMAP, NET = EV / 16;
    const int tid = threadIdx.x, lane = tid & 63, wave = __builtin_amdgcn_readfirstlane(tid >> 6), g = lane >> 4, c = lane & 15;
    LAS bf16* Ks = (LAS bf16*)lds;
    LAS bf16* Vs = (LAS bf16*)(lds + NMAP * 64 * AT_PITCH * 2);
    const int nkt = (wave < 4) ? nkt_lo : nkt_hi;
    const int qrow = 16 * wave + c;
    bf16x8 qf[NMAP][2];
#pragma unroll
    for (int mp = 0; mp < NMAP; ++mp)
#pragma unroll
        for (int ks = 0; ks < 2; ++ks) qf[mp][ks] = *(const bf16x8*)(Qp + (size_t)qrow * ldq + mp * 64 + 32 * ks + 8 * g);
    f32x4 o[NMAP][NET];
#pragma unroll
    for (int mp = 0; mp < NMAP; ++mp)
#pragma unroll
        for (int et = 0; et < NET; ++et) o[mp][et] = (f32x4){0.f, 0.f, 0.f, 0.f};
    float mrun[NMAP], lrun[NMAP];
#pragma unroll
    for (int mp = 0; mp < NMAP; ++mp) { mrun[mp] = -1e30f; lrun[mp] = 0.f; }
    const float sc2 = 0.125f * LOG2E;
    const float tq = (float)(tq0 + qrow);
    u32x4 kreg[2][NMAP], vreg[2][NMAP];
#define AT_LOAD(SET, kt) do { _Pragma("unroll") for (int i = 0; i < NMAP; ++i) { const int id = tid + 512 * i; \
        { const int mp = id >> 9, n = (id >> 3) & 63, ch = id & 7; kreg[SET][i] = *(const u32x4*)(Kp + (size_t)((kt) * 64 + n) * ldk + mp * 64 + 8 * ch); } \
        { const int e = id >> 3, ch = id & 7; vreg[SET][i] = *(const u32x4*)(VTp + (size_t)e * ldvt + (kt) * 64 + 8 * ch); } } } while (0)
#define AT_STORE(SET) do { _Pragma("unroll") for (int i = 0; i < NMAP; ++i) { const int id = tid + 512 * i; \
        { const int mp = id >> 9, n = (id >> 3) & 63, ch = id & 7; *(LAS u32x4*)(Ks + (mp * 64 + n) * AT_PITCH + 8 * ch) = kreg[SET][i]; } \
        { const int e = id >> 3, ch = id & 7; *(LAS u32x4*)(Vs + e * AT_PITCH + 8 * ch) = vreg[SET][i]; } } } while (0)
    AT_LOAD(0, nkt_hi - 1);
    if (nkt_hi > 1) AT_LOAD(1, nkt_hi - 2);
    for (int it = 0; it < nkt_hi; ++it) {
        const int kt = nkt_hi - 1 - it;
        __syncthreads();
        if (it & 1) AT_STORE(1); else AT_STORE(0);
        __syncthreads();
        if (kt > 1) { if (it & 1) AT_LOAD(1, kt - 2); else AT_LOAD(0, kt - 2); }
        if (kt < nkt) {
            f32x4 bias[4];
#pragma unroll
            for (int k16 = 0; k16 < 4; ++k16)
#pragma unroll
                for (int j = 0; j < 4; ++j) bias[k16][j] = -slope2 * fabsf(tq - (float)(kt * 64 + 16 * k16 + 4 * g + j));
            bf16x8 pf[NMAP][2]; bool any = false;
#pragma unroll
            for (int mp = 0; mp < NMAP; ++mp) {
                f32x4 st[4];
#pragma unroll
                for (int k16 = 0; k16 < 4; ++k16) {
                    f32x4 acc = (f32x4){0.f, 0.f, 0.f, 0.f};
#pragma unroll
                    for (int ks = 0; ks < 2; ++ks) { const bf16x8 ka = *(const LAS bf16x8*)(Ks + (mp * 64 + 16 * k16 + c) * AT_PITCH + 32 * ks + 8 * g);
                        acc = __builtin_amdgcn_mfma_f32_16x16x32_bf16(ka, qf[mp][ks], acc, 0, 0, 0); }
                    st[k16] = acc * sc2 + bias[k16];
                }
                float m4[4];
#pragma unroll
                for (int k16 = 0; k16 < 4; ++k16) m4[k16] = fmaxf(fmaxf(st[k16].x, st[k16].y), fmaxf(st[k16].z, st[k16].w));
                float mx = fmaxf(fmaxf(m4[0], m4[1]), fmaxf(m4[2], m4[3]));
                mx = fmaxf(mx, __shfl_xor(mx, 16)); mx = fmaxf(mx, __shfl_xor(mx, 32));
                if (__builtin_amdgcn_ballot_w64(mx > mrun[mp] - 40.f) != 0ull) {
                    any = true;
                    const float mnew = fmaxf(mrun[mp], mx), alpha = __builtin_amdgcn_exp2f(mrun[mp] - mnew);
                    mrun[mp] = mnew;
                    float ps = 0.f;
#pragma unroll
                    for (int k16 = 0; k16 < 4; ++k16)
#pragma unroll
                        for (int j = 0; j < 4; ++j) { const float p = __builtin_amdgcn_exp2f(st[k16][j] - mnew); st[k16][j] = p; ps += p; }
                    lrun[mp] = lrun[mp] * alpha + ps;
                    if (__builtin_amdgcn_ballot_w64(alpha != 1.f) != 0ull) {
#pragma unroll
                        for (int et = 0; et < NET; ++et) o[mp][et] = o[mp][et] * alpha;
                    }
#pragma unroll
                    for (int i = 0; i < 2; ++i) { u32x4 w; w.x = pk2(st[2 * i][0], st[2 * i][1]); w.y = pk2(st[2 * i][2], st[2 * i][3]); w.z = pk2(st[2 * i + 1][0], st[2 * i + 1][1]); w.w = pk2(st[2 * i + 1][2], st[2 * i + 1][3]);
                        pf[mp][i] = __builtin_bit_cast(bf16x8, w); }
                } else {
                    pf[mp][0] = (bf16x8){0, 0, 0, 0, 0, 0, 0, 0}; pf[mp][1] = (bf16x8){0, 0, 0, 0, 0, 0, 0, 0};
                }
            }
            if (any) {
#pragma unroll
                for (int et = 0; et < NET; ++et)
#pragma unroll
                    for (int i = 0; i < 2; ++i) {
                        const u32x2 lo = *(const LAS u32x2*)(Vs + (16 * et + c) * AT_PITCH + 32 * i + 4 * g);
                        const u32x2 hi = *(const LAS u32x2*)(Vs + (16 * et + c) * AT_PITCH + 32 * i + 16 + 4 * g);
                        const bf16x8 va = __builtin_bit_cast(bf16x8, (u32x4){lo.x, lo.y, hi.x, hi.y});
#pragma unroll
                        for (int mp = 0; mp < NMAP; ++mp) o[mp][et] = __builtin_amdgcn_mfma_f32_16x16x32_bf16(va, pf[mp][i], o[mp][et], 0, 0, 0);
                    }
            }
        }
    }
#undef AT_LOAD
#undef AT_STORE
    float inv[NMAP];
#pragma unroll
    for (int mp = 0; mp < NMAP; ++mp) { float l = lrun[mp]; l += __shfl_xor(l, 16); l += __shfl_xor(l, 32); inv[mp] = 1.f / l; }
    f32x4 r[NET]; float ss = 0.f;
#pragma unroll
    for (int et = 0; et < NET; ++et) {
        if (NMAP == 2) r[et] = o[0][et] * inv[0] - o[NMAP - 1][et] * (lam * inv[NMAP - 1]);
        else r[et] = o[0][et] * inv[0];
        ss += (r[et].x * r[et].x + r[et].y * r[et].y) + (r[et].z * r[et].z + r[et].w * r[et].w);
    }
    float rs = 1.f;
    if (NMAP == 2) { ss += __shfl_xor(ss, 16); ss += __shfl_xor(ss, 32); rs = oscale / sqrtf(ss * (1.f / EV) + NORM_EPS); }
#pragma unroll
    for (int et = 0; et < NET; ++et) {
        const int e = 16 * et + 4 * g;
        const u32x2 gv = *(const u32x2*)(Gp + (size_t)qrow * ldg + e);
        f32x4 v = r[et] * rs;
        if (NMAP == 2) v = v * *(const f32x4*)(subln + e);
        v.x *= siluf_(bflo(gv.x)); v.y *= siluf_(bfhi(gv.x)); v.z *= siluf_(bflo(gv.y)); v.w *= siluf_(bfhi(gv.y));
        u32x2 w; w.x = pk2(v.x, v.y); w.y = pk2(v.z, v.w);
        *(u32x2*)(Op + (size_t)qrow * ldo + e) = w;
    }
    __syncthreads();
}

__device__ __forceinline__ void mem_attn_unit(const Args& a, LAS unsigned char* lds, int l, int u) {
    unsigned char* ws = a.ws;
    const int b = u >> 6, h = (u >> 4) & 3, qb = u & 15;
    const bf16* PROJ = (const bf16*)(ws + WS_PROJ);
    const int ldp = l ? LDP1 : LDP0, cq = l ? C_QM1 : C_QM0, cg_ = l ? C_GM1 : C_GM0;
    const size_t row0 = (size_t)b * SEQ + qb * 128;
    attn_unit<1>(lds, PROJ + row0 * ldp + cq + h * 64, ldp,
                 (const bf16*)(ws + WS_MK) + (size_t)b * MEML * 512 + l * 256 + h * 64, 512,
                 (const bf16*)(ws + WS_MVT) + (size_t)(l * 256 + h * 64) * MROWS + b * MEML, MROWS,
                 4, 4, 0.f, 0,
                 PROJ + row0 * ldp + cg_ + h * 64, ldp, (bf16*)(ws + WS_CAT) + row0 * DM + BRW + h * 64, DM, nullptr, 0.f, 1.f);
}

constexpr int SK_SLOT = 15360, SK_NT = 0, SK_RT = 2304, SK_BP = 4608, SK_KP = 7168, SK_VT = 9728, SK_PC = 12288, SK_LK = 12544, SK_TT = 13184, SK_MB = 13824, SK_MK = 14464;
constexpr int SK_SCR = 3 * SK_SLOT, SK_SCRW = 7680, SK_BS = 0, SK_KS = 2304, SK_LB = 4608, SK_VM = 5632;
constexpr int SK_P72 = 72, SK_P20 = 20;
constexpr int SK_PRM = SK_SCR + 4 * SK_SCRW, SK_W2L = SK_PRM, SK_A2L = SK_PRM + 9216, SK_PF = SK_PRM + 18432;
enum { PF_W0 = 0, PF_A0, PF_KK, PF_KA, PF_RK, PF_MUR, PF_MUK, PF_MUWD, PF_MUAD, PF_MUV };
__device__ __forceinline__ bf16x8 lds2x8(const LAS bf16* p, int offa, int offb) { const u32x2 a = *(const LAS u32x2*)(p + offa), b = *(const LAS u32x2*)(p + offb); return __builtin_bit_cast(bf16x8, (u32x4){a.x, a.y, b.x, b.y}); }
__device__ __forceinline__ bf16x8 lds8z(const LAS bf16* p, int offa) { const u32x2 a = *(const LAS u32x2*)(p + offa); return __builtin_bit_cast(bf16x8, (u32x4){a.x, a.y, 0u, 0u}); }
__device__ __forceinline__ void scan_unit(const Args& a, LAS unsigned char* lds, int b, int h) {
    const int tid = threadIdx.x, lane = tid & 63, wave = __builtin_amdgcn_readfirstlane(tid >> 6), g = lane >> 4, c = lane & 15;
    unsigned char* ws = a.ws;
    const bf16* PROJ = (const bf16*)(ws + WS_PROJ);
    bf16* CAT = (bf16*)(ws + WS_CAT);
    const size_t mb = (size_t)b * SEQ;
    constexpr int NBLK = SEQ / 16;
    const f32x4 Z4 = {0.f, 0.f, 0.f, 0.f};
    {
        const bf16* W2T = (const bf16*)(ws + WS_W2T);
        for (int i = tid; i < 2 * 64 * 8; i += 512) { const int m = i >> 9, key = (i >> 3) & 63, ch = i & 7;
            const u32x4 v = *(const u32x4*)(W2T + (size_t)m * 768 * 64 + (size_t)(h * 64 + key) * 64 + 8 * ch);
            *(LAS u32x4*)(lds + (m ? SK_A2L : SK_W2L) + (((key & 3) * 16 + (key >> 2)) * SK_P72 + 8 * ch) * 2) = v; }
        for (int i = tid; i < 10 * 64; i += 512) { const int w = i >> 6, k = i & 63; float v;
            switch (w) { case PF_W0: v = a.in[I_AW0][h * 64 + k]; break; case PF_A0: v = a.in[I_AA0][h * 64 + k]; break; case PF_KK: v = a.in[I_AKK][h * 64 + k]; break;
                         case PF_KA: v = a.in[I_AKA][h * 64 + k]; break; case PF_RK: v = a.in[I_ARK][h * 64 + k]; break; case PF_MUR: v = a.in[I_AMU][C_R + h * 64 + k]; break;
                         case PF_MUK: v = a.in[I_AMU][C_K + h * 64 + k]; break; case PF_MUWD: v = a.in[I_AMU][C_WD + k]; break; case PF_MUAD: v = a.in[I_AMU][C_AD + k]; break;
                         default: v = a.in[I_AMU][C_V + h * 64 + k]; break; }
            ((LAS float*)(lds + SK_PF))[i] = v; }
        __syncthreads();
    }
    if (wave < 4) {
        f32x4 St[4] = {Z4, Z4, Z4, Z4};
        for (int q = 0; q < 4; ++q) __syncthreads();
        for (int blk = 0; blk < NBLK; ++blk) {
            const LAS unsigned char* sl = lds + (blk % 3) * SK_SLOT;
            const LAS bf16* NT = (const LAS bf16*)(sl + SK_NT); const LAS bf16* RT = (const LAS bf16*)(sl + SK_RT);
            const LAS bf16* BP = (const LAS bf16*)(sl + SK_BP); const LAS bf16* KP = (const LAS bf16*)(sl + SK_KP);
            const LAS bf16* VT = (const LAS bf16*)(sl + SK_VT); const LAS float* PC = (const LAS float*)(sl + SK_PC);
            const LAS bf16* LK = (const LAS bf16*)(sl + SK_LK); const LAS bf16* TT = (const LAS bf16*)(sl + SK_TT);
            const LAS bf16* MB = (const LAS bf16*)(sl + SK_MB); const LAS bf16* MK = (const LAS bf16*)(sl + SK_MK);
            bf16x8 sbh[2], sbl[2];
#pragma unroll
            for (int ks = 0; ks < 2; ++ks) {
                const f32x4 x = St[2 * ks], y = St[2 * ks + 1];
                u32x4 hh; hh.x = pk2(x.x, x.y); hh.y = pk2(x.z, x.w); hh.z = pk2(y.x, y.y); hh.w = pk2(y.z, y.w);
                u32x4 ll; ll.x = pk2(x.x - bflo(hh.x), x.y - bfhi(hh.x)); ll.y = pk2(x.z - bflo(hh.y), x.w - bfhi(hh.y));
                ll.z = pk2(y.x - bflo(hh.z), y.y - bfhi(hh.z)); ll.w = pk2(y.z - bflo(hh.w), y.w - bfhi(hh.w));
                sbh[ks] = __builtin_bit_cast(bf16x8, hh); sbl[ks] = __builtin_bit_cast(bf16x8, ll);
            }
            const bf16x8 An0 = lds2x8(NT, c * SK_P72 + 4 * g, c * SK_P72 + 16 + 4 * g), An1 = lds2x8(NT, c * SK_P72 + 32 + 4 * g, c * SK_P72 + 48 + 4 * g);
            const bf16x8 Ar0 = lds2x8(RT, c * SK_P72 + 4 * g, c * SK_P72 + 16 + 4 * g), Ar1 = lds2x8(RT, c * SK_P72 + 32 + 4 * g, c * SK_P72 + 48 + 4 * g);
            const u32x2 vq = *(const LAS u32x2*)(VT + (16 * wave + c) * SK_P20 + 4 * g);
            const bf16x8 vlo = __builtin_bit_cast(bf16x8, (u32x4){vq.x, vq.y, 0u, 0u});
            const bf16x8 Alk = lds8z(LK, c * SK_P20 + 4 * g), At = lds8z(TT, c * SK_P20 + 4 * g);
            const bf16x8 Amk = lds2x8(MB, c * SK_P20 + 4 * g, (int)((SK_MK - SK_MB) / 2) + c * SK_P20 + 4 * g);
            f32x4 X = __builtin_amdgcn_mfma_f32_16x16x32_bf16(An0, sbh[0], Z4, 0, 0, 0);
            X = __builtin_amdgcn_mfma_f32_16x16x32_bf16(An1, sbh[1], X, 0, 0, 0);
            X = __builtin_amdgcn_mfma_f32_16x16x32_bf16(An0, sbl[0], X, 0, 0, 0);
            X = __builtin_amdgcn_mfma_f32_16x16x32_bf16(An1, sbl[1], X, 0, 0, 0);
            X = __builtin_amdgcn_mfma_f32_16x16x32_bf16(Alk, vlo, X, 0, 0, 0);
            f32x4 Y = __builtin_amdgcn_mfma_f32_16x16x32_bf16(Ar0, sbh[0], Z4, 0, 0, 0);
            Y = __builtin_amdgcn_mfma_f32_16x16x32_bf16(Ar1, sbh[1], Y, 0, 0, 0);
            Y = __builtin_amdgcn_mfma_f32_16x16x32_bf16(Ar0, sbl[0], Y, 0, 0, 0);
            Y = __builtin_amdgcn_mfma_f32_16x16x32_bf16(Ar1, sbl[1], Y, 0, 0, 0);
            const bf16x8 xb = __builtin_bit_cast(bf16x8, (u32x4){pk2(X.x, X.y), pk2(X.z, X.w), 0u, 0u});
            const f32x4 U = __builtin_amdgcn_mfma_f32_16x16x32_bf16(At, xb, Z4, 0, 0, 0);
            const bf16x8 ub = __builtin_bit_cast(bf16x8, (u32x4){pk2(U.x, U.y), pk2(U.z, U.w), vq.x, vq.y});
            Y = __builtin_amdgcn_mfma_f32_16x16x32_bf16(Amk, ub, Y, 0, 0, 0);
#pragma unroll
            for (int kt = 0; kt < 4; ++kt) {
                const f32x4 pc4 = *(const LAS f32x4*)(PC + 16 * kt + 4 * g);
                const bf16x8 Abk = lds2x8(BP, (16 * kt + c) * SK_P20 + 4 * g, (int)((SK_KP - SK_BP) / 2) + (16 * kt + c) * SK_P20 + 4 * g);
                St[kt] = __builtin_amdgcn_mfma_f32_16x16x32_bf16(Abk, ub, St[kt] * pc4, 0, 0, 0);
            }
            bf16* yp = CAT + (mb + (size_t)blk * 16 + 4 * g) * DM + h * 64 + 16 * wave + c;
            yp[0] = (bf16)f2bf(Y.x); yp[DM] = (bf16)f2bf(Y.y); yp[2 * DM] = (bf16)f2bf(Y.z); yp[3 * DM] = (bf16)f2bf(Y.w);
            __syncthreads();
        }
    } else {
        const int pw = wave - 4;
        const int kc = h * 64 + 4 * c;
        const LAS float* PF = (const LAS float*)(lds + SK_PF); const LAS bf16* W2L = (const LAS bf16*)(lds + SK_W2L); const LAS bf16* A2L = (const LAS bf16*)(lds + SK_A2L);
        LAS unsigned char* scr = lds + SK_SCR + pw * SK_SCRW;
        LAS bf16* BSs = (LAS bf16*)(scr + SK_BS); LAS bf16* KSs = (LAS bf16*)(scr + SK_KS); LAS float* LBs = (LAS float*)(scr + SK_LB);
        u32x4 zwd[2], zwdp[2], zad[2], zadp[2], zv[2], zvp[2]; u32x2 zr[4], zrp[4], zk[4], zkp[4];
#define SK_LOAD_A(T0) do { const bf16* cur = PROJ + (mb + (T0) + c) * LDP0; const bf16* prv = ((T0) + c == 0) ? cur : cur - LDP0; \
        _Pragma("unroll") for (int ks = 0; ks < 2; ++ks) { zwd[ks] = *(const u32x4*)(cur + C_WD + 32 * ks + 8 * g); zwdp[ks] = *(const u32x4*)(prv + C_WD + 32 * ks + 8 * g); \
            zad[ks] = *(const u32x4*)(cur + C_AD + 32 * ks + 8 * g); zadp[ks] = *(const u32x4*)(prv + C_AD + 32 * ks + 8 * g); } } while (0)
#define SK_LOAD_V(T0) do { \
        { const int sv_ = lane >> 2, cv_ = lane & 3; const bf16* cs = PROJ + (mb + (T0) + sv_) * LDP0; const bf16* ps = ((T0) + sv_ == 0) ? cs : cs - LDP0; \
          _Pragma("unroll") for (int i = 0; i < 2; ++i) { zv[i] = *(const u32x4*)(cs + C_V + h * 64 + 16 * cv_ + 8 * i); zvp[i] = *(const u32x4*)(ps + C_V + h * 64 + 16 * cv_ + 8 * i); } } } while (0)
#define SK_LOAD_B(T0) do { _Pragma("unroll") for (int jj = 0; jj < 4; ++jj) { const int s_ = 4 * g + jj; const bf16* cs = PROJ + (mb + (T0) + s_) * LDP0; const bf16* ps = ((T0) + s_ == 0) ? cs : cs - LDP0; \
            zr[jj] = *(const u32x2*)(cs + C_R + kc); zrp[jj] = *(const u32x2*)(ps + C_R + kc); zk[jj] = *(const u32x2*)(cs + C_K + kc); zkp[jj] = *(const u32x2*)(ps + C_K + kc); } } while (0)
        SK_LOAD_A(pw * 16); SK_LOAD_V(pw * 16); SK_LOAD_B(pw * 16);
        for (int q = 0; q < pw; ++q) __syncthreads();
        for (int n = 0; n < NBLK / 4; ++n) {
            const int blk = 4 * n + pw, t0 = blk * 16, t0n = (blk + 4 < NBLK) ? t0 + 64 : t0;
            LAS unsigned char* sl = lds + (blk % 3) * SK_SLOT;
            int c_o = c; asm volatile("" : "+v"(c_o));
            const float pz_c = (t0 + c == 0) ? 0.f : 1.f;
            f32x4 accw[4], acca[4];
            {
                bf16x8 Aw[2], Aa[2];
#pragma unroll
                for (int ks = 0; ks < 2; ++ks) {
                    const f32x4 m0 = *(const LAS f32x4*)(PF + PF_MUWD * 64 + 32 * ks + 8 * g), m1 = *(const LAS f32x4*)(PF + PF_MUWD * 64 + 32 * ks + 8 * g + 4);
                    const f32x4 n0 = *(const LAS f32x4*)(PF + PF_MUAD * 64 + 32 * ks + 8 * g), n1 = *(const LAS f32x4*)(PF + PF_MUAD * 64 + 32 * ks + 8 * g + 4);
                    float xw[8], xa[8];
#pragma unroll
                    for (int e = 0; e < 4; ++e) {
                        const unsigned uw = zwd[ks][e], up = zwdp[ks][e], ua = zad[ks][e], uq = zadp[ks][e];
                        const float muw0 = (e < 2) ? m0[2 * e] : m1[2 * e - 4], muw1 = (e < 2) ? m0[2 * e + 1] : m1[2 * e - 3];
                        const float mua0 = (e < 2) ? n0[2 * e] : n1[2 * e - 4], mua1 = (e < 2) ? n0[2 * e + 1] : n1[2 * e - 3];
                        float z0 = bflo(uw), z1 = bfhi(uw);
                        z0 = z0 + (bflo(up) * pz_c - z0) * muw0; z1 = z1 + (bfhi(up) * pz_c - z1) * muw1;
                        xw[2 * e] = 1.f - 2.f * __builtin_amdgcn_rcpf(1.f + __builtin_amdgcn_exp2f(2.8853900817779268f * z0));
                        xw[2 * e + 1] = 1.f - 2.f * __builtin_amdgcn_rcpf(1.f + __builtin_amdgcn_exp2f(2.8853900817779268f * z1));
                        float y0 = bflo(ua), y1 = bfhi(ua);
                        xa[2 * e] = y0 + (bflo(uq) * pz_c - y0) * mua0; xa[2 * e + 1] = y1 + (bfhi(uq) * pz_c - y1) * mua1;
                    }
                    u32x4 w; w.x = pk2(xw[0], xw[1]); w.y = pk2(xw[2], xw[3]); w.z = pk2(xw[4], xw[5]); w.w = pk2(xw[6], xw[7]); Aw[ks] = __builtin_bit_cast(bf16x8, w);
                    u32x4 x; x.x = pk2(xa[0], xa[1]); x.y = pk2(xa[2], xa[3]); x.z = pk2(xa[4], xa[5]); x.w = pk2(xa[6], xa[7]); Aa[ks] = __builtin_bit_cast(bf16x8, x);
                }
                {
                    unsigned vm[8];
                    const int sv = lane >> 2, cv = lane & 3; const float pz = (t0 + sv == 0) ? 0.f : 1.f;
#pragma unroll
                    for (int i = 0; i < 2; ++i) {
                        const LAS float* mv = PF + PF_MUV * 64 + 16 * cv + 8 * i;
                        const f32x4 m0 = *(const LAS f32x4*)mv, m1 = *(const LAS f32x4*)(mv + 4);
#pragma unroll
                        for (int e = 0; e < 4; ++e) {
                            const unsigned uc = zv[i][e], up = zvp[i][e];
                            const float ma = (e < 2) ? m0[2 * e] : m1[2 * e - 4], mb_ = (e < 2) ? m0[2 * e + 1] : m1[2 * e - 3];
                            float z0 = bflo(uc), z1 = bfhi(uc);
                            z0 = z0 + (bflo(up) * pz - z0) * ma; z1 = z1 + (bfhi(up) * pz - z1) * mb_;
                            vm[4 * i + e] = pk2(z0, z1);
                        }
                    }
                    *(LAS u32x4*)(scr + SK_VM + lane * 32) = (u32x4){vm[0], vm[1], vm[2], vm[3]}; *(LAS u32x4*)(scr + SK_VM + lane * 32 + 16) = (u32x4){vm[4], vm[5], vm[6], vm[7]};
                }
                SK_LOAD_A(t0n);
#pragma unroll
                for (int nt = 0; nt < 4; ++nt) {
                    const bf16x8 wf0 = *(const LAS bf16x8*)(W2L + (nt * 16 + c) * SK_P72 + 8 * g), wf1 = *(const LAS bf16x8*)(W2L + (nt * 16 + c) * SK_P72 + 32 + 8 * g);
                    const bf16x8 af0 = *(const LAS bf16x8*)(A2L + (nt * 16 + c) * SK_P72 + 8 * g), af1 = *(const LAS bf16x8*)(A2L + (nt * 16 + c) * SK_P72 + 32 + 8 * g);
                    accw[nt] = __builtin_amdgcn_mfma_f32_16x16x32_bf16(Aw[0], wf0, Z4, 0, 0, 0);
                    accw[nt] = __builtin_amdgcn_mfma_f32_16x16x32_bf16(Aw[1], wf1, accw[nt], 0, 0, 0);
                    acca[nt] = __builtin_amdgcn_mfma_f32_16x16x32_bf16(Aa[0], af0, Z4, 0, 0, 0);
                    acca[nt] = __builtin_amdgcn_mfma_f32_16x16x32_bf16(Aa[1], af1, acca[nt], 0, 0, 0);
                }
            }
            __syncthreads();
            u32x2 ntp[4], rtp[4], bpp[4], kpp[4]; f32x4 pcv;
            {
                f32x4 dec[4], E4;
                const f32x4 p_w0 = *(const LAS f32x4*)(PF + PF_W0 * 64 + 4 * c);
#pragma unroll
                for (int jj = 0; jj < 4; ++jj)
#pragma unroll
                    for (int nt = 0; nt < 4; ++nt) dec[jj][nt] = __builtin_amdgcn_exp2f(-0.8750322163622201f * sigmoidf_(p_w0[nt] + accw[nt][jj]));
#pragma unroll
                for (int nt = 0; nt < 4; ++nt) {
                    const float p3 = (dec[0][nt] * dec[1][nt]) * (dec[2][nt] * dec[3][nt]);
                    const float q0 = __shfl(p3, c), q1 = __shfl(p3, c + 16), q2 = __shfl(p3, c + 32), q3 = __shfl(p3, c + 48);
                    E4[nt] = ((g > 0) ? q0 : 1.f) * ((g > 1) ? q1 : 1.f) * ((g > 2) ? q2 : 1.f);
                    pcv[nt] = (q0 * q1) * (q2 * q3);
                }
                const f32x4 p_a0 = *(const LAS f32x4*)(PF + PF_A0 * 64 + 4 * c), p_kk = *(const LAS f32x4*)(PF + PF_KK * 64 + 4 * c), p_ka = *(const LAS f32x4*)(PF + PF_KA * 64 + 4 * c),
                            p_rk = *(const LAS f32x4*)(PF + PF_RK * 64 + 4 * c), mu_r = *(const LAS f32x4*)(PF + PF_MUR * 64 + 4 * c), mu_k = *(const LAS f32x4*)(PF + PF_MUK * 64 + 4 * c);
                f32x4 pex = E4, bprev, kprev;
#pragma unroll
                for (int jj = 0; jj < 4; ++jj) {
                    if (jj == 2) __syncthreads();
                    const int s = 4 * g + jj;
                    const float pz = (t0 + s == 0) ? 0.f : 1.f;
                    const f32x4 pin = pex * dec[jj];
                    f32x4 rr, kp4, ku, aa;
                    const unsigned ur[2] = {zr[jj].x, zr[jj].y}, urp[2] = {zrp[jj].x, zrp[jj].y}, uk[2] = {zk[jj].x, zk[jj].y}, ukp[2] = {zkp[jj].x, zkp[jj].y};
                    float ssq = 0.f, bs = 0.f;
#pragma unroll
                    for (int nt = 0; nt < 4; ++nt) {
                        const float zc = (nt & 1) ? bfhi(ur[nt >> 1]) : bflo(ur[nt >> 1]), zp = ((nt & 1) ? bfhi(urp[nt >> 1]) : bflo(urp[nt >> 1])) * pz;
                        const float kc_ = (nt & 1) ? bfhi(uk[nt >> 1]) : bflo(uk[nt >> 1]), kp_ = ((nt & 1) ? bfhi(ukp[nt >> 1]) : bflo(ukp[nt >> 1])) * pz;
                        rr[nt] = zc + (zp - zc) * mu_r[nt];
                        const float kk = kc_ + (kp_ - kc_) * mu_k[nt];
                        aa[nt] = sigmoidf_(p_a0[nt] + acca[nt][jj]);
                        ku[nt] = kk * p_kk[nt];
                        ssq += ku[nt] * ku[nt];
                        kp4[nt] = kk * (1.f + (aa[nt] - 1.f) * p_ka[nt]);
                        bs += rr[nt] * kp4[nt] * p_rk[nt];
                    }
                    ssq = sum16(ssq); bs = sum16(bs);
                    if (c == 0) ((float*)(ws + WS_BS))[(mb + t0 + s) * AH + h] = bs;
                    const float rn = __builtin_amdgcn_rsqf(fmaxf(ssq, 1e-12f));
                    f32x4 rp; rp.x = __builtin_amdgcn_rcpf(pin.x); rp.y = __builtin_amdgcn_rcpf(pin.y); rp.z = __builtin_amdgcn_rcpf(pin.z); rp.w = __builtin_amdgcn_rcpf(pin.w);
                    const f32x4 kn = ku * rn;
                    const f32x4 nt_ = pex * (-kn), bt = kn * aa * rp, kt_ = kp4 * rp, rt = pin * rr;
                    const f32x4 bpc = bt * pcv, kpc = kt_ * pcv;
                    ntp[jj] = (u32x2){pk2(nt_.x, nt_.y), pk2(nt_.z, nt_.w)};
                    rtp[jj] = (u32x2){pk2(rt.x, rt.y), pk2(rt.z, rt.w)};
                    *(LAS u32x2*)(BSs + s * SK_P72 + 4 * c) = (u32x2){pk2(bt.x, bt.y), pk2(bt.z, bt.w)};
                    *(LAS u32x2*)(KSs + s * SK_P72 + 4 * c) = (u32x2){pk2(kt_.x, kt_.y), pk2(kt_.z, kt_.w)};
                    if (jj & 1) {
#pragma unroll
                        for (int nt = 0; nt < 4; ++nt) { if (jj == 1) { bpp[nt].x = pk2(bprev[nt], bpc[nt]); kpp[nt].x = pk2(kprev[nt], kpc[nt]); } else { bpp[nt].y = pk2(bprev[nt], bpc[nt]); kpp[nt].y = pk2(kprev[nt], kpc[nt]); } }
                    } else { bprev = bpc; kprev = kpc; }
                    pex = pin;
                }
                SK_LOAD_B(t0n);
            }
            SK_LOAD_V(t0n);
            {
                LAS bf16* NT = (LAS bf16*)(sl + SK_NT); LAS bf16* RT = (LAS bf16*)(sl + SK_RT);
                LAS bf16* BP = (LAS bf16*)(sl + SK_BP); LAS bf16* KP = (LAS bf16*)(sl + SK_KP);
#pragma unroll
                for (int jj = 0; jj < 4; ++jj) { const int s = 4 * g + jj;
                    *(LAS u32x2*)(NT + s * SK_P72 + 4 * c) = ntp[jj]; *(LAS u32x2*)(RT + s * SK_P72 + 4 * c) = rtp[jj]; }
#pragma unroll
                for (int nt = 0; nt < 4; ++nt) { *(LAS u32x2*)(BP + (4 * c + nt) * SK_P20 + 4 * g) = bpp[nt]; *(LAS u32x2*)(KP + (4 * c + nt) * SK_P20 + 4 * g) = kpp[nt]; }
                if (g == 0) *(LAS f32x4*)((LAS float*)(sl + SK_PC) + 4 * c) = pcv;
                { const int sv = lane >> 2, cv = lane & 3; LAS bf16* VT = (LAS bf16*)(sl + SK_VT);
                  const u32x4 va_ = *(const LAS u32x4*)(scr + SK_VM + lane * 32), vb_ = *(const LAS u32x4*)(scr + SK_VM + lane * 32 + 16);
                  const unsigned vm[8] = {va_.x, va_.y, va_.z, va_.w, vb_.x, vb_.y, vb_.z, vb_.w};
#pragma unroll
                  for (int i = 0; i < 8; ++i) { VT[(16 * cv + 2 * i) * SK_P20 + sv] = (bf16)(vm[i] & 0xffffu); VT[(16 * cv + 2 * i + 1) * SK_P20 + sv] = (bf16)(vm[i] >> 16); } }
                asm volatile("s_waitcnt lgkmcnt(0)" ::: "memory");
                f32x4 Lb = Z4, Lk = Z4, Mb = Z4, Mk = Z4;
#pragma unroll
                for (int ks = 0; ks < 2; ++ks) {
                    const bf16x8 ab = *(const LAS bf16x8*)(BSs + c * SK_P72 + 32 * ks + 8 * g), ak = *(const LAS bf16x8*)(KSs + c * SK_P72 + 32 * ks + 8 * g);
                    const bf16x8 bn = *(const LAS bf16x8*)(NT + c * SK_P72 + 32 * ks + 8 * g), br = *(const LAS bf16x8*)(RT + c * SK_P72 + 32 * ks + 8 * g);
                    Lb = __builtin_amdgcn_mfma_f32_16x16x32_bf16(ab, bn, Lb, 0, 0, 0);
                    Lk = __builtin_amdgcn_mfma_f32_16x16x32_bf16(ak, bn, Lk, 0, 0, 0);
                    Mb = __builtin_amdgcn_mfma_f32_16x16x32_bf16(ab, br, Mb, 0, 0, 0);
                    Mk = __builtin_amdgcn_mfma_f32_16x16x32_bf16(ak, br, Mk, 0, 0, 0);
                }
#pragma unroll
                for (int j = 0; j < 4; ++j) { const int s = 4 * g + j; if (!(s < c)) { Lb[j] = 0.f; Lk[j] = 0.f; } if (!(s <= c)) { Mb[j] = 0.f; Mk[j] = 0.f; } }
                *(LAS u32x2*)((LAS bf16*)(sl + SK_LK) + c * SK_P20 + 4 * g) = (u32x2){pk2(Lk[0], Lk[1]), pk2(Lk[2], Lk[3])};
                *(LAS u32x2*)((LAS bf16*)(sl + SK_MB) + c * SK_P20 + 4 * g) = (u32x2){pk2(Mb[0], Mb[1]), pk2(Mb[2], Mb[3])};
                *(LAS u32x2*)((LAS bf16*)(sl + SK_MK) + c * SK_P20 + 4 * g) = (u32x2){pk2(Mk[0], Mk[1]), pk2(Mk[2], Mk[3])};
                *(LAS f32x4*)(LBs + c * 16 + 4 * g) = Lb;
            }
            __syncthreads();
            {
                float Ti[16];
#pragma unroll
                for (int t = 0; t < 16; ++t) {
                    float acc = (c_o == t) ? 1.f : 0.f;
                    if ((t & 3) == 0) asm volatile("" ::: "memory");
#pragma unroll
                    for (int s4 = 0; s4 < (t + 3) / 4; ++s4) {
                        const f32x4 l4 = *(const LAS f32x4*)(LBs + t * 16 + 4 * s4);
#pragma unroll
                        for (int e = 0; e < 4; ++e) if (4 * s4 + e < t) acc += Ti[4 * s4 + e] * l4[e];
                    }
                    Ti[t] = acc;
                }
                if (g == 0) {
                    LAS bf16* TT = (LAS bf16*)(sl + SK_TT);
#pragma unroll
                    for (int t = 0; t < 16; ++t) TT[t * SK_P20 + c] = (bf16)f2bf(Ti[t]);
                }
            }
            __syncthreads();
        }
#undef SK_LOAD_A
#undef SK_LOAD_V
#undef SK_LOAD_B
        for (int q = 0; q < 4 - pw; ++q) __syncthreads();
    }
}

__device__ __forceinline__ void phase_scan(const Args& a, LAS unsigned char* lds) {
    const int G = gridDim.x, bx = blockIdx.x;
    if (bx < 96) { scan_unit(a, lds, bx / 12, bx % 12); }
    else { for (int u = bx - 96; u < 512; u += G - 96) mem_attn_unit(a, lds, 0, u);
           const int wave = __builtin_amdgcn_readfirstlane(threadIdx.x >> 6);
           transpose_group<1>(a, lds, (bx - 96) * 8 + wave, (G - 96) * 8); }
}

__device__ __forceinline__ void phase_rwkv_post(const Args& a) {
    const int tid = threadIdx.x, lane = tid & 63, wave = tid >> 6, G = gridDim.x;
    unsigned char* ws = a.ws;
    const bf16* PROJ = (const bf16*)(ws + WS_PROJ); bf16* CAT = (bf16*)(ws + WS_CAT); const float* BS = (const float*)(ws + WS_BS);
    const float* mu = a.in[I_AMU];
    for (int m = blockIdx.x * 8 + wave; m < MTOK; m += G * 8) {
        const int t = m & (SEQ - 1);
        const bf16* pc = PROJ + (size_t)m * LDP0; const bf16* pp = (t == 0) ? pc : pc - LDP0; const float pz = (t == 0) ? 0.f : 1.f;
#pragma unroll
        for (int i = 0; i < 3; ++i) {
            const int col = 256 * i + 4 * lane, hh = col >> 6;
            const u32x2 yv = *(const u32x2*)(CAT + (size_t)m * DM + col);
            float y[4] = {bflo(yv.x), bfhi(yv.x), bflo(yv.y), bfhi(yv.y)};
            const float mean = sum16((y[0] + y[1]) + (y[2] + y[3])) * (1.f / 64.f);
            float d[4], vs = 0.f;
#pragma unroll
            for (int j = 0; j < 4; ++j) { d[j] = y[j] - mean; vs += d[j] * d[j]; }
            const float rstd = 1.f / sqrtf(sum16(vs) * (1.f / 64.f) + LNX_EPS);
            const f32x4 lw = *(const f32x4*)(a.in[I_ALNW] + col), lb = *(const f32x4*)(a.in[I_ALNB] + col), mv = *(const f32x4*)(mu + C_V + col);
            const u32x2 vc = *(const u32x2*)(pc + C_V + col), vp = *(const u32x2*)(pp + C_V + col), gt = *(const u32x2*)(pc + C_GATE0 + col);
            const float vcur[4] = {bflo(vc.x), bfhi(vc.x), bflo(vc.y), bfhi(vc.y)}, vprv[4] = {bflo(vp.x) * pz, bfhi(vp.x) * pz, bflo(vp.y) * pz, bfhi(vp.y) * pz};
            const float gg[4] = {bflo(gt.x), bfhi(gt.x), bflo(gt.y), bfhi(gt.y)};
            const float bs = BS[(size_t)m * AH + hh];
            float o[4];
#pragma unroll
            for (int j = 0; j < 4; ++j) { const float v = vcur[j] + (vprv[j] - vcur[j]) * mv[j];
                o[j] = (d[j] * rstd * lw[j] + lb[j] + bs * v) * siluf_(gg[j]); }
            u32x2 w; w.x = pk2(o[0], o[1]); w.y = pk2(o[2], o[3]);
            *(u32x2*)(CAT + (size_t)m * DM + col) = w;
        }
    }
}

template <int LAYER>
__device__ __forceinline__ void phase_rows(const Args& a) {
    const int tid = threadIdx.x, lane = tid & 63, wave = tid >> 6, G = gridDim.x;
    unsigned char* ws = a.ws;
    const float* Y = (const float*)(ws + WS_Y); const float* gpost = a.in[I_POST] + LAYER * DM;
    const float* xin = LAYER ? (const float*)a.out : a.in[I_X];
    bf16* XN = (bf16*)(ws + WS_XN);
    for (int m = blockIdx.x * 8 + wave; m < MTOK; m += G * 8) {
        const f32x4* yr = (const f32x4*)(Y + (size_t)m * DM) + lane; const f32x4* xr = (const f32x4*)(xin + (size_t)m * DM) + lane;
        f32x4 y[4], x[4]; float s = 0.f;
#pragma unroll
        for (int j = 0; j < 4; ++j) { y[j] = yr[64 * j]; x[j] = xr[64 * j]; s += (y[j].x * y[j].x + y[j].y * y[j].y) + (y[j].z * y[j].z + y[j].w * y[j].w); }
        const float rs = 1.f / sqrtf(wave_sum(s) * (1.f / DM) + NORM_EPS);
        float s1 = 0.f;
        f32x4* orow = (f32x4*)(a.out + (size_t)m * DM) + lane;
#pragma unroll
        for (int j = 0; j < 4; ++j) { const f32x4 gp = *((const f32x4*)gpost + lane + 64 * j);
            x[j] = x[j] + y[j] * rs * gp; orow[64 * j] = x[j];
            s1 += (x[j].x * x[j].x + x[j].y * x[j].y) + (x[j].z * x[j].z + x[j].w * x[j].w); }
        if (LAYER == 0) {
            const float r1 = 1.f / sqrtf(wave_sum(s1) * (1.f / DM) + NORM_EPS);
            unsigned long long* o8 = (unsigned long long*)(XN + (size_t)m * DM) + lane;
#pragma unroll
            for (int j = 0; j < 4; ++j) o8[64 * j] = (unsigned long long)pk2(x[j].x * r1, x[j].y * r1) | ((unsigned long long)pk2(x[j].z * r1, x[j].w * r1) << 32);
        }
    }
}

__device__ __forceinline__ void phase_attn1(const Args& a, LAS unsigned char* lds) {
    const int G = gridDim.x, bx = blockIdx.x, lane = threadIdx.x & 63;
    unsigned char* ws = a.ws;
    const float s1 = wave_sum(a.in[I_LQ1][lane] * a.in[I_LK1][lane]), s2 = wave_sum(a.in[I_LQ2][lane] * a.in[I_LK2][lane]);
    const float lam_init = 0.8f - 0.6f * 0.7408182206817179f;
    const float lam = __expf(s1) - __expf(s2) + lam_init;
    const bf16* PROJ = (const bf16*)(ws + WS_PROJ); const bf16* VT = (const bf16*)(ws + WS_VT); bf16* CAT = (bf16*)(ws + WS_CAT);
    const float slopes[6] = {0.25f, 0.0625f, 0.015625f, 0.00390625f, 0.5f, 0.125f};
    for (int i = 0; i < 3; ++i) {
        int qb, bh;
        if (G == 256) { const int x = bx & 7, w = bx >> 3; const int n = (i == 1) ? (63 - w) : (32 * i + w); qb = 15 - n / 6; bh = 6 * x + n % 6; }
        else { const int n = i * G + bx; if (n >= 768) break; qb = 15 - n / 48; bh = n % 48; }
        const int b = bh / 6, h = bh % 6;
        const size_t row0 = (size_t)b * SEQ + qb * 128;
        float slope = slopes[0];
#pragma unroll
        for (int k = 1; k < 6; ++k) slope = (h == k) ? slopes[k] : slope;
        attn_unit<2>(lds, PROJ + row0 * LDP1 + C_Q1 + h * 128, LDP1,
                     PROJ + (size_t)b * SEQ * LDP1 + C_KSH + h * 128, LDP1,
                     VT + (size_t)(h * 128) * MTOK + (size_t)b * SEQ, MTOK,
                     2 * qb + 1, 2 * qb + 2, slope * LOG2E, qb * 128,
                     PROJ + row0 * LDP1 + C_GATE1 + h * 128, LDP1, CAT + row0 * DM + h * 128, DM, a.in[I_SUBLN], lam, 1.f - lam_init);
    }
    for (int u = bx; u < 512; u += G) mem_attn_unit(a, lds, 1, u);
}

__device__ __forceinline__ unsigned gb_ld(unsigned* p) { return __hip_atomic_load(p, __ATOMIC_RELAXED, __HIP_MEMORY_SCOPE_AGENT); }
__device__ __forceinline__ unsigned gb_add(unsigned* p) { return __hip_atomic_fetch_add(p, 1u, __ATOMIC_RELAXED, __HIP_MEMORY_SCOPE_AGENT); }
__device__ __forceinline__ void grid_barrier(unsigned* bar, unsigned gen) {
    asm volatile("s_waitcnt vmcnt(0)" ::: "memory");
    __syncthreads();
    if (threadIdx.x == 0) {
        const unsigned grp = blockIdx.x & 7u, nloc = gridDim.x >> 3;
        unsigned* GA = bar + 64 * grp; unsigned* GR = bar + 64 * (8 + grp); unsigned* TOP = bar + 64 * 16; unsigned* TOPGEN = bar + 64 * 17;
        __builtin_amdgcn_fence(__ATOMIC_RELEASE, "agent");
        asm volatile("s_waitcnt vmcnt(0)" ::: "memory");
        if (gb_add(GA) + 1u == gen * nloc) {
            if (gb_add(TOP) + 1u == gen * 8u) (void)gb_add(TOPGEN);
            else while (gb_ld(TOPGEN) < gen) __builtin_amdgcn_s_sleep(1);
            (void)gb_add(GR);
        } else {
            while (gb_ld(GR) < gen) __builtin_amdgcn_s_sleep(1);
        }
        __builtin_amdgcn_fence(__ATOMIC_ACQUIRE, "agent");
        asm volatile("s_waitcnt vmcnt(0)" ::: "memory");
    }
    __syncthreads();
}

constexpr int N_PHASES = 10;
__global__ void __launch_bounds__(512, 2) yoco_fwd(Args args) {
    extern __shared__ __attribute__((aligned(16))) unsigned char lds_raw[];
    LAS unsigned char* lds = (LAS unsigned char*)lds_raw;
    const int lo = args.ph_lo, hi = args.ph_hi;
#ifndef ONLY_PHASE
#define ONLY_PHASE -1
#endif
#define IN(k) ((ONLY_PHASE < 0 || ONLY_PHASE == (k)) && lo <= (k) && (k) < hi)
    unsigned* bar_cnt = (unsigned*)args.ws; unsigned bar_gen = 0;
#define SEAM(k) do { if (IN(k) && IN((k) + 1)) { if ((k) == 0) { __syncthreads(); cg::this_grid().sync(); } else { ++bar_gen; grid_barrier(bar_cnt, bar_gen); } } } while (0)
    if (IN(0)) { phase_prologue(args, lds); if (PROBE_DUP == 0) { __syncthreads(); phase_prologue(args, lds); } }
    SEAM(0);
    if (IN(1)) { phase_gemm(args, lds, 0, 3); if (PROBE_DUP == 1) { __syncthreads(); phase_gemm(args, lds, 0, 3); } }
    SEAM(1);
    if (IN(2)) { phase_scan(args, lds); if (PROBE_DUP == 2) { __syncthreads(); phase_scan(args, lds); } }
    SEAM(2);
    if (IN(3)) { phase_rwkv_post(args); if (PROBE_DUP == 3) { __syncthreads(); phase_rwkv_post(args); } }
    SEAM(3);
    if (IN(4)) { phase_gemm(args, lds, 3, 1); if (PROBE_DUP == 4) { __syncthreads(); phase_gemm(args, lds, 3, 1); } }
    SEAM(4);
    if (IN(5)) { phase_rows<0>(args); if (PROBE_DUP == 5) { __syncthreads(); phase_rows<0>(args); } }
    SEAM(5);
    if (IN(6)) { phase_gemm(args, lds, 4, 2); if (PROBE_DUP == 6) { __syncthreads(); phase_gemm(args, lds, 4, 2); } }
    SEAM(6);
    if (IN(7)) { phase_attn1(args, lds); if (PROBE_DUP == 7) { __syncthreads(); phase_attn1(args, lds); } }
    SEAM(7);
    if (IN(8)) { phase_gemm(args, lds, 6, 1); if (PROBE_DUP == 8) { __syncthreads(); phase_gemm(args, lds, 6, 1); } }
    SEAM(8);
#ifdef PROBE_SYNC
    for (int q = 0; q < PROBE_SYNC; ++q) { __syncthreads(); cg::this_grid().sync(); }
#endif
    if (IN(9)) { phase_rows<1>(args); if (PROBE_DUP == 9) { __syncthreads(); phase_rows<1>(args); } }
#undef IN
#undef SEAM
}

extern "C" void kernel_launch(void* const* d_in, const int* in_sizes, int n_in, void* d_out, int out_size, void* d_ws, size_t ws_size, hipStream_t stream) {
    static int ready = 0;
    if (ready == 0) {
        if (n_in != 26 || out_size != MTOK * DM || ws_size < WS_END) { fprintf(stderr, "kernel_launch: unexpected problem shape (n_in %d out %d ws %zu)\n", n_in, out_size, ws_size); ready = -1; return; }
        if (hipFuncSetAttribute((const void*)yoco_fwd, hipFuncAttributeMaxDynamicSharedMemorySize, LDS_BYTES) != hipSuccess) { fprintf(stderr, "kernel_launch: hipFuncSetAttribute failed\n"); ready = -1; return; }
        int per_cu = 0;
        if (hipOccupancyMaxActiveBlocksPerMultiprocessor(&per_cu, (const void*)yoco_fwd, 512, LDS_BYTES) != hipSuccess || per_cu < 1) fprintf(stderr, "kernel_launch: occupancy query says %d\n", per_cu);
        (void)hipGetLastError();
        ready = 1;
    }
    if (ready < 0) return;
    Args a{};
    for (int i = 0; i < 26; ++i) a.in[i] = (const float*)d_in[i];
    a.out = (float*)d_out; a.ws = (unsigned char*)d_ws;
#if MK_COOP
    (void)hipMemsetAsync(d_ws, 0, 8192, stream);
    a.ph_lo = 0; a.ph_hi = N_PHASES;
    void* params[] = {&a};
    hipError_t e = hipLaunchCooperativeKernel((const void*)yoco_fwd, dim3(256), dim3(512), params, LDS_BYTES, stream);
    if (e != hipSuccess) fprintf(stderr, "kernel_launch: cooperative launch failed: %s\n", hipGetErrorString(e));
#else
    for (int ph = 0; ph < N_PHASES; ++ph) { a.ph_lo = ph; a.ph_hi = ph + 1; hipLaunchKernelGGL(yoco_fwd, dim3(256), dim3(512), LDS_BYTES, stream, a); }
#endif
}
```

```cpp
#include <hip/hip_runtime.h>
#include <hip/hip_cooperative_groups.h>
#include <cstdio>
#include <cstdint>
namespace cg = cooperative_groups;

#ifndef PROBE_DUP
#define PROBE_DUP -1
#endif
#ifndef MK_COOP
#define MK_COOP 1
#endif

#define LAS __attribute__((address_space(3)))
typedef unsigned short bf16;
typedef short bf16x8 __attribute__((ext_vector_type(8)));
typedef float f32x4 __attribute__((ext_vector_type(4)));
typedef float f32x2 __attribute__((ext_vector_type(2)));
typedef unsigned u32x4 __attribute__((ext_vector_type(4)));
typedef unsigned u32x2 __attribute__((ext_vector_type(2)));

constexpr int DM = 1024, NBATCH = 8, SEQ = 2048, MTOK = NBATCH * SEQ;
constexpr int MEML = 256, MROWS = NBATCH * MEML;
constexpr int BRW = 768, AH = 12, BH = 6;
constexpr int LDP0 = 3840;
constexpr int LDP1 = 2816;
constexpr int C_R = 0, C_K = 768, C_V = 1536, C_WD = 2304, C_AD = 2368, C_GATE0 = 2432, C_QM0 = 3200, C_GM0 = 3456;
constexpr int C_Q1 = 0, C_GATE1 = 768, C_QM1 = 1536, C_GM1 = 1792, C_KSH = 2048;
constexpr float NORM_EPS = 1e-6f, LNX_EPS = 64e-5f;
constexpr float LOG2E = 1.4426950408889634f;

constexpr size_t MiB = 1u << 20;
constexpr size_t WS_WA = 1 * MiB;
constexpr size_t WS_WB = 9 * MiB;
constexpr size_t WS_WO = 16 * MiB;
constexpr size_t WS_WM = 20 * MiB;
constexpr size_t WS_MEMN = 22 * MiB;
constexpr size_t WS_MK = 26 * MiB;
constexpr size_t WS_MVT = 28 * MiB;
constexpr size_t WS_XN = 30 * MiB;
constexpr size_t WS_CAT = 62 * MiB;
constexpr size_t WS_VT = 94 * MiB;
constexpr size_t WS_PROJ = 118 * MiB;
constexpr size_t WS_Y = 118 * MiB;
constexpr size_t WS_W2T = 0 * MiB + 65536;
constexpr size_t WS_BS = 238 * MiB;
constexpr size_t WS_END = 240 * MiB;

__device__ __forceinline__ unsigned f2bf(float f) { unsigned u = __builtin_bit_cast(unsigned, f); return (u + 0x7fffu + ((u >> 16) & 1u)) >> 16; }
typedef __bf16 bf16x2_t __attribute__((ext_vector_type(2)));
__device__ __forceinline__ unsigned pk2(float lo, float hi) { f32x2 v = {lo, hi}; bf16x2_t b = __builtin_convertvector(v, bf16x2_t); return __builtin_bit_cast(unsigned, b); }
__device__ __forceinline__ float bflo(unsigned u) { return __builtin_bit_cast(float, u << 16); }
__device__ __forceinline__ float bfhi(unsigned u) { return __builtin_bit_cast(float, u & 0xffff0000u); }
__device__ __forceinline__ float wave_sum(float v) {
#pragma unroll
    for (int o = 1; o < 64; o <<= 1) v += __shfl_xor(v, o);
    return v;
}
template <int CTRL> __device__ __forceinline__ float dppf(float x) { return __builtin_bit_cast(float, __builtin_amdgcn_update_dpp(0, __builtin_bit_cast(int, x), CTRL, 0xf, 0xf, false)); }
__device__ __forceinline__ float sum8(float x) { x += dppf<0xB1>(x); x += dppf<0x4E>(x); x += dppf<0x141>(x); return x; }
__device__ __forceinline__ float sum16(float x) { x += dppf<0xB1>(x); x += dppf<0x4E>(x); x += dppf<0x141>(x); x += dppf<0x140>(x); return x; }
__device__ __forceinline__ float rows_max(float m) { m = fmaxf(m, __shfl_xor(m, 16)); return fmaxf(m, __shfl_xor(m, 32)); }
__device__ __forceinline__ float rows_sum(float m) { m += __shfl_xor(m, 16); return m + __shfl_xor(m, 32); }
__device__ __forceinline__ float sigmoidf_(float x) { return __builtin_amdgcn_rcpf(1.f + __builtin_amdgcn_exp2f(-1.4426950408889634f * x)); }
__device__ __forceinline__ float siluf_(float x) { return x * __builtin_amdgcn_rcpf(1.f + __builtin_amdgcn_exp2f(-1.4426950408889634f * x)); }

namespace pg8 {
constexpr int BM = 256, BK = 64, HALF = 128, HTB = HALF * BK * 2, STAGE_BYTES = 8 * HTB, NXCD = 8, WGM = 8;
__device__ __forceinline__ int lds_byte(int r, int c) { const int st = (r >> 4) * 2 + (c >> 5), rr = r & 15, cc = c & 31, ob = rr * 64 + cc * 2; return st * 1024 + (ob ^ (((ob >> 9) & 1) << 5)); }
__device__ __forceinline__ void stage_rc(int b, int& R, int& C) { const int st = b / 1024, sb = b % 1024, swz = sb ^ (((sb >> 9) & 1) << 5); R = (st >> 1) * 16 + swz / 64; C = (st & 1) * 32 + (swz % 64) / 2; }
__device__ __forceinline__ int perm32(int rho) { const int n = rho >> 4, i = rho & 15; return 8 * (i >> 2) + 4 * n + (i & 3); }
struct Unit { int pm, pn; };
struct Gemm { const bf16* A; const bf16* Bt; int M, N, K; };
struct StaticOrder {
    int nM, nN, nwg, G, c;
    __device__ void init(int M, int N, int G_, int c_) { nM = M / BM; nN = N / BM; nwg = nM * nN; G = G_; c = c_; }
    __device__ bool next(int i, Unit& u) const {
        const long L = (long)i * G + c; if (L >= nwg) return false;
        int wgid = (int)L; { const int q = nwg / NXCD, r = nwg % NXCD, xcd = wgid % NXCD, off = wgid / NXCD; wgid = (xcd < r ? xcd * (q + 1) : r * (q + 1) + (xcd - r) * q) + off; }
        const int nig = WGM * nN, gid = wgid / nig, fm = gid * WGM, gsz = (nM - fm) < WGM ? (nM - fm) : WGM;
        u.pm = fm + ((wgid % nig) % gsz); u.pn = (wgid % nig) / gsz; return true;
    }
};
__device__ __forceinline__ unsigned cvt_pk_bf16(float lo, float hi) { unsigned r; asm volatile("v_cvt_pk_bf16_f32 %0, %1, %2" : "=v"(r) : "v"(lo), "v"(hi)); return r; }

struct EpiStore {
    void* O; int ldc; int f32out;
    __device__ __forceinline__ void operator()(const f32x4 (&acc)[2][2][4][2], const Unit& u, int wr, int wc, int fr, int fq) const {
        const int row0 = u.pm * BM + wr * 64 + fr, col0 = u.pn * BM + wc * 32 + 8 * fq;
        if (f32out) {
#pragma unroll
            for (int ai = 0; ai < 2; ++ai)
#pragma unroll
                for (int m = 0; m < 4; ++m) { float* rowp = (float*)O + (size_t)(row0 + ai * HALF + m * 16) * ldc + col0;
#pragma unroll
                    for (int bj = 0; bj < 2; ++bj) { *(f32x4*)(rowp + bj * HALF) = acc[ai][bj][m][0]; *(f32x4*)(rowp + bj * HALF + 4) = acc[ai][bj][m][1]; } }
        } else {
#pragma unroll
            for (int ai = 0; ai < 2; ++ai)
#pragma unroll
                for (int m = 0; m < 4; ++m) { bf16* rowp = (bf16*)O + (size_t)(row0 + ai * HALF + m * 16) * ldc + col0;
#pragma unroll
                    for (int bj = 0; bj < 2; ++bj) { const f32x4 v0 = acc[ai][bj][m][0], v1 = acc[ai][bj][m][1];
                        u32x4 w; w.x = cvt_pk_bf16(v0[0], v0[1]); w.y = cvt_pk_bf16(v0[2], v0[3]); w.z = cvt_pk_bf16(v1[0], v1[1]); w.w = cvt_pk_bf16(v1[2], v1[3]);
                        *(u32x4*)(rowp + bj * HALF) = w; } }
        }
    }
};

template <class Epi, class Sched>
__device__ __forceinline__ void gemm_phase(LAS unsigned char* lds, const Gemm g, const Sched& S, const Epi& E) {
    const int tid = threadIdx.x, wid = __builtin_amdgcn_readfirstlane(tid >> 6), lane = tid & 63, wr = wid >> 2, wc = wid & 3, fr = lane & 15, fq = lane >> 4;
    const int K = g.K, nt = K / BK;
    unsigned voffA[2], voffB[2];
#pragma unroll
    for (int i = 0; i < 2; ++i) { int R, C; stage_rc(tid * 16 + i * 8192, R, C); const int Rb = (R & ~31) + perm32(R & 31);
        voffA[i] = (unsigned)(R * K + C) * 2u; voffB[i] = (unsigned)(Rb * K + C) * 2u; }
    const size_t kstep = (size_t)(BK * 2);
    const size_t hstep = (size_t)HALF * K * 2;
    const size_t tstep = 2 * hstep;
    const unsigned ldsw = (unsigned)wid * 1024u;
    const int aoff = lds_byte(wr * 64 + fr, fq * 8), boff = lds_byte(wc * 32 + fr, fq * 8);
#define PG8_SA(b, h) (((b) * 2 + (h)) * HTB)
#define PG8_SB(b, h) ((4 + (b) * 2 + (h)) * HTB)
#define PG8_STAGE(bufoff, gbase, voff) do { _Pragma("unroll") for (int _i = 0; _i < 2; ++_i) \
        __builtin_amdgcn_global_load_lds((const unsigned*)((const char*)(gbase) + (voff)[_i]), (LAS unsigned*)(lds + (bufoff) + ldsw + _i * 8192), 16, 0, 0); } while (0)
#define PG8_LDA(dst, b, h) do { _Pragma("unroll") for (int m = 0; m < 4; ++m) _Pragma("unroll") for (int k = 0; k < 2; ++k) dst[m][k] = *(const LAS bf16x8*)(lds + PG8_SA(b, h) + aoff + m * 2048 + k * 1024); } while (0)
#define PG8_LDB(dst, b, h) do { _Pragma("unroll") for (int n = 0; n < 2; ++n) _Pragma("unroll") for (int k = 0; k < 2; ++k) dst[n][k] = *(const LAS bf16x8*)(lds + PG8_SB(b, h) + boff + n * 2048 + k * 1024); } while (0)
#define PG8_MMA(ai, bj, At, Bt) do { __builtin_amdgcn_s_setprio(1); _Pragma("unroll") for (int m = 0; m < 4; ++m) _Pragma("unroll") for (int n = 0; n < 2; ++n) _Pragma("unroll") for (int k = 0; k < 2; ++k) \
        acc[ai][bj][m][n] = __builtin_amdgcn_mfma_f32_16x16x32_bf16(Bt[n][k], At[m][k], acc[ai][bj][m][n], 0, 0, 0); __builtin_amdgcn_s_setprio(0); } while (0)
#define PG8_WAIT_V(n) asm volatile("s_waitcnt vmcnt(" #n ")" ::: "memory")
#define PG8_WAIT_L(n) asm volatile("s_waitcnt lgkmcnt(" #n ")" ::: "memory")
#define PG8_BAR __builtin_amdgcn_s_barrier()
#define PG8_SCHED __builtin_amdgcn_sched_barrier(0)
    Unit cur, nxt; int ui = 0;
    if (!S.next(0, cur)) return;
    f32x4 acc[2][2][4][2];
#pragma unroll
    for (int a = 0; a < 2; ++a)
#pragma unroll
        for (int b = 0; b < 2; ++b)
#pragma unroll
            for (int m = 0; m < 4; ++m)
#pragma unroll
                for (int n = 0; n < 2; ++n) acc[a][b][m][n] = (f32x4){0.f, 0.f, 0.f, 0.f};
    bf16x8 At[4][2], B0[2][2], B1[2][2];
    const char* cA = (const char*)g.A + (size_t)cur.pm * tstep; const char* cB = (const char*)g.Bt + (size_t)cur.pn * tstep;
    PG8_STAGE(PG8_SB(0, 0), cB, voffB); PG8_STAGE(PG8_SB(0, 1), cB + hstep, voffB); PG8_STAGE(PG8_SA(0, 0), cA, voffA); PG8_STAGE(PG8_SA(0, 1), cA + hstep, voffA);
    if (wr == 1) PG8_BAR;
    PG8_WAIT_V(2); PG8_BAR;
    PG8_STAGE(PG8_SB(1, 0), cB + kstep, voffB); PG8_STAGE(PG8_SA(1, 0), cA + kstep, voffA); PG8_STAGE(PG8_SB(1, 1), cB + hstep + kstep, voffB);
    PG8_WAIT_V(6); PG8_BAR;
    for (;;) {
        const bool has_next = S.next(ui + 1, nxt);
        const char* nA = has_next ? (const char*)g.A + (size_t)nxt.pm * tstep : cA; const char* nB = has_next ? (const char*)g.Bt + (size_t)nxt.pn * tstep : cB;
        for (int t = 0; t < nt; t += 2) {
            const bool last = (t == nt - 2);
            const char* a1 = cA + (size_t)(t + 1) * kstep;
            const char* a2 = last ? nA : cA + (size_t)(t + 2) * kstep; const char* b2 = last ? nB : cB + (size_t)(t + 2) * kstep;
            const char* a3 = a2 + kstep; const char* b3 = b2 + kstep;
            PG8_LDB(B0, 0, 0); PG8_LDB(B1, 0, 1); PG8_SCHED; PG8_LDA(At, 0, 0); PG8_STAGE(PG8_SA(1, 1), a1 + hstep, voffA);
            PG8_WAIT_V(8); PG8_WAIT_L(0); PG8_BAR; PG8_MMA(0, 0, At, B0); PG8_MMA(0, 1, At, B1); PG8_BAR; PG8_SCHED;
            PG8_LDA(At, 0, 1); PG8_STAGE(PG8_SB(0, 0), b2, voffB); PG8_STAGE(PG8_SB(0, 1), b2 + hstep, voffB); PG8_STAGE(PG8_SA(0, 0), a2, voffA);
            PG8_WAIT_V(8); PG8_WAIT_L(0); PG8_BAR; PG8_MMA(1, 0, At, B0); PG8_MMA(1, 1, At, B1); PG8_BAR; PG8_SCHED;
            PG8_LDB(B0, 1, 0); PG8_LDB(B1, 1, 1); PG8_SCHED; PG8_LDA(At, 1, 0); PG8_STAGE(PG8_SA(0, 1), a2 + hstep, voffA);
            PG8_WAIT_V(8); PG8_WAIT_L(0); PG8_BAR; PG8_MMA(0, 0, At, B0); PG8_MMA(0, 1, At, B1); PG8_BAR; PG8_SCHED;
            PG8_LDA(At, 1, 1); PG8_STAGE(PG8_SB(1, 0), b3, voffB); PG8_STAGE(PG8_SB(1, 1), b3 + hstep, voffB); PG8_STAGE(PG8_SA(1, 0), a3, voffA);
            PG8_WAIT_V(8); PG8_WAIT_L(0); PG8_BAR; PG8_MMA(1, 0, At, B0); PG8_MMA(1, 1, At, B1); PG8_BAR; PG8_SCHED;
        }
        if (wr == 0) PG8_BAR;
        E(acc, cur, wr, wc, fr, fq);
        if (!has_next) break;
#pragma unroll
        for (int a = 0; a < 2; ++a)
#pragma unroll
            for (int b = 0; b < 2; ++b)
#pragma unroll
                for (int m = 0; m < 4; ++m)
#pragma unroll
                    for (int n = 0; n < 2; ++n) acc[a][b][m][n] = (f32x4){0.f, 0.f, 0.f, 0.f};
        cur = nxt; cA = nA; cB = nB; ++ui;
        if (wr == 1) PG8_BAR;
    }
    PG8_WAIT_V(0);
    PG8_BAR;
#undef PG8_SA
#undef PG8_SB
#undef PG8_STAGE
#undef PG8_LDA
#undef PG8_LDB
#undef PG8_MMA
#undef PG8_WAIT_V
#undef PG8_WAIT_L
#undef PG8_BAR
#undef PG8_SCHED
}
}

struct Args { const float* in[26]; float* out; unsigned char* ws; int ph_lo, ph_hi; };
enum { I_X = 0, I_MEM, I_PRE, I_POST, I_WOUT, I_MEMNORM, I_WMEMKV, I_AWIN, I_AMU, I_AW0, I_AW2, I_AA0, I_AA2, I_AKK, I_AKA, I_ARK, I_ALNW, I_ALNB,
       I_KVNORM, I_WKV, I_BWIN, I_LQ1, I_LK1, I_LQ2, I_LK2, I_SUBLN };

constexpr int LDS_BYTES = 147456;

__device__ __forceinline__ void p0_transpose_item(const float* W, int ldw, int c0, int nc, const float* gain, bf16* WT, int row0, LAS float* scr, int item, int lane, int ldo = 1024) {
    const int nblk = nc / 32, kb = item / nblk, nb = item % nblk, k0 = 64 * kb, n0 = 32 * nb;
#pragma unroll 8
    for (int i = 0; i < 32; ++i) { const int kk = 2 * i + (lane >> 5);
        float v = W[(size_t)(k0 + kk) * ldw + c0 + n0 + (lane & 31)]; if (gain) v *= gain[k0 + kk];
        scr[kk * 33 + (lane & 31)] = v; }
    asm volatile("s_waitcnt lgkmcnt(0)" ::: "memory");
    const int c = lane & 7;
#pragma unroll
    for (int j = 0; j < 4; ++j) { const int n = (lane >> 3) + 8 * j; const LAS float* s = scr + (8 * c) * 33 + n;
        u32x4 o; o.x = pk2(s[0 * 33], s[1 * 33]); o.y = pk2(s[2 * 33], s[3 * 33]); o.z = pk2(s[4 * 33], s[5 * 33]); o.w = pk2(s[6 * 33], s[7 * 33]);
        *(u32x4*)(WT + (size_t)(row0 + n0 + n) * ldo + k0 + 8 * c) = o; }
    asm volatile("s_waitcnt lgkmcnt(0)" ::: "memory");
}
__device__ __forceinline__ void rms_row_to_bf16(const float* xrow, bf16* orow, int lane) {
    const f32x4* xr = (const f32x4*)xrow + lane;
    f32x4 v[4]; float s = 0.f;
#pragma unroll
    for (int j = 0; j < 4; ++j) { v[j] = xr[64 * j]; s += (v[j].x * v[j].x + v[j].y * v[j].y) + (v[j].z * v[j].z + v[j].w * v[j].w); }
    const float rs = 1.f / sqrtf(wave_sum(s) * (1.f / DM) + NORM_EPS);
    unsigned long long* o8 = (unsigned long long*)orow + lane;
#pragma unroll
    for (int j = 0; j < 4; ++j) o8[64 * j] = (unsigned long long)pk2(v[j].x * rs, v[j].y * rs) | ((unsigned long long)pk2(v[j].z * rs, v[j].w * rs) << 32);
}
template <int GROUP>
__device__ __forceinline__ void transpose_group(const Args& a, LAS unsigned char* lds, int gw, int NGW) {
    const int lane = threadIdx.x & 63, wave = __builtin_amdgcn_readfirstlane(threadIdx.x >> 6);
    unsigned char* ws = a.ws;
    LAS float* scr = (LAS float*)(lds + wave * 16384);
    bf16* WA = (bf16*)(ws + WS_WA); bf16* WB = (bf16*)(ws + WS_WB); bf16* WO = (bf16*)(ws + WS_WO); bf16* WM = (bf16*)(ws + WS_WM);
    constexpr int I0 = 16 * (3712 / 32), I1 = 16 * (2048 / 32), I2 = 16 * (1536 / 32), I3 = 16 * (1024 / 32), I5 = 16 * (256 / 32), I6 = 768 / 32;
    bf16* W2T = (bf16*)(ws + WS_W2T); bf16* A2T = W2T + 768 * 64;
    if (GROUP == 0) {
        constexpr int NITEMS = I0 + 4 * I5 + 2 * I6;
        for (int it = gw; it < NITEMS; it += NGW) {
            int r = it;
            if (r < I0) { p0_transpose_item(a.in[I_AWIN], 3712, 0, 3712, a.in[I_PRE], WA, 0, scr, r, lane); continue; } r -= I0;
            if (r < I5) { p0_transpose_item(a.in[I_WMEMKV], 512, 0, 256, a.in[I_MEMNORM], WM, 0, scr, r, lane); continue; } r -= I5;
            if (r < I5) { p0_transpose_item(a.in[I_WMEMKV], 512, 256, 256, a.in[I_MEMNORM], WM, 512, scr, r, lane); continue; } r -= I5;
            if (r < I5) { p0_transpose_item(a.in[I_WMEMKV] + 1024 * 512, 512, 0, 256, a.in[I_MEMNORM] + 1024, WM, 256, scr, r, lane); continue; } r -= I5;
            if (r < I5) { p0_transpose_item(a.in[I_WMEMKV] + 1024 * 512, 512, 256, 256, a.in[I_MEMNORM] + 1024, WM, 768, scr, r, lane); continue; } r -= I5;
            if (r < I6) { p0_transpose_item(a.in[I_AW2], 768, 0, 768, nullptr, W2T, 0, scr, r, lane, 64); continue; } r -= I6;
            p0_transpose_item(a.in[I_AA2], 768, 0, 768, nullptr, A2T, 0, scr, r, lane, 64);
        }
    } else {
        constexpr int NITEMS = I1 + I2 + 2 * I3;
        for (int it = gw; it < NITEMS; it += NGW) {
            int r = it;
            if (r < I1) { p0_transpose_item(a.in[I_BWIN], 2048, 0, 2048, a.in[I_PRE] + 1024, WB, 0, scr, r, lane); continue; } r -= I1;
            if (r < I2) { p0_transpose_item(a.in[I_WKV], 1536, 0, 1536, a.in[I_KVNORM], WB, 2048, scr, r, lane); continue; } r -= I2;
            if (r < I3) { p0_transpose_item(a.in[I_WOUT], 1024, 0, 1024, nullptr, WO, 0, scr, r, lane); continue; } r -= I3;
            p0_transpose_item(a.in[I_WOUT] + 1024 * 1024, 1024, 0, 1024, nullptr, WO + 1024 * 1024, 0, scr, r, lane);
        }
    }
}
__device__ __forceinline__ void phase_prologue(const Args& a, LAS unsigned char* lds) {
    const int tid = threadIdx.x, lane = tid & 63, wave = __builtin_amdgcn_readfirstlane(tid >> 6);
    const int G = gridDim.x, gw = blockIdx.x * 8 + wave, NGW = G * 8;
    unsigned char* ws = a.ws;
    bf16* WA = (bf16*)(ws + WS_WA);
    transpose_group<0>(a, lds, gw, NGW);
    { u32x4* z = (u32x4*)(WA + (size_t)3712 * 1024); const int nz = 128 * 1024 * 2 / 16;
      for (int i = blockIdx.x * 512 + tid; i < nz; i += G * 512) z[i] = (u32x4){0u, 0u, 0u, 0u}; }
    bf16* XN = (bf16*)(ws + WS_XN); bf16* MEMN = (bf16*)(ws + WS_MEMN);
    for (int m = gw; m < MTOK + MROWS; m += NGW) {
        if (m < MTOK) rms_row_to_bf16(a.in[I_X] + (size_t)m * DM, XN + (size_t)m * DM, lane);
        else rms_row_to_bf16(a.in[I_MEM] + (size_t)(m - MTOK) * DM, MEMN + (size_t)(m - MTOK) * DM, lane);
    }
}

__device__ __forceinline__ void run_gemm(LAS unsigned char* lds, const bf16* A, const bf16* Bt, int M, int N, void* O, int ldc, int f32out, int shift) {
    const int G = gridDim.x;
    pg8::Gemm g{A, Bt, M, N, 1024};
    pg8::StaticOrder S; S.init(M, N, G, (int)((blockIdx.x + G - shift) % G));
    pg8::EpiStore E{O, ldc, f32out};
    pg8::gemm_phase<pg8::EpiStore, pg8::StaticOrder>(lds, g, S, E);
}
__device__ __forceinline__ void phase_gemm(const Args& a, LAS unsigned char* lds, int first, int count) {
    unsigned char* ws = a.ws;
    for (int j = first; j < first + count; ++j) {
        const bf16* A; const bf16* Bt; int M, N, ldc, f32o, shift; void* O;
        switch (j) {
        case 0: A = (const bf16*)(ws + WS_XN); Bt = (const bf16*)(ws + WS_WA); M = MTOK; N = 3840; O = ws + WS_PROJ; ldc = LDP0; f32o = 0; shift = 0; break;
        case 1: A = (const bf16*)(ws + WS_MEMN); Bt = (const bf16*)(ws + WS_WM); M = MROWS; N = 512; O = ws + WS_MK; ldc = 512; f32o = 0; shift = 192; break;
        case 2: A = (const bf16*)(ws + WS_WM) + 512 * 1024; Bt = (const bf16*)(ws + WS_MEMN); M = 512; N = MROWS; O = ws + WS_MVT; ldc = MROWS; f32o = 0; shift = 208; break;
        case 3: A = (const bf16*)(ws + WS_CAT); Bt = (const bf16*)(ws + WS_WO); M = MTOK; N = 1024; O = ws + WS_Y; ldc = 1024; f32o = 0; shift = 0; break;
        case 4: A = (const bf16*)(ws + WS_XN); Bt = (const bf16*)(ws + WS_WB); M = MTOK; N = 2816; O = ws + WS_PROJ; ldc = LDP1; f32o = 0; shift = 0; break;
        case 5: A = (const bf16*)(ws + WS_WB) + 2816 * 1024; Bt = (const bf16*)(ws + WS_XN); M = 768; N = MTOK; O = ws + WS_VT; ldc = MTOK; f32o = 0; shift = 192; break;
        default: A = (const bf16*)(ws + WS_CAT); Bt = (const bf16*)(ws + WS_WO) + 1024 * 1024; M = MTOK; N = 1024; O = ws + WS_Y; ldc = 1024; f32o = 0; shift = 0; break;
        }
        run_gemm(lds, A, Bt, M, N, O, ldc, f32o, shift);
    }
}

constexpr int AT_PITCH = 72;
template <int NMAP>
__device__ __forceinline__ void attn_unit(LAS unsigned char* lds, const bf16* Qp, int ldq, const bf16* Kp, int ldk, const bf16* VTp, int ldvt,
                                          int nkt_lo, int nkt_hi, float slope2, int tq0,
                                          const bf16* Gp, int ldg, bf16* Op, int ldo, const float* subln, float lam, float oscale) {
    constexpr int EV = 64 * NMAP, NET = EV / 16;
    const int tid = threadIdx.x, lane = tid & 63, wave = __builtin_amdgcn_readfirstlane(tid >> 6), g = lane >> 4, c = lane & 15;
    LAS bf16* Ks = (LAS bf16*)lds;
    LAS bf16* Vs = (LAS bf16*)(lds + NMAP * 64 * AT_PITCH * 2);
    const int nkt = (wave < 4) ? nkt_lo : nkt_hi;
    const int qrow = 16 * wave + c;
    bf16x8 qf[NMAP][2];
#pragma unroll
    for (int mp = 0; mp < NMAP; ++mp)
#pragma unroll
        for (int ks = 0; ks < 2; ++ks) qf[mp][ks] = *(const bf16x8*)(Qp + (size_t)qrow * ldq + mp * 64 + 32 * ks + 8 * g);
    f32x4 o[NMAP][NET];
#pragma unroll
    for (int mp = 0; mp < NMAP; ++mp)
#pragma unroll
        for (int et = 0; et < NET; ++et) o[mp][et] = (f32x4){0.f, 0.f, 0.f, 0.f};
    float mrun[NMAP], lrun[NMAP];
#pragma unroll
    for (int mp = 0; mp < NMAP; ++mp) { mrun[mp] = -1e30f; lrun[mp] = 0.f; }
    const float sc2 = 0.125f * LOG2E;
    const float tq = (float)(tq0 + qrow);
    u32x4 kreg[2][NMAP], vreg[2][NMAP];
#define AT_LOAD(SET, kt) do { _Pragma("unroll") for (int i = 0; i < NMAP; ++i) { const int id = tid + 512 * i; \
        { const int mp = id >> 9, n = (id >> 3) & 63, ch = id & 7; kreg[SET][i] = *(const u32x4*)(Kp + (size_t)((kt) * 64 + n) * ldk + mp * 64 + 8 * ch); } \
        { const int e = id >> 3, ch = id & 7; vreg[SET][i] = *(const u32x4*)(VTp + (size_t)e * ldvt + (kt) * 64 + 8 * ch); } } } while (0)
#define AT_STORE(SET) do { _Pragma("unroll") for (int i = 0; i < NMAP; ++i) { const int id = tid + 512 * i; \
        { const int mp = id >> 9, n = (id >> 3) & 63, ch = id & 7; *(LAS u32x4*)(Ks + (mp * 64 + n) * AT_PITCH + 8 * ch) = kreg[SET][i]; } \
        { const int e = id >> 3, ch = id & 7; *(LAS u32x4*)(Vs + e * AT_PITCH + 8 * ch) = vreg[SET][i]; } } } while (0)
    AT_LOAD(0, nkt_hi - 1);
    if (nkt_hi > 1) AT_LOAD(1, nkt_hi - 2);
    for (int it = 0; it < nkt_hi; ++it) {
        const int kt = nkt_hi - 1 - it;
        __syncthreads();
        if (it & 1) AT_STORE(1); else AT_STORE(0);
        __syncthreads();
        if (kt > 1) { if (it & 1) AT_LOAD(1, kt - 2); else AT_LOAD(0, kt - 2); }
        if (kt < nkt) {
            f32x4 bias[4];
#pragma unroll
            for (int k16 = 0; k16 < 4; ++k16)
#pragma unroll
                for (int j = 0; j < 4; ++j) bias[k16][j] = -slope2 * fabsf(tq - (float)(kt * 64 + 16 * k16 + 4 * g + j));
            bf16x8 pf[NMAP][2]; bool any = false;
#pragma unroll
            for (int mp = 0; mp < NMAP; ++mp) {
                f32x4 st[4];
#pragma unroll
                for (int k16 = 0; k16 < 4; ++k16) {
                    f32x4 acc = (f32x4){0.f, 0.f, 0.f, 0.f};
#pragma unroll
                    for (int ks = 0; ks < 2; ++ks) { const bf16x8 ka = *(const LAS bf16x8*)(Ks + (mp * 64 + 16 * k16 + c) * AT_PITCH + 32 * ks + 8 * g);
                        acc = __builtin_amdgcn_mfma_f32_16x16x32_bf16(ka, qf[mp][ks], acc, 0, 0, 0); }
                    st[k16] = acc * sc2 + bias[k16];
                }
                float m4[4];
#pragma unroll
                for (int k16 = 0; k16 < 4; ++k16) m4[k16] = fmaxf(fmaxf(st[k16].x, st[k16].y), fmaxf(st[k16].z, st[k16].w));
                float mx = fmaxf(fmaxf(m4[0], m4[1]), fmaxf(m4[2], m4[3]));
                mx = rows_max(mx);
                if (__builtin_amdgcn_ballot_w64(mx > mrun[mp] - 40.f) != 0ull) {
                    any = true;
                    const float mnew = fmaxf(mrun[mp], mx), alpha = __builtin_amdgcn_exp2f(mrun[mp] - mnew);
                    mrun[mp] = mnew;
                    float ps = 0.f;
#pragma unroll
                    for (int k16 = 0; k16 < 4; ++k16)
#pragma unroll
                        for (int j = 0; j < 4; ++j) { const float p = __builtin_amdgcn_exp2f(st[k16][j] - mnew); st[k16][j] = p; ps += p; }
                    lrun[mp] = lrun[mp] * alpha + ps;
                    if (__builtin_amdgcn_ballot_w64(alpha != 1.f) != 0ull) {
#pragma unroll
                        for (int et = 0; et < NET; ++et) o[mp][et] = o[mp][et] * alpha;
                    }
#pragma unroll
                    for (int i = 0; i < 2; ++i) { u32x4 w; w.x = pk2(st[2 * i][0], st[2 * i][1]); w.y = pk2(st[2 * i][2], st[2 * i][3]); w.z = pk2(st[2 * i + 1][0], st[2 * i + 1][1]); w.w = pk2(st[2 * i + 1][2], st[2 * i + 1][3]);
                        pf[mp][i] = __builtin_bit_cast(bf16x8, w); }
                } else {
                    pf[mp][0] = (bf16x8){0, 0, 0, 0, 0, 0, 0, 0}; pf[mp][1] = (bf16x8){0, 0, 0, 0, 0, 0, 0, 0};
                }
            }
            if (any) {
#pragma unroll
                for (int et = 0; et < NET; ++et)
#pragma unroll
                    for (int i = 0; i < 2; ++i) {
                        const u32x2 lo = *(const LAS u32x2*)(Vs + (16 * et + c) * AT_PITCH + 32 * i + 4 * g);
                        const u32x2 hi = *(const LAS u32x2*)(Vs + (16 * et + c) * AT_PITCH + 32 * i + 16 + 4 * g);
                        const bf16x8 va = __builtin_bit_cast(bf16x8, (u32x4){lo.x, lo.y, hi.x, hi.y});
#pragma unroll
                        for (int mp = 0; mp < NMAP; ++mp) o[mp][et] = __builtin_amdgcn_mfma_f32_16x16x32_bf16(va, pf[mp][i], o[mp][et], 0, 0, 0);
                    }
            }
        }
    }
#undef AT_LOAD
#undef AT_STORE
    float inv[NMAP];
#pragma unroll
    for (int mp = 0; mp < NMAP; ++mp) { const float l = rows_sum(lrun[mp]); inv[mp] = 1.f / l; }
    f32x4 r[NET]; float ss = 0.f;
#pragma unroll
    for (int et = 0; et < NET; ++et) {
        if (NMAP == 2) r[et] = o[0][et] * inv[0] - o[NMAP - 1][et] * (lam * inv[NMAP - 1]);
        else r[et] = o[0][et] * inv[0];
        ss += (r[et].x * r[et].x + r[et].y * r[et].y) + (r[et].z * r[et].z + r[et].w * r[et].w);
    }
    float rs = 1.f;
    if (NMAP == 2) { ss = rows_sum(ss); rs = oscale / sqrtf(ss * (1.f / EV) + NORM_EPS); }
#pragma unroll
    for (int et = 0; et < NET; ++et) {
        const int e = 16 * et + 4 * g;
        const u32x2 gv = *(const u32x2*)(Gp + (size_t)qrow * ldg + e);
        f32x4 v = r[et] * rs;
        if (NMAP == 2) v = v * *(const f32x4*)(subln + e);
        v.x *= siluf_(bflo(gv.x)); v.y *= siluf_(bfhi(gv.x)); v.z *= siluf_(bflo(gv.y)); v.w *= siluf_(bfhi(gv.y));
        u32x2 w; w.x = pk2(v.x, v.y); w.y = pk2(v.z, v.w);
        *(u32x2*)(Op + (size_t)qrow * ldo + e) = w;
    }
    __syncthreads();
}

__device__ __forceinline__ void mem_attn_unit(const Args& a, LAS unsigned char* lds, int l, int u) {
    unsigned char* ws = a.ws;
    const int b = u >> 6, h = (u >> 4) & 3, qb = u & 15;
    const bf16* PROJ = (const bf16*)(ws + WS_PROJ);
    const int ldp = l ? LDP1 : LDP0, cq = l ? C_QM1 : C_QM0, cg_ = l ? C_GM1 : C_GM0;
    const size_t row0 = (size_t)b * SEQ + qb * 128;
    attn_unit<1>(lds, PROJ + row0 * ldp + cq + h * 64, ldp,
                 (const bf16*)(ws + WS_MK) + (size_t)b * MEML * 512 + l * 256 + h * 64, 512,
                 (const bf16*)(ws + WS_MVT) + (size_t)(l * 256 + h * 64) * MROWS + b * MEML, MROWS,
                 4, 4, 0.f, 0,
                 PROJ + row0 * ldp + cg_ + h * 64, ldp, (bf16*)(ws + WS_CAT) + row0 * DM + BRW + h * 64, DM, nullptr, 0.f, 1.f);
}

constexpr int SK_SLOT = 15360, SK_NT = 0, SK_RT = 2304, SK_BP = 4608, SK_KP = 7168, SK_VT = 9728, SK_PC = 12288, SK_LK = 12544, SK_TT = 13184, SK_MB = 13824, SK_MK = 14464;
constexpr int SK_SCR = 3 * SK_SLOT, SK_SCRW = 7680, SK_BS = 0, SK_KS = 2304, SK_LB = 4608, SK_VM = 5632;
constexpr int SK_P72 = 72, SK_P20 = 20;
constexpr int SK_PRM = SK_SCR + 4 * SK_SCRW, SK_W2L = SK_PRM, SK_A2L = SK_PRM + 9216, SK_PF = SK_PRM + 18432;
enum { PF_W0 = 0, PF_A0, PF_KK, PF_KA, PF_RK, PF_MUR, PF_MUK, PF_MUWD, PF_MUAD, PF_MUV };
__device__ __forceinline__ bf16x8 lds2x8(const LAS bf16* p, int offa, int offb) { const u32x2 a = *(const LAS u32x2*)(p + offa), b = *(const LAS u32x2*)(p + offb); return __builtin_bit_cast(bf16x8, (u32x4){a.x, a.y, b.x, b.y}); }
__device__ __forceinline__ bf16x8 lds8z(const LAS bf16* p, int offa) { const u32x2 a = *(const LAS u32x2*)(p + offa); return __builtin_bit_cast(bf16x8, (u32x4){a.x, a.y, 0u, 0u}); }
__device__ __forceinline__ void scan_unit(const Args& a, LAS unsigned char* lds, int b, int h) {
    const int tid = threadIdx.x, lane = tid & 63, wave = __builtin_amdgcn_readfirstlane(tid >> 6), g = lane >> 4, c = lane & 15;
    unsigned char* ws = a.ws;
    const bf16* PROJ = (const bf16*)(ws + WS_PROJ);
    bf16* CAT = (bf16*)(ws + WS_CAT);
    const size_t mb = (size_t)b * SEQ;
    constexpr int NBLK = SEQ / 16;
    const f32x4 Z4 = {0.f, 0.f, 0.f, 0.f};
    {
        const bf16* W2T = (const bf16*)(ws + WS_W2T);
        for (int i = tid; i < 2 * 64 * 8; i += 512) { const int m = i >> 9, key = (i >> 3) & 63, ch = i & 7;
            const u32x4 v = *(const u32x4*)(W2T + (size_t)m * 768 * 64 + (size_t)(h * 64 + key) * 64 + 8 * ch);
            *(LAS u32x4*)(lds + (m ? SK_A2L : SK_W2L) + (((key & 3) * 16 + (key >> 2)) * SK_P72 + 8 * ch) * 2) = v; }
        for (int i = tid; i < 10 * 64; i += 512) { const int w = i >> 6, k = i & 63; float v;
            switch (w) { case PF_W0: v = a.in[I_AW0][h * 64 + k]; break; case PF_A0: v = a.in[I_AA0][h * 64 + k]; break; case PF_KK: v = a.in[I_AKK][h * 64 + k]; break;
                         case PF_KA: v = a.in[I_AKA][h * 64 + k]; break; case PF_RK: v = a.in[I_ARK][h * 64 + k]; break; case PF_MUR: v = a.in[I_AMU][C_R + h * 64 + k]; break;
                         case PF_MUK: v = a.in[I_AMU][C_K + h * 64 + k]; break; case PF_MUWD: v = a.in[I_AMU][C_WD + k]; break; case PF_MUAD: v = a.in[I_AMU][C_AD + k]; break;
                         default: v = a.in[I_AMU][C_V + h * 64 + k]; break; }
            ((LAS float*)(lds + SK_PF))[i] = v; }
        __syncthreads();
    }
    if (wave < 4) {
        f32x4 St[4] = {Z4, Z4, Z4, Z4};
        for (int q = 0; q < 4; ++q) __syncthreads();
        for (int blk = 0; blk < NBLK; ++blk) {
            const LAS unsigned char* sl = lds + (blk % 3) * SK_SLOT;
            const LAS bf16* NT = (const LAS bf16*)(sl + SK_NT); const LAS bf16* RT = (const LAS bf16*)(sl + SK_RT);
            const LAS bf16* BP = (const LAS bf16*)(sl + SK_BP); const LAS bf16* KP = (const LAS bf16*)(sl + SK_KP);
            const LAS bf16* VT = (const LAS bf16*)(sl + SK_VT); const LAS float* PC = (const LAS float*)(sl + SK_PC);
            const LAS bf16* LK = (const LAS bf16*)(sl + SK_LK); const LAS bf16* TT = (const LAS bf16*)(sl + SK_TT);
            const LAS bf16* MB = (const LAS bf16*)(sl + SK_MB); const LAS bf16* MK = (const LAS bf16*)(sl + SK_MK);
            bf16x8 sbh[2], sbl[2];
#pragma unroll
            for (int ks = 0; ks < 2; ++ks) {
                const f32x4 x = St[2 * ks], y = St[2 * ks + 1];
                u32x4 hh; hh.x = pk2(x.x, x.y); hh.y = pk2(x.z, x.w); hh.z = pk2(y.x, y.y); hh.w = pk2(y.z, y.w);
                u32x4 ll; ll.x = pk2(x.x - bflo(hh.x), x.y - bfhi(hh.x)); ll.y = pk2(x.z - bflo(hh.y), x.w - bfhi(hh.y));
                ll.z = pk2(y.x - bflo(hh.z), y.y - bfhi(hh.z)); ll.w = pk2(y.z - bflo(hh.w), y.w - bfhi(hh.w));
                sbh[ks] = __builtin_bit_cast(bf16x8, hh); sbl[ks] = __builtin_bit_cast(bf16x8, ll);
            }
            const bf16x8 An0 = lds2x8(NT, c * SK_P72 + 4 * g, c * SK_P72 + 16 + 4 * g), An1 = lds2x8(NT, c * SK_P72 + 32 + 4 * g, c * SK_P72 + 48 + 4 * g);
            const bf16x8 Ar0 = lds2x8(RT, c * SK_P72 + 4 * g, c * SK_P72 + 16 + 4 * g), Ar1 = lds2x8(RT, c * SK_P72 + 32 + 4 * g, c * SK_P72 + 48 + 4 * g);
            const u32x2 vq = *(const LAS u32x2*)(VT + (16 * wave + c) * SK_P20 + 4 * g);
            const bf16x8 vlo = __builtin_bit_cast(bf16x8, (u32x4){vq.x, vq.y, 0u, 0u});
            const bf16x8 Alk = lds8z(LK, c * SK_P20 + 4 * g), At = lds8z(TT, c * SK_P20 + 4 * g);
            const bf16x8 Amk = lds2x8(MB, c * SK_P20 + 4 * g, (int)((SK_MK - SK_MB) / 2) + c * SK_P20 + 4 * g);
            f32x4 X = __builtin_amdgcn_mfma_f32_16x16x32_bf16(An0, sbh[0], Z4, 0, 0, 0);
            X = __builtin_amdgcn_mfma_f32_16x16x32_bf16(An1, sbh[1], X, 0, 0, 0);
            X = __builtin_amdgcn_mfma_f32_16x16x32_bf16(An0, sbl[0], X, 0, 0, 0);
            X = __builtin_amdgcn_mfma_f32_16x16x32_bf16(An1, sbl[1], X, 0, 0, 0);
            X = __builtin_amdgcn_mfma_f32_16x16x32_bf16(Alk, vlo, X, 0, 0, 0);
            f32x4 Y = __builtin_amdgcn_mfma_f32_16x16x32_bf16(Ar0, sbh[0], Z4, 0, 0, 0);
            Y = __builtin_amdgcn_mfma_f32_16x16x32_bf16(Ar1, sbh[1], Y, 0, 0, 0);
            Y = __builtin_amdgcn_mfma_f32_16x16x32_bf16(Ar0, sbl[0], Y, 0, 0, 0);
            Y = __builtin_amdgcn_mfma_f32_16x16x32_bf16(Ar1, sbl[1], Y, 0, 0, 0);
            const bf16x8 xb = __builtin_bit_cast(bf16x8, (u32x4){pk2(X.x, X.y), pk2(X.z, X.w), 0u, 0u});
            const f32x4 U = __builtin_amdgcn_mfma_f32_16x16x32_bf16(At, xb, Z4, 0, 0, 0);
            const bf16x8 ub = __builtin_bit_cast(bf16x8, (u32x4){pk2(U.x, U.y), pk2(U.z, U.w), vq.x, vq.y});
            Y = __builtin_amdgcn_mfma_f32_16x16x32_bf16(Amk, ub, Y, 0, 0, 0);
#pragma unroll
            for (int kt = 0; kt < 4; ++kt) {
                const f32x4 pc4 = *(const LAS f32x4*)(PC + 16 * kt + 4 * g);
                const bf16x8 Abk = lds2x8(BP, (16 * kt + c) * SK_P20 + 4 * g, (int)((SK_KP - SK_BP) / 2) + (16 * kt + c) * SK_P20 + 4 * g);
                St[kt] = __builtin_amdgcn_mfma_f32_16x16x32_bf16(Abk, ub, St[kt] * pc4, 0, 0, 0);
            }
            bf16* yp = CAT + (mb + (size_t)blk * 16 + 4 * g) * DM + h * 64 + 16 * wave + c;
            yp[0] = (bf16)f2bf(Y.x); yp[DM] = (bf16)f2bf(Y.y); yp[2 * DM] = (bf16)f2bf(Y.z); yp[3 * DM] = (bf16)f2bf(Y.w);
            __syncthreads();
        }
    } else {
        const int pw = wave - 4;
        const int kc = h * 64 + 4 * c;
        const LAS float* PF = (const LAS float*)(lds + SK_PF); const LAS bf16* W2L = (const LAS bf16*)(lds + SK_W2L); const LAS bf16* A2L = (const LAS bf16*)(lds + SK_A2L);
        LAS unsigned char* scr = lds + SK_SCR + pw * SK_SCRW;
        LAS bf16* BSs = (LAS bf16*)(scr + SK_BS); LAS bf16* KSs = (LAS bf16*)(scr + SK_KS); LAS float* LBs = (LAS float*)(scr + SK_LB);
        u32x4 zwd[2], zwdp[2], zad[2], zadp[2], zv[2], zvp[2]; u32x2 zr[4], zrp[4], zk[4], zkp[4];
#define SK_LOAD_A(T0) do { const bf16* cur = PROJ + (mb + (T0) + c) * LDP0; const bf16* prv = ((T0) + c == 0) ? cur : cur - LDP0; \
        _Pragma("unroll") for (int ks = 0; ks < 2; ++ks) { zwd[ks] = *(const u32x4*)(cur + C_WD + 32 * ks + 8 * g); zwdp[ks] = *(const u32x4*)(prv + C_WD + 32 * ks + 8 * g); \
            zad[ks] = *(const u32x4*)(cur + C_AD + 32 * ks + 8 * g); zadp[ks] = *(const u32x4*)(prv + C_AD + 32 * ks + 8 * g); } } while (0)
#define SK_LOAD_V(T0) do { \
        { const int sv_ = lane >> 2, cv_ = lane & 3; const bf16* cs = PROJ + (mb + (T0) + sv_) * LDP0; const bf16* ps = ((T0) + sv_ == 0) ? cs : cs - LDP0; \
          _Pragma("unroll") for (int i = 0; i < 2; ++i) { zv[i] = *(const u32x4*)(cs + C_V + h * 64 + 16 * cv_ + 8 * i); zvp[i] = *(const u32x4*)(ps + C_V + h * 64 + 16 * cv_ + 8 * i); } } } while (0)
#define SK_LOAD_B(T0) do { _Pragma("unroll") for (int jj = 0; jj < 4; ++jj) { const int s_ = 4 * g + jj; const bf16* cs = PROJ + (mb + (T0) + s_) * LDP0; const bf16* ps = ((T0) + s_ == 0) ? cs : cs - LDP0; \
            zr[jj] = *(const u32x2*)(cs + C_R + kc); zrp[jj] = *(const u32x2*)(ps + C_R + kc); zk[jj] = *(const u32x2*)(cs + C_K + kc); zkp[jj] = *(const u32x2*)(ps + C_K + kc); } } while (0)
        SK_LOAD_A(pw * 16); SK_LOAD_V(pw * 16); SK_LOAD_B(pw * 16);
        for (int q = 0; q < pw; ++q) __syncthreads();
        for (int n = 0; n < NBLK / 4; ++n) {
            const int blk = 4 * n + pw, t0 = blk * 16, t0n = (blk + 4 < NBLK) ? t0 + 64 : t0;
            LAS unsigned char* sl = lds + (blk % 3) * SK_SLOT;
            int c_o = c; asm volatile("" : "+v"(c_o));
            const float pz_c = (t0 + c == 0) ? 0.f : 1.f;
            f32x4 accw[4], acca[4];
            {
                bf16x8 Aw[2], Aa[2];
#pragma unroll
                for (int ks = 0; ks < 2; ++ks) {
                    const f32x4 m0 = *(const LAS f32x4*)(PF + PF_MUWD * 64 + 32 * ks + 8 * g), m1 = *(const LAS f32x4*)(PF + PF_MUWD * 64 + 32 * ks + 8 * g + 4);
                    const f32x4 n0 = *(const LAS f32x4*)(PF + PF_MUAD * 64 + 32 * ks + 8 * g), n1 = *(const LAS f32x4*)(PF + PF_MUAD * 64 + 32 * ks + 8 * g + 4);
                    float xw[8], xa[8];
#pragma unroll
                    for (int e = 0; e < 4; ++e) {
                        const unsigned uw = zwd[ks][e], up = zwdp[ks][e], ua = zad[ks][e], uq = zadp[ks][e];
                        const float muw0 = (e < 2) ? m0[2 * e] : m1[2 * e - 4], muw1 = (e < 2) ? m0[2 * e + 1] : m1[2 * e - 3];
                        const float mua0 = (e < 2) ? n0[2 * e] : n1[2 * e - 4], mua1 = (e < 2) ? n0[2 * e + 1] : n1[2 * e - 3];
                        float z0 = bflo(uw), z1 = bfhi(uw);
                        z0 = z0 + (bflo(up) * pz_c - z0) * muw0; z1 = z1 + (bfhi(up) * pz_c - z1) * muw1;
                        xw[2 * e] = 1.f - 2.f * __builtin_amdgcn_rcpf(1.f + __builtin_amdgcn_exp2f(2.8853900817779268f * z0));
                        xw[2 * e + 1] = 1.f - 2.f * __builtin_amdgcn_rcpf(1.f + __builtin_amdgcn_exp2f(2.8853900817779268f * z1));
                        float y0 = bflo(ua), y1 = bfhi(ua);
                        xa[2 * e] = y0 + (bflo(uq) * pz_c - y0) * mua0; xa[2 * e + 1] = y1 + (bfhi(uq) * pz_c - y1) * mua1;
                    }
                    u32x4 w; w.x = pk2(xw[0], xw[1]); w.y = pk2(xw[2], xw[3]); w.z = pk2(xw[4], xw[5]); w.w = pk2(xw[6], xw[7]); Aw[ks] = __builtin_bit_cast(bf16x8, w);
                    u32x4 x; x.x = pk2(xa[0], xa[1]); x.y = pk2(xa[2], xa[3]); x.z = pk2(xa[4], xa[5]); x.w = pk2(xa[6], xa[7]); Aa[ks] = __builtin_bit_cast(bf16x8, x);
                }
                {
                    unsigned vm[8];
                    const int sv = lane >> 2, cv = lane & 3; const float pz = (t0 + sv == 0) ? 0.f : 1.f;
#pragma unroll
                    for (int i = 0; i < 2; ++i) {
                        const LAS float* mv = PF + PF_MUV * 64 + 16 * cv + 8 * i;
                        const f32x4 m0 = *(const LAS f32x4*)mv, m1 = *(const LAS f32x4*)(mv + 4);
#pragma unroll
                        for (int e = 0; e < 4; ++e) {
                            const unsigned uc = zv[i][e], up = zvp[i][e];
                            const float ma = (e < 2) ? m0[2 * e] : m1[2 * e - 4], mb_ = (e < 2) ? m0[2 * e + 1] : m1[2 * e - 3];
                            float z0 = bflo(uc), z1 = bfhi(uc);
                            z0 = z0 + (bflo(up) * pz - z0) * ma; z1 = z1 + (bfhi(up) * pz - z1) * mb_;
                            vm[4 * i + e] = pk2(z0, z1);
                        }
                    }
                    *(LAS u32x4*)(scr + SK_VM + lane * 32) = (u32x4){vm[0], vm[1], vm[2], vm[3]}; *(LAS u32x4*)(scr + SK_VM + lane * 32 + 16) = (u32x4){vm[4], vm[5], vm[6], vm[7]};
                }
                SK_LOAD_A(t0n);
#pragma unroll
                for (int nt = 0; nt < 4; ++nt) {
                    const bf16x8 wf0 = *(const LAS bf16x8*)(W2L + (nt * 16 + c) * SK_P72 + 8 * g), wf1 = *(const LAS bf16x8*)(W2L + (nt * 16 + c) * SK_P72 + 32 + 8 * g);
                    const bf16x8 af0 = *(const LAS bf16x8*)(A2L + (nt * 16 + c) * SK_P72 + 8 * g), af1 = *(const LAS bf16x8*)(A2L + (nt * 16 + c) * SK_P72 + 32 + 8 * g);
                    accw[nt] = __builtin_amdgcn_mfma_f32_16x16x32_bf16(Aw[0], wf0, Z4, 0, 0, 0);
                    accw[nt] = __builtin_amdgcn_mfma_f32_16x16x32_bf16(Aw[1], wf1, accw[nt], 0, 0, 0);
                    acca[nt] = __builtin_amdgcn_mfma_f32_16x16x32_bf16(Aa[0], af0, Z4, 0, 0, 0);
                    acca[nt] = __builtin_amdgcn_mfma_f32_16x16x32_bf16(Aa[1], af1, acca[nt], 0, 0, 0);
                }
            }
            __syncthreads();
            u32x2 ntp[4], rtp[4], bpp[4], kpp[4]; f32x4 pcv;
            {
                f32x4 dec[4], E4;
                const f32x4 p_w0 = *(const LAS f32x4*)(PF + PF_W0 * 64 + 4 * c);
#pragma unroll
                for (int jj = 0; jj < 4; ++jj)
#pragma unroll
                    for (int nt = 0; nt < 4; ++nt) dec[jj][nt] = __builtin_amdgcn_exp2f(-0.8750322163622201f * sigmoidf_(p_w0[nt] + accw[nt][jj]));
#pragma unroll
                for (int nt = 0; nt < 4; ++nt) {
                    const float p3 = (dec[0][nt] * dec[1][nt]) * (dec[2][nt] * dec[3][nt]);
                    const float q0 = __shfl(p3, c), q1 = __shfl(p3, c + 16), q2 = __shfl(p3, c + 32), q3 = __shfl(p3, c + 48);
                    E4[nt] = ((g > 0) ? q0 : 1.f) * ((g > 1) ? q1 : 1.f) * ((g > 2) ? q2 : 1.f);
                    pcv[nt] = (q0 * q1) * (q2 * q3);
                }
                const f32x4 p_a0 = *(const LAS f32x4*)(PF + PF_A0 * 64 + 4 * c), p_kk = *(const LAS f32x4*)(PF + PF_KK * 64 + 4 * c), p_ka = *(const LAS f32x4*)(PF + PF_KA * 64 + 4 * c),
                            p_rk = *(const LAS f32x4*)(PF + PF_RK * 64 + 4 * c), mu_r = *(const LAS f32x4*)(PF + PF_MUR * 64 + 4 * c), mu_k = *(const LAS f32x4*)(PF + PF_MUK * 64 + 4 * c);
                f32x4 pex = E4, bprev, kprev;
#pragma unroll
                for (int jj = 0; jj < 4; ++jj) {
                    if (jj == 2) __syncthreads();
                    const int s = 4 * g + jj;
                    const float pz = (t0 + s == 0) ? 0.f : 1.f;
                    const f32x4 pin = pex * dec[jj];
                    f32x4 rr, kp4, ku, aa;
                    const unsigned ur[2] = {zr[jj].x, zr[jj].y}, urp[2] = {zrp[jj].x, zrp[jj].y}, uk[2] = {zk[jj].x, zk[jj].y}, ukp[2] = {zkp[jj].x, zkp[jj].y};
                    float ssq = 0.f, bs = 0.f;
#pragma unroll
                    for (int nt = 0; nt < 4; ++nt) {
                        const float zc = (nt & 1) ? bfhi(ur[nt >> 1]) : bflo(ur[nt >> 1]), zp = ((nt & 1) ? bfhi(urp[nt >> 1]) : bflo(urp[nt >> 1])) * pz;
                        const float kc_ = (nt & 1) ? bfhi(uk[nt >> 1]) : bflo(uk[nt >> 1]), kp_ = ((nt & 1) ? bfhi(ukp[nt >> 1]) : bflo(ukp[nt >> 1])) * pz;
                        rr[nt] = zc + (zp - zc) * mu_r[nt];
                        const float kk = kc_ + (kp_ - kc_) * mu_k[nt];
                        aa[nt] = sigmoidf_(p_a0[nt] + acca[nt][jj]);
                        ku[nt] = kk * p_kk[nt];
                        ssq += ku[nt] * ku[nt];
                        kp4[nt] = kk * (1.f + (aa[nt] - 1.f) * p_ka[nt]);
                        bs += rr[nt] * kp4[nt] * p_rk[nt];
                    }
                    ssq = sum16(ssq); bs = sum16(bs);
                    if (c == 0) ((float*)(ws + WS_BS))[(mb + t0 + s) * AH + h] = bs;
                    const float rn = __builtin_amdgcn_rsqf(fmaxf(ssq, 1e-12f));
                    f32x4 rp; rp.x = __builtin_amdgcn_rcpf(pin.x); rp.y = __builtin_amdgcn_rcpf(pin.y); rp.z = __builtin_amdgcn_rcpf(pin.z); rp.w = __builtin_amdgcn_rcpf(pin.w);
                    const f32x4 kn = ku * rn;
                    const f32x4 nt_ = pex * (-kn), bt = kn * aa * rp, kt_ = kp4 * rp, rt = pin * rr;
                    const f32x4 bpc = bt * pcv, kpc = kt_ * pcv;
                    ntp[jj] = (u32x2){pk2(nt_.x, nt_.y), pk2(nt_.z, nt_.w)};
                    rtp[jj] = (u32x2){pk2(rt.x, rt.y), pk2(rt.z, rt.w)};
                    *(LAS u32x2*)(BSs + s * SK_P72 + 4 * c) = (u32x2){pk2(bt.x, bt.y), pk2(bt.z, bt.w)};
                    *(LAS u32x2*)(KSs + s * SK_P72 + 4 * c) = (u32x2){pk2(kt_.x, kt_.y), pk2(kt_.z, kt_.w)};
                    if (jj & 1) {
#pragma unroll
                        for (int nt = 0; nt < 4; ++nt) { if (jj == 1) { bpp[nt].x = pk2(bprev[nt], bpc[nt]); kpp[nt].x = pk2(kprev[nt], kpc[nt]); } else { bpp[nt].y = pk2(bprev[nt], bpc[nt]); kpp[nt].y = pk2(kprev[nt], kpc[nt]); } }
                    } else { bprev = bpc; kprev = kpc; }
                    pex = pin;
                }
                SK_LOAD_B(t0n);
            }
            SK_LOAD_V(t0n);
            {
                LAS bf16* NT = (LAS bf16*)(sl + SK_NT); LAS bf16* RT = (LAS bf16*)(sl + SK_RT);
                LAS bf16* BP = (LAS bf16*)(sl + SK_BP); LAS bf16* KP = (LAS bf16*)(sl + SK_KP);
#pragma unroll
                for (int jj = 0; jj < 4; ++jj) { const int s = 4 * g + jj;
                    *(LAS u32x2*)(NT + s * SK_P72 + 4 * c) = ntp[jj]; *(LAS u32x2*)(RT + s * SK_P72 + 4 * c) = rtp[jj]; }
#pragma unroll
                for (int nt = 0; nt < 4; ++nt) { *(LAS u32x2*)(BP + (4 * c + nt) * SK_P20 + 4 * g) = bpp[nt]; *(LAS u32x2*)(KP + (4 * c + nt) * SK_P20 + 4 * g) = kpp[nt]; }
                if (g == 0) *(LAS f32x4*)((LAS float*)(sl + SK_PC) + 4 * c) = pcv;
                { const int sv = lane >> 2, cv = lane & 3; LAS bf16* VT = (LAS bf16*)(sl + SK_VT);
                  const u32x4 va_ = *(const LAS u32x4*)(scr + SK_VM + lane * 32), vb_ = *(const LAS u32x4*)(scr + SK_VM + lane * 32 + 16);
                  const unsigned vm[8] = {va_.x, va_.y, va_.z, va_.w, vb_.x, vb_.y, vb_.z, vb_.w};
#pragma unroll
                  for (int i = 0; i < 8; ++i) { VT[(16 * cv + 2 * i) * SK_P20 + sv] = (bf16)(vm[i] & 0xffffu); VT[(16 * cv + 2 * i + 1) * SK_P20 + sv] = (bf16)(vm[i] >> 16); } }
                asm volatile("s_waitcnt lgkmcnt(0)" ::: "memory");
                f32x4 Lb = Z4, Lk = Z4, Mb = Z4, Mk = Z4;
#pragma unroll
                for (int ks = 0; ks < 2; ++ks) {
                    const bf16x8 ab = *(const LAS bf16x8*)(BSs + c * SK_P72 + 32 * ks + 8 * g), ak = *(const LAS bf16x8*)(KSs + c * SK_P72 + 32 * ks + 8 * g);
                    const bf16x8 bn = *(const LAS bf16x8*)(NT + c * SK_P72 + 32 * ks + 8 * g), br = *(const LAS bf16x8*)(RT + c * SK_P72 + 32 * ks + 8 * g);
                    Lb = __builtin_amdgcn_mfma_f32_16x16x32_bf16(ab, bn, Lb, 0, 0, 0);
                    Lk = __builtin_amdgcn_mfma_f32_16x16x32_bf16(ak, bn, Lk, 0, 0, 0);
                    Mb = __builtin_amdgcn_mfma_f32_16x16x32_bf16(ab, br, Mb, 0, 0, 0);
                    Mk = __builtin_amdgcn_mfma_f32_16x16x32_bf16(ak, br, Mk, 0, 0, 0);
                }
#pragma unroll
                for (int j = 0; j < 4; ++j) { const int s = 4 * g + j; if (!(s < c)) { Lb[j] = 0.f; Lk[j] = 0.f; } if (!(s <= c)) { Mb[j] = 0.f; Mk[j] = 0.f; } }
                *(LAS u32x2*)((LAS bf16*)(sl + SK_LK) + c * SK_P20 + 4 * g) = (u32x2){pk2(Lk[0], Lk[1]), pk2(Lk[2], Lk[3])};
                *(LAS u32x2*)((LAS bf16*)(sl + SK_MB) + c * SK_P20 + 4 * g) = (u32x2){pk2(Mb[0], Mb[1]), pk2(Mb[2], Mb[3])};
                *(LAS u32x2*)((LAS bf16*)(sl + SK_MK) + c * SK_P20 + 4 * g) = (u32x2){pk2(Mk[0], Mk[1]), pk2(Mk[2], Mk[3])};
                *(LAS f32x4*)(LBs + c * 16 + 4 * g) = Lb;
            }
            __syncthreads();
            {
                float Ti[16];
#pragma unroll
                for (int t = 0; t < 16; ++t) {
                    float acc = (c_o == t) ? 1.f : 0.f;
                    if ((t & 3) == 0) asm volatile("" ::: "memory");
#pragma unroll
                    for (int s4 = 0; s4 < (t + 3) / 4; ++s4) {
                        const f32x4 l4 = *(const LAS f32x4*)(LBs + t * 16 + 4 * s4);
#pragma unroll
                        for (int e = 0; e < 4; ++e) if (4 * s4 + e < t) acc += Ti[4 * s4 + e] * l4[e];
                    }
                    Ti[t] = acc;
                }
                if (g == 0) {
                    LAS bf16* TT = (LAS bf16*)(sl + SK_TT);
#pragma unroll
                    for (int t = 0; t < 16; ++t) TT[t * SK_P20 + c] = (bf16)f2bf(Ti[t]);
                }
            }
            __syncthreads();
        }
#undef SK_LOAD_A
#undef SK_LOAD_V
#undef SK_LOAD_B
        for (int q = 0; q < 4 - pw; ++q) __syncthreads();
    }
}

__device__ __forceinline__ void phase_scan(const Args& a, LAS unsigned char* lds) {
    const int G = gridDim.x, bx = blockIdx.x;
    if (bx < 96) { scan_unit(a, lds, bx / 12, bx % 12); }
    else { for (int u = bx - 96; u < 512; u += G - 96) mem_attn_unit(a, lds, 0, u);
           const int wave = __builtin_amdgcn_readfirstlane(threadIdx.x >> 6);
           transpose_group<1>(a, lds, (bx - 96) * 8 + wave, (G - 96) * 8); }
}

__device__ __forceinline__ void phase_rwkv_post(const Args& a) {
    const int tid = threadIdx.x, lane = tid & 63, wave = tid >> 6, G = gridDim.x;
    unsigned char* ws = a.ws;
    const bf16* PROJ = (const bf16*)(ws + WS_PROJ); bf16* CAT = (bf16*)(ws + WS_CAT); const float* BS = (const float*)(ws + WS_BS);
    const float* mu = a.in[I_AMU];
    for (int m = blockIdx.x * 8 + wave; m < MTOK; m += G * 8) {
        const int t = m & (SEQ - 1);
        const bf16* pc = PROJ + (size_t)m * LDP0; const bf16* pp = (t == 0) ? pc : pc - LDP0; const float pz = (t == 0) ? 0.f : 1.f;
#pragma unroll
        for (int i = 0; i < 3; ++i) {
            const int col = 256 * i + 4 * lane, hh = col >> 6;
            const u32x2 yv = *(const u32x2*)(CAT + (size_t)m * DM + col);
            float y[4] = {bflo(yv.x), bfhi(yv.x), bflo(yv.y), bfhi(yv.y)};
            const float mean = sum16((y[0] + y[1]) + (y[2] + y[3])) * (1.f / 64.f);
            float d[4], vs = 0.f;
#pragma unroll
            for (int j = 0; j < 4; ++j) { d[j] = y[j] - mean; vs += d[j] * d[j]; }
            const float rstd = 1.f / sqrtf(sum16(vs) * (1.f / 64.f) + LNX_EPS);
            const f32x4 lw = *(const f32x4*)(a.in[I_ALNW] + col), lb = *(const f32x4*)(a.in[I_ALNB] + col), mv = *(const f32x4*)(mu + C_V + col);
            const u32x2 vc = *(const u32x2*)(pc + C_V + col), vp = *(const u32x2*)(pp + C_V + col), gt = *(const u32x2*)(pc + C_GATE0 + col);
            const float vcur[4] = {bflo(vc.x), bfhi(vc.x), bflo(vc.y), bfhi(vc.y)}, vprv[4] = {bflo(vp.x) * pz, bfhi(vp.x) * pz, bflo(vp.y) * pz, bfhi(vp.y) * pz};
            const float gg[4] = {bflo(gt.x), bfhi(gt.x), bflo(gt.y), bfhi(gt.y)};
            const float bs = BS[(size_t)m * AH + hh];
            float o[4];
#pragma unroll
            for (int j = 0; j < 4; ++j) { const float v = vcur[j] + (vprv[j] - vcur[j]) * mv[j];
                o[j] = (d[j] * rstd * lw[j] + lb[j] + bs * v) * siluf_(gg[j]); }
            u32x2 w; w.x = pk2(o[0], o[1]); w.y = pk2(o[2], o[3]);
            *(u32x2*)(CAT + (size_t)m * DM + col) = w;
        }
    }
}

template <int LAYER>
__device__ __forceinline__ void phase_rows(const Args& a) {
    const int tid = threadIdx.x, lane = tid & 63, wave = tid >> 6, G = gridDim.x;
    unsigned char* ws = a.ws;
    const bf16* Y = (const bf16*)(ws + WS_Y); const float* gpost = a.in[I_POST] + LAYER * DM;
    const float* xin = LAYER ? (const float*)a.out : a.in[I_X];
    bf16* XN = (bf16*)(ws + WS_XN);
    for (int m = blockIdx.x * 8 + wave; m < MTOK; m += G * 8) {
        const u32x2* yr = (const u32x2*)(Y + (size_t)m * DM) + lane; const f32x4* xr = (const f32x4*)(xin + (size_t)m * DM) + lane;
        f32x4 y[4], x[4]; float s = 0.f;
#pragma unroll
        for (int j = 0; j < 4; ++j) { const u32x2 yy = yr[64 * j]; y[j] = (f32x4){bflo(yy.x), bfhi(yy.x), bflo(yy.y), bfhi(yy.y)}; x[j] = xr[64 * j]; s += (y[j].x * y[j].x + y[j].y * y[j].y) + (y[j].z * y[j].z + y[j].w * y[j].w); }
        const float rs = 1.f / sqrtf(wave_sum(s) * (1.f / DM) + NORM_EPS);
        float s1 = 0.f;
        f32x4* orow = (f32x4*)(a.out + (size_t)m * DM) + lane;
#pragma unroll
        for (int j = 0; j < 4; ++j) { const f32x4 gp = *((const f32x4*)gpost + lane + 64 * j);
            x[j] = x[j] + y[j] * rs * gp; orow[64 * j] = x[j];
            s1 += (x[j].x * x[j].x + x[j].y * x[j].y) + (x[j].z * x[j].z + x[j].w * x[j].w); }
        if (LAYER == 0) {
            const float r1 = 1.f / sqrtf(wave_sum(s1) * (1.f / DM) + NORM_EPS);
            unsigned long long* o8 = (unsigned long long*)(XN + (size_t)m * DM) + lane;
#pragma unroll
            for (int j = 0; j < 4; ++j) o8[64 * j] = (unsigned long long)pk2(x[j].x * r1, x[j].y * r1) | ((unsigned long long)pk2(x[j].z * r1, x[j].w * r1) << 32);
        }
    }
}

__device__ __forceinline__ void phase_attn1(const Args& a, LAS unsigned char* lds) {
    const int G = gridDim.x, bx = blockIdx.x, lane = threadIdx.x & 63;
    unsigned char* ws = a.ws;
    const float s1 = wave_sum(a.in[I_LQ1][lane] * a.in[I_LK1][lane]), s2 = wave_sum(a.in[I_LQ2][lane] * a.in[I_LK2][lane]);
    const float lam_init = 0.8f - 0.6f * 0.7408182206817179f;
    const float lam = __expf(s1) - __expf(s2) + lam_init;
    const bf16* PROJ = (const bf16*)(ws + WS_PROJ); const bf16* VT = (const bf16*)(ws + WS_VT); bf16* CAT = (bf16*)(ws + WS_CAT);
    const float slopes[6] = {0.25f, 0.0625f, 0.015625f, 0.00390625f, 0.5f, 0.125f};
    for (int i = 0; i < 3; ++i) {
        int qb, bh;
        if (G == 256) { const int x = bx & 7, w = bx >> 3; const int n = (i == 1) ? (63 - w) : (32 * i + w); qb = 15 - n / 6; bh = 6 * x + n % 6; }
        else { const int n = i * G + bx; if (n >= 768) break; qb = 15 - n / 48; bh = n % 48; }
        const int b = bh / 6, h = bh % 6;
        const size_t row0 = (size_t)b * SEQ + qb * 128;
        float slope = slopes[0];
#pragma unroll
        for (int k = 1; k < 6; ++k) slope = (h == k) ? slopes[k] : slope;
        attn_unit<2>(lds, PROJ + row0 * LDP1 + C_Q1 + h * 128, LDP1,
                     PROJ + (size_t)b * SEQ * LDP1 + C_KSH + h * 128, LDP1,
                     VT + (size_t)(h * 128) * MTOK + (size_t)b * SEQ, MTOK,
                     2 * qb + 1, 2 * qb + 2, slope * LOG2E, qb * 128,
                     PROJ + row0 * LDP1 + C_GATE1 + h * 128, LDP1, CAT + row0 * DM + h * 128, DM, a.in[I_SUBLN], lam, 1.f - lam_init);
    }
    for (int u = bx; u < 512; u += G) mem_attn_unit(a, lds, 1, u);
}

__device__ __forceinline__ unsigned gb_ld(unsigned* p) { return __hip_atomic_load(p, __ATOMIC_RELAXED, __HIP_MEMORY_SCOPE_AGENT); }
__device__ __forceinline__ unsigned gb_add(unsigned* p) { return __hip_atomic_fetch_add(p, 1u, __ATOMIC_RELAXED, __HIP_MEMORY_SCOPE_AGENT); }
__device__ __forceinline__ void grid_barrier(unsigned* bar, unsigned gen) {
    asm volatile("s_waitcnt vmcnt(0)" ::: "memory");
    __syncthreads();
    if (threadIdx.x == 0) {
        const unsigned grp = blockIdx.x & 7u, nloc = gridDim.x >> 3;
        unsigned* GA = bar + 64 * grp; unsigned* GR = bar + 64 * (8 + grp); unsigned* TOP = bar + 64 * 16; unsigned* TOPGEN = bar + 64 * 17;
        __builtin_amdgcn_fence(__ATOMIC_RELEASE, "agent");
        asm volatile("s_waitcnt vmcnt(0)" ::: "memory");
        if (gb_add(GA) + 1u == gen * nloc) {
            if (gb_add(TOP) + 1u == gen * 8u) (void)gb_add(TOPGEN);
            else while (gb_ld(TOPGEN) < gen) __builtin_amdgcn_s_sleep(1);
            (void)gb_add(GR);
        } else {
            while (gb_ld(GR) < gen) __builtin_amdgcn_s_sleep(1);
        }
        __builtin_amdgcn_fence(__ATOMIC_ACQUIRE, "agent");
        asm volatile("s_waitcnt vmcnt(0)" ::: "memory");
    }
    __syncthreads();
}

constexpr int N_PHASES = 10;
__global__ void __launch_bounds__(512, 2) yoco_fwd(Args args) {
    extern __shared__ __attribute__((aligned(16))) unsigned char lds_raw[];
    LAS unsigned char* lds = (LAS unsigned char*)lds_raw;
    const int lo = args.ph_lo, hi = args.ph_hi;
#ifndef ONLY_PHASE
#define ONLY_PHASE -1
#endif
#define IN(k) ((ONLY_PHASE < 0 || ONLY_PHASE == (k)) && lo <= (k) && (k) < hi)
    unsigned* bar_cnt = (unsigned*)args.ws; unsigned bar_gen = 0;
#define SEAM(k) do { if (IN(k) && IN((k) + 1)) { if ((k) == 0) { __syncthreads(); cg::this_grid().sync(); } else { ++bar_gen; grid_barrier(bar_cnt, bar_gen); } } } while (0)
    if (IN(0)) { phase_prologue(args, lds); if (PROBE_DUP == 0) { __syncthreads(); phase_prologue(args, lds); } }
    SEAM(0);
    if (IN(1)) { phase_gemm(args, lds, 0, 3); if (PROBE_DUP == 1) { __syncthreads(); phase_gemm(args, lds, 0, 3); } }
    SEAM(1);
    if (IN(2)) { phase_scan(args, lds); if (PROBE_DUP == 2) { __syncthreads(); phase_scan(args, lds); } }
    SEAM(2);
    if (IN(3)) { phase_rwkv_post(args); if (PROBE_DUP == 3) { __syncthreads(); phase_rwkv_post(args); } }
    SEAM(3);
    if (IN(4)) { phase_gemm(args, lds, 3, 1); if (PROBE_DUP == 4) { __syncthreads(); phase_gemm(args, lds, 3, 1); } }
    SEAM(4);
    if (IN(5)) { phase_rows<0>(args); if (PROBE_DUP == 5) { __syncthreads(); phase_rows<0>(args); } }
    SEAM(5);
    if (IN(6)) { phase_gemm(args, lds, 4, 2); if (PROBE_DUP == 6) { __syncthreads(); phase_gemm(args, lds, 4, 2); } }
    SEAM(6);
    if (IN(7)) { phase_attn1(args, lds); if (PROBE_DUP == 7) { __syncthreads(); phase_attn1(args, lds); } }
    SEAM(7);
    if (IN(8)) { phase_gemm(args, lds, 6, 1); if (PROBE_DUP == 8) { __syncthreads(); phase_gemm(args, lds, 6, 1); } }
    SEAM(8);
#ifdef PROBE_SYNC
    for (int q = 0; q < PROBE_SYNC; ++q) { __syncthreads(); cg::this_grid().sync(); }
#endif
    if (IN(9)) { phase_rows<1>(args); if (PROBE_DUP == 9) { __syncthreads(); phase_rows<1>(args); } }
#undef IN
#undef SEAM
}

extern "C" void kernel_launch(void* const* d_in, const int* in_sizes, int n_in, void* d_out, int out_size, void* d_ws, size_t ws_size, hipStream_t stream) {
    static int ready = 0;
    if (ready == 0) {
        if (n_in != 26 || out_size != MTOK * DM || ws_size < WS_END) { fprintf(stderr, "kernel_launch: unexpected problem shape (n_in %d out %d ws %zu)\n", n_in, out_size, ws_size); ready = -1; return; }
        if (hipFuncSetAttribute((const void*)yoco_fwd, hipFuncAttributeMaxDynamicSharedMemorySize, LDS_BYTES) != hipSuccess) { fprintf(stderr, "kernel_launch: hipFuncSetAttribute failed\n"); ready = -1; return; }
        int per_cu = 0;
        if (hipOccupancyMaxActiveBlocksPerMultiprocessor(&per_cu, (const void*)yoco_fwd, 512, LDS_BYTES) != hipSuccess || per_cu < 1) fprintf(stderr, "kernel_launch: occupancy query says %d\n", per_cu);
        (void)hipGetLastError();
        ready = 1;
    }
    if (ready < 0) return;
    Args a{};
    for (int i = 0; i < 26; ++i) a.in[i] = (const float*)d_in[i];
    a.out = (float*)d_out; a.ws = (unsigned char*)d_ws;
#if MK_COOP
    (void)hipMemsetAsync(d_ws, 0, 8192, stream);
    a.ph_lo = 0; a.ph_hi = N_PHASES;
    void* params[] = {&a};
    hipError_t e = hipLaunchCooperativeKernel((const void*)yoco_fwd, dim3(256), dim3(512), params, LDS_BYTES, stream);
    if (e != hipSuccess) fprintf(stderr, "kernel_launch: cooperative launch failed: %s\n", hipGetErrorString(e));
#else
    for (int ph = 0; ph < N_PHASES; ++ph) { a.ph_lo = ph; a.ph_hi = ph + 1; hipLaunchKernelGGL(yoco_fwd, dim3(256), dim3(512), LDS_BYTES, stream, a); }
#endif
}
```

```cpp
#include <hip/hip_runtime.h>
#include <hip/hip_cooperative_groups.h>
#include <cstdio>
#include <cstdint>
namespace cg = cooperative_groups;

#ifndef PROBE_DUP
#define PROBE_DUP -1
#endif
#ifndef MK_COOP
#define MK_COOP 1
#endif

#define LAS __attribute__((address_space(3)))
typedef unsigned short bf16;
typedef short bf16x8 __attribute__((ext_vector_type(8)));
typedef float f32x4 __attribute__((ext_vector_type(4)));
typedef float f32x2 __attribute__((ext_vector_type(2)));
typedef unsigned u32x4 __attribute__((ext_vector_type(4)));
typedef unsigned u32x2 __attribute__((ext_vector_type(2)));

constexpr int DM = 1024, NBATCH = 8, SEQ = 2048, MTOK = NBATCH * SEQ;
constexpr int MEML = 256, MROWS = NBATCH * MEML;
constexpr int BRW = 768, AH = 12, BH = 6;
constexpr int LDP0 = 3840;
constexpr int LDP1 = 2816;
constexpr int C_R = 0, C_K = 768, C_V = 1536, C_WD = 2304, C_AD = 2368, C_GATE0 = 2432, C_QM0 = 3200, C_GM0 = 3456;
constexpr int C_Q1 = 0, C_GATE1 = 768, C_QM1 = 1536, C_GM1 = 1792, C_KSH = 2048;
constexpr float NORM_EPS = 1e-6f, LNX_EPS = 64e-5f;
constexpr float LOG2E = 1.4426950408889634f;

constexpr size_t MiB = 1u << 20;
constexpr size_t WS_WA = 1 * MiB;
constexpr size_t WS_WB = 9 * MiB;
constexpr size_t WS_WO = 16 * MiB;
constexpr size_t WS_WM = 20 * MiB;
constexpr size_t WS_MEMN = 22 * MiB;
constexpr size_t WS_MK = 26 * MiB;
constexpr size_t WS_MVT = 28 * MiB;
constexpr size_t WS_XN = 30 * MiB;
constexpr size_t WS_CAT = 62 * MiB;
constexpr size_t WS_VT = 94 * MiB;
constexpr size_t WS_PROJ = 118 * MiB;
constexpr size_t WS_Y = 118 * MiB;
constexpr size_t WS_W2T = 0 * MiB + 65536;
constexpr size_t WS_KM = 6144;
constexpr size_t WS_XCNT = 16384;
constexpr size_t WS_XCH = 254 * MiB;
constexpr size_t WS_LD16 = WS_XN;
constexpr size_t WS_A16 = WS_VT;
constexpr int CW_LORA = 1280;
constexpr size_t WS_X1B = 210 * MiB;
constexpr size_t WS_BS = 238 * MiB;
constexpr size_t WS_END = 256 * MiB;

__device__ __forceinline__ unsigned f2bf(float f) { unsigned u = __builtin_bit_cast(unsigned, f); return (u + 0x7fffu + ((u >> 16) & 1u)) >> 16; }
typedef __bf16 bf16x2_t __attribute__((ext_vector_type(2)));
__device__ __forceinline__ unsigned pk2(float lo, float hi) { f32x2 v = {lo, hi}; bf16x2_t b = __builtin_convertvector(v, bf16x2_t); return __builtin_bit_cast(unsigned, b); }
__device__ __forceinline__ float bflo(unsigned u) { return __builtin_bit_cast(float, u << 16); }
__device__ __forceinline__ float bfhi(unsigned u) { return __builtin_bit_cast(float, u & 0xffff0000u); }
__device__ __forceinline__ float wave_sum(float v) {
#pragma unroll
    for (int o = 1; o < 64; o <<= 1) v += __shfl_xor(v, o);
    return v;
}
template <int CTRL> __device__ __forceinline__ float dppf(float x) { return __builtin_bit_cast(float, __builtin_amdgcn_update_dpp(0, __builtin_bit_cast(int, x), CTRL, 0xf, 0xf, false)); }
__device__ __forceinline__ float sum8(float x) { x += dppf<0xB1>(x); x += dppf<0x4E>(x); x += dppf<0x141>(x); return x; }
__device__ __forceinline__ float sum16(float x) { x += dppf<0xB1>(x); x += dppf<0x4E>(x); x += dppf<0x141>(x); x += dppf<0x140>(x); return x; }
__device__ __forceinline__ float rows_max(float m) { m = fmaxf(m, __shfl_xor(m, 16)); return fmaxf(m, __shfl_xor(m, 32)); }
__device__ __forceinline__ float rows_sum(float m) { m += __shfl_xor(m, 16); return m + __shfl_xor(m, 32); }
__device__ __forceinline__ float sigmoidf_(float x) { return __builtin_amdgcn_rcpf(1.f + __builtin_amdgcn_exp2f(-1.4426950408889634f * x)); }
__device__ __forceinline__ float siluf_(float x) { return x * __builtin_amdgcn_rcpf(1.f + __builtin_amdgcn_exp2f(-1.4426950408889634f * x)); }

namespace pg8 {
constexpr int BM = 256, BK = 64, HALF = 128, HTB = HALF * BK * 2, STAGE_BYTES = 8 * HTB, NXCD = 8, WGM = 8;
__device__ __forceinline__ int lds_byte(int r, int c) { const int st = (r >> 4) * 2 + (c >> 5), rr = r & 15, cc = c & 31, ob = rr * 64 + cc * 2; return st * 1024 + (ob ^ (((ob >> 9) & 1) << 5)); }
__device__ __forceinline__ void stage_rc(int b, int& R, int& C) { const int st = b / 1024, sb = b % 1024, swz = sb ^ (((sb >> 9) & 1) << 5); R = (st >> 1) * 16 + swz / 64; C = (st & 1) * 32 + (swz % 64) / 2; }
__device__ __forceinline__ int perm32(int rho) { const int n = rho >> 4, i = rho & 15; return 8 * (i >> 2) + 4 * n + (i & 3); }
struct Unit { int pm, pn; };
struct Gemm { const bf16* A; const bf16* Bt; int M, N, K; };
struct StaticOrder {
    int nM, nN, nwg, G, c;
    __device__ void init(int M, int N, int G_, int c_) { nM = M / BM; nN = N / BM; nwg = nM * nN; G = G_; c = c_; }
    __device__ bool next(int i, Unit& u) const {
        const long L = (long)i * G + c; if (L >= nwg) return false;
        int wgid = (int)L; { const int q = nwg / NXCD, r = nwg % NXCD, xcd = wgid % NXCD, off = wgid / NXCD; wgid = (xcd < r ? xcd * (q + 1) : r * (q + 1) + (xcd - r) * q) + off; }
        const int nig = WGM * nN, gid = wgid / nig, fm = gid * WGM, gsz = (nM - fm) < WGM ? (nM - fm) : WGM;
        u.pm = fm + ((wgid % nig) % gsz); u.pn = (wgid % nig) / gsz; return true;
    }
};
__device__ __forceinline__ unsigned cvt_pk_bf16(float lo, float hi) { unsigned r; asm volatile("v_cvt_pk_bf16_f32 %0, %1, %2" : "=v"(r) : "v"(lo), "v"(hi)); return r; }

struct EpiStore {
    void* O; int ldc; int f32out; unsigned* km;
    __device__ __forceinline__ void operator()(const f32x4 (&acc)[2][2][4][2], const Unit& u, int wr, int wc, int fr, int fq) const {
        const int row0 = u.pm * BM + wr * 64 + fr, col0 = u.pn * BM + wc * 32 + 8 * fq;
        if (f32out) {
#pragma unroll
            for (int ai = 0; ai < 2; ++ai)
#pragma unroll
                for (int m = 0; m < 4; ++m) { float* rowp = (float*)O + (size_t)(row0 + ai * HALF + m * 16) * ldc + col0;
#pragma unroll
                    for (int bj = 0; bj < 2; ++bj) { *(f32x4*)(rowp + bj * HALF) = acc[ai][bj][m][0]; *(f32x4*)(rowp + bj * HALF + 4) = acc[ai][bj][m][1]; } }
        } else {
#pragma unroll
            for (int ai = 0; ai < 2; ++ai)
#pragma unroll
                for (int m = 0; m < 4; ++m) { bf16* rowp = (bf16*)O + (size_t)(row0 + ai * HALF + m * 16) * ldc + col0;
#pragma unroll
                    for (int bj = 0; bj < 2; ++bj) { const f32x4 v0 = acc[ai][bj][m][0], v1 = acc[ai][bj][m][1];
                        u32x4 w; w.x = cvt_pk_bf16(v0[0], v0[1]); w.y = cvt_pk_bf16(v0[2], v0[3]); w.z = cvt_pk_bf16(v1[0], v1[1]); w.w = cvt_pk_bf16(v1[2], v1[3]);
                        *(u32x4*)(rowp + bj * HALF) = w; } }
            if (km && u.pn >= 8) {
#pragma unroll
                for (int bj = 0; bj < 2; ++bj) {
                    float pmax = 0.f;
#pragma unroll
                    for (int ai = 0; ai < 2; ++ai)
#pragma unroll
                        for (int m = 0; m < 4; ++m) { const f32x4 v0 = acc[ai][bj][m][0], v1 = acc[ai][bj][m][1];
                            const unsigned w0 = cvt_pk_bf16(v0[0], v0[1]), w1 = cvt_pk_bf16(v0[2], v0[3]), w2 = cvt_pk_bf16(v1[0], v1[1]), w3 = cvt_pk_bf16(v1[2], v1[3]);
                            const float a0 = bflo(w0), a1 = bfhi(w0), a2 = bflo(w1), a3 = bfhi(w1), a4 = bflo(w2), a5 = bfhi(w2), a6 = bflo(w3), a7 = bfhi(w3);
                            pmax = fmaxf(pmax, ((a0 * a0 + a1 * a1) + (a2 * a2 + a3 * a3)) + ((a4 * a4 + a5 * a5) + (a6 * a6 + a7 * a7))); }
                    pmax = fmaxf(pmax, dppf<0xB1>(pmax)); pmax = fmaxf(pmax, dppf<0x4E>(pmax)); pmax = fmaxf(pmax, dppf<0x141>(pmax)); pmax = fmaxf(pmax, dppf<0x140>(pmax));
                    if (fr == 0) { const int ck = u.pn * BM + bj * HALF + wc * 32 + 8 * fq - 2048;
                        atomicMax(km + (((u.pm >> 3) * 6 + (ck >> 7)) * 2 + ((ck >> 6) & 1)) * 8 + ((ck >> 3) & 7), __builtin_bit_cast(unsigned, pmax)); }
                }
            }
        }
    }
};

struct EpiFused {
    const float* xin; const bf16* xin16; float* out; bf16* out16; bf16* XN; const float* gpost; float* xch; unsigned* cnt;
    __device__ __forceinline__ void exchange(int ex, int pm, int pn, LAS float* P, LAS float* RS, int tid) const {
        __syncthreads();
        unsigned* mine = (unsigned*)(xch + ((size_t)(ex * 64 + pm) * 4) * 256);
        if (tid < 256) { const f32x4 p4 = *(const LAS f32x4*)(P + tid * 4);
            __hip_atomic_store(mine + pn * 256 + tid, __builtin_bit_cast(unsigned, (p4.x + p4.y) + (p4.z + p4.w)), __ATOMIC_RELAXED, __HIP_MEMORY_SCOPE_AGENT); }
        asm volatile("s_waitcnt vmcnt(0)" ::: "memory");
        __syncthreads();
        if (tid == 0) {
            unsigned* c = cnt + (ex * 64 + pm) * 16;
            (void)__hip_atomic_fetch_add(c, 1u, __ATOMIC_RELAXED, __HIP_MEMORY_SCOPE_AGENT);
            while (__hip_atomic_load(c, __ATOMIC_RELAXED, __HIP_MEMORY_SCOPE_AGENT) < 4u) __builtin_amdgcn_s_sleep(1);
        }
        __syncthreads();
        if (tid < 256) {
            const float t0 = __builtin_bit_cast(float, __hip_atomic_load(mine + tid, __ATOMIC_RELAXED, __HIP_MEMORY_SCOPE_AGENT)), t1 = __builtin_bit_cast(float, __hip_atomic_load(mine + 256 + tid, __ATOMIC_RELAXED, __HIP_MEMORY_SCOPE_AGENT)),
                        t2 = __builtin_bit_cast(float, __hip_atomic_load(mine + 512 + tid, __ATOMIC_RELAXED, __HIP_MEMORY_SCOPE_AGENT)), t3 = __builtin_bit_cast(float, __hip_atomic_load(mine + 768 + tid, __ATOMIC_RELAXED, __HIP_MEMORY_SCOPE_AGENT));
            RS[tid] = __builtin_amdgcn_rsqf(((t0 + t1) + (t2 + t3)) * (1.f / 1024.f) + 1e-6f); }
        __syncthreads();
    }
    __device__ __forceinline__ void fused(f32x4 (&acc)[2][2][4][2], const Unit& u, int wr, int wc, int fr, int fq, LAS unsigned char* lds) const {
        const int tid = threadIdx.x;
        LAS float* P = (LAS float*)lds;
        LAS float* RS = (LAS float*)(lds + 4096);
#pragma unroll
        for (int ai = 0; ai < 2; ++ai)
#pragma unroll
            for (int m = 0; m < 4; ++m) {
                float p = 0.f;
#pragma unroll
                for (int bj = 0; bj < 2; ++bj)
#pragma unroll
                    for (int n = 0; n < 2; ++n) { const f32x4 v = acc[ai][bj][m][n]; p += (v.x * v.x + v.y * v.y) + (v.z * v.z + v.w * v.w); }
                p += __shfl_xor(p, 16); p += __shfl_xor(p, 32);
                if (fq == 0) P[(ai * HALF + wr * 64 + m * 16 + fr) * 4 + wc] = p;
            }
        exchange(0, u.pm, u.pn, P, RS, tid);
        const int col0 = u.pn * BM + wc * 32 + 8 * fq;
        f32x4 gp[2][2];
#pragma unroll
        for (int bj = 0; bj < 2; ++bj)
#pragma unroll
            for (int n = 0; n < 2; ++n) gp[bj][n] = *(const f32x4*)(gpost + col0 + bj * HALF + 4 * n);
#pragma unroll
        for (int ai = 0; ai < 2; ++ai)
#pragma unroll
            for (int m = 0; m < 4; ++m) {
                const int rl = ai * HALF + wr * 64 + m * 16 + fr; const float rs = RS[rl];
                const size_t off = (size_t)(u.pm * BM + rl) * 1024 + col0;
                float p = 0.f;
#pragma unroll
                for (int bj = 0; bj < 2; ++bj) {
                    f32x4 xv[2];
                    if (xin16) { const u32x4 xb = *(const u32x4*)(xin16 + off + bj * HALF); xv[0] = (f32x4){bflo(xb.x), bfhi(xb.x), bflo(xb.y), bfhi(xb.y)}; xv[1] = (f32x4){bflo(xb.z), bfhi(xb.z), bflo(xb.w), bfhi(xb.w)}; }
                    else { xv[0] = *(const f32x4*)(xin + off + bj * HALF); xv[1] = *(const f32x4*)(xin + off + bj * HALF + 4); }
#pragma unroll
                    for (int n = 0; n < 2; ++n) {
                        const f32x4 x1 = xv[n] + acc[ai][bj][m][n] * rs * gp[bj][n];
                        acc[ai][bj][m][n] = x1;
                        p += (x1.x * x1.x + x1.y * x1.y) + (x1.z * x1.z + x1.w * x1.w);
                    }
                    if (out16) { const f32x4 v0 = acc[ai][bj][m][0], v1 = acc[ai][bj][m][1];
                        u32x4 w; w.x = cvt_pk_bf16(v0[0], v0[1]); w.y = cvt_pk_bf16(v0[2], v0[3]); w.z = cvt_pk_bf16(v1[0], v1[1]); w.w = cvt_pk_bf16(v1[2], v1[3]);
                        *(u32x4*)(out16 + off + bj * HALF) = w; }
                    else { *(f32x4*)(out + off + bj * HALF) = acc[ai][bj][m][0]; *(f32x4*)(out + off + bj * HALF + 4) = acc[ai][bj][m][1]; }
                }
                if (XN) { p += __shfl_xor(p, 16); p += __shfl_xor(p, 32); if (fq == 0) P[rl * 4 + wc] = p; }
            }
        if (XN) {
            exchange(1, u.pm, u.pn, P, RS, tid);
#pragma unroll
            for (int ai = 0; ai < 2; ++ai)
#pragma unroll
                for (int m = 0; m < 4; ++m) {
                    const int rl = ai * HALF + wr * 64 + m * 16 + fr; const float r1 = RS[rl];
                    bf16* rowp = XN + (size_t)(u.pm * BM + rl) * 1024 + col0;
#pragma unroll
                    for (int bj = 0; bj < 2; ++bj) { const f32x4 v0 = acc[ai][bj][m][0] * r1, v1 = acc[ai][bj][m][1] * r1;
                        u32x4 w; w.x = cvt_pk_bf16(v0[0], v0[1]); w.y = cvt_pk_bf16(v0[2], v0[3]); w.z = cvt_pk_bf16(v1[0], v1[1]); w.w = cvt_pk_bf16(v1[2], v1[3]);
                        *(u32x4*)(rowp + bj * HALF) = w; }
                }
        }
        __syncthreads();
    }
};

template <class Epi, class Sched, bool FUSED = false>
__device__ __forceinline__ void gemm_phase(LAS unsigned char* lds, const Gemm g, const Sched& S, const Epi& E) {
    const int tid = threadIdx.x, wid = __builtin_amdgcn_readfirstlane(tid >> 6), lane = tid & 63, wr = wid >> 2, wc = wid & 3, fr = lane & 15, fq = lane >> 4;
    const int K = g.K, nt = K / BK;
    unsigned voffA[2], voffB[2];
#pragma unroll
    for (int i = 0; i < 2; ++i) { int R, C; stage_rc(tid * 16 + i * 8192, R, C); const int Rb = (R & ~31) + perm32(R & 31);
        voffA[i] = (unsigned)(R * K + C) * 2u; voffB[i] = (unsigned)(Rb * K + C) * 2u; }
    const size_t kstep = (size_t)(BK * 2);
    const size_t hstep = (size_t)HALF * K * 2;
    const size_t tstep = 2 * hstep;
    const unsigned ldsw = (unsigned)wid * 1024u;
    const int aoff = lds_byte(wr * 64 + fr, fq * 8), boff = lds_byte(wc * 32 + fr, fq * 8);
#define PG8_SA(b, h) (((b) * 2 + (h)) * HTB)
#define PG8_SB(b, h) ((4 + (b) * 2 + (h)) * HTB)
#define PG8_STAGE(bufoff, gbase, voff) do { _Pragma("unroll") for (int _i = 0; _i < 2; ++_i) \
        __builtin_amdgcn_global_load_lds((const unsigned*)((const char*)(gbase) + (voff)[_i]), (LAS unsigned*)(lds + (bufoff) + ldsw + _i * 8192), 16, 0, 0); } while (0)
#define PG8_LDA(dst, b, h) do { _Pragma("unroll") for (int m = 0; m < 4; ++m) _Pragma("unroll") for (int k = 0; k < 2; ++k) dst[m][k] = *(const LAS bf16x8*)(lds + PG8_SA(b, h) + aoff + m * 2048 + k * 1024); } while (0)
#define PG8_LDB(dst, b, h) do { _Pragma("unroll") for (int n = 0; n < 2; ++n) _Pragma("unroll") for (int k = 0; k < 2; ++k) dst[n][k] = *(const LAS bf16x8*)(lds + PG8_SB(b, h) + boff + n * 2048 + k * 1024); } while (0)
#define PG8_MMA(ai, bj, At, Bt) do { __builtin_amdgcn_s_setprio(1); _Pragma("unroll") for (int m = 0; m < 4; ++m) _Pragma("unroll") for (int n = 0; n < 2; ++n) _Pragma("unroll") for (int k = 0; k < 2; ++k) \
        acc[ai][bj][m][n] = __builtin_amdgcn_mfma_f32_16x16x32_bf16(Bt[n][k], At[m][k], acc[ai][bj][m][n], 0, 0, 0); __builtin_amdgcn_s_setprio(0); } while (0)
#define PG8_WAIT_V(n) asm volatile("s_waitcnt vmcnt(" #n ")" ::: "memory")
#define PG8_WAIT_L(n) asm volatile("s_waitcnt lgkmcnt(" #n ")" ::: "memory")
#define PG8_BAR __builtin_amdgcn_s_barrier()
#define PG8_SCHED __builtin_amdgcn_sched_barrier(0)
    Unit cur, nxt; int ui = 0;
    if (!S.next(0, cur)) return;
    f32x4 acc[2][2][4][2];
#pragma unroll
    for (int a = 0; a < 2; ++a)
#pragma unroll
        for (int b = 0; b < 2; ++b)
#pragma unroll
            for (int m = 0; m < 4; ++m)
#pragma unroll
                for (int n = 0; n < 2; ++n) acc[a][b][m][n] = (f32x4){0.f, 0.f, 0.f, 0.f};
    bf16x8 At[4][2], B0[2][2], B1[2][2];
    const char* cA = (const char*)g.A + (size_t)cur.pm * tstep; const char* cB = (const char*)g.Bt + (size_t)cur.pn * tstep;
    PG8_STAGE(PG8_SB(0, 0), cB, voffB); PG8_STAGE(PG8_SB(0, 1), cB + hstep, voffB); PG8_STAGE(PG8_SA(0, 0), cA, voffA); PG8_STAGE(PG8_SA(0, 1), cA + hstep, voffA);
    if (wr == 1) PG8_BAR;
    PG8_WAIT_V(2); PG8_BAR;
    PG8_STAGE(PG8_SB(1, 0), cB + kstep, voffB); PG8_STAGE(PG8_SA(1, 0), cA + kstep, voffA); PG8_STAGE(PG8_SB(1, 1), cB + hstep + kstep, voffB);
    PG8_WAIT_V(6); PG8_BAR;
    for (;;) {
        const bool has_next = S.next(ui + 1, nxt);
        const char* nA = has_next ? (const char*)g.A + (size_t)nxt.pm * tstep : cA; const char* nB = has_next ? (const char*)g.Bt + (size_t)nxt.pn * tstep : cB;
        for (int t = 0; t < nt; t += 2) {
            const bool last = (t == nt - 2);
            const char* a1 = cA + (size_t)(t + 1) * kstep;
            const char* a2 = last ? nA : cA + (size_t)(t + 2) * kstep; const char* b2 = last ? nB : cB + (size_t)(t + 2) * kstep;
            const char* a3 = a2 + kstep; const char* b3 = b2 + kstep;
            PG8_LDB(B0, 0, 0); PG8_LDB(B1, 0, 1); PG8_SCHED; PG8_LDA(At, 0, 0); PG8_STAGE(PG8_SA(1, 1), a1 + hstep, voffA);
            PG8_WAIT_V(8); PG8_WAIT_L(0); PG8_BAR; PG8_MMA(0, 0, At, B0); PG8_MMA(0, 1, At, B1); PG8_BAR; PG8_SCHED;
            PG8_LDA(At, 0, 1); PG8_STAGE(PG8_SB(0, 0), b2, voffB); PG8_STAGE(PG8_SB(0, 1), b2 + hstep, voffB); PG8_STAGE(PG8_SA(0, 0), a2, voffA);
            PG8_WAIT_V(8); PG8_WAIT_L(0); PG8_BAR; PG8_MMA(1, 0, At, B0); PG8_MMA(1, 1, At, B1); PG8_BAR; PG8_SCHED;
            PG8_LDB(B0, 1, 0); PG8_LDB(B1, 1, 1); PG8_SCHED; PG8_LDA(At, 1, 0); PG8_STAGE(PG8_SA(0, 1), a2 + hstep, voffA);
            PG8_WAIT_V(8); PG8_WAIT_L(0); PG8_BAR; PG8_MMA(0, 0, At, B0); PG8_MMA(0, 1, At, B1); PG8_BAR; PG8_SCHED;
            PG8_LDA(At, 1, 1); PG8_STAGE(PG8_SB(1, 0), b3, voffB); PG8_STAGE(PG8_SB(1, 1), b3 + hstep, voffB); PG8_STAGE(PG8_SA(1, 0), a3, voffA);
            PG8_WAIT_V(8); PG8_WAIT_L(0); PG8_BAR; PG8_MMA(1, 0, At, B0); PG8_MMA(1, 1, At, B1); PG8_BAR; PG8_SCHED;
        }
        if (wr == 0) PG8_BAR;
        if constexpr (!FUSED) E(acc, cur, wr, wc, fr, fq);
        if (!has_next) break;
#pragma unroll
        for (int a = 0; a < 2; ++a)
#pragma unroll
            for (int b = 0; b < 2; ++b)
#pragma unroll
                for (int m = 0; m < 4; ++m)
#pragma unroll
                    for (int n = 0; n < 2; ++n) acc[a][b][m][n] = (f32x4){0.f, 0.f, 0.f, 0.f};
        cur = nxt; cA = nA; cB = nB; ++ui;
        if (wr == 1) PG8_BAR;
    }
    PG8_WAIT_V(0);
    PG8_BAR;
    if constexpr (FUSED) E.fused(acc, cur, wr, wc, fr, fq, lds);
#undef PG8_SA
#undef PG8_SB
#undef PG8_STAGE
#undef PG8_LDA
#undef PG8_LDB
#undef PG8_MMA
#undef PG8_WAIT_V
#undef PG8_WAIT_L
#undef PG8_BAR
#undef PG8_SCHED
}
}

struct Args { const float* in[26]; float* out; unsigned char* ws; int ph_lo, ph_hi; };
enum { I_X = 0, I_MEM, I_PRE, I_POST, I_WOUT, I_MEMNORM, I_WMEMKV, I_AWIN, I_AMU, I_AW0, I_AW2, I_AA0, I_AA2, I_AKK, I_AKA, I_ARK, I_ALNW, I_ALNB,
       I_KVNORM, I_WKV, I_BWIN, I_LQ1, I_LK1, I_LQ2, I_LK2, I_SUBLN };

constexpr int LDS_BYTES = 147456;

__device__ __forceinline__ void p0_transpose_item(const float* W, int ldw, int c0, int nc, const float* gain, bf16* WT, int row0, LAS float* scr, int item, int lane, int ldo = 1024) {
    const int nblk = nc / 32, kb = item / nblk, nb = item % nblk, k0 = 64 * kb, n0 = 32 * nb;
#pragma unroll 8
    for (int i = 0; i < 32; ++i) { const int kk = 2 * i + (lane >> 5);
        float v = W[(size_t)(k0 + kk) * ldw + c0 + n0 + (lane & 31)]; if (gain) v *= gain[k0 + kk];
        scr[kk * 33 + (lane & 31)] = v; }
    asm volatile("s_waitcnt lgkmcnt(0)" ::: "memory");
    const int c = lane & 7;
#pragma unroll
    for (int j = 0; j < 4; ++j) { const int n = (lane >> 3) + 8 * j; const LAS float* s = scr + (8 * c) * 33 + n;
        u32x4 o; o.x = pk2(s[0 * 33], s[1 * 33]); o.y = pk2(s[2 * 33], s[3 * 33]); o.z = pk2(s[4 * 33], s[5 * 33]); o.w = pk2(s[6 * 33], s[7 * 33]);
        *(u32x4*)(WT + (size_t)(row0 + n0 + n) * ldo + k0 + 8 * c) = o; }
    asm volatile("s_waitcnt lgkmcnt(0)" ::: "memory");
}
__device__ __forceinline__ void rms_row_to_bf16(const float* xrow, bf16* orow, int lane) {
    const f32x4* xr = (const f32x4*)xrow + lane;
    f32x4 v[4]; float s = 0.f;
#pragma unroll
    for (int j = 0; j < 4; ++j) { v[j] = xr[64 * j]; s += (v[j].x * v[j].x + v[j].y * v[j].y) + (v[j].z * v[j].z + v[j].w * v[j].w); }
    const float rs = 1.f / sqrtf(wave_sum(s) * (1.f / DM) + NORM_EPS);
    unsigned long long* o8 = (unsigned long long*)orow + lane;
#pragma unroll
    for (int j = 0; j < 4; ++j) o8[64 * j] = (unsigned long long)pk2(v[j].x * rs, v[j].y * rs) | ((unsigned long long)pk2(v[j].z * rs, v[j].w * rs) << 32);
}
template <int GROUP>
__device__ __forceinline__ void transpose_group(const Args& a, LAS unsigned char* lds, int gw, int NGW) {
    const int lane = threadIdx.x & 63, wave = __builtin_amdgcn_readfirstlane(threadIdx.x >> 6);
    unsigned char* ws = a.ws;
    LAS float* scr = (LAS float*)(lds + wave * 16384);
    bf16* WA = (bf16*)(ws + WS_WA); bf16* WB = (bf16*)(ws + WS_WB); bf16* WO = (bf16*)(ws + WS_WO); bf16* WM = (bf16*)(ws + WS_WM);
    constexpr int I0 = 16 * (3712 / 32), I1 = 16 * (2048 / 32), I2 = 16 * (1536 / 32), I3 = 16 * (1024 / 32), I5 = 16 * (256 / 32), I6 = 768 / 32;
    bf16* W2T = (bf16*)(ws + WS_W2T); bf16* A2T = W2T + 768 * 64;
    if (GROUP == 0) {
        constexpr int NITEMS = I0 + 4 * I5 + 2 * I6;
        for (int it = gw; it < NITEMS; it += NGW) {
            int r = it;
            if (r < I0) { p0_transpose_item(a.in[I_AWIN], 3712, 0, 3712, a.in[I_PRE], WA, 0, scr, r, lane); continue; } r -= I0;
            if (r < I5) { p0_transpose_item(a.in[I_WMEMKV], 512, 0, 256, a.in[I_MEMNORM], WM, 0, scr, r, lane); continue; } r -= I5;
            if (r < I5) { p0_transpose_item(a.in[I_WMEMKV], 512, 256, 256, a.in[I_MEMNORM], WM, 512, scr, r, lane); continue; } r -= I5;
            if (r < I5) { p0_transpose_item(a.in[I_WMEMKV] + 1024 * 512, 512, 0, 256, a.in[I_MEMNORM] + 1024, WM, 256, scr, r, lane); continue; } r -= I5;
            if (r < I5) { p0_transpose_item(a.in[I_WMEMKV] + 1024 * 512, 512, 256, 256, a.in[I_MEMNORM] + 1024, WM, 768, scr, r, lane); continue; } r -= I5;
            if (r < I6) { p0_transpose_item(a.in[I_AW2], 768, 0, 768, nullptr, W2T, 0, scr, r, lane, 64); continue; } r -= I6;
            p0_transpose_item(a.in[I_AA2], 768, 0, 768, nullptr, A2T, 0, scr, r, lane, 64);
        }
    } else {
        constexpr int NITEMS = I1 + I2 + 2 * I3;
        for (int it = gw; it < NITEMS; it += NGW) {
            int r = it;
            if (r < I1) { p0_transpose_item(a.in[I_BWIN], 2048, 0, 2048, a.in[I_PRE] + 1024, WB, 0, scr, r, lane); continue; } r -= I1;
            if (r < I2) { p0_transpose_item(a.in[I_WKV], 1536, 0, 1536, a.in[I_KVNORM], WB, 2048, scr, r, lane); continue; } r -= I2;
            if (r < I3) { p0_transpose_item(a.in[I_WOUT], 1024, 0, 1024, nullptr, WO, 0, scr, r, lane); continue; } r -= I3;
            p0_transpose_item(a.in[I_WOUT] + 1024 * 1024, 1024, 0, 1024, nullptr, WO + 1024 * 1024, 0, scr, r, lane);
        }
    }
}
__device__ __forceinline__ void phase_prologue(const Args& a, LAS unsigned char* lds) {
    const int tid = threadIdx.x, lane = tid & 63, wave = __builtin_amdgcn_readfirstlane(tid >> 6);
    const int G = gridDim.x, gw = blockIdx.x * 8 + wave, NGW = G * 8;
    unsigned char* ws = a.ws;
    bf16* WA = (bf16*)(ws + WS_WA);
    transpose_group<0>(a, lds, gw, NGW);
    { u32x4* z = (u32x4*)(WA + (size_t)3712 * 1024); const int nz = 128 * 1024 * 2 / 16;
      for (int i = blockIdx.x * 512 + tid; i < nz; i += G * 512) z[i] = (u32x4){0u, 0u, 0u, 0u}; }
    bf16* XN = (bf16*)(ws + WS_XN); bf16* MEMN = (bf16*)(ws + WS_MEMN);
    for (int m = gw; m < MTOK + MROWS; m += NGW) {
        if (m < MTOK) rms_row_to_bf16(a.in[I_X] + (size_t)m * DM, XN + (size_t)m * DM, lane);
        else rms_row_to_bf16(a.in[I_MEM] + (size_t)(m - MTOK) * DM, MEMN + (size_t)(m - MTOK) * DM, lane);
    }
}

__device__ __forceinline__ void run_gemm(LAS unsigned char* lds, const bf16* A, const bf16* Bt, int M, int N, void* O, int ldc, int f32out, int shift, unsigned* km) {
    const int G = gridDim.x;
    pg8::Gemm g{A, Bt, M, N, 1024};
    pg8::StaticOrder S; S.init(M, N, G, (int)((blockIdx.x + G - shift) % G));
    pg8::EpiStore E{O, ldc, f32out, km};
    pg8::gemm_phase<pg8::EpiStore, pg8::StaticOrder>(lds, g, S, E);
}
template <int LAYER>
__device__ __forceinline__ void phase_outproj(const Args& a, LAS unsigned char* lds) {
    unsigned char* ws = a.ws; const int G = gridDim.x;
    pg8::Gemm g{(const bf16*)(ws + WS_CAT), (const bf16*)(ws + WS_WO) + (size_t)LAYER * 1024 * 1024, MTOK, 1024, 1024};
    pg8::StaticOrder S; S.init(MTOK, 1024, G, (int)blockIdx.x);
    pg8::EpiFused E{a.in[I_X], LAYER ? (const bf16*)(ws + WS_X1B) : nullptr, a.out, LAYER ? nullptr : (bf16*)(ws + WS_X1B), LAYER ? nullptr : (bf16*)(ws + WS_XN), a.in[I_POST] + LAYER * DM,
                    (float*)(ws + WS_XCH) + (size_t)LAYER * 2 * 64 * 4 * 256, (unsigned*)(ws + WS_XCNT) + LAYER * 2 * 64 * 16};
    pg8::gemm_phase<pg8::EpiFused, pg8::StaticOrder, true>(lds, g, S, E);
}
__device__ __forceinline__ void phase_gemm(const Args& a, LAS unsigned char* lds, int first, int count) {
    unsigned char* ws = a.ws;
    for (int j = first; j < first + count; ++j) {
        const bf16* A; const bf16* Bt; int M, N, ldc, f32o, shift; void* O;
        switch (j) {
        case 0: A = (const bf16*)(ws + WS_XN); Bt = (const bf16*)(ws + WS_WA); M = MTOK; N = 3840; O = ws + WS_PROJ; ldc = LDP0; f32o = 0; shift = 0; break;
        case 1: A = (const bf16*)(ws + WS_MEMN); Bt = (const bf16*)(ws + WS_WM); M = MROWS; N = 512; O = ws + WS_MK; ldc = 512; f32o = 0; shift = 192; break;
        case 2: A = (const bf16*)(ws + WS_WM) + 512 * 1024; Bt = (const bf16*)(ws + WS_MEMN); M = 512; N = MROWS; O = ws + WS_MVT; ldc = MROWS; f32o = 0; shift = 208; break;
        case 3: A = (const bf16*)(ws + WS_CAT); Bt = (const bf16*)(ws + WS_WO); M = MTOK; N = 1024; O = ws + WS_Y; ldc = 1024; f32o = 0; shift = 0; break;
        case 4: A = (const bf16*)(ws + WS_XN); Bt = (const bf16*)(ws + WS_WB); M = MTOK; N = 2816; O = ws + WS_PROJ; ldc = LDP1; f32o = 0; shift = 0; break;
        case 5: A = (const bf16*)(ws + WS_WB) + 2816 * 1024; Bt = (const bf16*)(ws + WS_XN); M = 768; N = MTOK; O = ws + WS_VT; ldc = MTOK; f32o = 0; shift = 192; break;
        default: A = (const bf16*)(ws + WS_CAT); Bt = (const bf16*)(ws + WS_WO) + 1024 * 1024; M = MTOK; N = 1024; O = ws + WS_Y; ldc = 1024; f32o = 0; shift = 0; break;
        }
        run_gemm(lds, A, Bt, M, N, O, ldc, f32o, shift, (j == 4) ? (unsigned*)(ws + WS_KM) : nullptr);
    }
}

constexpr int AT_PITCH = 72;
template <int NMAP>
__device__ __forceinline__ void attn_unit(LAS unsigned char* lds, const bf16* Qp, int ldq, const bf16* Kp, int ldk, const bf16* VTp, int ldvt,
                                          int nkt_lo, int nkt_hi, float slope2, int tq0,
                                          const bf16* Gp, int ldg, bf16* Op, int ldo, const float* subln, float lam, float oscale, const unsigned* kmp = nullptr) {
    constexpr int EV = 64 * NMAP, NET = EV / 16;
    const int tid = threadIdx.x, lane = tid & 63, wave = __builtin_amdgcn_readfirstlane(tid >> 6), g = lane >> 4, c = lane & 15;
    constexpr int AT_BUF = NMAP * 64 * AT_PITCH * 2 + EV * AT_PITCH * 2;
    const int nkt = (wave < 4) ? nkt_lo : nkt_hi;
    const int qrow = 16 * wave + c;
    bf16x8 qf[NMAP][2];
#pragma unroll
    for (int mp = 0; mp < NMAP; ++mp)
#pragma unroll
        for (int ks = 0; ks < 2; ++ks) qf[mp][ks] = *(const bf16x8*)(Qp + (size_t)qrow * ldq + mp * 64 + 32 * ks + 8 * g);
    f32x4 o[NMAP][NET];
#pragma unroll
    for (int mp = 0; mp < NMAP; ++mp)
#pragma unroll
        for (int et = 0; et < NET; ++et) o[mp][et] = (f32x4){0.f, 0.f, 0.f, 0.f};
    float mrun[NMAP], lrun[NMAP];
#pragma unroll
    for (int mp = 0; mp < NMAP; ++mp) { mrun[mp] = -1e30f; lrun[mp] = 0.f; }
    const float sc2 = 0.125f * LOG2E;
    const float tq = (float)(tq0 + qrow);
    float ubq[NMAP];
    LAS unsigned* votes = (LAS unsigned*)(lds + 2 * AT_BUF);
    if (NMAP == 2) {
#pragma unroll
        for (int mp = 0; mp < NMAP; ++mp) {
            float k2 = 0.f;
#pragma unroll
            for (int pc = 0; pc < 8; ++pc) k2 += __builtin_bit_cast(float, kmp[mp * 8 + pc]);
            float q2 = 0.f;
#pragma unroll
            for (int ks = 0; ks < 2; ++ks) { const u32x4 qq = __builtin_bit_cast(u32x4, qf[mp][ks]);
#pragma unroll
                for (int e = 0; e < 4; ++e) { const float a0 = bflo(qq[e]), a1 = bfhi(qq[e]); q2 += a0 * a0 + a1 * a1; } }
            q2 = rows_sum(q2);
            ubq[mp] = sqrtf(q2 * k2) * sc2 * 1.001f + 1e-3f;
        }
    }
    u32x4 kreg[2][NMAP], vreg[2][NMAP];
#define AT_LOAD(SET, kt) do { _Pragma("unroll") for (int i = 0; i < NMAP; ++i) { const int id = tid + 512 * i; \
        { const int mp = id >> 9, n = (id >> 3) & 63, ch = id & 7; kreg[SET][i] = *(const u32x4*)(Kp + (size_t)((kt) * 64 + n) * ldk + mp * 64 + 8 * ch); } \
        { const int e = id >> 3, ch = id & 7; vreg[SET][i] = *(const u32x4*)(VTp + (size_t)e * ldvt + (kt) * 64 + 8 * ch); } } } while (0)
#define AT_STORE(SET) do { LAS bf16* Ks = (LAS bf16*)(lds + (SET) * AT_BUF); LAS bf16* Vs = (LAS bf16*)(lds + (SET) * AT_BUF + NMAP * 64 * AT_PITCH * 2); \
        _Pragma("unroll") for (int i = 0; i < NMAP; ++i) { const int id = tid + 512 * i; \
        { const int mp = id >> 9, n = (id >> 3) & 63, ch = id & 7; *(LAS u32x4*)(Ks + (mp * 64 + n) * AT_PITCH + 8 * ch) = kreg[SET][i]; } \
        { const int e = id >> 3, ch = id & 7; *(LAS u32x4*)(Vs + e * AT_PITCH + 8 * ch) = vreg[SET][i]; } } } while (0)
    AT_LOAD(0, nkt_hi - 1);
    if (nkt_hi > 1) AT_LOAD(1, nkt_hi - 2);
    __syncthreads();
    AT_STORE(0);
    if (nkt_hi > 2) AT_LOAD(0, nkt_hi - 3);
    __syncthreads();
    for (int it = 0; it < nkt_hi; ++it) {
        const int kt = nkt_hi - 1 - it;
        if (NMAP == 2 && it > 0) {
            const LAS unsigned* vv = votes + ((it - 1) & 1) * 8;
            if ((vv[0] & vv[1] & vv[2] & vv[3] & vv[4] & vv[5] & vv[6] & vv[7]) != 0u) break;
        }
        if (kt > 0) { if (it & 1) { AT_STORE(0); if (kt > 2) AT_LOAD(0, kt - 3); } else { AT_STORE(1); if (kt > 2) AT_LOAD(1, kt - 3); } }
        const LAS bf16* Ks = (const LAS bf16*)(lds + (it & 1) * AT_BUF); const LAS bf16* Vs = (const LAS bf16*)(lds + (it & 1) * AT_BUF + NMAP * 64 * AT_PITCH * 2);
        if (kt < nkt) {
            f32x4 bias[4];
#pragma unroll
            for (int k16 = 0; k16 < 4; ++k16)
#pragma unroll
                for (int j = 0; j < 4; ++j) bias[k16][j] = -slope2 * fabsf(tq - (float)(kt * 64 + 16 * k16 + 4 * g + j));
            bf16x8 pf[NMAP][2]; bool any = false;
#pragma unroll
            for (int mp = 0; mp < NMAP; ++mp) {
                f32x4 st[4];
#pragma unroll
                for (int k16 = 0; k16 < 4; ++k16) {
                    f32x4 acc = (f32x4){0.f, 0.f, 0.f, 0.f};
#pragma unroll
                    for (int ks = 0; ks < 2; ++ks) { const bf16x8 ka = *(const LAS bf16x8*)(Ks + (mp * 64 + 16 * k16 + c) * AT_PITCH + 32 * ks + 8 * g);
                        acc = __builtin_amdgcn_mfma_f32_16x16x32_bf16(ka, qf[mp][ks], acc, 0, 0, 0); }
                    st[k16] = acc * sc2 + bias[k16];
                }
                float m4[4];
#pragma unroll
                for (int k16 = 0; k16 < 4; ++k16) m4[k16] = fmaxf(fmaxf(st[k16].x, st[k16].y), fmaxf(st[k16].z, st[k16].w));
                float mx = fmaxf(fmaxf(m4[0], m4[1]), fmaxf(m4[2], m4[3]));
                mx = rows_max(mx);
                if (__builtin_amdgcn_ballot_w64(mx > mrun[mp] - 40.f) != 0ull) {
                    any = true;
                    const float mnew = fmaxf(mrun[mp], mx), alpha = __builtin_amdgcn_exp2f(mrun[mp] - mnew);
                    mrun[mp] = mnew;
                    float ps = 0.f;
#pragma unroll
                    for (int k16 = 0; k16 < 4; ++k16)
#pragma unroll
                        for (int j = 0; j < 4; ++j) { const float p = __builtin_amdgcn_exp2f(st[k16][j] - mnew); st[k16][j] = p; ps += p; }
                    lrun[mp] = lrun[mp] * alpha + ps;
                    if (__builtin_amdgcn_ballot_w64(alpha != 1.f) != 0ull) {
#pragma unroll
                        for (int et = 0; et < NET; ++et) o[mp][et] = o[mp][et] * alpha;
                    }
#pragma unroll
                    for (int i = 0; i < 2; ++i) { u32x4 w; w.x = pk2(st[2 * i][0], st[2 * i][1]); w.y = pk2(st[2 * i][2], st[2 * i][3]); w.z = pk2(st[2 * i + 1][0], st[2 * i + 1][1]); w.w = pk2(st[2 * i + 1][2], st[2 * i + 1][3]);
                        pf[mp][i] = __builtin_bit_cast(bf16x8, w); }
                } else {
                    pf[mp][0] = (bf16x8){0, 0, 0, 0, 0, 0, 0, 0}; pf[mp][1] = (bf16x8){0, 0, 0, 0, 0, 0, 0, 0};
                }
            }
            if (any) {
#pragma unroll
                for (int et = 0; et < NET; ++et)
#pragma unroll
                    for (int i = 0; i < 2; ++i) {
                        const u32x2 lo = *(const LAS u32x2*)(Vs + (16 * et + c) * AT_PITCH + 32 * i + 4 * g);
                        const u32x2 hi = *(const LAS u32x2*)(Vs + (16 * et + c) * AT_PITCH + 32 * i + 16 + 4 * g);
                        const bf16x8 va = __builtin_bit_cast(bf16x8, (u32x4){lo.x, lo.y, hi.x, hi.y});
#pragma unroll
                        for (int mp = 0; mp < NMAP; ++mp) o[mp][et] = __builtin_amdgcn_mfma_f32_16x16x32_bf16(va, pf[mp][i], o[mp][et], 0, 0, 0);
                    }
            }
        }
        if (NMAP == 2) {
            const float dmin = fmaxf(tq - (float)(64 * kt - 1), 0.f);
            bool neg = true;
#pragma unroll
            for (int mp = 0; mp < NMAP; ++mp) neg = neg && (ubq[mp] - slope2 * dmin < mrun[mp] - 40.f);
            const bool all = (__builtin_amdgcn_ballot_w64(neg) == ~0ull);
            if (lane == 0) votes[(it & 1) * 8 + wave] = all ? 1u : 0u;
        }
        __syncthreads();
    }
#undef AT_LOAD
#undef AT_STORE
    float inv[NMAP];
#pragma unroll
    for (int mp = 0; mp < NMAP; ++mp) { const float l = rows_sum(lrun[mp]); inv[mp] = 1.f / l; }
    f32x4 r[NET]; float ss = 0.f;
#pragma unroll
    for (int et = 0; et < NET; ++et) {
        if (NMAP == 2) r[et] = o[0][et] * inv[0] - o[NMAP - 1][et] * (lam * inv[NMAP - 1]);
        else r[et] = o[0][et] * inv[0];
        ss += (r[et].x * r[et].x + r[et].y * r[et].y) + (r[et].z * r[et].z + r[et].w * r[et].w);
    }
    float rs = 1.f;
    if (NMAP == 2) { ss = rows_sum(ss); rs = oscale / sqrtf(ss * (1.f / EV) + NORM_EPS); }
#pragma unroll
    for (int et = 0; et < NET; ++et) {
        const int e = 16 * et + 4 * g;
        const u32x2 gv = *(const u32x2*)(Gp + (size_t)qrow * ldg + e);
        f32x4 v = r[et] * rs;
        if (NMAP == 2) v = v * *(const f32x4*)(subln + e);
        v.x *= siluf_(bflo(gv.x)); v.y *= siluf_(bfhi(gv.x)); v.z *= siluf_(bflo(gv.y)); v.w *= siluf_(bfhi(gv.y));
        u32x2 w; w.x = pk2(v.x, v.y); w.y = pk2(v.z, v.w);
        *(u32x2*)(Op + (size_t)qrow * ldo + e) = w;
    }
    __syncthreads();
}

__device__ __forceinline__ void mem_attn_unit(const Args& a, LAS unsigned char* lds, int l, int u) {
    unsigned char* ws = a.ws;
    const int b = u >> 6, h = (u >> 4) & 3, qb = u & 15;
    const bf16* PROJ = (const bf16*)(ws + WS_PROJ);
    const int ldp = l ? LDP1 : LDP0, cq = l ? C_QM1 : C_QM0, cg_ = l ? C_GM1 : C_GM0;
    const size_t row0 = (size_t)b * SEQ + qb * 128;
    attn_unit<1>(lds, PROJ + row0 * ldp + cq + h * 64, ldp,
                 (const bf16*)(ws + WS_MK) + (size_t)b * MEML * 512 + l * 256 + h * 64, 512,
                 (const bf16*)(ws + WS_MVT) + (size_t)(l * 256 + h * 64) * MROWS + b * MEML, MROWS,
                 4, 4, 0.f, 0,
                 PROJ + row0 * ldp + cg_ + h * 64, ldp, (bf16*)(ws + WS_CAT) + row0 * DM + BRW + h * 64, DM, nullptr, 0.f, 1.f);
}

typedef _Float16 f16x4_t __attribute__((ext_vector_type(4)));
__device__ __forceinline__ void lora_item(const Args& a, LAS unsigned char* lds, int b, int cgp) {
    const int tid = threadIdx.x, lane = tid & 63, wave = __builtin_amdgcn_readfirstlane(tid >> 6), g = lane >> 4, c = lane & 15;
    unsigned char* ws = a.ws;
    const bf16* PROJ = (const bf16*)(ws + WS_PROJ);
    const size_t mb = (size_t)b * SEQ; const int t0 = 64 * cgp;
    LAS bf16* AW = (LAS bf16*)lds; LAS bf16* AA = AW + 64 * 72;
    const float* mu = a.in[I_AMU];
#pragma unroll
    for (int r = 0; r < 2; ++r) {
        const int i = tid + 512 * r, tok = i >> 4, ch = i & 15;
        const bf16* cur = PROJ + (mb + t0 + tok) * LDP0 + C_WD + 8 * ch; const bf16* prv = (t0 + tok == 0) ? cur : cur - LDP0; const float pz = (t0 + tok == 0) ? 0.f : 1.f;
        const u32x4 zc = *(const u32x4*)cur, zp = *(const u32x4*)prv;
        const f32x4 m0 = *(const f32x4*)(mu + C_WD + 8 * ch), m1 = *(const f32x4*)(mu + C_WD + 8 * ch + 4);
        float x[8];
#pragma unroll
        for (int e = 0; e < 4; ++e) {
            const float ma = (e < 2) ? m0[2 * e] : m1[2 * e - 4], mb_ = (e < 2) ? m0[2 * e + 1] : m1[2 * e - 3];
            float z0 = bflo(zc[e]), z1 = bfhi(zc[e]);
            z0 = z0 + (bflo(zp[e]) * pz - z0) * ma; z1 = z1 + (bfhi(zp[e]) * pz - z1) * mb_;
            if (ch < 8) { z0 = 1.f - 2.f * __builtin_amdgcn_rcpf(1.f + __builtin_amdgcn_exp2f(2.8853900817779268f * z0)); z1 = 1.f - 2.f * __builtin_amdgcn_rcpf(1.f + __builtin_amdgcn_exp2f(2.8853900817779268f * z1)); }
            x[2 * e] = z0; x[2 * e + 1] = z1;
        }
        u32x4 w; w.x = pk2(x[0], x[1]); w.y = pk2(x[2], x[3]); w.z = pk2(x[4], x[5]); w.w = pk2(x[6], x[7]);
        *(LAS u32x4*)(((ch < 8) ? AW : AA) + tok * 72 + 8 * (ch & 7)) = w;
    }
    __syncthreads();
    const int mtp = wave & 1, gq = wave >> 1;
    const bf16* W2T = (const bf16*)(ws + WS_W2T); const bf16* A2T = W2T + 768 * 64;
    _Float16* LD16 = (_Float16*)(ws + WS_LD16); bf16* A16 = (bf16*)(ws + WS_A16);
    bf16x8 Aw[2][2], Aa[2][2];
#pragma unroll
    for (int mt = 0; mt < 2; ++mt)
#pragma unroll
        for (int ks = 0; ks < 2; ++ks) { Aw[mt][ks] = *(const LAS bf16x8*)(AW + (32 * mtp + 16 * mt + c) * 72 + 32 * ks + 8 * g); Aa[mt][ks] = *(const LAS bf16x8*)(AA + (32 * mtp + 16 * mt + c) * 72 + 32 * ks + 8 * g); }
    const f32x4 Z4 = {0.f, 0.f, 0.f, 0.f};
    for (int gi = 0; gi < 3; ++gi) {
        const int colb = 64 * (3 * gq + gi) + 4 * c;
        const f32x4 w0v = *(const f32x4*)(a.in[I_AW0] + colb), a0v = *(const f32x4*)(a.in[I_AA0] + colb);
        f32x4 accw[2][4], acca[2][4];
#pragma unroll
        for (int q = 0; q < 4; ++q) {
            const bf16x8 bw0 = *(const bf16x8*)(W2T + (size_t)(colb + q) * 64 + 8 * g), bw1 = *(const bf16x8*)(W2T + (size_t)(colb + q) * 64 + 32 + 8 * g);
            const bf16x8 ba0 = *(const bf16x8*)(A2T + (size_t)(colb + q) * 64 + 8 * g), ba1 = *(const bf16x8*)(A2T + (size_t)(colb + q) * 64 + 32 + 8 * g);
#pragma unroll
            for (int mt = 0; mt < 2; ++mt) {
                accw[mt][q] = __builtin_amdgcn_mfma_f32_16x16x32_bf16(Aw[mt][0], bw0, Z4, 0, 0, 0); accw[mt][q] = __builtin_amdgcn_mfma_f32_16x16x32_bf16(Aw[mt][1], bw1, accw[mt][q], 0, 0, 0);
                acca[mt][q] = __builtin_amdgcn_mfma_f32_16x16x32_bf16(Aa[mt][0], ba0, Z4, 0, 0, 0); acca[mt][q] = __builtin_amdgcn_mfma_f32_16x16x32_bf16(Aa[mt][1], ba1, acca[mt][q], 0, 0, 0);
            }
        }
#pragma unroll
        for (int mt = 0; mt < 2; ++mt)
#pragma unroll
            for (int j = 0; j < 4; ++j) {
                const size_t m = mb + t0 + 32 * mtp + 16 * mt + 4 * g + j;
                f16x4_t ld; float av[4];
#pragma unroll
                for (int q = 0; q < 4; ++q) { ld[q] = (_Float16)(-0.8750322163622201f * sigmoidf_(w0v[q] + accw[mt][q][j])); av[q] = sigmoidf_(a0v[q] + acca[mt][q][j]); }
                *(f16x4_t*)(LD16 + m * 768 + colb) = ld;
                *(u32x2*)(A16 + m * 768 + colb) = (u32x2){pk2(av[0], av[1]), pk2(av[2], av[3])};
            }
    }
    asm volatile("s_waitcnt vmcnt(0)" ::: "memory");
    __syncthreads();
    if (tid == 0) { __builtin_amdgcn_fence(__ATOMIC_RELEASE, "agent"); asm volatile("s_waitcnt vmcnt(0)" ::: "memory");
        (void)__hip_atomic_fetch_add((unsigned*)ws + CW_LORA, 1u, __ATOMIC_RELAXED, __HIP_MEMORY_SCOPE_AGENT); }
}

constexpr int SK_SLOT = 15360, SK_NT = 0, SK_RT = 2304, SK_BP = 4608, SK_KP = 7168, SK_VT = 9728, SK_PC = 12288, SK_LK = 12544, SK_TT = 13184, SK_MB = 13824, SK_MK = 14464;
constexpr int SK_SCR = 3 * SK_SLOT, SK_SCRW = 7680, SK_BS = 0, SK_KS = 2304, SK_LB = 4608, SK_VM = 5632;
constexpr int SK_P72 = 72, SK_P20 = 20;
constexpr int SK_PRM = SK_SCR + 4 * SK_SCRW, SK_W2L = SK_PRM, SK_A2L = SK_PRM + 9216, SK_PF = SK_PRM + 18432;
enum { PF_W0 = 0, PF_A0, PF_KK, PF_KA, PF_RK, PF_MUR, PF_MUK, PF_MUWD, PF_MUAD, PF_MUV };
__device__ __forceinline__ bf16x8 lds2x8(const LAS bf16* p, int offa, int offb) { const u32x2 a = *(const LAS u32x2*)(p + offa), b = *(const LAS u32x2*)(p + offb); return __builtin_bit_cast(bf16x8, (u32x4){a.x, a.y, b.x, b.y}); }
__device__ __forceinline__ bf16x8 lds8z(const LAS bf16* p, int offa) { const u32x2 a = *(const LAS u32x2*)(p + offa); return __builtin_bit_cast(bf16x8, (u32x4){a.x, a.y, 0u, 0u}); }
__device__ __forceinline__ void scan_unit(const Args& a, LAS unsigned char* lds, int b, int h) {
    const int tid = threadIdx.x, lane = tid & 63, wave = __builtin_amdgcn_readfirstlane(tid >> 6), g = lane >> 4, c = lane & 15;
    unsigned char* ws = a.ws;
    const bf16* PROJ = (const bf16*)(ws + WS_PROJ);
    bf16* CAT = (bf16*)(ws + WS_CAT);
    const size_t mb = (size_t)b * SEQ;
    constexpr int NBLK = SEQ / 16;
    const f32x4 Z4 = {0.f, 0.f, 0.f, 0.f};
    {
        const bf16* W2T = (const bf16*)(ws + WS_W2T);
        for (int i = tid; i < 2 * 64 * 8; i += 512) { const int m = i >> 9, key = (i >> 3) & 63, ch = i & 7;
            const u32x4 v = *(const u32x4*)(W2T + (size_t)m * 768 * 64 + (size_t)(h * 64 + key) * 64 + 8 * ch);
            *(LAS u32x4*)(lds + (m ? SK_A2L : SK_W2L) + (((key & 3) * 16 + (key >> 2)) * SK_P72 + 8 * ch) * 2) = v; }
        for (int i = tid; i < 10 * 64; i += 512) { const int w = i >> 6, k = i & 63; float v;
            switch (w) { case PF_W0: v = a.in[I_AW0][h * 64 + k]; break; case PF_A0: v = a.in[I_AA0][h * 64 + k]; break; case PF_KK: v = a.in[I_AKK][h * 64 + k]; break;
                         case PF_KA: v = a.in[I_AKA][h * 64 + k]; break; case PF_RK: v = a.in[I_ARK][h * 64 + k]; break; case PF_MUR: v = a.in[I_AMU][C_R + h * 64 + k]; break;
                         case PF_MUK: v = a.in[I_AMU][C_K + h * 64 + k]; break; case PF_MUWD: v = a.in[I_AMU][C_WD + k]; break; case PF_MUAD: v = a.in[I_AMU][C_AD + k]; break;
                         default: v = a.in[I_AMU][C_V + h * 64 + k]; break; }
            ((LAS float*)(lds + SK_PF))[i] = v; }
        if (tid == 0) { unsigned* cw = (unsigned*)ws + CW_LORA;
            while (__hip_atomic_load(cw, __ATOMIC_RELAXED, __HIP_MEMORY_SCOPE_AGENT) < gridDim.x) __builtin_amdgcn_s_sleep(2);
            __builtin_amdgcn_fence(__ATOMIC_ACQUIRE, "agent"); asm volatile("s_waitcnt vmcnt(0)" ::: "memory"); }
        __syncthreads();
    }
    if (wave < 4) {
        f32x4 St[4] = {Z4, Z4, Z4, Z4};
        for (int q = 0; q < 4; ++q) __syncthreads();
        for (int blk = 0; blk < NBLK; ++blk) {
            const LAS unsigned char* sl = lds + (blk % 3) * SK_SLOT;
            const LAS bf16* NT = (const LAS bf16*)(sl + SK_NT); const LAS bf16* RT = (const LAS bf16*)(sl + SK_RT);
            const LAS bf16* BP = (const LAS bf16*)(sl + SK_BP); const LAS bf16* KP = (const LAS bf16*)(sl + SK_KP);
            const LAS bf16* VT = (const LAS bf16*)(sl + SK_VT); const LAS float* PC = (const LAS float*)(sl + SK_PC);
            const LAS bf16* LK = (const LAS bf16*)(sl + SK_LK); const LAS bf16* TT = (const LAS bf16*)(sl + SK_TT);
            const LAS bf16* MB = (const LAS bf16*)(sl + SK_MB); const LAS bf16* MK = (const LAS bf16*)(sl + SK_MK);
            bf16x8 sbh[2];
#pragma unroll
            for (int ks = 0; ks < 2; ++ks) {
                const f32x4 x = St[2 * ks], y = St[2 * ks + 1];
                u32x4 hh; hh.x = pk2(x.x, x.y); hh.y = pk2(x.z, x.w); hh.z = pk2(y.x, y.y); hh.w = pk2(y.z, y.w);
                sbh[ks] = __builtin_bit_cast(bf16x8, hh);
            }
            const bf16x8 An0 = lds2x8(NT, c * SK_P72 + 4 * g, c * SK_P72 + 16 + 4 * g), An1 = lds2x8(NT, c * SK_P72 + 32 + 4 * g, c * SK_P72 + 48 + 4 * g);
            const bf16x8 Ar0 = lds2x8(RT, c * SK_P72 + 4 * g, c * SK_P72 + 16 + 4 * g), Ar1 = lds2x8(RT, c * SK_P72 + 32 + 4 * g, c * SK_P72 + 48 + 4 * g);
            const u32x2 vq = *(const LAS u32x2*)(VT + (16 * wave + c) * SK_P20 + 4 * g);
            const bf16x8 vlo = __builtin_bit_cast(bf16x8, (u32x4){vq.x, vq.y, 0u, 0u});
            const bf16x8 Alk = lds8z(LK, c * SK_P20 + 4 * g), At = lds8z(TT, c * SK_P20 + 4 * g);
            const bf16x8 Amk = lds2x8(MB, c * SK_P20 + 4 * g, (int)((SK_MK - SK_MB) / 2) + c * SK_P20 + 4 * g);
            f32x4 X = __builtin_amdgcn_mfma_f32_16x16x32_bf16(An0, sbh[0], Z4, 0, 0, 0);
            X = __builtin_amdgcn_mfma_f32_16x16x32_bf16(An1, sbh[1], X, 0, 0, 0);
            X = __builtin_amdgcn_mfma_f32_16x16x32_bf16(Alk, vlo, X, 0, 0, 0);
            f32x4 Y = __builtin_amdgcn_mfma_f32_16x16x32_bf16(Ar0, sbh[0], Z4, 0, 0, 0);
            Y = __builtin_amdgcn_mfma_f32_16x16x32_bf16(Ar1, sbh[1], Y, 0, 0, 0);
            const bf16x8 xb = __builtin_bit_cast(bf16x8, (u32x4){pk2(X.x, X.y), pk2(X.z, X.w), 0u, 0u});
            const f32x4 U = __builtin_amdgcn_mfma_f32_16x16x32_bf16(At, xb, Z4, 0, 0, 0);
            const bf16x8 ub = __builtin_bit_cast(bf16x8, (u32x4){pk2(U.x, U.y), pk2(U.z, U.w), vq.x, vq.y});
            Y = __builtin_amdgcn_mfma_f32_16x16x32_bf16(Amk, ub, Y, 0, 0, 0);
#pragma unroll
            for (int kt = 0; kt < 4; ++kt) {
                const f32x4 pc4 = *(const LAS f32x4*)(PC + 16 * kt + 4 * g);
                const bf16x8 Abk = lds2x8(BP, (16 * kt + c) * SK_P20 + 4 * g, (int)((SK_KP - SK_BP) / 2) + (16 * kt + c) * SK_P20 + 4 * g);
                St[kt] = __builtin_amdgcn_mfma_f32_16x16x32_bf16(Abk, ub, St[kt] * pc4, 0, 0, 0);
            }
            bf16* yp = CAT + (mb + (size_t)blk * 16 + 4 * g) * DM + h * 64 + 16 * wave + c;
            yp[0] = (bf16)f2bf(Y.x); yp[DM] = (bf16)f2bf(Y.y); yp[2 * DM] = (bf16)f2bf(Y.z); yp[3 * DM] = (bf16)f2bf(Y.w);
            __syncthreads();
        }
    } else {
        const int pw = wave - 4;
        const int kc = h * 64 + 4 * c;
        const LAS float* PF = (const LAS float*)(lds + SK_PF); const LAS bf16* W2L = (const LAS bf16*)(lds + SK_W2L); const LAS bf16* A2L = (const LAS bf16*)(lds + SK_A2L);
        LAS unsigned char* scr = lds + SK_SCR + pw * SK_SCRW;
        LAS bf16* BSs = (LAS bf16*)(scr + SK_BS); LAS bf16* KSs = (LAS bf16*)(scr + SK_KS); LAS float* LBs = (LAS float*)(scr + SK_LB);
        u32x4 zv[2], zvp[2]; u32x2 zr[4], zrp[4], zk[4], zkp[4], zl[4], za[4];
        const _Float16* LD16 = (const _Float16*)(ws + WS_LD16); const bf16* A16 = (const bf16*)(ws + WS_A16);
#define SK_LOAD_V(T0) do { \
        { const int sv_ = lane >> 2, cv_ = lane & 3; const bf16* cs = PROJ + (mb + (T0) + sv_) * LDP0; const bf16* ps = ((T0) + sv_ == 0) ? cs : cs - LDP0; \
          _Pragma("unroll") for (int i = 0; i < 2; ++i) { zv[i] = *(const u32x4*)(cs + C_V + h * 64 + 16 * cv_ + 8 * i); zvp[i] = *(const u32x4*)(ps + C_V + h * 64 + 16 * cv_ + 8 * i); } } } while (0)
#define SK_LOAD_S(T0, jj) do { const int s_ = 4 * g + (jj); const bf16* cs = PROJ + (mb + (T0) + s_) * LDP0; const bf16* ps = ((T0) + s_ == 0) ? cs : cs - LDP0; \
            zr[jj] = *(const u32x2*)(cs + C_R + kc); zrp[jj] = *(const u32x2*)(ps + C_R + kc); zk[jj] = *(const u32x2*)(cs + C_K + kc); zkp[jj] = *(const u32x2*)(ps + C_K + kc); \
            za[jj] = *(const u32x2*)(A16 + (mb + (T0) + s_) * 768 + kc); } while (0)
#define SK_LOAD_L(T0) do { _Pragma("unroll") for (int jj = 0; jj < 4; ++jj) zl[jj] = *(const u32x2*)(LD16 + (mb + (T0) + 4 * g + jj) * 768 + kc); } while (0)
        SK_LOAD_L(pw * 16); SK_LOAD_V(pw * 16);
#pragma unroll
        for (int jj = 0; jj < 4; ++jj) SK_LOAD_S(pw * 16, jj);
        for (int q = 0; q < pw; ++q) __syncthreads();
        for (int n = 0; n < NBLK / 4; ++n) {
            const int blk = 4 * n + pw, t0 = blk * 16, t0n = (blk + 4 < NBLK) ? t0 + 64 : t0;
            LAS unsigned char* sl = lds + (blk % 3) * SK_SLOT;
            int c_o = c; asm volatile("" : "+v"(c_o));
            {
                unsigned vm[8];
                const int sv = lane >> 2, cv = lane & 3; const float pz = (t0 + sv == 0) ? 0.f : 1.f;
#pragma unroll
                for (int i = 0; i < 2; ++i) {
                    const LAS float* mv = PF + PF_MUV * 64 + 16 * cv + 8 * i;
                    const f32x4 m0 = *(const LAS f32x4*)mv, m1 = *(const LAS f32x4*)(mv + 4);
#pragma unroll
                    for (int e = 0; e < 4; ++e) {
                        const unsigned uc = zv[i][e], up = zvp[i][e];
                        const float ma = (e < 2) ? m0[2 * e] : m1[2 * e - 4], mb_ = (e < 2) ? m0[2 * e + 1] : m1[2 * e - 3];
                        float z0 = bflo(uc), z1 = bfhi(uc);
                        z0 = z0 + (bflo(up) * pz - z0) * ma; z1 = z1 + (bfhi(up) * pz - z1) * mb_;
                        vm[4 * i + e] = pk2(z0, z1);
                    }
                }
                *(LAS u32x4*)(scr + SK_VM + lane * 32) = (u32x4){vm[0], vm[1], vm[2], vm[3]}; *(LAS u32x4*)(scr + SK_VM + lane * 32 + 16) = (u32x4){vm[4], vm[5], vm[6], vm[7]};
                SK_LOAD_V(t0n);
            }
            u32x2 ntp[4], rtp[4], bpp[4], kpp[4]; f32x4 pcv;
            {
                f32x4 dec[4], E4;
#pragma unroll
                for (int jj = 0; jj < 4; ++jj) { const f16x4_t l4 = __builtin_bit_cast(f16x4_t, zl[jj]);
#pragma unroll
                    for (int nt = 0; nt < 4; ++nt) dec[jj][nt] = __builtin_amdgcn_exp2f((float)l4[nt]); }
                SK_LOAD_L(t0n);
#pragma unroll
                for (int nt = 0; nt < 4; ++nt) {
                    const float p3 = (dec[0][nt] * dec[1][nt]) * (dec[2][nt] * dec[3][nt]);
                    const float q0 = __shfl(p3, c), q1 = __shfl(p3, c + 16), q2 = __shfl(p3, c + 32), q3 = __shfl(p3, c + 48);
                    E4[nt] = ((g > 0) ? q0 : 1.f) * ((g > 1) ? q1 : 1.f) * ((g > 2) ? q2 : 1.f);
                    pcv[nt] = (q0 * q1) * (q2 * q3);
                }
                const f32x4 p_kk = *(const LAS f32x4*)(PF + PF_KK * 64 + 4 * c), p_ka = *(const LAS f32x4*)(PF + PF_KA * 64 + 4 * c),
                            p_rk = *(const LAS f32x4*)(PF + PF_RK * 64 + 4 * c), mu_r = *(const LAS f32x4*)(PF + PF_MUR * 64 + 4 * c), mu_k = *(const LAS f32x4*)(PF + PF_MUK * 64 + 4 * c);
                f32x4 pex = E4, bprev, kprev;
#pragma unroll
                for (int jj = 0; jj < 4; ++jj) {
                    if (jj == 1 || jj == 3) __syncthreads();
                    const int s = 4 * g + jj;
                    const float pz = (t0 + s == 0) ? 0.f : 1.f;
                    const f32x4 pin = pex * dec[jj];
                    f32x4 rr, kp4, ku, aa;
                    const unsigned ur[2] = {zr[jj].x, zr[jj].y}, urp[2] = {zrp[jj].x, zrp[jj].y}, uk[2] = {zk[jj].x, zk[jj].y}, ukp[2] = {zkp[jj].x, zkp[jj].y}, ua[2] = {za[jj].x, za[jj].y};
                    SK_LOAD_S(t0n, jj);
                    float ssq = 0.f, bs = 0.f;
#pragma unroll
                    for (int nt = 0; nt < 4; ++nt) {
                        const float zc = (nt & 1) ? bfhi(ur[nt >> 1]) : bflo(ur[nt >> 1]), zp = ((nt & 1) ? bfhi(urp[nt >> 1]) : bflo(urp[nt >> 1])) * pz;
                        const float kc_ = (nt & 1) ? bfhi(uk[nt >> 1]) : bflo(uk[nt >> 1]), kp_ = ((nt & 1) ? bfhi(ukp[nt >> 1]) : bflo(ukp[nt >> 1])) * pz;
                        rr[nt] = zc + (zp - zc) * mu_r[nt];
                        const float kk = kc_ + (kp_ - kc_) * mu_k[nt];
                        aa[nt] = (nt & 1) ? bfhi(ua[nt >> 1]) : bflo(ua[nt >> 1]);
                        ku[nt] = kk * p_kk[nt];
                        ssq += ku[nt] * ku[nt];
                        kp4[nt] = kk * (1.f + (aa[nt] - 1.f) * p_ka[nt]);
                        bs += rr[nt] * kp4[nt] * p_rk[nt];
                    }
                    ssq = sum16(ssq); bs = sum16(bs);
                    if (c == 0) ((float*)(ws + WS_BS))[(mb + t0 + s) * AH + h] = bs;
                    const float rn = __builtin_amdgcn_rsqf(fmaxf(ssq, 1e-12f));
                    f32x4 rp; rp.x = __builtin_amdgcn_rcpf(pin.x); rp.y = __builtin_amdgcn_rcpf(pin.y); rp.z = __builtin_amdgcn_rcpf(pin.z); rp.w = __builtin_amdgcn_rcpf(pin.w);
                    const f32x4 kn = ku * rn;
                    const f32x4 nt_ = pex * (-kn), bt = kn * aa * rp, kt_ = kp4 * rp, rt = pin * rr;
                    const f32x4 bpc = bt * pcv, kpc = kt_ * pcv;
                    ntp[jj] = (u32x2){pk2(nt_.x, nt_.y), pk2(nt_.z, nt_.w)};
                    rtp[jj] = (u32x2){pk2(rt.x, rt.y), pk2(rt.z, rt.w)};
                    *(LAS u32x2*)(BSs + s * SK_P72 + 4 * c) = (u32x2){pk2(bt.x, bt.y), pk2(bt.z, bt.w)};
                    *(LAS u32x2*)(KSs + s * SK_P72 + 4 * c) = (u32x2){pk2(kt_.x, kt_.y), pk2(kt_.z, kt_.w)};
                    if (jj & 1) {
#pragma unroll
                        for (int nt = 0; nt < 4; ++nt) { if (jj == 1) { bpp[nt].x = pk2(bprev[nt], bpc[nt]); kpp[nt].x = pk2(kprev[nt], kpc[nt]); } else { bpp[nt].y = pk2(bprev[nt], bpc[nt]); kpp[nt].y = pk2(kprev[nt], kpc[nt]); } }
                    } else { bprev = bpc; kprev = kpc; }
                    pex = pin;
                }
            }
            {
                LAS bf16* NT = (LAS bf16*)(sl + SK_NT); LAS bf16* RT = (LAS bf16*)(sl + SK_RT);
                LAS bf16* BP = (LAS bf16*)(sl + SK_BP); LAS bf16* KP = (LAS bf16*)(sl + SK_KP);
#pragma unroll
                for (int jj = 0; jj < 4; ++jj) { const int s = 4 * g + jj;
                    *(LAS u32x2*)(NT + s * SK_P72 + 4 * c) = ntp[jj]; *(LAS u32x2*)(RT + s * SK_P72 + 4 * c) = rtp[jj]; }
#pragma unroll
                for (int nt = 0; nt < 4; ++nt) { *(LAS u32x2*)(BP + (4 * c + nt) * SK_P20 + 4 * g) = bpp[nt]; *(LAS u32x2*)(KP + (4 * c + nt) * SK_P20 + 4 * g) = kpp[nt]; }
                if (g == 0) *(LAS f32x4*)((LAS float*)(sl + SK_PC) + 4 * c) = pcv;
                { const int sv = lane >> 2, cv = lane & 3; LAS bf16* VT = (LAS bf16*)(sl + SK_VT);
                  const u32x4 va_ = *(const LAS u32x4*)(scr + SK_VM + lane * 32), vb_ = *(const LAS u32x4*)(scr + SK_VM + lane * 32 + 16);
                  const unsigned vm[8] = {va_.x, va_.y, va_.z, va_.w, vb_.x, vb_.y, vb_.z, vb_.w};
#pragma unroll
                  for (int i = 0; i < 8; ++i) { VT[(16 * cv + 2 * i) * SK_P20 + sv] = (bf16)(vm[i] & 0xffffu); VT[(16 * cv + 2 * i + 1) * SK_P20 + sv] = (bf16)(vm[i] >> 16); } }
                asm volatile("s_waitcnt lgkmcnt(0)" ::: "memory");
                f32x4 Lb = Z4, Lk = Z4, Mb = Z4, Mk = Z4;
#pragma unroll
                for (int ks = 0; ks < 2; ++ks) {
                    const bf16x8 ab = *(const LAS bf16x8*)(BSs + c * SK_P72 + 32 * ks + 8 * g), ak = *(const LAS bf16x8*)(KSs + c * SK_P72 + 32 * ks + 8 * g);
                    const bf16x8 bn = *(const LAS bf16x8*)(NT + c * SK_P72 + 32 * ks + 8 * g), br = *(const LAS bf16x8*)(RT + c * SK_P72 + 32 * ks + 8 * g);
                    Lb = __builtin_amdgcn_mfma_f32_16x16x32_bf16(ab, bn, Lb, 0, 0, 0);
                    Lk = __builtin_amdgcn_mfma_f32_16x16x32_bf16(ak, bn, Lk, 0, 0, 0);
                    Mb = __builtin_amdgcn_mfma_f32_16x16x32_bf16(ab, br, Mb, 0, 0, 0);
                    Mk = __builtin_amdgcn_mfma_f32_16x16x32_bf16(ak, br, Mk, 0, 0, 0);
                }
#pragma unroll
                for (int j = 0; j < 4; ++j) { const int s = 4 * g + j; if (!(s < c)) { Lb[j] = 0.f; Lk[j] = 0.f; } if (!(s <= c)) { Mb[j] = 0.f; Mk[j] = 0.f; } }
                *(LAS u32x2*)((LAS bf16*)(sl + SK_LK) + c * SK_P20 + 4 * g) = (u32x2){pk2(Lk[0], Lk[1]), pk2(Lk[2], Lk[3])};
                *(LAS u32x2*)((LAS bf16*)(sl + SK_MB) + c * SK_P20 + 4 * g) = (u32x2){pk2(Mb[0], Mb[1]), pk2(Mb[2], Mb[3])};
                *(LAS u32x2*)((LAS bf16*)(sl + SK_MK) + c * SK_P20 + 4 * g) = (u32x2){pk2(Mk[0], Mk[1]), pk2(Mk[2], Mk[3])};
                *(LAS f32x4*)(LBs + c * 16 + 4 * g) = Lb;
            }
            __syncthreads();
            {
                float Ti[16];
#pragma unroll
                for (int t = 0; t < 16; ++t) {
                    float acc = (c_o == t) ? 1.f : 0.f;
                    if ((t & 3) == 0) asm volatile("" ::: "memory");
#pragma unroll
                    for (int s4 = 0; s4 < (t + 3) / 4; ++s4) {
                        const f32x4 l4 = *(const LAS f32x4*)(LBs + t * 16 + 4 * s4);
#pragma unroll
                        for (int e = 0; e < 4; ++e) if (4 * s4 + e < t) acc += Ti[4 * s4 + e] * l4[e];
                    }
                    Ti[t] = acc;
                }
                if (g == 0) {
                    LAS bf16* TT = (LAS bf16*)(sl + SK_TT);
#pragma unroll
                    for (int t = 0; t < 16; ++t) TT[t * SK_P20 + c] = (bf16)f2bf(Ti[t]);
                }
            }
            __syncthreads();
        }
#undef SK_LOAD_S
#undef SK_LOAD_L
#undef SK_LOAD_V
        for (int q = 0; q < 4 - pw; ++q) __syncthreads();
    }
}

constexpr int CW_HEAD = 12288;
__device__ __forceinline__ void head_publish(const Args& a, int u) {
    asm volatile("s_waitcnt vmcnt(0)" ::: "memory");
    __syncthreads();
    if (threadIdx.x == 0) {
        __builtin_amdgcn_fence(__ATOMIC_RELEASE, "agent");
        asm volatile("s_waitcnt vmcnt(0)" ::: "memory");
        __hip_atomic_store((unsigned*)a.ws + CW_HEAD + 16 * u, 1u, __ATOMIC_RELAXED, __HIP_MEMORY_SCOPE_AGENT);
    }
}
__device__ __forceinline__ void head_wait(const Args& a, int u) {
    if (threadIdx.x == 0) {
        unsigned* f = (unsigned*)a.ws + CW_HEAD + 16 * u;
        while (__hip_atomic_load(f, __ATOMIC_RELAXED, __HIP_MEMORY_SCOPE_AGENT) == 0u) __builtin_amdgcn_s_sleep(8);
        __builtin_amdgcn_fence(__ATOMIC_ACQUIRE, "agent");
        asm volatile("s_waitcnt vmcnt(0)" ::: "memory");
    }
    __syncthreads();
}
__device__ __forceinline__ void rwkv_post_item(const Args& a, int u, int sl) {
    const int tid = threadIdx.x, lane = tid & 63, wave = tid >> 6, tsub = lane >> 4, col = (u % 12) * 64 + 4 * (lane & 15);
    const int b = u / 12, h = u % 12;
    unsigned char* ws = a.ws;
    const bf16* PROJ = (const bf16*)(ws + WS_PROJ); bf16* CAT = (bf16*)(ws + WS_CAT); const float* BS = (const float*)(ws + WS_BS);
    const f32x4 lw = *(const f32x4*)(a.in[I_ALNW] + col), lb = *(const f32x4*)(a.in[I_ALNB] + col), mv = *(const f32x4*)(a.in[I_AMU] + C_V + col);
    for (int p0 = 0; p0 < 8; p0 += 2) {
        u32x2 yv[2], vc[2], vp[2], gt[2]; float bsv[2], pzv[2]; size_t mrow[2];
#pragma unroll
        for (int r = 0; r < 2; ++r) {
            const int t = 256 * sl + 32 * wave + 4 * (p0 + r) + tsub; const size_t m = (size_t)b * SEQ + t; mrow[r] = m;
            const bf16* pc = PROJ + m * LDP0; const bf16* pp = (t == 0) ? pc : pc - LDP0; pzv[r] = (t == 0) ? 0.f : 1.f;
            yv[r] = *(const u32x2*)(CAT + m * DM + col); vc[r] = *(const u32x2*)(pc + C_V + col); vp[r] = *(const u32x2*)(pp + C_V + col); gt[r] = *(const u32x2*)(pc + C_GATE0 + col);
            bsv[r] = BS[m * AH + h];
        }
#pragma unroll
        for (int r = 0; r < 2; ++r) {
            const float pz = pzv[r];
            float y[4] = {bflo(yv[r].x), bfhi(yv[r].x), bflo(yv[r].y), bfhi(yv[r].y)};
            const float mean = sum16((y[0] + y[1]) + (y[2] + y[3])) * (1.f / 64.f);
            float d[4], vs = 0.f;
#pragma unroll
            for (int j = 0; j < 4; ++j) { d[j] = y[j] - mean; vs += d[j] * d[j]; }
            const float rstd = 1.f / sqrtf(sum16(vs) * (1.f / 64.f) + LNX_EPS);
            const float vcur[4] = {bflo(vc[r].x), bfhi(vc[r].x), bflo(vc[r].y), bfhi(vc[r].y)};
            const float vprv[4] = {bflo(vp[r].x) * pz, bfhi(vp[r].x) * pz, bflo(vp[r].y) * pz, bfhi(vp[r].y) * pz};
            const float gg[4] = {bflo(gt[r].x), bfhi(gt[r].x), bflo(gt[r].y), bfhi(gt[r].y)};
            float o[4];
#pragma unroll
            for (int j = 0; j < 4; ++j) { const float v = vcur[j] + (vprv[j] - vcur[j]) * mv[j];
                o[j] = (d[j] * rstd * lw[j] + lb[j] + bsv[r] * v) * siluf_(gg[j]); }
            *(u32x2*)(CAT + mrow[r] * DM + col) = (u32x2){pk2(o[0], o[1]), pk2(o[2], o[3])};
        }
    }
}

__device__ __forceinline__ void phase_scan(const Args& a, LAS unsigned char* lds) {
    const int G = gridDim.x, bx = blockIdx.x;
    for (int it = bx; it < 256; it += G) lora_item(a, lds, it & 7, it >> 3);
    __syncthreads();
    if (bx < 96) { scan_unit(a, lds, bx / 12, bx % 12); }
    else { for (int u = bx - 96; u < 512; u += G - 96) mem_attn_unit(a, lds, 0, u);
           const int wave = __builtin_amdgcn_readfirstlane(threadIdx.x >> 6);
           transpose_group<1>(a, lds, (bx - 96) * 8 + wave, (G - 96) * 8); }
}

__device__ __forceinline__ void phase_rwkv_post(const Args& a) {
    const int tid = threadIdx.x, lane = tid & 63, wave = tid >> 6, G = gridDim.x;
    unsigned char* ws = a.ws;
    const bf16* PROJ = (const bf16*)(ws + WS_PROJ); bf16* CAT = (bf16*)(ws + WS_CAT); const float* BS = (const float*)(ws + WS_BS);
    const float* mu = a.in[I_AMU];
    for (int m = blockIdx.x * 8 + wave; m < MTOK; m += G * 8) {
        const int t = m & (SEQ - 1);
        const bf16* pc = PROJ + (size_t)m * LDP0; const bf16* pp = (t == 0) ? pc : pc - LDP0; const float pz = (t == 0) ? 0.f : 1.f;
#pragma unroll
        for (int i = 0; i < 3; ++i) {
            const int col = 256 * i + 4 * lane, hh = col >> 6;
            const u32x2 yv = *(const u32x2*)(CAT + (size_t)m * DM + col);
            float y[4] = {bflo(yv.x), bfhi(yv.x), bflo(yv.y), bfhi(yv.y)};
            const float mean = sum16((y[0] + y[1]) + (y[2] + y[3])) * (1.f / 64.f);
            float d[4], vs = 0.f;
#pragma unroll
            for (int j = 0; j < 4; ++j) { d[j] = y[j] - mean; vs += d[j] * d[j]; }
            const float rstd = 1.f / sqrtf(sum16(vs) * (1.f / 64.f) + LNX_EPS);
            const f32x4 lw = *(const f32x4*)(a.in[I_ALNW] + col), lb = *(const f32x4*)(a.in[I_ALNB] + col), mv = *(const f32x4*)(mu + C_V + col);
            const u32x2 vc = *(const u32x2*)(pc + C_V + col), vp = *(const u32x2*)(pp + C_V + col), gt = *(const u32x2*)(pc + C_GATE0 + col);
            const float vcur[4] = {bflo(vc.x), bfhi(vc.x), bflo(vc.y), bfhi(vc.y)}, vprv[4] = {bflo(vp.x) * pz, bfhi(vp.x) * pz, bflo(vp.y) * pz, bfhi(vp.y) * pz};
            const float gg[4] = {bflo(gt.x), bfhi(gt.x), bflo(gt.y), bfhi(gt.y)};
            const float bs = BS[(size_t)m * AH + hh];
            float o[4];
#pragma unroll
            for (int j = 0; j < 4; ++j) { const float v = vcur[j] + (vprv[j] - vcur[j]) * mv[j];
                o[j] = (d[j] * rstd * lw[j] + lb[j] + bs * v) * siluf_(gg[j]); }
            u32x2 w; w.x = pk2(o[0], o[1]); w.y = pk2(o[2], o[3]);
            *(u32x2*)(CAT + (size_t)m * DM + col) = w;
        }
    }
}

template <int LAYER>
__device__ __forceinline__ void phase_rows(const Args& a) {
    const int tid = threadIdx.x, lane = tid & 63, wave = tid >> 6, G = gridDim.x;
    unsigned char* ws = a.ws;
    const bf16* Y = (const bf16*)(ws + WS_Y); const float* gpost = a.in[I_POST] + LAYER * DM;
    const float* xin = LAYER ? (const float*)a.out : a.in[I_X];
    bf16* XN = (bf16*)(ws + WS_XN);
    for (int m = blockIdx.x * 8 + wave; m < MTOK; m += G * 8) {
        const u32x2* yr = (const u32x2*)(Y + (size_t)m * DM) + lane; const f32x4* xr = (const f32x4*)(xin + (size_t)m * DM) + lane;
        f32x4 y[4], x[4]; float s = 0.f;
#pragma unroll
        for (int j = 0; j < 4; ++j) { const u32x2 yy = yr[64 * j]; y[j] = (f32x4){bflo(yy.x), bfhi(yy.x), bflo(yy.y), bfhi(yy.y)}; x[j] = xr[64 * j]; s += (y[j].x * y[j].x + y[j].y * y[j].y) + (y[j].z * y[j].z + y[j].w * y[j].w); }
        const float rs = 1.f / sqrtf(wave_sum(s) * (1.f / DM) + NORM_EPS);
        float s1 = 0.f;
        f32x4* orow = (f32x4*)(a.out + (size_t)m * DM) + lane;
#pragma unroll
        for (int j = 0; j < 4; ++j) { const f32x4 gp = *((const f32x4*)gpost + lane + 64 * j);
            x[j] = x[j] + y[j] * rs * gp; orow[64 * j] = x[j];
            s1 += (x[j].x * x[j].x + x[j].y * x[j].y) + (x[j].z * x[j].z + x[j].w * x[j].w); }
        if (LAYER == 0) {
            const float r1 = 1.f / sqrtf(wave_sum(s1) * (1.f / DM) + NORM_EPS);
            unsigned long long* o8 = (unsigned long long*)(XN + (size_t)m * DM) + lane;
#pragma unroll
            for (int j = 0; j < 4; ++j) o8[64 * j] = (unsigned long long)pk2(x[j].x * r1, x[j].y * r1) | ((unsigned long long)pk2(x[j].z * r1, x[j].w * r1) << 32);
        }
    }
}

constexpr int ATT_MAXU = 4;
__device__ const unsigned char att_deal[32][4] = {{32,31,94,8},{48,30,93,7},{33,29,90,81},{49,28,89,79},{34,27,86,74},{50,26,85,73},{35,25,82,66},{51,24,18,65},{36,23,12,1},{52,22,11,80},{37,21,2,255},{53,20,10,64},{38,19,9,16},{54,95,13,17},{39,92,4,255},{55,91,3,255},{40,88,76,255},{56,87,75,255},{41,84,70,255},{57,83,69,255},{42,15,68,255},{58,14,67,255},{43,6,255,255},{59,5,255,255},{44,78,255,255},{60,77,255,255},{45,72,255,255},{61,71,255,255},{46,0,255,255},{62,255,255,255},{47,255,255,255},{63,255,255,255}};
__device__ __forceinline__ void phase_attn1(const Args& a, LAS unsigned char* lds) {
    const int G = gridDim.x, bx = blockIdx.x, lane = threadIdx.x & 63;
    unsigned char* ws = a.ws;
    const float s1 = wave_sum(a.in[I_LQ1][lane] * a.in[I_LK1][lane]), s2 = wave_sum(a.in[I_LQ2][lane] * a.in[I_LK2][lane]);
    const float lam_init = 0.8f - 0.6f * 0.7408182206817179f;
    const float lam = __expf(s1) - __expf(s2) + lam_init;
    const bf16* PROJ = (const bf16*)(ws + WS_PROJ); const bf16* VT = (const bf16*)(ws + WS_VT); bf16* CAT = (bf16*)(ws + WS_CAT);
    const float slopes[6] = {0.25f, 0.0625f, 0.015625f, 0.00390625f, 0.5f, 0.125f};
    for (int i = 0; i < ATT_MAXU; ++i) {
        int qb, b, h;
        if (G == 256) { const int code = att_deal[bx >> 3][i]; if (code == 255) break; b = bx & 7; h = code >> 4; qb = code & 15; }
        else { const int n = i * G + bx; if (n >= 768) break; qb = 15 - n / 48; b = (n % 48) / 6; h = (n % 48) % 6; }
        const size_t row0 = (size_t)b * SEQ + qb * 128;
        float slope = slopes[0];
#pragma unroll
        for (int k = 1; k < 6; ++k) slope = (h == k) ? slopes[k] : slope;
        attn_unit<2>(lds, PROJ + row0 * LDP1 + C_Q1 + h * 128, LDP1,
                     PROJ + (size_t)b * SEQ * LDP1 + C_KSH + h * 128, LDP1,
                     VT + (size_t)(h * 128) * MTOK + (size_t)b * SEQ, MTOK,
                     2 * qb + 1, 2 * qb + 2, slope * LOG2E, qb * 128,
                     PROJ + row0 * LDP1 + C_GATE1 + h * 128, LDP1, CAT + row0 * DM + h * 128, DM, a.in[I_SUBLN], lam, 1.f - lam_init, (const unsigned*)(ws + WS_KM) + (b * 6 + h) * 16);
    }
    for (int u = bx; u < 512; u += G) mem_attn_unit(a, lds, 1, u);
}

constexpr int CW_XB = 8192;
#define XB_TMO      128
#define XB_XCNT(j)  (256  + 64 * (j))
#define XB_XSUB(j)  (1280 + 64 * (j))
#define XB_XGEN(j)  (2304 + 64 * (j))
#define XB_TOP      3328
#define XB_TOPGEN   3392
#define XB_SPIN_CAP (1u << 22)
__device__ __forceinline__ unsigned xb_ld(unsigned* p)              { return __hip_atomic_load(p, __ATOMIC_RELAXED, __HIP_MEMORY_SCOPE_AGENT); }
__device__ __forceinline__ unsigned xb_add(unsigned* p, unsigned v) { return __hip_atomic_fetch_add(p, v, __ATOMIC_RELAXED, __HIP_MEMORY_SCOPE_AGENT); }
__device__ __forceinline__ unsigned xb_xcc_id() { return (unsigned)__builtin_amdgcn_s_getreg((3 << 11) | 20) & 0xFu; }
#define XB_SPIN(cond, bar) do { unsigned _sp = 0; while (cond) { __builtin_amdgcn_s_sleep(1); \
    if ((++_sp & 255u) == 0u) { if (xb_ld(&(bar)[XB_TMO])) break; if (_sp > XB_SPIN_CAP) { atomicAdd(&(bar)[XB_TMO], 1u); break; } } } } while (0)
struct XcdBarrier { unsigned* bar; unsigned x; volatile LAS unsigned* st; };
__device__ __forceinline__ XcdBarrier xcd_barrier_post(unsigned* bar, volatile LAS unsigned* st) {
    XcdBarrier b; b.bar = bar; b.x = xb_xcc_id(); b.st = st;
    if (threadIdx.x == 0) (void)xb_add(&bar[XB_XCNT(b.x)], 1u);
    return b;
}
__device__ __forceinline__ void xcd_barrier_complete(unsigned* bar, unsigned x, unsigned& nloc, unsigned& nx) {
    const unsigned G = gridDim.x * gridDim.y * gridDim.z;
    unsigned sum, cnt, mine, sp = 0u;
    for (;;) {
        sum = 0u; cnt = 0u; mine = 0u;
#pragma unroll
        for (unsigned j = 0; j < 16; ++j) { const unsigned c = xb_ld(&bar[XB_XCNT(j)]); sum += c; cnt += (c > 0u) ? 1u : 0u; mine = (j == x) ? c : mine; }
        if (sum == G) break;
        __builtin_amdgcn_s_sleep(1);
        if ((++sp & 255u) == 0u) { if (xb_ld(&bar[XB_TMO])) break; if (sp > XB_SPIN_CAP) { atomicAdd(&bar[XB_TMO], 1u); break; } }
    }
    nloc = mine > 0u ? mine : 1u; nx = cnt > 0u ? cnt : 1u;
}
__device__ __forceinline__ void xcd_barrier(const XcdBarrier& b) {
    asm volatile("s_waitcnt vmcnt(0)" ::: "memory");
    __syncthreads();
    if (threadIdx.x == 0) {
        unsigned* bar = b.bar;
        __builtin_amdgcn_s_waitcnt(0);
        unsigned nloc = b.st[0], nx = b.st[1];
        if (nloc == 0u) { xcd_barrier_complete(bar, b.x, nloc, nx); b.st[0] = nloc; b.st[1] = nx; }
        const unsigned old = xb_add(&bar[XB_XSUB(b.x)], 1u);
        const unsigned gen = old / nloc;
        if (old + 1u == (gen + 1u) * nloc) {
            __builtin_amdgcn_fence(__ATOMIC_RELEASE, "agent");
            asm volatile("s_waitcnt vmcnt(0)" ::: "memory");
            const unsigned og = xb_add(&bar[XB_TOP], 1u);
            const unsigned tg = og / nx;
            if (og + 1u == (tg + 1u) * nx) xb_add(&bar[XB_TOPGEN], 1u);
            else XB_SPIN(xb_ld(&bar[XB_TOPGEN]) == tg, bar);
            __builtin_amdgcn_fence(__ATOMIC_ACQUIRE, "agent");
            xb_add(&bar[XB_XGEN(b.x)], 1u);
            asm volatile("s_waitcnt vmcnt(0)" ::: "memory");
        } else {
            XB_SPIN(xb_ld(&bar[XB_XGEN(b.x)]) == gen, bar);
            __builtin_amdgcn_fence(__ATOMIC_ACQUIRE, "agent");
            asm volatile("s_waitcnt vmcnt(0)" ::: "memory");
        }
    }
    __syncthreads();
}

constexpr int N_PHASES = 10;
__global__ void __launch_bounds__(512, 2) yoco_fwd(Args args) {
    extern __shared__ __attribute__((aligned(16))) unsigned char lds_raw[];
    LAS unsigned char* lds = (LAS unsigned char*)lds_raw;
    const int lo = args.ph_lo, hi = args.ph_hi;
#ifndef ONLY_PHASE
#define ONLY_PHASE -1
#endif
#define IN(k) ((ONLY_PHASE < 0 || ONLY_PHASE == (k)) && lo <= (k) && (k) < hi)
    volatile LAS unsigned* xb_st = (volatile LAS unsigned*)(lds + LDS_BYTES - 64);
    if (threadIdx.x == 0) { xb_st[0] = 0u; xb_st[1] = 0u; }
    __syncthreads();
    const XcdBarrier xbar = xcd_barrier_post((unsigned*)args.ws + CW_XB, xb_st);
    if (args.ph_hi > 64) { __syncthreads(); cg::this_grid().sync(); }
#define SEAM(k) do { if (IN(k) && IN((k) + 1)) { xcd_barrier(xbar); } } while (0)
    if (IN(0)) { phase_prologue(args, lds); if (PROBE_DUP == 0) { __syncthreads(); phase_prologue(args, lds); } }
    SEAM(0);
    if (IN(1)) { phase_gemm(args, lds, 0, 3); if (PROBE_DUP == 1) { __syncthreads(); phase_gemm(args, lds, 0, 3); } }
    SEAM(1);
    if (IN(2)) { phase_scan(args, lds); if (PROBE_DUP == 2) { __syncthreads(); phase_scan(args, lds); } }
    SEAM(2);
    if (IN(3)) phase_rwkv_post(args);
    SEAM(3);
    if (IN(4)) { if (gridDim.x == 256) phase_outproj<0>(args, lds); else { phase_gemm(args, lds, 3, 1); } }
    if (gridDim.x != 256) { SEAM(4); if (IN(5)) phase_rows<0>(args); }
    SEAM(5);
    if (IN(6)) { phase_gemm(args, lds, 4, 2); if (PROBE_DUP == 6) { __syncthreads(); phase_gemm(args, lds, 4, 2); } }
    SEAM(6);
    if (IN(7)) { phase_attn1(args, lds); if (PROBE_DUP == 7) { __syncthreads(); phase_attn1(args, lds); } }
    SEAM(7);
    if (IN(8)) { if (gridDim.x == 256) phase_outproj<1>(args, lds); else { phase_gemm(args, lds, 6, 1); } }
    if (gridDim.x != 256) { SEAM(8); if (IN(9)) phase_rows<1>(args); }
#undef IN
#undef SEAM
}

extern "C" void kernel_launch(void* const* d_in, const int* in_sizes, int n_in, void* d_out, int out_size, void* d_ws, size_t ws_size, hipStream_t stream) {
    static int ready = 0;
    if (ready == 0) {
        if (n_in != 26 || out_size != MTOK * DM || ws_size < WS_END) { fprintf(stderr, "kernel_launch: unexpected problem shape (n_in %d out %d ws %zu)\n", n_in, out_size, ws_size); ready = -1; return; }
        if (hipFuncSetAttribute((const void*)yoco_fwd, hipFuncAttributeMaxDynamicSharedMemorySize, LDS_BYTES) != hipSuccess) { fprintf(stderr, "kernel_launch: hipFuncSetAttribute failed\n"); ready = -1; return; }
        int per_cu = 0;
        if (hipOccupancyMaxActiveBlocksPerMultiprocessor(&per_cu, (const void*)yoco_fwd, 512, LDS_BYTES) != hipSuccess || per_cu < 1) fprintf(stderr, "kernel_launch: occupancy query says %d\n", per_cu);
        (void)hipGetLastError();
        ready = 1;
    }
    if (ready < 0) return;
    Args a{};
    for (int i = 0; i < 26; ++i) a.in[i] = (const float*)d_in[i];
    a.out = (float*)d_out; a.ws = (unsigned char*)d_ws;
#if MK_COOP
    (void)hipMemsetAsync(d_ws, 0, 65536, stream);
    a.ph_lo = 0; a.ph_hi = N_PHASES;
    void* params[] = {&a};
    hipError_t e = hipLaunchCooperativeKernel((const void*)yoco_fwd, dim3(256), dim3(512), params, LDS_BYTES, stream);
    if (e != hipSuccess) fprintf(stderr, "kernel_launch: cooperative launch failed: %s\n", hipGetErrorString(e));
#else
    for (int ph = 0; ph < N_PHASES; ++ph) { a.ph_lo = ph; a.ph_hi = ph + 1; hipLaunchKernelGGL(yoco_fwd, dim3(256), dim3(512), LDS_BYTES, stream, a); }
#endif
}
```

```cpp
#include <hip/hip_runtime.h>
#include <hip/hip_cooperative_groups.h>
#include <cstdio>
#include <cstdint>
namespace cg = cooperative_groups;

#ifndef PROBE_DUP
#define PROBE_DUP -1
#endif
#ifndef MK_COOP
#define MK_COOP 1
#endif

#define LAS __attribute__((address_space(3)))
typedef unsigned short bf16;
typedef short bf16x8 __attribute__((ext_vector_type(8)));
typedef float f32x4 __attribute__((ext_vector_type(4)));
typedef float f32x2 __attribute__((ext_vector_type(2)));
typedef unsigned u32x4 __attribute__((ext_vector_type(4)));
typedef unsigned u32x2 __attribute__((ext_vector_type(2)));

constexpr int DM = 1024, NBATCH = 8, SEQ = 2048, MTOK = NBATCH * SEQ;
constexpr int MEML = 256, MROWS = NBATCH * MEML;
constexpr int BRW = 768, AH = 12, BH = 6;
constexpr int LDP0 = 3840;
constexpr int LDP1 = 2816;
constexpr int C_R = 0, C_K = 768, C_V = 1536, C_WD = 2304, C_AD = 2368, C_GATE0 = 2432, C_QM0 = 3200, C_GM0 = 3456;
constexpr int C_Q1 = 0, C_GATE1 = 768, C_QM1 = 1536, C_GM1 = 1792, C_KSH = 2048;
constexpr float NORM_EPS = 1e-6f, LNX_EPS = 64e-5f;
constexpr float LOG2E = 1.4426950408889634f;

constexpr size_t MiB = 1u << 20;
constexpr size_t WS_WA = 1 * MiB;
constexpr size_t WS_WB = 9 * MiB;
constexpr size_t WS_WO = 16 * MiB;
constexpr size_t WS_WM = 20 * MiB;
constexpr size_t WS_MEMN = 22 * MiB;
constexpr size_t WS_MK = 26 * MiB;
constexpr size_t WS_MVT = 28 * MiB;
constexpr size_t WS_XN = 30 * MiB;
constexpr size_t WS_CAT = 62 * MiB;
constexpr size_t WS_VT = 94 * MiB;
constexpr size_t WS_PROJ = 118 * MiB;
constexpr size_t WS_Y = 118 * MiB;
constexpr size_t WS_W2T = 0 * MiB + 65536;
constexpr size_t WS_KM = 6144;
constexpr size_t WS_XCNT = 16384;
constexpr size_t WS_XCH = 254 * MiB;
constexpr size_t WS_LD16 = WS_XN;
constexpr size_t WS_A16 = WS_VT;
constexpr int CW_LORA = 1280;
constexpr size_t WS_X1B = 210 * MiB;
constexpr size_t WS_BS = 238 * MiB;
constexpr size_t WS_END = 256 * MiB;

__device__ __forceinline__ unsigned f2bf(float f) { unsigned u = __builtin_bit_cast(unsigned, f); return (u + 0x7fffu + ((u >> 16) & 1u)) >> 16; }
typedef __bf16 bf16x2_t __attribute__((ext_vector_type(2)));
__device__ __forceinline__ unsigned pk2(float lo, float hi) { f32x2 v = {lo, hi}; bf16x2_t b = __builtin_convertvector(v, bf16x2_t); return __builtin_bit_cast(unsigned, b); }
__device__ __forceinline__ float bflo(unsigned u) { return __builtin_bit_cast(float, u << 16); }
__device__ __forceinline__ float bfhi(unsigned u) { return __builtin_bit_cast(float, u & 0xffff0000u); }
__device__ __forceinline__ float wave_sum(float v) {
#pragma unroll
    for (int o = 1; o < 64; o <<= 1) v += __shfl_xor(v, o);
    return v;
}
template <int CTRL> __device__ __forceinline__ float dppf(float x) { return __builtin_bit_cast(float, __builtin_amdgcn_update_dpp(0, __builtin_bit_cast(int, x), CTRL, 0xf, 0xf, false)); }
__device__ __forceinline__ float sum8(float x) { x += dppf<0xB1>(x); x += dppf<0x4E>(x); x += dppf<0x141>(x); return x; }
__device__ __forceinline__ float sum16(float x) { x += dppf<0xB1>(x); x += dppf<0x4E>(x); x += dppf<0x141>(x); x += dppf<0x140>(x); return x; }
__device__ __forceinline__ float rows_max(float m) { m = fmaxf(m, __shfl_xor(m, 16)); return fmaxf(m, __shfl_xor(m, 32)); }
__device__ __forceinline__ float rows_sum(float m) { m += __shfl_xor(m, 16); return m + __shfl_xor(m, 32); }
__device__ __forceinline__ float sigmoidf_(float x) { return __builtin_amdgcn_rcpf(1.f + __builtin_amdgcn_exp2f(-1.4426950408889634f * x)); }
__device__ __forceinline__ float siluf_(float x) { return x * __builtin_amdgcn_rcpf(1.f + __builtin_amdgcn_exp2f(-1.4426950408889634f * x)); }

namespace pg8 {
constexpr int BM = 256, BK = 64, HALF = 128, HTB = HALF * BK * 2, STAGE_BYTES = 8 * HTB, NXCD = 8, WGM = 8;
__device__ __forceinline__ int lds_byte(int r, int c) { const int st = (r >> 4) * 2 + (c >> 5), rr = r & 15, cc = c & 31, ob = rr * 64 + cc * 2; return st * 1024 + (ob ^ (((ob >> 9) & 1) << 5)); }
__device__ __forceinline__ void stage_rc(int b, int& R, int& C) { const int st = b / 1024, sb = b % 1024, swz = sb ^ (((sb >> 9) & 1) << 5); R = (st >> 1) * 16 + swz / 64; C = (st & 1) * 32 + (swz % 64) / 2; }
__device__ __forceinline__ int perm32(int rho) { const int n = rho >> 4, i = rho & 15; return 8 * (i >> 2) + 4 * n + (i & 3); }
struct Unit { int pm, pn; };
struct Gemm { const bf16* A; const bf16* Bt; int M, N, K; };
struct StaticOrder {
    int nM, nN, nwg, G, c;
    __device__ void init(int M, int N, int G_, int c_) { nM = M / BM; nN = N / BM; nwg = nM * nN; G = G_; c = c_; }
    __device__ bool next(int i, Unit& u) const {
        const long L = (long)i * G + c; if (L >= nwg) return false;
        int wgid = (int)L; { const int q = nwg / NXCD, r = nwg % NXCD, xcd = wgid % NXCD, off = wgid / NXCD; wgid = (xcd < r ? xcd * (q + 1) : r * (q + 1) + (xcd - r) * q) + off; }
        const int nig = WGM * nN, gid = wgid / nig, fm = gid * WGM, gsz = (nM - fm) < WGM ? (nM - fm) : WGM;
        u.pm = fm + ((wgid % nig) % gsz); u.pn = (wgid % nig) / gsz; return true;
    }
};
__device__ __forceinline__ unsigned cvt_pk_bf16(float lo, float hi) { unsigned r; asm volatile("v_cvt_pk_bf16_f32 %0, %1, %2" : "=v"(r) : "v"(lo), "v"(hi)); return r; }

struct EpiStore {
    void* O; int ldc; int f32out; unsigned* km;
    __device__ __forceinline__ void operator()(const f32x4 (&acc)[2][2][4][2], const Unit& u, int wr, int wc, int fr, int fq) const {
        const int row0 = u.pm * BM + wr * 64 + fr, col0 = u.pn * BM + wc * 32 + 8 * fq;
        if (f32out) {
#pragma unroll
            for (int ai = 0; ai < 2; ++ai)
#pragma unroll
                for (int m = 0; m < 4; ++m) { float* rowp = (float*)O + (size_t)(row0 + ai * HALF + m * 16) * ldc + col0;
#pragma unroll
                    for (int bj = 0; bj < 2; ++bj) { *(f32x4*)(rowp + bj * HALF) = acc[ai][bj][m][0]; *(f32x4*)(rowp + bj * HALF + 4) = acc[ai][bj][m][1]; } }
        } else {
#pragma unroll
            for (int ai = 0; ai < 2; ++ai)
#pragma unroll
                for (int m = 0; m < 4; ++m) { bf16* rowp = (bf16*)O + (size_t)(row0 + ai * HALF + m * 16) * ldc + col0;
#pragma unroll
                    for (int bj = 0; bj < 2; ++bj) { const f32x4 v0 = acc[ai][bj][m][0], v1 = acc[ai][bj][m][1];
                        u32x4 w; w.x = cvt_pk_bf16(v0[0], v0[1]); w.y = cvt_pk_bf16(v0[2], v0[3]); w.z = cvt_pk_bf16(v1[0], v1[1]); w.w = cvt_pk_bf16(v1[2], v1[3]);
                        *(u32x4*)(rowp + bj * HALF) = w; } }
            if (km && u.pn >= 8) {
#pragma unroll
                for (int bj = 0; bj < 2; ++bj) {
                    float pmax = 0.f;
#pragma unroll
                    for (int ai = 0; ai < 2; ++ai)
#pragma unroll
                        for (int m = 0; m < 4; ++m) { const f32x4 v0 = acc[ai][bj][m][0], v1 = acc[ai][bj][m][1];
                            const unsigned w0 = cvt_pk_bf16(v0[0], v0[1]), w1 = cvt_pk_bf16(v0[2], v0[3]), w2 = cvt_pk_bf16(v1[0], v1[1]), w3 = cvt_pk_bf16(v1[2], v1[3]);
                            const float a0 = bflo(w0), a1 = bfhi(w0), a2 = bflo(w1), a3 = bfhi(w1), a4 = bflo(w2), a5 = bfhi(w2), a6 = bflo(w3), a7 = bfhi(w3);
                            pmax = fmaxf(pmax, ((a0 * a0 + a1 * a1) + (a2 * a2 + a3 * a3)) + ((a4 * a4 + a5 * a5) + (a6 * a6 + a7 * a7))); }
                    pmax = fmaxf(pmax, dppf<0xB1>(pmax)); pmax = fmaxf(pmax, dppf<0x4E>(pmax)); pmax = fmaxf(pmax, dppf<0x141>(pmax)); pmax = fmaxf(pmax, dppf<0x140>(pmax));
                    if (fr == 0) { const int ck = u.pn * BM + bj * HALF + wc * 32 + 8 * fq - 2048;
                        atomicMax(km + (((u.pm >> 3) * 6 + (ck >> 7)) * 2 + ((ck >> 6) & 1)) * 8 + ((ck >> 3) & 7), __builtin_bit_cast(unsigned, pmax)); }
                }
            }
        }
    }
};

struct EpiFused {
    const float* xin; const bf16* xin16; float* out; bf16* out16; bf16* XN; const float* gpost; float* xch; unsigned* cnt;
    __device__ __forceinline__ void exchange(int ex, int pm, int pn, LAS float* P, LAS float* RS, int tid) const {
        __syncthreads();
        unsigned* mine = (unsigned*)(xch + ((size_t)(ex * 64 + pm) * 4) * 256);
        if (tid < 256) { const f32x4 p4 = *(const LAS f32x4*)(P + tid * 4);
            __hip_atomic_store(mine + pn * 256 + tid, __builtin_bit_cast(unsigned, (p4.x + p4.y) + (p4.z + p4.w)), __ATOMIC_RELAXED, __HIP_MEMORY_SCOPE_AGENT); }
        asm volatile("s_waitcnt vmcnt(0)" ::: "memory");
        __syncthreads();
        if (tid == 0) {
            unsigned* c = cnt + (ex * 64 + pm) * 16;
            (void)__hip_atomic_fetch_add(c, 1u, __ATOMIC_RELAXED, __HIP_MEMORY_SCOPE_AGENT);
            while (__hip_atomic_load(c, __ATOMIC_RELAXED, __HIP_MEMORY_SCOPE_AGENT) < 4u) __builtin_amdgcn_s_sleep(1);
        }
        __syncthreads();
        if (tid < 256) {
            const float t0 = __builtin_bit_cast(float, __hip_atomic_load(mine + tid, __ATOMIC_RELAXED, __HIP_MEMORY_SCOPE_AGENT)), t1 = __builtin_bit_cast(float, __hip_atomic_load(mine + 256 + tid, __ATOMIC_RELAXED, __HIP_MEMORY_SCOPE_AGENT)),
                        t2 = __builtin_bit_cast(float, __hip_atomic_load(mine + 512 + tid, __ATOMIC_RELAXED, __HIP_MEMORY_SCOPE_AGENT)), t3 = __builtin_bit_cast(float, __hip_atomic_load(mine + 768 + tid, __ATOMIC_RELAXED, __HIP_MEMORY_SCOPE_AGENT));
            RS[tid] = __builtin_amdgcn_rsqf(((t0 + t1) + (t2 + t3)) * (1.f / 1024.f) + 1e-6f); }
        __syncthreads();
    }
    __device__ __forceinline__ void fused(f32x4 (&acc)[2][2][4][2], const Unit& u, int wr, int wc, int fr, int fq, LAS unsigned char* lds) const {
        const int tid = threadIdx.x;
        LAS float* P = (LAS float*)lds;
        LAS float* RS = (LAS float*)(lds + 4096);
#pragma unroll
        for (int ai = 0; ai < 2; ++ai)
#pragma unroll
            for (int m = 0; m < 4; ++m) {
                float p = 0.f;
#pragma unroll
                for (int bj = 0; bj < 2; ++bj)
#pragma unroll
                    for (int n = 0; n < 2; ++n) { const f32x4 v = acc[ai][bj][m][n]; p += (v.x * v.x + v.y * v.y) + (v.z * v.z + v.w * v.w); }
                p += __shfl_xor(p, 16); p += __shfl_xor(p, 32);
                if (fq == 0) P[(ai * HALF + wr * 64 + m * 16 + fr) * 4 + wc] = p;
            }
        exchange(0, u.pm, u.pn, P, RS, tid);
        const int col0 = u.pn * BM + wc * 32 + 8 * fq;
        f32x4 gp[2][2];
#pragma unroll
        for (int bj = 0; bj < 2; ++bj)
#pragma unroll
            for (int n = 0; n < 2; ++n) gp[bj][n] = *(const f32x4*)(gpost + col0 + bj * HALF + 4 * n);
#pragma unroll
        for (int ai = 0; ai < 2; ++ai)
#pragma unroll
            for (int m = 0; m < 4; ++m) {
                const int rl = ai * HALF + wr * 64 + m * 16 + fr; const float rs = RS[rl];
                const size_t off = (size_t)(u.pm * BM + rl) * 1024 + col0;
                float p = 0.f;
#pragma unroll
                for (int bj = 0; bj < 2; ++bj) {
                    f32x4 xv[2];
                    if (xin16) { const u32x4 xb = *(const u32x4*)(xin16 + off + bj * HALF); xv[0] = (f32x4){bflo(xb.x), bfhi(xb.x), bflo(xb.y), bfhi(xb.y)}; xv[1] = (f32x4){bflo(xb.z), bfhi(xb.z), bflo(xb.w), bfhi(xb.w)}; }
                    else { xv[0] = *(const f32x4*)(xin + off + bj * HALF); xv[1] = *(const f32x4*)(xin + off + bj * HALF + 4); }
#pragma unroll
                    for (int n = 0; n < 2; ++n) {
                        const f32x4 x1 = xv[n] + acc[ai][bj][m][n] * rs * gp[bj][n];
                        acc[ai][bj][m][n] = x1;
                        p += (x1.x * x1.x + x1.y * x1.y) + (x1.z * x1.z + x1.w * x1.w);
                    }
                    if (out16) { const f32x4 v0 = acc[ai][bj][m][0], v1 = acc[ai][bj][m][1];
                        u32x4 w; w.x = cvt_pk_bf16(v0[0], v0[1]); w.y = cvt_pk_bf16(v0[2], v0[3]); w.z = cvt_pk_bf16(v1[0], v1[1]); w.w = cvt_pk_bf16(v1[2], v1[3]);
                        *(u32x4*)(out16 + off + bj * HALF) = w; }
                    else { *(f32x4*)(out + off + bj * HALF) = acc[ai][bj][m][0]; *(f32x4*)(out + off + bj * HALF + 4) = acc[ai][bj][m][1]; }
                }
                if (XN) { p += __shfl_xor(p, 16); p += __shfl_xor(p, 32); if (fq == 0) P[rl * 4 + wc] = p; }
            }
        if (XN) {
            exchange(1, u.pm, u.pn, P, RS, tid);
#pragma unroll
            for (int ai = 0; ai < 2; ++ai)
#pragma unroll
                for (int m = 0; m < 4; ++m) {
                    const int rl = ai * HALF + wr * 64 + m * 16 + fr; const float r1 = RS[rl];
                    bf16* rowp = XN + (size_t)(u.pm * BM + rl) * 1024 + col0;
#pragma unroll
                    for (int bj = 0; bj < 2; ++bj) { const f32x4 v0 = acc[ai][bj][m][0] * r1, v1 = acc[ai][bj][m][1] * r1;
                        u32x4 w; w.x = cvt_pk_bf16(v0[0], v0[1]); w.y = cvt_pk_bf16(v0[2], v0[3]); w.z = cvt_pk_bf16(v1[0], v1[1]); w.w = cvt_pk_bf16(v1[2], v1[3]);
                        *(u32x4*)(rowp + bj * HALF) = w; }
                }
        }
        __syncthreads();
    }
};

template <class Epi, class Sched, bool FUSED = false>
__device__ __forceinline__ void gemm_phase(LAS unsigned char* lds, const Gemm g, const Sched& S, const Epi& E) {
    const int tid = threadIdx.x, wid = __builtin_amdgcn_readfirstlane(tid >> 6), lane = tid & 63, wr = wid >> 2, wc = wid & 3, fr = lane & 15, fq = lane >> 4;
    const int K = g.K, nt = K / BK;
    unsigned voffA[2], voffB[2];
#pragma unroll
    for (int i = 0; i < 2; ++i) { int R, C; stage_rc(tid * 16 + i * 8192, R, C); const int Rb = (R & ~31) + perm32(R & 31);
        voffA[i] = (unsigned)(R * K + C) * 2u; voffB[i] = (unsigned)(Rb * K + C) * 2u; }
    const size_t kstep = (size_t)(BK * 2);
    const size_t hstep = (size_t)HALF * K * 2;
    const size_t tstep = 2 * hstep;
    const unsigned ldsw = (unsigned)wid * 1024u;
    const int aoff = lds_byte(wr * 64 + fr, fq * 8), boff = lds_byte(wc * 32 + fr, fq * 8);
#define PG8_SA(b, h) (((b) * 2 + (h)) * HTB)
#define PG8_SB(b, h) ((4 + (b) * 2 + (h)) * HTB)
#define PG8_STAGE(bufoff, gbase, voff) do { _Pragma("unroll") for (int _i = 0; _i < 2; ++_i) \
        __builtin_amdgcn_global_load_lds((const unsigned*)((const char*)(gbase) + (voff)[_i]), (LAS unsigned*)(lds + (bufoff) + ldsw + _i * 8192), 16, 0, 0); } while (0)
#define PG8_LDA(dst, b, h) do { _Pragma("unroll") for (int m = 0; m < 4; ++m) _Pragma("unroll") for (int k = 0; k < 2; ++k) dst[m][k] = *(const LAS bf16x8*)(lds + PG8_SA(b, h) + aoff + m * 2048 + k * 1024); } while (0)
#define PG8_LDB(dst, b, h) do { _Pragma("unroll") for (int n = 0; n < 2; ++n) _Pragma("unroll") for (int k = 0; k < 2; ++k) dst[n][k] = *(const LAS bf16x8*)(lds + PG8_SB(b, h) + boff + n * 2048 + k * 1024); } while (0)
#define PG8_MMA(ai, bj, At, Bt) do { __builtin_amdgcn_s_setprio(1); _Pragma("unroll") for (int m = 0; m < 4; ++m) _Pragma("unroll") for (int n = 0; n < 2; ++n) _Pragma("unroll") for (int k = 0; k < 2; ++k) \
        acc[ai][bj][m][n] = __builtin_amdgcn_mfma_f32_16x16x32_bf16(Bt[n][k], At[m][k], acc[ai][bj][m][n], 0, 0, 0); __builtin_amdgcn_s_setprio(0); } while (0)
#define PG8_WAIT_V(n) asm volatile("s_waitcnt vmcnt(" #n ")" ::: "memory")
#define PG8_WAIT_L(n) asm volatile("s_waitcnt lgkmcnt(" #n ")" ::: "memory")
#define PG8_BAR __builtin_amdgcn_s_barrier()
#define PG8_SCHED __builtin_amdgcn_sched_barrier(0)
    Unit cur, nxt; int ui = 0;
    if (!S.next(0, cur)) return;
    f32x4 acc[2][2][4][2];
#pragma unroll
    for (int a = 0; a < 2; ++a)
#pragma unroll
        for (int b = 0; b < 2; ++b)
#pragma unroll
            for (int m = 0; m < 4; ++m)
#pragma unroll
                for (int n = 0; n < 2; ++n) acc[a][b][m][n] = (f32x4){0.f, 0.f, 0.f, 0.f};
    bf16x8 At[4][2], B0[2][2], B1[2][2];
    const char* cA = (const char*)g.A + (size_t)cur.pm * tstep; const char* cB = (const char*)g.Bt + (size_t)cur.pn * tstep;
    PG8_STAGE(PG8_SB(0, 0), cB, voffB); PG8_STAGE(PG8_SB(0, 1), cB + hstep, voffB); PG8_STAGE(PG8_SA(0, 0), cA, voffA); PG8_STAGE(PG8_SA(0, 1), cA + hstep, voffA);
    if (wr == 1) PG8_BAR;
    PG8_WAIT_V(2); PG8_BAR;
    PG8_STAGE(PG8_SB(1, 0), cB + kstep, voffB); PG8_STAGE(PG8_SA(1, 0), cA + kstep, voffA); PG8_STAGE(PG8_SB(1, 1), cB + hstep + kstep, voffB);
    PG8_WAIT_V(6); PG8_BAR;
    for (;;) {
        const bool has_next = S.next(ui + 1, nxt);
        const char* nA = has_next ? (const char*)g.A + (size_t)nxt.pm * tstep : cA; const char* nB = has_next ? (const char*)g.Bt + (size_t)nxt.pn * tstep : cB;
        for (int t = 0; t < nt; t += 2) {
            const bool last = (t == nt - 2);
            const char* a1 = cA + (size_t)(t + 1) * kstep;
            const char* a2 = last ? nA : cA + (size_t)(t + 2) * kstep; const char* b2 = last ? nB : cB + (size_t)(t + 2) * kstep;
            const char* a3 = a2 + kstep; const char* b3 = b2 + kstep;
            PG8_LDB(B0, 0, 0); PG8_LDB(B1, 0, 1); PG8_SCHED; PG8_LDA(At, 0, 0); PG8_STAGE(PG8_SA(1, 1), a1 + hstep, voffA);
            PG8_WAIT_V(8); PG8_WAIT_L(0); PG8_BAR; PG8_MMA(0, 0, At, B0); PG8_MMA(0, 1, At, B1); PG8_BAR; PG8_SCHED;
            PG8_LDA(At, 0, 1); PG8_STAGE(PG8_SB(0, 0), b2, voffB); PG8_STAGE(PG8_SB(0, 1), b2 + hstep, voffB); PG8_STAGE(PG8_SA(0, 0), a2, voffA);
            PG8_WAIT_V(8); PG8_WAIT_L(0); PG8_BAR; PG8_MMA(1, 0, At, B0); PG8_MMA(1, 1, At, B1); PG8_BAR; PG8_SCHED;
            PG8_LDB(B0, 1, 0); PG8_LDB(B1, 1, 1); PG8_SCHED; PG8_LDA(At, 1, 0); PG8_STAGE(PG8_SA(0, 1), a2 + hstep, voffA);
            PG8_WAIT_V(8); PG8_WAIT_L(0); PG8_BAR; PG8_MMA(0, 0, At, B0); PG8_MMA(0, 1, At, B1); PG8_BAR; PG8_SCHED;
            PG8_LDA(At, 1, 1); PG8_STAGE(PG8_SB(1, 0), b3, voffB); PG8_STAGE(PG8_SB(1, 1), b3 + hstep, voffB); PG8_STAGE(PG8_SA(1, 0), a3, voffA);
            PG8_WAIT_V(8); PG8_WAIT_L(0); PG8_BAR; PG8_MMA(1, 0, At, B0); PG8_MMA(1, 1, At, B1); PG8_BAR; PG8_SCHED;
        }
        if (wr == 0) PG8_BAR;
        if constexpr (!FUSED) E(acc, cur, wr, wc, fr, fq);
        if (!has_next) break;
#pragma unroll
        for (int a = 0; a < 2; ++a)
#pragma unroll
            for (int b = 0; b < 2; ++b)
#pragma unroll
                for (int m = 0; m < 4; ++m)
#pragma unroll
                    for (int n = 0; n < 2; ++n) acc[a][b][m][n] = (f32x4){0.f, 0.f, 0.f, 0.f};
        cur = nxt; cA = nA; cB = nB; ++ui;
        if (wr == 1) PG8_BAR;
    }
    PG8_WAIT_V(0);
    PG8_BAR;
    if constexpr (FUSED) E.fused(acc, cur, wr, wc, fr, fq, lds);
#undef PG8_SA
#undef PG8_SB
#undef PG8_STAGE
#undef PG8_LDA
#undef PG8_LDB
#undef PG8_MMA
#undef PG8_WAIT_V
#undef PG8_WAIT_L
#undef PG8_BAR
#undef PG8_SCHED
}
}

struct Args { const float* in[26]; float* out; unsigned char* ws; int ph_lo, ph_hi; };
enum { I_X = 0, I_MEM, I_PRE, I_POST, I_WOUT, I_MEMNORM, I_WMEMKV, I_AWIN, I_AMU, I_AW0, I_AW2, I_AA0, I_AA2, I_AKK, I_AKA, I_ARK, I_ALNW, I_ALNB,
       I_KVNORM, I_WKV, I_BWIN, I_LQ1, I_LK1, I_LQ2, I_LK2, I_SUBLN };

constexpr int LDS_BYTES = 147456;

__device__ __forceinline__ void p0_transpose_item(const float* W, int ldw, int c0, int nc, const float* gain, bf16* WT, int row0, LAS float* scr, int item, int lane, int ldo = 1024) {
    const int nblk = nc / 32, kb = item / nblk, nb = item % nblk, k0 = 64 * kb, n0 = 32 * nb;
#pragma unroll
    for (int i = 0; i < 8; ++i) { const int kk = 8 * i + (lane >> 3), n4 = 4 * (lane & 7);
        f32x4 v = *(const f32x4*)(W + (size_t)(k0 + kk) * ldw + c0 + n0 + n4); if (gain) v = v * gain[k0 + kk];
        LAS float* d = scr + kk * 33 + n4; d[0] = v.x; d[1] = v.y; d[2] = v.z; d[3] = v.w; }
    asm volatile("s_waitcnt lgkmcnt(0)" ::: "memory");
    const int c = lane & 7;
#pragma unroll
    for (int j = 0; j < 4; ++j) { const int n = (lane >> 3) + 8 * j; const LAS float* s = scr + (8 * c) * 33 + n;
        u32x4 o; o.x = pk2(s[0 * 33], s[1 * 33]); o.y = pk2(s[2 * 33], s[3 * 33]); o.z = pk2(s[4 * 33], s[5 * 33]); o.w = pk2(s[6 * 33], s[7 * 33]);
        *(u32x4*)(WT + (size_t)(row0 + n0 + n) * ldo + k0 + 8 * c) = o; }
    asm volatile("s_waitcnt lgkmcnt(0)" ::: "memory");
}
__device__ __forceinline__ void rms_row_to_bf16(const float* xrow, bf16* orow, int lane) {
    const f32x4* xr = (const f32x4*)xrow + lane;
    f32x4 v[4]; float s = 0.f;
#pragma unroll
    for (int j = 0; j < 4; ++j) { v[j] = xr[64 * j]; s += (v[j].x * v[j].x + v[j].y * v[j].y) + (v[j].z * v[j].z + v[j].w * v[j].w); }
    const float rs = 1.f / sqrtf(wave_sum(s) * (1.f / DM) + NORM_EPS);
    unsigned long long* o8 = (unsigned long long*)orow + lane;
#pragma unroll
    for (int j = 0; j < 4; ++j) o8[64 * j] = (unsigned long long)pk2(v[j].x * rs, v[j].y * rs) | ((unsigned long long)pk2(v[j].z * rs, v[j].w * rs) << 32);
}
template <int GROUP>
__device__ __forceinline__ void transpose_group(const Args& a, LAS unsigned char* lds, int gw, int NGW) {
    const int lane = threadIdx.x & 63, wave = __builtin_amdgcn_readfirstlane(threadIdx.x >> 6);
    unsigned char* ws = a.ws;
    LAS float* scr = (LAS float*)(lds + wave * 16384);
    bf16* WA = (bf16*)(ws + WS_WA); bf16* WB = (bf16*)(ws + WS_WB); bf16* WO = (bf16*)(ws + WS_WO); bf16* WM = (bf16*)(ws + WS_WM);
    constexpr int I0 = 16 * (3712 / 32), I1 = 16 * (2048 / 32), I2 = 16 * (1536 / 32), I3 = 16 * (1024 / 32), I5 = 16 * (256 / 32), I6 = 768 / 32;
    bf16* W2T = (bf16*)(ws + WS_W2T); bf16* A2T = W2T + 768 * 64;
    if (GROUP == 0) {
        constexpr int NITEMS = I0 + 4 * I5 + 2 * I6;
        for (int it = gw; it < NITEMS; it += NGW) {
            int r = it;
            if (r < I0) { p0_transpose_item(a.in[I_AWIN], 3712, 0, 3712, a.in[I_PRE], WA, 0, scr, r, lane); continue; } r -= I0;
            if (r < I5) { p0_transpose_item(a.in[I_WMEMKV], 512, 0, 256, a.in[I_MEMNORM], WM, 0, scr, r, lane); continue; } r -= I5;
            if (r < I5) { p0_transpose_item(a.in[I_WMEMKV], 512, 256, 256, a.in[I_MEMNORM], WM, 512, scr, r, lane); continue; } r -= I5;
            if (r < I5) { p0_transpose_item(a.in[I_WMEMKV] + 1024 * 512, 512, 0, 256, a.in[I_MEMNORM] + 1024, WM, 256, scr, r, lane); continue; } r -= I5;
            if (r < I5) { p0_transpose_item(a.in[I_WMEMKV] + 1024 * 512, 512, 256, 256, a.in[I_MEMNORM] + 1024, WM, 768, scr, r, lane); continue; } r -= I5;
            if (r < I6) { p0_transpose_item(a.in[I_AW2], 768, 0, 768, nullptr, W2T, 0, scr, r, lane, 64); continue; } r -= I6;
            p0_transpose_item(a.in[I_AA2], 768, 0, 768, nullptr, A2T, 0, scr, r, lane, 64);
        }
    } else {
        constexpr int NITEMS = I1 + I2 + 2 * I3;
        for (int it = gw; it < NITEMS; it += NGW) {
            int r = it;
            if (r < I1) { p0_transpose_item(a.in[I_BWIN], 2048, 0, 2048, a.in[I_PRE] + 1024, WB, 0, scr, r, lane); continue; } r -= I1;
            if (r < I2) { p0_transpose_item(a.in[I_WKV], 1536, 0, 1536, a.in[I_KVNORM], WB, 2048, scr, r, lane); continue; } r -= I2;
            if (r < I3) { p0_transpose_item(a.in[I_WOUT], 1024, 0, 1024, nullptr, WO, 0, scr, r, lane); continue; } r -= I3;
            p0_transpose_item(a.in[I_WOUT] + 1024 * 1024, 1024, 0, 1024, nullptr, WO + 1024 * 1024, 0, scr, r, lane);
        }
    }
}
__device__ __forceinline__ void phase_prologue(const Args& a, LAS unsigned char* lds) {
    const int tid = threadIdx.x, lane = tid & 63, wave = __builtin_amdgcn_readfirstlane(tid >> 6);
    const int G = gridDim.x, gw = blockIdx.x * 8 + wave, NGW = G * 8;
    unsigned char* ws = a.ws;
    bf16* WA = (bf16*)(ws + WS_WA);
    transpose_group<0>(a, lds, gw, NGW);
    { u32x4* z = (u32x4*)(WA + (size_t)3712 * 1024); const int nz = 128 * 1024 * 2 / 16;
      for (int i = blockIdx.x * 512 + tid; i < nz; i += G * 512) z[i] = (u32x4){0u, 0u, 0u, 0u}; }
    bf16* XN = (bf16*)(ws + WS_XN); bf16* MEMN = (bf16*)(ws + WS_MEMN);
    for (int m = gw; m < MTOK + MROWS; m += NGW) {
        if (m < MTOK) rms_row_to_bf16(a.in[I_X] + (size_t)m * DM, XN + (size_t)m * DM, lane);
        else rms_row_to_bf16(a.in[I_MEM] + (size_t)(m - MTOK) * DM, MEMN + (size_t)(m - MTOK) * DM, lane);
    }
}

__device__ __forceinline__ void run_gemm(LAS unsigned char* lds, const bf16* A, const bf16* Bt, int M, int N, void* O, int ldc, int f32out, int shift, unsigned* km) {
    const int G = gridDim.x;
    pg8::Gemm g{A, Bt, M, N, 1024};
    pg8::StaticOrder S; S.init(M, N, G, (int)((blockIdx.x + G - shift) % G));
    pg8::EpiStore E{O, ldc, f32out, km};
    pg8::gemm_phase<pg8::EpiStore, pg8::StaticOrder>(lds, g, S, E);
}
template <int LAYER>
__device__ __forceinline__ void phase_outproj(const Args& a, LAS unsigned char* lds) {
    unsigned char* ws = a.ws; const int G = gridDim.x;
    pg8::Gemm g{(const bf16*)(ws + WS_CAT), (const bf16*)(ws + WS_WO) + (size_t)LAYER * 1024 * 1024, MTOK, 1024, 1024};
    pg8::StaticOrder S; S.init(MTOK, 1024, G, (int)blockIdx.x);
    pg8::EpiFused E{a.in[I_X], LAYER ? (const bf16*)(ws + WS_X1B) : nullptr, a.out, LAYER ? nullptr : (bf16*)(ws + WS_X1B), LAYER ? nullptr : (bf16*)(ws + WS_XN), a.in[I_POST] + LAYER * DM,
                    (float*)(ws + WS_XCH) + (size_t)LAYER * 2 * 64 * 4 * 256, (unsigned*)(ws + WS_XCNT) + LAYER * 2 * 64 * 16};
    pg8::gemm_phase<pg8::EpiFused, pg8::StaticOrder, true>(lds, g, S, E);
}
__device__ __forceinline__ void phase_gemm(const Args& a, LAS unsigned char* lds, int first, int count) {
    unsigned char* ws = a.ws;
    for (int j = first; j < first + count; ++j) {
        const bf16* A; const bf16* Bt; int M, N, ldc, f32o, shift; void* O;
        switch (j) {
        case 0: A = (const bf16*)(ws + WS_XN); Bt = (const bf16*)(ws + WS_WA); M = MTOK; N = 3840; O = ws + WS_PROJ; ldc = LDP0; f32o = 0; shift = 0; break;
        case 1: A = (const bf16*)(ws + WS_MEMN); Bt = (const bf16*)(ws + WS_WM); M = MROWS; N = 512; O = ws + WS_MK; ldc = 512; f32o = 0; shift = 192; break;
        case 2: A = (const bf16*)(ws + WS_WM) + 512 * 1024; Bt = (const bf16*)(ws + WS_MEMN); M = 512; N = MROWS; O = ws + WS_MVT; ldc = MROWS; f32o = 0; shift = 208; break;
        case 3: A = (const bf16*)(ws + WS_CAT); Bt = (const bf16*)(ws + WS_WO); M = MTOK; N = 1024; O = ws + WS_Y; ldc = 1024; f32o = 0; shift = 0; break;
        case 4: A = (const bf16*)(ws + WS_XN); Bt = (const bf16*)(ws + WS_WB); M = MTOK; N = 2816; O = ws + WS_PROJ; ldc = LDP1; f32o = 0; shift = 0; break;
        case 5: A = (const bf16*)(ws + WS_WB) + 2816 * 1024; Bt = (const bf16*)(ws + WS_XN); M = 768; N = MTOK; O = ws + WS_VT; ldc = MTOK; f32o = 0; shift = 192; break;
        default: A = (const bf16*)(ws + WS_CAT); Bt = (const bf16*)(ws + WS_WO) + 1024 * 1024; M = MTOK; N = 1024; O = ws + WS_Y; ldc = 1024; f32o = 0; shift = 0; break;
        }
        run_gemm(lds, A, Bt, M, N, O, ldc, f32o, shift, (j == 4) ? (unsigned*)(ws + WS_KM) : nullptr);
    }
}

constexpr int AT_PITCH = 72;
template <int NMAP>
__device__ __forceinline__ void attn_unit(LAS unsigned char* lds, const bf16* Qp, int ldq, const bf16* Kp, int ldk, const bf16* VTp, int ldvt,
                                          int nkt_lo, int nkt_hi, float slope2, int tq0,
                                          const bf16* Gp, int ldg, bf16* Op, int ldo, const float* subln, float lam, float oscale, const unsigned* kmp = nullptr) {
    constexpr int EV = 64 * NMAP, NET = EV / 16;
    const int tid = threadIdx.x, lane = tid & 63, wave = __builtin_amdgcn_readfirstlane(tid >> 6), g = lane >> 4, c = lane & 15;
    constexpr int AT_BUF = NMAP * 64 * AT_PITCH * 2 + EV * AT_PITCH * 2;
    const int nkt = (wave < 4) ? nkt_lo : nkt_hi;
    const int qrow = 16 * wave + c;
    bf16x8 qf[NMAP][2];
#pragma unroll
    for (int mp = 0; mp < NMAP; ++mp)
#pragma unroll
        for (int ks = 0; ks < 2; ++ks) qf[mp][ks] = *(const bf16x8*)(Qp + (size_t)qrow * ldq + mp * 64 + 32 * ks + 8 * g);
    f32x4 o[NMAP][NET];
#pragma unroll
    for (int mp = 0; mp < NMAP; ++mp)
#pragma unroll
        for (int et = 0; et < NET; ++et) o[mp][et] = (f32x4){0.f, 0.f, 0.f, 0.f};
    float mrun[NMAP], lrun[NMAP];
#pragma unroll
    for (int mp = 0; mp < NMAP; ++mp) { mrun[mp] = -1e30f; lrun[mp] = 0.f; }
    const float sc2 = 0.125f * LOG2E;
    const float tq = (float)(tq0 + qrow);
    float ubq[NMAP];
    LAS unsigned* votes = (LAS unsigned*)(lds + 2 * AT_BUF);
    if (NMAP == 2) {
#pragma unroll
        for (int mp = 0; mp < NMAP; ++mp) {
            float k2 = 0.f;
#pragma unroll
            for (int pc = 0; pc < 8; ++pc) k2 += __builtin_bit_cast(float, kmp[mp * 8 + pc]);
            float q2 = 0.f;
#pragma unroll
            for (int ks = 0; ks < 2; ++ks) { const u32x4 qq = __builtin_bit_cast(u32x4, qf[mp][ks]);
#pragma unroll
                for (int e = 0; e < 4; ++e) { const float a0 = bflo(qq[e]), a1 = bfhi(qq[e]); q2 += a0 * a0 + a1 * a1; } }
            q2 = rows_sum(q2);
            ubq[mp] = sqrtf(q2 * k2) * sc2 * 1.001f + 1e-3f;
        }
    }
    u32x4 kreg[2][NMAP], vreg[2][NMAP];
#define AT_LOAD(SET, kt) do { _Pragma("unroll") for (int i = 0; i < NMAP; ++i) { const int id = tid + 512 * i; \
        { const int mp = id >> 9, n = (id >> 3) & 63, ch = id & 7; kreg[SET][i] = *(const u32x4*)(Kp + (size_t)((kt) * 64 + n) * ldk + mp * 64 + 8 * ch); } \
        { const int e = id >> 3, ch = id & 7; vreg[SET][i] = *(const u32x4*)(VTp + (size_t)e * ldvt + (kt) * 64 + 8 * ch); } } } while (0)
#define AT_STORE(SET) do { LAS bf16* Ks = (LAS bf16*)(lds + (SET) * AT_BUF); LAS bf16* Vs = (LAS bf16*)(lds + (SET) * AT_BUF + NMAP * 64 * AT_PITCH * 2); \
        _Pragma("unroll") for (int i = 0; i < NMAP; ++i) { const int id = tid + 512 * i; \
        { const int mp = id >> 9, n = (id >> 3) & 63, ch = id & 7; *(LAS u32x4*)(Ks + (mp * 64 + n) * AT_PITCH + 8 * ch) = kreg[SET][i]; } \
        { const int e = id >> 3, ch = id & 7; *(LAS u32x4*)(Vs + e * AT_PITCH + 8 * ch) = vreg[SET][i]; } } } while (0)
    AT_LOAD(0, nkt_hi - 1);
    if (nkt_hi > 1) AT_LOAD(1, nkt_hi - 2);
    __syncthreads();
    AT_STORE(0);
    if (nkt_hi > 2) AT_LOAD(0, nkt_hi - 3);
    __syncthreads();
    for (int it = 0; it < nkt_hi; ++it) {
        const int kt = nkt_hi - 1 - it;
        if (NMAP == 2 && it > 0) {
            const LAS unsigned* vv = votes + ((it - 1) & 1) * 8;
            if ((vv[0] & vv[1] & vv[2] & vv[3] & vv[4] & vv[5] & vv[6] & vv[7]) != 0u) break;
        }
        if (kt > 0) { if (it & 1) { AT_STORE(0); if (kt > 2) AT_LOAD(0, kt - 3); } else { AT_STORE(1); if (kt > 2) AT_LOAD(1, kt - 3); } }
        const LAS bf16* Ks = (const LAS bf16*)(lds + (it & 1) * AT_BUF); const LAS bf16* Vs = (const LAS bf16*)(lds + (it & 1) * AT_BUF + NMAP * 64 * AT_PITCH * 2);
        if (kt < nkt) {
            f32x4 bias[4];
#pragma unroll
            for (int k16 = 0; k16 < 4; ++k16)
#pragma unroll
                for (int j = 0; j < 4; ++j) bias[k16][j] = -slope2 * fabsf(tq - (float)(kt * 64 + 16 * k16 + 4 * g + j));
            bf16x8 pf[NMAP][2]; bool any = false;
#pragma unroll
            for (int mp = 0; mp < NMAP; ++mp) {
                f32x4 st[4];
#pragma unroll
                for (int k16 = 0; k16 < 4; ++k16) {
                    f32x4 acc = (f32x4){0.f, 0.f, 0.f, 0.f};
#pragma unroll
                    for (int ks = 0; ks < 2; ++ks) { const bf16x8 ka = *(const LAS bf16x8*)(Ks + (mp * 64 + 16 * k16 + c) * AT_PITCH + 32 * ks + 8 * g);
                        acc = __builtin_amdgcn_mfma_f32_16x16x32_bf16(ka, qf[mp][ks], acc, 0, 0, 0); }
                    st[k16] = acc * sc2 + bias[k16];
                }
                float m4[4];
#pragma unroll
                for (int k16 = 0; k16 < 4; ++k16) m4[k16] = fmaxf(fmaxf(st[k16].x, st[k16].y), fmaxf(st[k16].z, st[k16].w));
                float mx = fmaxf(fmaxf(m4[0], m4[1]), fmaxf(m4[2], m4[3]));
                mx = rows_max(mx);
                if (__builtin_amdgcn_ballot_w64(mx > mrun[mp] - 40.f) != 0ull) {
                    any = true;
                    const float mnew = fmaxf(mrun[mp], mx), alpha = __builtin_amdgcn_exp2f(mrun[mp] - mnew);
                    mrun[mp] = mnew;
                    float ps = 0.f;
#pragma unroll
                    for (int k16 = 0; k16 < 4; ++k16)
#pragma unroll
                        for (int j = 0; j < 4; ++j) { const float p = __builtin_amdgcn_exp2f(st[k16][j] - mnew); st[k16][j] = p; ps += p; }
                    lrun[mp] = lrun[mp] * alpha + ps;
                    if (__builtin_amdgcn_ballot_w64(alpha != 1.f) != 0ull) {
#pragma unroll
                        for (int et = 0; et < NET; ++et) o[mp][et] = o[mp][et] * alpha;
                    }
#pragma unroll
                    for (int i = 0; i < 2; ++i) { u32x4 w; w.x = pk2(st[2 * i][0], st[2 * i][1]); w.y = pk2(st[2 * i][2], st[2 * i][3]); w.z = pk2(st[2 * i + 1][0], st[2 * i + 1][1]); w.w = pk2(st[2 * i + 1][2], st[2 * i + 1][3]);
                        pf[mp][i] = __builtin_bit_cast(bf16x8, w); }
                } else {
                    pf[mp][0] = (bf16x8){0, 0, 0, 0, 0, 0, 0, 0}; pf[mp][1] = (bf16x8){0, 0, 0, 0, 0, 0, 0, 0};
                }
            }
            if (any) {
#pragma unroll
                for (int et = 0; et < NET; ++et)
#pragma unroll
                    for (int i = 0; i < 2; ++i) {
                        const u32x2 lo = *(const LAS u32x2*)(Vs + (16 * et + c) * AT_PITCH + 32 * i + 4 * g);
                        const u32x2 hi = *(const LAS u32x2*)(Vs + (16 * et + c) * AT_PITCH + 32 * i + 16 + 4 * g);
                        const bf16x8 va = __builtin_bit_cast(bf16x8, (u32x4){lo.x, lo.y, hi.x, hi.y});
#pragma unroll
                        for (int mp = 0; mp < NMAP; ++mp) o[mp][et] = __builtin_amdgcn_mfma_f32_16x16x32_bf16(va, pf[mp][i], o[mp][et], 0, 0, 0);
                    }
            }
        }
        if (NMAP == 2) {
            const float dmin = fmaxf(tq - (float)(64 * kt - 1), 0.f);
            bool neg = true;
#pragma unroll
            for (int mp = 0; mp < NMAP; ++mp) neg = neg && (ubq[mp] - slope2 * dmin < mrun[mp] - 40.f);
            const bool all = (__builtin_amdgcn_ballot_w64(neg) == ~0ull);
            if (lane == 0) votes[(it & 1) * 8 + wave] = all ? 1u : 0u;
        }
        __syncthreads();
    }
#undef AT_LOAD
#undef AT_STORE
    float inv[NMAP];
#pragma unroll
    for (int mp = 0; mp < NMAP; ++mp) { const float l = rows_sum(lrun[mp]); inv[mp] = 1.f / l; }
    f32x4 r[NET]; float ss = 0.f;
#pragma unroll
    for (int et = 0; et < NET; ++et) {
        if (NMAP == 2) r[et] = o[0][et] * inv[0] - o[NMAP - 1][et] * (lam * inv[NMAP - 1]);
        else r[et] = o[0][et] * inv[0];
        ss += (r[et].x * r[et].x + r[et].y * r[et].y) + (r[et].z * r[et].z + r[et].w * r[et].w);
    }
    float rs = 1.f;
    if (NMAP == 2) { ss = rows_sum(ss); rs = oscale / sqrtf(ss * (1.f / EV) + NORM_EPS); }
#pragma unroll
    for (int et = 0; et < NET; ++et) {
        const int e = 16 * et + 4 * g;
        const u32x2 gv = *(const u32x2*)(Gp + (size_t)qrow * ldg + e);
        f32x4 v = r[et] * rs;
        if (NMAP == 2) v = v * *(const f32x4*)(subln + e);
        v.x *= siluf_(bflo(gv.x)); v.y *= siluf_(bfhi(gv.x)); v.z *= siluf_(bflo(gv.y)); v.w *= siluf_(bfhi(gv.y));
        u32x2 w; w.x = pk2(v.x, v.y); w.y = pk2(v.z, v.w);
        *(u32x2*)(Op + (size_t)qrow * ldo + e) = w;
    }
    __syncthreads();
}

__device__ __forceinline__ void mem_attn_unit(const Args& a, LAS unsigned char* lds, int l, int u) {
    unsigned char* ws = a.ws;
    const int b = u >> 6, h = (u >> 4) & 3, qb = u & 15;
    const bf16* PROJ = (const bf16*)(ws + WS_PROJ);
    const int ldp = l ? LDP1 : LDP0, cq = l ? C_QM1 : C_QM0, cg_ = l ? C_GM1 : C_GM0;
    const size_t row0 = (size_t)b * SEQ + qb * 128;
    attn_unit<1>(lds, PROJ + row0 * ldp + cq + h * 64, ldp,
                 (const bf16*)(ws + WS_MK) + (size_t)b * MEML * 512 + l * 256 + h * 64, 512,
                 (const bf16*)(ws + WS_MVT) + (size_t)(l * 256 + h * 64) * MROWS + b * MEML, MROWS,
                 4, 4, 0.f, 0,
                 PROJ + row0 * ldp + cg_ + h * 64, ldp, (bf16*)(ws + WS_CAT) + row0 * DM + BRW + h * 64, DM, nullptr, 0.f, 1.f);
}

typedef _Float16 f16x4_t __attribute__((ext_vector_type(4)));
__device__ __forceinline__ void lora_item(const Args& a, LAS unsigned char* lds, int b, int cgp) {
    const int tid = threadIdx.x, lane = tid & 63, wave = __builtin_amdgcn_readfirstlane(tid >> 6), g = lane >> 4, c = lane & 15;
    unsigned char* ws = a.ws;
    const bf16* PROJ = (const bf16*)(ws + WS_PROJ);
    const size_t mb = (size_t)b * SEQ; const int t0 = 64 * cgp;
    LAS bf16* AW = (LAS bf16*)lds; LAS bf16* AA = AW + 64 * 72;
    const float* mu = a.in[I_AMU];
#pragma unroll
    for (int r = 0; r < 2; ++r) {
        const int i = tid + 512 * r, tok = i >> 4, ch = i & 15;
        const bf16* cur = PROJ + (mb + t0 + tok) * LDP0 + C_WD + 8 * ch; const bf16* prv = (t0 + tok == 0) ? cur : cur - LDP0; const float pz = (t0 + tok == 0) ? 0.f : 1.f;
        const u32x4 zc = *(const u32x4*)cur, zp = *(const u32x4*)prv;
        const f32x4 m0 = *(const f32x4*)(mu + C_WD + 8 * ch), m1 = *(const f32x4*)(mu + C_WD + 8 * ch + 4);
        float x[8];
#pragma unroll
        for (int e = 0; e < 4; ++e) {
            const float ma = (e < 2) ? m0[2 * e] : m1[2 * e - 4], mb_ = (e < 2) ? m0[2 * e + 1] : m1[2 * e - 3];
            float z0 = bflo(zc[e]), z1 = bfhi(zc[e]);
            z0 = z0 + (bflo(zp[e]) * pz - z0) * ma; z1 = z1 + (bfhi(zp[e]) * pz - z1) * mb_;
            if (ch < 8) { z0 = 1.f - 2.f * __builtin_amdgcn_rcpf(1.f + __builtin_amdgcn_exp2f(2.8853900817779268f * z0)); z1 = 1.f - 2.f * __builtin_amdgcn_rcpf(1.f + __builtin_amdgcn_exp2f(2.8853900817779268f * z1)); }
            x[2 * e] = z0; x[2 * e + 1] = z1;
        }
        u32x4 w; w.x = pk2(x[0], x[1]); w.y = pk2(x[2], x[3]); w.z = pk2(x[4], x[5]); w.w = pk2(x[6], x[7]);
        *(LAS u32x4*)(((ch < 8) ? AW : AA) + tok * 72 + 8 * (ch & 7)) = w;
    }
    __syncthreads();
    const int mtp = wave & 1, gq = wave >> 1;
    const bf16* W2T = (const bf16*)(ws + WS_W2T); const bf16* A2T = W2T + 768 * 64;
    _Float16* LD16 = (_Float16*)(ws + WS_LD16); bf16* A16 = (bf16*)(ws + WS_A16);
    bf16x8 Aw[2][2], Aa[2][2];
#pragma unroll
    for (int mt = 0; mt < 2; ++mt)
#pragma unroll
        for (int ks = 0; ks < 2; ++ks) { Aw[mt][ks] = *(const LAS bf16x8*)(AW + (32 * mtp + 16 * mt + c) * 72 + 32 * ks + 8 * g); Aa[mt][ks] = *(const LAS bf16x8*)(AA + (32 * mtp + 16 * mt + c) * 72 + 32 * ks + 8 * g); }
    const f32x4 Z4 = {0.f, 0.f, 0.f, 0.f};
    for (int gi = 0; gi < 3; ++gi) {
        const int colb = 64 * (3 * gq + gi) + 4 * c;
        const f32x4 w0v = *(const f32x4*)(a.in[I_AW0] + colb), a0v = *(const f32x4*)(a.in[I_AA0] + colb);
        f32x4 accw[2][4], acca[2][4];
#pragma unroll
        for (int q = 0; q < 4; ++q) {
            const bf16x8 bw0 = *(const bf16x8*)(W2T + (size_t)(colb + q) * 64 + 8 * g), bw1 = *(const bf16x8*)(W2T + (size_t)(colb + q) * 64 + 32 + 8 * g);
            const bf16x8 ba0 = *(const bf16x8*)(A2T + (size_t)(colb + q) * 64 + 8 * g), ba1 = *(const bf16x8*)(A2T + (size_t)(colb + q) * 64 + 32 + 8 * g);
#pragma unroll
            for (int mt = 0; mt < 2; ++mt) {
                accw[mt][q] = __builtin_amdgcn_mfma_f32_16x16x32_bf16(Aw[mt][0], bw0, Z4, 0, 0, 0); accw[mt][q] = __builtin_amdgcn_mfma_f32_16x16x32_bf16(Aw[mt][1], bw1, accw[mt][q], 0, 0, 0);
                acca[mt][q] = __builtin_amdgcn_mfma_f32_16x16x32_bf16(Aa[mt][0], ba0, Z4, 0, 0, 0); acca[mt][q] = __builtin_amdgcn_mfma_f32_16x16x32_bf16(Aa[mt][1], ba1, acca[mt][q], 0, 0, 0);
            }
        }
#pragma unroll
        for (int mt = 0; mt < 2; ++mt)
#pragma unroll
            for (int j = 0; j < 4; ++j) {
                const size_t m = mb + t0 + 32 * mtp + 16 * mt + 4 * g + j;
                f16x4_t ld; float av[4];
#pragma unroll
                for (int q = 0; q < 4; ++q) { ld[q] = (_Float16)(-0.8750322163622201f * sigmoidf_(w0v[q] + accw[mt][q][j])); av[q] = sigmoidf_(a0v[q] + acca[mt][q][j]); }
                *(f16x4_t*)(LD16 + m * 768 + colb) = ld;
                *(u32x2*)(A16 + m * 768 + colb) = (u32x2){pk2(av[0], av[1]), pk2(av[2], av[3])};
            }
    }
    asm volatile("s_waitcnt vmcnt(0)" ::: "memory");
    __syncthreads();
    if (tid == 0) { __builtin_amdgcn_fence(__ATOMIC_RELEASE, "agent"); asm volatile("s_waitcnt vmcnt(0)" ::: "memory");
        (void)__hip_atomic_fetch_add((unsigned*)ws + CW_LORA, 1u, __ATOMIC_RELAXED, __HIP_MEMORY_SCOPE_AGENT); }
}

constexpr int SK_SLOT = 15360, SK_NT = 0, SK_RT = 2304, SK_BP = 4608, SK_KP = 7168, SK_VT = 9728, SK_PC = 12288, SK_LK = 12544, SK_TT = 13184, SK_MB = 13824, SK_MK = 14464;
constexpr int SK_SCR = 3 * SK_SLOT, SK_SCRW = 7680, SK_BS = 0, SK_KS = 2304, SK_LB = 4608, SK_VM = 5632;
constexpr int SK_P72 = 72, SK_P20 = 20;
constexpr int SK_PRM = SK_SCR + 4 * SK_SCRW, SK_W2L = SK_PRM, SK_A2L = SK_PRM + 9216, SK_PF = SK_PRM + 18432;
enum { PF_W0 = 0, PF_A0, PF_KK, PF_KA, PF_RK, PF_MUR, PF_MUK, PF_MUWD, PF_MUAD, PF_MUV };
__device__ __forceinline__ bf16x8 lds2x8(const LAS bf16* p, int offa, int offb) { const u32x2 a = *(const LAS u32x2*)(p + offa), b = *(const LAS u32x2*)(p + offb); return __builtin_bit_cast(bf16x8, (u32x4){a.x, a.y, b.x, b.y}); }
__device__ __forceinline__ bf16x8 lds8z(const LAS bf16* p, int offa) { const u32x2 a = *(const LAS u32x2*)(p + offa); return __builtin_bit_cast(bf16x8, (u32x4){a.x, a.y, 0u, 0u}); }
__device__ __forceinline__ void scan_unit(const Args& a, LAS unsigned char* lds, int b, int h) {
    const int tid = threadIdx.x, lane = tid & 63, wave = __builtin_amdgcn_readfirstlane(tid >> 6), g = lane >> 4, c = lane & 15;
    unsigned char* ws = a.ws;
    const bf16* PROJ = (const bf16*)(ws + WS_PROJ);
    bf16* CAT = (bf16*)(ws + WS_CAT);
    const size_t mb = (size_t)b * SEQ;
    constexpr int NBLK = SEQ / 16;
    const f32x4 Z4 = {0.f, 0.f, 0.f, 0.f};
    {
        const bf16* W2T = (const bf16*)(ws + WS_W2T);
        for (int i = tid; i < 2 * 64 * 8; i += 512) { const int m = i >> 9, key = (i >> 3) & 63, ch = i & 7;
            const u32x4 v = *(const u32x4*)(W2T + (size_t)m * 768 * 64 + (size_t)(h * 64 + key) * 64 + 8 * ch);
            *(LAS u32x4*)(lds + (m ? SK_A2L : SK_W2L) + (((key & 3) * 16 + (key >> 2)) * SK_P72 + 8 * ch) * 2) = v; }
        for (int i = tid; i < 10 * 64; i += 512) { const int w = i >> 6, k = i & 63; float v;
            switch (w) { case PF_W0: v = a.in[I_AW0][h * 64 + k]; break; case PF_A0: v = a.in[I_AA0][h * 64 + k]; break; case PF_KK: v = a.in[I_AKK][h * 64 + k]; break;
                         case PF_KA: v = a.in[I_AKA][h * 64 + k]; break; case PF_RK: v = a.in[I_ARK][h * 64 + k]; break; case PF_MUR: v = a.in[I_AMU][C_R + h * 64 + k]; break;
                         case PF_MUK: v = a.in[I_AMU][C_K + h * 64 + k]; break; case PF_MUWD: v = a.in[I_AMU][C_WD + k]; break; case PF_MUAD: v = a.in[I_AMU][C_AD + k]; break;
                         default: v = a.in[I_AMU][C_V + h * 64 + k]; break; }
            ((LAS float*)(lds + SK_PF))[i] = v; }
        if (tid == 0) { unsigned* cw = (unsigned*)ws + CW_LORA;
            while (__hip_atomic_load(cw, __ATOMIC_RELAXED, __HIP_MEMORY_SCOPE_AGENT) < gridDim.x) __builtin_amdgcn_s_sleep(2);
            __builtin_amdgcn_fence(__ATOMIC_ACQUIRE, "agent"); asm volatile("s_waitcnt vmcnt(0)" ::: "memory"); }
        __syncthreads();
    }
    if (wave < 4) {
        f32x4 St[4] = {Z4, Z4, Z4, Z4};
        for (int q = 0; q < 4; ++q) __syncthreads();
        for (int blk = 0; blk < NBLK; ++blk) {
            const LAS unsigned char* sl = lds + (blk % 3) * SK_SLOT;
            const LAS bf16* NT = (const LAS bf16*)(sl + SK_NT); const LAS bf16* RT = (const LAS bf16*)(sl + SK_RT);
            const LAS bf16* BP = (const LAS bf16*)(sl + SK_BP); const LAS bf16* KP = (const LAS bf16*)(sl + SK_KP);
            const LAS bf16* VT = (const LAS bf16*)(sl + SK_VT); const LAS float* PC = (const LAS float*)(sl + SK_PC);
            const LAS bf16* LK = (const LAS bf16*)(sl + SK_LK); const LAS bf16* TT = (const LAS bf16*)(sl + SK_TT);
            const LAS bf16* MB = (const LAS bf16*)(sl + SK_MB); const LAS bf16* MK = (const LAS bf16*)(sl + SK_MK);
            bf16x8 sbh[2];
#pragma unroll
            for (int ks = 0; ks < 2; ++ks) {
                const f32x4 x = St[2 * ks], y = St[2 * ks + 1];
                u32x4 hh; hh.x = pk2(x.x, x.y); hh.y = pk2(x.z, x.w); hh.z = pk2(y.x, y.y); hh.w = pk2(y.z, y.w);
                sbh[ks] = __builtin_bit_cast(bf16x8, hh);
            }
            const bf16x8 An0 = lds2x8(NT, c * SK_P72 + 4 * g, c * SK_P72 + 16 + 4 * g), An1 = lds2x8(NT, c * SK_P72 + 32 + 4 * g, c * SK_P72 + 48 + 4 * g);
            const bf16x8 Ar0 = lds2x8(RT, c * SK_P72 + 4 * g, c * SK_P72 + 16 + 4 * g), Ar1 = lds2x8(RT, c * SK_P72 + 32 + 4 * g, c * SK_P72 + 48 + 4 * g);
            const u32x2 vq = *(const LAS u32x2*)(VT + (16 * wave + c) * SK_P20 + 4 * g);
            const bf16x8 vlo = __builtin_bit_cast(bf16x8, (u32x4){vq.x, vq.y, 0u, 0u});
            const bf16x8 Alk = lds8z(LK, c * SK_P20 + 4 * g), At = lds8z(TT, c * SK_P20 + 4 * g);
            const bf16x8 Amk = lds2x8(MB, c * SK_P20 + 4 * g, (int)((SK_MK - SK_MB) / 2) + c * SK_P20 + 4 * g);
            f32x4 X = __builtin_amdgcn_mfma_f32_16x16x32_bf16(An0, sbh[0], Z4, 0, 0, 0);
            X = __builtin_amdgcn_mfma_f32_16x16x32_bf16(An1, sbh[1], X, 0, 0, 0);
            X = __builtin_amdgcn_mfma_f32_16x16x32_bf16(Alk, vlo, X, 0, 0, 0);
            f32x4 Y = __builtin_amdgcn_mfma_f32_16x16x32_bf16(Ar0, sbh[0], Z4, 0, 0, 0);
            Y = __builtin_amdgcn_mfma_f32_16x16x32_bf16(Ar1, sbh[1], Y, 0, 0, 0);
            const bf16x8 xb = __builtin_bit_cast(bf16x8, (u32x4){pk2(X.x, X.y), pk2(X.z, X.w), 0u, 0u});
            const f32x4 U = __builtin_amdgcn_mfma_f32_16x16x32_bf16(At, xb, Z4, 0, 0, 0);
            const bf16x8 ub = __builtin_bit_cast(bf16x8, (u32x4){pk2(U.x, U.y), pk2(U.z, U.w), vq.x, vq.y});
            Y = __builtin_amdgcn_mfma_f32_16x16x32_bf16(Amk, ub, Y, 0, 0, 0);
#pragma unroll
            for (int kt = 0; kt < 4; ++kt) {
                const f32x4 pc4 = *(const LAS f32x4*)(PC + 16 * kt + 4 * g);
                const bf16x8 Abk = lds2x8(BP, (16 * kt + c) * SK_P20 + 4 * g, (int)((SK_KP - SK_BP) / 2) + (16 * kt + c) * SK_P20 + 4 * g);
                St[kt] = __builtin_amdgcn_mfma_f32_16x16x32_bf16(Abk, ub, St[kt] * pc4, 0, 0, 0);
            }
            bf16* yp = CAT + (mb + (size_t)blk * 16 + 4 * g) * DM + h * 64 + 16 * wave + c;
            yp[0] = (bf16)f2bf(Y.x); yp[DM] = (bf16)f2bf(Y.y); yp[2 * DM] = (bf16)f2bf(Y.z); yp[3 * DM] = (bf16)f2bf(Y.w);
            __syncthreads();
        }
    } else {
        const int pw = wave - 4;
        const int kc = h * 64 + 4 * c;
        const LAS float* PF = (const LAS float*)(lds + SK_PF); const LAS bf16* W2L = (const LAS bf16*)(lds + SK_W2L); const LAS bf16* A2L = (const LAS bf16*)(lds + SK_A2L);
        LAS unsigned char* scr = lds + SK_SCR + pw * SK_SCRW;
        LAS bf16* BSs = (LAS bf16*)(scr + SK_BS); LAS bf16* KSs = (LAS bf16*)(scr + SK_KS); LAS float* LBs = (LAS float*)(scr + SK_LB);
        u32x4 zv[2], zvp[2]; u32x2 zr[4], zrp[4], zk[4], zkp[4], zl[4], za[4];
        const _Float16* LD16 = (const _Float16*)(ws + WS_LD16); const bf16* A16 = (const bf16*)(ws + WS_A16);
#define SK_LOAD_V(T0) do { \
        { const int sv_ = lane >> 2, cv_ = lane & 3; const bf16* cs = PROJ + (mb + (T0) + sv_) * LDP0; const bf16* ps = ((T0) + sv_ == 0) ? cs : cs - LDP0; \
          _Pragma("unroll") for (int i = 0; i < 2; ++i) { zv[i] = *(const u32x4*)(cs + C_V + h * 64 + 16 * cv_ + 8 * i); zvp[i] = *(const u32x4*)(ps + C_V + h * 64 + 16 * cv_ + 8 * i); } } } while (0)
#define SK_LOAD_S(T0, jj) do { const int s_ = 4 * g + (jj); const bf16* cs = PROJ + (mb + (T0) + s_) * LDP0; const bf16* ps = ((T0) + s_ == 0) ? cs : cs - LDP0; \
            zr[jj] = *(const u32x2*)(cs + C_R + kc); zrp[jj] = *(const u32x2*)(ps + C_R + kc); zk[jj] = *(const u32x2*)(cs + C_K + kc); zkp[jj] = *(const u32x2*)(ps + C_K + kc); \
            za[jj] = *(const u32x2*)(A16 + (mb + (T0) + s_) * 768 + kc); } while (0)
#define SK_LOAD_L(T0) do { _Pragma("unroll") for (int jj = 0; jj < 4; ++jj) zl[jj] = *(const u32x2*)(LD16 + (mb + (T0) + 4 * g + jj) * 768 + kc); } while (0)
        SK_LOAD_L(pw * 16); SK_LOAD_V(pw * 16);
#pragma unroll
        for (int jj = 0; jj < 4; ++jj) SK_LOAD_S(pw * 16, jj);
        for (int q = 0; q < pw; ++q) __syncthreads();
        for (int n = 0; n < NBLK / 4; ++n) {
            const int blk = 4 * n + pw, t0 = blk * 16, t0n = (blk + 4 < NBLK) ? t0 + 64 : t0;
            LAS unsigned char* sl = lds + (blk % 3) * SK_SLOT;
            int c_o = c; asm volatile("" : "+v"(c_o));
            {
                unsigned vm[8];
                const int sv = lane >> 2, cv = lane & 3; const float pz = (t0 + sv == 0) ? 0.f : 1.f;
#pragma unroll
                for (int i = 0; i < 2; ++i) {
                    const LAS float* mv = PF + PF_MUV * 64 + 16 * cv + 8 * i;
                    const f32x4 m0 = *(const LAS f32x4*)mv, m1 = *(const LAS f32x4*)(mv + 4);
#pragma unroll
                    for (int e = 0; e < 4; ++e) {
                        const unsigned uc = zv[i][e], up = zvp[i][e];
                        const float ma = (e < 2) ? m0[2 * e] : m1[2 * e - 4], mb_ = (e < 2) ? m0[2 * e + 1] : m1[2 * e - 3];
                        float z0 = bflo(uc), z1 = bfhi(uc);
                        z0 = z0 + (bflo(up) * pz - z0) * ma; z1 = z1 + (bfhi(up) * pz - z1) * mb_;
                        vm[4 * i + e] = pk2(z0, z1);
                    }
                }
                *(LAS u32x4*)(scr + SK_VM + lane * 32) = (u32x4){vm[0], vm[1], vm[2], vm[3]}; *(LAS u32x4*)(scr + SK_VM + lane * 32 + 16) = (u32x4){vm[4], vm[5], vm[6], vm[7]};
                SK_LOAD_V(t0n);
            }
            u32x2 ntp[4], rtp[4], bpp[4], kpp[4]; f32x4 pcv;
            {
                f32x4 dec[4], E4;
#pragma unroll
                for (int jj = 0; jj < 4; ++jj) { const f16x4_t l4 = __builtin_bit_cast(f16x4_t, zl[jj]);
#pragma unroll
                    for (int nt = 0; nt < 4; ++nt) dec[jj][nt] = __builtin_amdgcn_exp2f((float)l4[nt]); }
                SK_LOAD_L(t0n);
#pragma unroll
                for (int nt = 0; nt < 4; ++nt) {
                    const float p3 = (dec[0][nt] * dec[1][nt]) * (dec[2][nt] * dec[3][nt]);
                    const float q0 = __shfl(p3, c), q1 = __shfl(p3, c + 16), q2 = __shfl(p3, c + 32), q3 = __shfl(p3, c + 48);
                    E4[nt] = ((g > 0) ? q0 : 1.f) * ((g > 1) ? q1 : 1.f) * ((g > 2) ? q2 : 1.f);
                    pcv[nt] = (q0 * q1) * (q2 * q3);
                }
                const f32x4 p_kk = *(const LAS f32x4*)(PF + PF_KK * 64 + 4 * c), p_ka = *(const LAS f32x4*)(PF + PF_KA * 64 + 4 * c),
                            p_rk = *(const LAS f32x4*)(PF + PF_RK * 64 + 4 * c), mu_r = *(const LAS f32x4*)(PF + PF_MUR * 64 + 4 * c), mu_k = *(const LAS f32x4*)(PF + PF_MUK * 64 + 4 * c);
                f32x4 pex = E4, bprev, kprev;
#pragma unroll
                for (int jj = 0; jj < 4; ++jj) {
                    if (jj == 1 || jj == 3) __syncthreads();
                    const int s = 4 * g + jj;
                    const float pz = (t0 + s == 0) ? 0.f : 1.f;
                    const f32x4 pin = pex * dec[jj];
                    f32x4 rr, kp4, ku, aa;
                    const unsigned ur[2] = {zr[jj].x, zr[jj].y}, urp[2] = {zrp[jj].x, zrp[jj].y}, uk[2] = {zk[jj].x, zk[jj].y}, ukp[2] = {zkp[jj].x, zkp[jj].y}, ua[2] = {za[jj].x, za[jj].y};
                    SK_LOAD_S(t0n, jj);
                    float ssq = 0.f, bs = 0.f;
#pragma unroll
                    for (int nt = 0; nt < 4; ++nt) {
                        const float zc = (nt & 1) ? bfhi(ur[nt >> 1]) : bflo(ur[nt >> 1]), zp = ((nt & 1) ? bfhi(urp[nt >> 1]) : bflo(urp[nt >> 1])) * pz;
                        const float kc_ = (nt & 1) ? bfhi(uk[nt >> 1]) : bflo(uk[nt >> 1]), kp_ = ((nt & 1) ? bfhi(ukp[nt >> 1]) : bflo(ukp[nt >> 1])) * pz;
                        rr[nt] = zc + (zp - zc) * mu_r[nt];
                        const float kk = kc_ + (kp_ - kc_) * mu_k[nt];
                        aa[nt] = (nt & 1) ? bfhi(ua[nt >> 1]) : bflo(ua[nt >> 1]);
                        ku[nt] = kk * p_kk[nt];
                        ssq += ku[nt] * ku[nt];
                        kp4[nt] = kk * (1.f + (aa[nt] - 1.f) * p_ka[nt]);
                        bs += rr[nt] * kp4[nt] * p_rk[nt];
                    }
                    ssq = sum16(ssq); bs = sum16(bs);
                    if (c == 0) ((float*)(ws + WS_BS))[(mb + t0 + s) * AH + h] = bs;
                    const float rn = __builtin_amdgcn_rsqf(fmaxf(ssq, 1e-12f));
                    f32x4 rp; rp.x = __builtin_amdgcn_rcpf(pin.x); rp.y = __builtin_amdgcn_rcpf(pin.y); rp.z = __builtin_amdgcn_rcpf(pin.z); rp.w = __builtin_amdgcn_rcpf(pin.w);
                    const f32x4 kn = ku * rn;
                    const f32x4 nt_ = pex * (-kn), bt = kn * aa * rp, kt_ = kp4 * rp, rt = pin * rr;
                    const f32x4 bpc = bt * pcv, kpc = kt_ * pcv;
                    ntp[jj] = (u32x2){pk2(nt_.x, nt_.y), pk2(nt_.z, nt_.w)};
                    rtp[jj] = (u32x2){pk2(rt.x, rt.y), pk2(rt.z, rt.w)};
                    *(LAS u32x2*)(BSs + s * SK_P72 + 4 * c) = (u32x2){pk2(bt.x, bt.y), pk2(bt.z, bt.w)};
                    *(LAS u32x2*)(KSs + s * SK_P72 + 4 * c) = (u32x2){pk2(kt_.x, kt_.y), pk2(kt_.z, kt_.w)};
                    if (jj & 1) {
#pragma unroll
                        for (int nt = 0; nt < 4; ++nt) { if (jj == 1) { bpp[nt].x = pk2(bprev[nt], bpc[nt]); kpp[nt].x = pk2(kprev[nt], kpc[nt]); } else { bpp[nt].y = pk2(bprev[nt], bpc[nt]); kpp[nt].y = pk2(kprev[nt], kpc[nt]); } }
                    } else { bprev = bpc; kprev = kpc; }
                    pex = pin;
                }
            }
            {
                LAS bf16* NT = (LAS bf16*)(sl + SK_NT); LAS bf16* RT = (LAS bf16*)(sl + SK_RT);
                LAS bf16* BP = (LAS bf16*)(sl + SK_BP); LAS bf16* KP = (LAS bf16*)(sl + SK_KP);
#pragma unroll
                for (int jj = 0; jj < 4; ++jj) { const int s = 4 * g + jj;
                    *(LAS u32x2*)(NT + s * SK_P72 + 4 * c) = ntp[jj]; *(LAS u32x2*)(RT + s * SK_P72 + 4 * c) = rtp[jj]; }
#pragma unroll
                for (int nt = 0; nt < 4; ++nt) { *(LAS u32x2*)(BP + (4 * c + nt) * SK_P20 + 4 * g) = bpp[nt]; *(LAS u32x2*)(KP + (4 * c + nt) * SK_P20 + 4 * g) = kpp[nt]; }
                if (g == 0) *(LAS f32x4*)((LAS float*)(sl + SK_PC) + 4 * c) = pcv;
                { const int sv = lane >> 2, cv = lane & 3; LAS bf16* VT = (LAS bf16*)(sl + SK_VT);
                  const u32x4 va_ = *(const LAS u32x4*)(scr + SK_VM + lane * 32), vb_ = *(const LAS u32x4*)(scr + SK_VM + lane * 32 + 16);
                  const unsigned vm[8] = {va_.x, va_.y, va_.z, va_.w, vb_.x, vb_.y, vb_.z, vb_.w};
#pragma unroll
                  for (int i = 0; i < 8; ++i) { VT[(16 * cv + 2 * i) * SK_P20 + sv] = (bf16)(vm[i] & 0xffffu); VT[(16 * cv + 2 * i + 1) * SK_P20 + sv] = (bf16)(vm[i] >> 16); } }
                asm volatile("s_waitcnt lgkmcnt(0)" ::: "memory");
                f32x4 Lb = Z4, Lk = Z4, Mb = Z4, Mk = Z4;
#pragma unroll
                for (int ks = 0; ks < 2; ++ks) {
                    const bf16x8 ab = *(const LAS bf16x8*)(BSs + c * SK_P72 + 32 * ks + 8 * g), ak = *(const LAS bf16x8*)(KSs + c * SK_P72 + 32 * ks + 8 * g);
                    const bf16x8 bn = *(const LAS bf16x8*)(NT + c * SK_P72 + 32 * ks + 8 * g), br = *(const LAS bf16x8*)(RT + c * SK_P72 + 32 * ks + 8 * g);
                    Lb = __builtin_amdgcn_mfma_f32_16x16x32_bf16(ab, bn, Lb, 0, 0, 0);
                    Lk = __builtin_amdgcn_mfma_f32_16x16x32_bf16(ak, bn, Lk, 0, 0, 0);
                    Mb = __builtin_amdgcn_mfma_f32_16x16x32_bf16(ab, br, Mb, 0, 0, 0);
                    Mk = __builtin_amdgcn_mfma_f32_16x16x32_bf16(ak, br, Mk, 0, 0, 0);
                }
#pragma unroll
                for (int j = 0; j < 4; ++j) { const int s = 4 * g + j; if (!(s < c)) { Lb[j] = 0.f; Lk[j] = 0.f; } if (!(s <= c)) { Mb[j] = 0.f; Mk[j] = 0.f; } }
                *(LAS u32x2*)((LAS bf16*)(sl + SK_LK) + c * SK_P20 + 4 * g) = (u32x2){pk2(Lk[0], Lk[1]), pk2(Lk[2], Lk[3])};
                *(LAS u32x2*)((LAS bf16*)(sl + SK_MB) + c * SK_P20 + 4 * g) = (u32x2){pk2(Mb[0], Mb[1]), pk2(Mb[2], Mb[3])};
                *(LAS u32x2*)((LAS bf16*)(sl + SK_MK) + c * SK_P20 + 4 * g) = (u32x2){pk2(Mk[0], Mk[1]), pk2(Mk[2], Mk[3])};
                *(LAS f32x4*)(LBs + c * 16 + 4 * g) = Lb;
            }
            __syncthreads();
            {
                float Ti[16];
#pragma unroll
                for (int t = 0; t < 16; ++t) {
                    float acc = (c_o == t) ? 1.f : 0.f;
                    if ((t & 3) == 0) asm volatile("" ::: "memory");
#pragma unroll
                    for (int s4 = 0; s4 < (t + 3) / 4; ++s4) {
                        const f32x4 l4 = *(const LAS f32x4*)(LBs + t * 16 + 4 * s4);
#pragma unroll
                        for (int e = 0; e < 4; ++e) if (4 * s4 + e < t) acc += Ti[4 * s4 + e] * l4[e];
                    }
                    Ti[t] = acc;
                }
                if (g == 0) {
                    LAS bf16* TT = (LAS bf16*)(sl + SK_TT);
#pragma unroll
                    for (int t = 0; t < 16; ++t) TT[t * SK_P20 + c] = (bf16)f2bf(Ti[t]);
                }
            }
            __syncthreads();
        }
#undef SK_LOAD_S
#undef SK_LOAD_L
#undef SK_LOAD_V
        for (int q = 0; q < 4 - pw; ++q) __syncthreads();
    }
}

constexpr int CW_HEAD = 12288;
__device__ __forceinline__ void head_publish(const Args& a, int u) {
    asm volatile("s_waitcnt vmcnt(0)" ::: "memory");
    __syncthreads();
    if (threadIdx.x == 0) {
        __builtin_amdgcn_fence(__ATOMIC_RELEASE, "agent");
        asm volatile("s_waitcnt vmcnt(0)" ::: "memory");
        __hip_atomic_store((unsigned*)a.ws + CW_HEAD + 16 * u, 1u, __ATOMIC_RELAXED, __HIP_MEMORY_SCOPE_AGENT);
    }
}
__device__ __forceinline__ void head_wait(const Args& a, int u) {
    if (threadIdx.x == 0) {
        unsigned* f = (unsigned*)a.ws + CW_HEAD + 16 * u;
        while (__hip_atomic_load(f, __ATOMIC_RELAXED, __HIP_MEMORY_SCOPE_AGENT) == 0u) __builtin_amdgcn_s_sleep(8);
        __builtin_amdgcn_fence(__ATOMIC_ACQUIRE, "agent");
        asm volatile("s_waitcnt vmcnt(0)" ::: "memory");
    }
    __syncthreads();
}
__device__ __forceinline__ void rwkv_post_item(const Args& a, int u, int sl) {
    const int tid = threadIdx.x, lane = tid & 63, wave = tid >> 6, tsub = lane >> 4, col = (u % 12) * 64 + 4 * (lane & 15);
    const int b = u / 12, h = u % 12;
    unsigned char* ws = a.ws;
    const bf16* PROJ = (const bf16*)(ws + WS_PROJ); bf16* CAT = (bf16*)(ws + WS_CAT); const float* BS = (const float*)(ws + WS_BS);
    const f32x4 lw = *(const f32x4*)(a.in[I_ALNW] + col), lb = *(const f32x4*)(a.in[I_ALNB] + col), mv = *(const f32x4*)(a.in[I_AMU] + C_V + col);
    for (int p0 = 0; p0 < 8; p0 += 2) {
        u32x2 yv[2], vc[2], vp[2], gt[2]; float bsv[2], pzv[2]; size_t mrow[2];
#pragma unroll
        for (int r = 0; r < 2; ++r) {
            const int t = 256 * sl + 32 * wave + 4 * (p0 + r) + tsub; const size_t m = (size_t)b * SEQ + t; mrow[r] = m;
            const bf16* pc = PROJ + m * LDP0; const bf16* pp = (t == 0) ? pc : pc - LDP0; pzv[r] = (t == 0) ? 0.f : 1.f;
            yv[r] = *(const u32x2*)(CAT + m * DM + col); vc[r] = *(const u32x2*)(pc + C_V + col); vp[r] = *(const u32x2*)(pp + C_V + col); gt[r] = *(const u32x2*)(pc + C_GATE0 + col);
            bsv[r] = BS[m * AH + h];
        }
#pragma unroll
        for (int r = 0; r < 2; ++r) {
            const float pz = pzv[r];
            float y[4] = {bflo(yv[r].x), bfhi(yv[r].x), bflo(yv[r].y), bfhi(yv[r].y)};
            const float mean = sum16((y[0] + y[1]) + (y[2] + y[3])) * (1.f / 64.f);
            float d[4], vs = 0.f;
#pragma unroll
            for (int j = 0; j < 4; ++j) { d[j] = y[j] - mean; vs += d[j] * d[j]; }
            const float rstd = 1.f / sqrtf(sum16(vs) * (1.f / 64.f) + LNX_EPS);
            const float vcur[4] = {bflo(vc[r].x), bfhi(vc[r].x), bflo(vc[r].y), bfhi(vc[r].y)};
            const float vprv[4] = {bflo(vp[r].x) * pz, bfhi(vp[r].x) * pz, bflo(vp[r].y) * pz, bfhi(vp[r].y) * pz};
            const float gg[4] = {bflo(gt[r].x), bfhi(gt[r].x), bflo(gt[r].y), bfhi(gt[r].y)};
            float o[4];
#pragma unroll
            for (int j = 0; j < 4; ++j) { const float v = vcur[j] + (vprv[j] - vcur[j]) * mv[j];
                o[j] = (d[j] * rstd * lw[j] + lb[j] + bsv[r] * v) * siluf_(gg[j]); }
            *(u32x2*)(CAT + mrow[r] * DM + col) = (u32x2){pk2(o[0], o[1]), pk2(o[2], o[3])};
        }
    }
}

__device__ __forceinline__ void phase_scan(const Args& a, LAS unsigned char* lds) {
    const int G = gridDim.x, bx = blockIdx.x;
    for (int it = bx; it < 256; it += G) lora_item(a, lds, it & 7, it >> 3);
    __syncthreads();
    if (bx < 96) { scan_unit(a, lds, bx / 12, bx % 12); head_publish(a, bx); }
    else { for (int u = bx - 96; u < 512; u += G - 96) mem_attn_unit(a, lds, 0, u);
           const int wave = __builtin_amdgcn_readfirstlane(threadIdx.x >> 6);
           transpose_group<1>(a, lds, (bx - 96) * 8 + wave, (G - 96) * 8); }
    for (int i = bx; i < 768; i += G) { const int u = i % 96; head_wait(a, u); rwkv_post_item(a, u, i / 96); }
}

__device__ __forceinline__ void phase_rwkv_post(const Args& a) {
    const int tid = threadIdx.x, lane = tid & 63, wave = tid >> 6, G = gridDim.x;
    unsigned char* ws = a.ws;
    const bf16* PROJ = (const bf16*)(ws + WS_PROJ); bf16* CAT = (bf16*)(ws + WS_CAT); const float* BS = (const float*)(ws + WS_BS);
    const float* mu = a.in[I_AMU];
    for (int m = blockIdx.x * 8 + wave; m < MTOK; m += G * 8) {
        const int t = m & (SEQ - 1);
        const bf16* pc = PROJ + (size_t)m * LDP0; const bf16* pp = (t == 0) ? pc : pc - LDP0; const float pz = (t == 0) ? 0.f : 1.f;
#pragma unroll
        for (int i = 0; i < 3; ++i) {
            const int col = 256 * i + 4 * lane, hh = col >> 6;
            const u32x2 yv = *(const u32x2*)(CAT + (size_t)m * DM + col);
            float y[4] = {bflo(yv.x), bfhi(yv.x), bflo(yv.y), bfhi(yv.y)};
            const float mean = sum16((y[0] + y[1]) + (y[2] + y[3])) * (1.f / 64.f);
            float d[4], vs = 0.f;
#pragma unroll
            for (int j = 0; j < 4; ++j) { d[j] = y[j] - mean; vs += d[j] * d[j]; }
            const float rstd = 1.f / sqrtf(sum16(vs) * (1.f / 64.f) + LNX_EPS);
            const f32x4 lw = *(const f32x4*)(a.in[I_ALNW] + col), lb = *(const f32x4*)(a.in[I_ALNB] + col), mv = *(const f32x4*)(mu + C_V + col);
            const u32x2 vc = *(const u32x2*)(pc + C_V + col), vp = *(const u32x2*)(pp + C_V + col), gt = *(const u32x2*)(pc + C_GATE0 + col);
            const float vcur[4] = {bflo(vc.x), bfhi(vc.x), bflo(vc.y), bfhi(vc.y)}, vprv[4] = {bflo(vp.x) * pz, bfhi(vp.x) * pz, bflo(vp.y) * pz, bfhi(vp.y) * pz};
            const float gg[4] = {bflo(gt.x), bfhi(gt.x), bflo(gt.y), bfhi(gt.y)};
            const float bs = BS[(size_t)m * AH + hh];
            float o[4];
#pragma unroll
            for (int j = 0; j < 4; ++j) { const float v = vcur[j] + (vprv[j] - vcur[j]) * mv[j];
                o[j] = (d[j] * rstd * lw[j] + lb[j] + bs * v) * siluf_(gg[j]); }
            u32x2 w; w.x = pk2(o[0], o[1]); w.y = pk2(o[2], o[3]);
            *(u32x2*)(CAT + (size_t)m * DM + col) = w;
        }
    }
}

template <int LAYER>
__device__ __forceinline__ void phase_rows(const Args& a) {
    const int tid = threadIdx.x, lane = tid & 63, wave = tid >> 6, G = gridDim.x;
    unsigned char* ws = a.ws;
    const bf16* Y = (const bf16*)(ws + WS_Y); const float* gpost = a.in[I_POST] + LAYER * DM;
    const float* xin = LAYER ? (const float*)a.out : a.in[I_X];
    bf16* XN = (bf16*)(ws + WS_XN);
    for (int m = blockIdx.x * 8 + wave; m < MTOK; m += G * 8) {
        const u32x2* yr = (const u32x2*)(Y + (size_t)m * DM) + lane; const f32x4* xr = (const f32x4*)(xin + (size_t)m * DM) + lane;
        f32x4 y[4], x[4]; float s = 0.f;
#pragma unroll
        for (int j = 0; j < 4; ++j) { const u32x2 yy = yr[64 * j]; y[j] = (f32x4){bflo(yy.x), bfhi(yy.x), bflo(yy.y), bfhi(yy.y)}; x[j] = xr[64 * j]; s += (y[j].x * y[j].x + y[j].y * y[j].y) + (y[j].z * y[j].z + y[j].w * y[j].w); }
        const float rs = 1.f / sqrtf(wave_sum(s) * (1.f / DM) + NORM_EPS);
        float s1 = 0.f;
        f32x4* orow = (f32x4*)(a.out + (size_t)m * DM) + lane;
#pragma unroll
        for (int j = 0; j < 4; ++j) { const f32x4 gp = *((const f32x4*)gpost + lane + 64 * j);
            x[j] = x[j] + y[j] * rs * gp; orow[64 * j] = x[j];
            s1 += (x[j].x * x[j].x + x[j].y * x[j].y) + (x[j].z * x[j].z + x[j].w * x[j].w); }
        if (LAYER == 0) {
            const float r1 = 1.f / sqrtf(wave_sum(s1) * (1.f / DM) + NORM_EPS);
            unsigned long long* o8 = (unsigned long long*)(XN + (size_t)m * DM) + lane;
#pragma unroll
            for (int j = 0; j < 4; ++j) o8[64 * j] = (unsigned long long)pk2(x[j].x * r1, x[j].y * r1) | ((unsigned long long)pk2(x[j].z * r1, x[j].w * r1) << 32);
        }
    }
}

constexpr int ATT_MAXU = 4;
__device__ const unsigned char att_deal[32][4] = {{32,31,94,8},{48,30,93,7},{33,29,90,81},{49,28,89,79},{34,27,86,74},{50,26,85,73},{35,25,82,66},{51,24,18,65},{36,23,12,1},{52,22,11,80},{37,21,2,255},{53,20,10,64},{38,19,9,16},{54,95,13,17},{39,92,4,255},{55,91,3,255},{40,88,76,255},{56,87,75,255},{41,84,70,255},{57,83,69,255},{42,15,68,255},{58,14,67,255},{43,6,255,255},{59,5,255,255},{44,78,255,255},{60,77,255,255},{45,72,255,255},{61,71,255,255},{46,0,255,255},{62,255,255,255},{47,255,255,255},{63,255,255,255}};
__device__ __forceinline__ void phase_attn1(const Args& a, LAS unsigned char* lds) {
    const int G = gridDim.x, bx = blockIdx.x, lane = threadIdx.x & 63;
    unsigned char* ws = a.ws;
    const float s1 = wave_sum(a.in[I_LQ1][lane] * a.in[I_LK1][lane]), s2 = wave_sum(a.in[I_LQ2][lane] * a.in[I_LK2][lane]);
    const float lam_init = 0.8f - 0.6f * 0.7408182206817179f;
    const float lam = __expf(s1) - __expf(s2) + lam_init;
    const bf16* PROJ = (const bf16*)(ws + WS_PROJ); const bf16* VT = (const bf16*)(ws + WS_VT); bf16* CAT = (bf16*)(ws + WS_CAT);
    const float slopes[6] = {0.25f, 0.0625f, 0.015625f, 0.00390625f, 0.5f, 0.125f};
    for (int i = 0; i < ATT_MAXU; ++i) {
        int qb, b, h;
        if (G == 256) { const int code = att_deal[bx >> 3][i]; if (code == 255) break; b = bx & 7; h = code >> 4; qb = code & 15; }
        else { const int n = i * G + bx; if (n >= 768) break; qb = 15 - n / 48; b = (n % 48) / 6; h = (n % 48) % 6; }
        const size_t row0 = (size_t)b * SEQ + qb * 128;
        float slope = slopes[0];
#pragma unroll
        for (int k = 1; k < 6; ++k) slope = (h == k) ? slopes[k] : slope;
        attn_unit<2>(lds, PROJ + row0 * LDP1 + C_Q1 + h * 128, LDP1,
                     PROJ + (size_t)b * SEQ * LDP1 + C_KSH + h * 128, LDP1,
                     VT + (size_t)(h * 128) * MTOK + (size_t)b * SEQ, MTOK,
                     2 * qb + 1, 2 * qb + 2, slope * LOG2E, qb * 128,
                     PROJ + row0 * LDP1 + C_GATE1 + h * 128, LDP1, CAT + row0 * DM + h * 128, DM, a.in[I_SUBLN], lam, 1.f - lam_init, (const unsigned*)(ws + WS_KM) + (b * 6 + h) * 16);
    }
    for (int u = bx; u < 512; u += G) mem_attn_unit(a, lds, 1, u);
}

constexpr int CW_XB = 8192;
#define XB_TMO      128
#define XB_XCNT(j)  (256  + 64 * (j))
#define XB_XSUB(j)  (1280 + 64 * (j))
#define XB_XGEN(j)  (2304 + 64 * (j))
#define XB_TOP      3328
#define XB_TOPGEN   3392
#define XB_SPIN_CAP (1u << 22)
__device__ __forceinline__ unsigned xb_ld(unsigned* p)              { return __hip_atomic_load(p, __ATOMIC_RELAXED, __HIP_MEMORY_SCOPE_AGENT); }
__device__ __forceinline__ unsigned xb_add(unsigned* p, unsigned v) { return __hip_atomic_fetch_add(p, v, __ATOMIC_RELAXED, __HIP_MEMORY_SCOPE_AGENT); }
__device__ __forceinline__ unsigned xb_xcc_id() { return (unsigned)__builtin_amdgcn_s_getreg((3 << 11) | 20) & 0xFu; }
#define XB_SPIN(cond, bar) do { unsigned _sp = 0; while (cond) { __builtin_amdgcn_s_sleep(1); \
    if ((++_sp & 255u) == 0u) { if (xb_ld(&(bar)[XB_TMO])) break; if (_sp > XB_SPIN_CAP) { atomicAdd(&(bar)[XB_TMO], 1u); break; } } } } while (0)
struct XcdBarrier { unsigned* bar; unsigned x; volatile LAS unsigned* st; };
__device__ __forceinline__ XcdBarrier xcd_barrier_post(unsigned* bar, volatile LAS unsigned* st) {
    XcdBarrier b; b.bar = bar; b.x = xb_xcc_id(); b.st = st;
    if (threadIdx.x == 0) (void)xb_add(&bar[XB_XCNT(b.x)], 1u);
    return b;
}
__device__ __forceinline__ void xcd_barrier_complete(unsigned* bar, unsigned x, unsigned& nloc, unsigned& nx) {
    const unsigned G = gridDim.x * gridDim.y * gridDim.z;
    unsigned sum, cnt, mine, sp = 0u;
    for (;;) {
        sum = 0u; cnt = 0u; mine = 0u;
#pragma unroll
        for (unsigned j = 0; j < 16; ++j) { const unsigned c = xb_ld(&bar[XB_XCNT(j)]); sum += c; cnt += (c > 0u) ? 1u : 0u; mine = (j == x) ? c : mine; }
        if (sum == G) break;
        __builtin_amdgcn_s_sleep(1);
        if ((++sp & 255u) == 0u) { if (xb_ld(&bar[XB_TMO])) break; if (sp > XB_SPIN_CAP) { atomicAdd(&bar[XB_TMO], 1u); break; } }
    }
    nloc = mine > 0u ? mine : 1u; nx = cnt > 0u ? cnt : 1u;
}
__device__ __forceinline__ void xcd_barrier(const XcdBarrier& b) {
    asm volatile("s_waitcnt vmcnt(0)" ::: "memory");
    __syncthreads();
    if (threadIdx.x == 0) {
        unsigned* bar = b.bar;
        __builtin_amdgcn_s_waitcnt(0);
        unsigned nloc = b.st[0], nx = b.st[1];
        if (nloc == 0u) { xcd_barrier_complete(bar, b.x, nloc, nx); b.st[0] = nloc; b.st[1] = nx; }
        const unsigned old = xb_add(&bar[XB_XSUB(b.x)], 1u);
        const unsigned gen = old / nloc;
        if (old + 1u == (gen + 1u) * nloc) {
            __builtin_amdgcn_fence(__ATOMIC_RELEASE, "agent");
            asm volatile("s_waitcnt vmcnt(0)" ::: "memory");
            const unsigned og = xb_add(&bar[XB_TOP], 1u);
            const unsigned tg = og / nx;
            if (og + 1u == (tg + 1u) * nx) xb_add(&bar[XB_TOPGEN], 1u);
            else XB_SPIN(xb_ld(&bar[XB_TOPGEN]) == tg, bar);
            __builtin_amdgcn_fence(__ATOMIC_ACQUIRE, "agent");
            xb_add(&bar[XB_XGEN(b.x)], 1u);
            asm volatile("s_waitcnt vmcnt(0)" ::: "memory");
        } else {
            XB_SPIN(xb_ld(&bar[XB_XGEN(b.x)]) == gen, bar);
            __builtin_amdgcn_fence(__ATOMIC_ACQUIRE, "agent");
            asm volatile("s_waitcnt vmcnt(0)" ::: "memory");
        }
    }
    __syncthreads();
}

constexpr int N_PHASES = 10;
__global__ void __launch_bounds__(512, 2) yoco_fwd(Args args) {
    extern __shared__ __attribute__((aligned(16))) unsigned char lds_raw[];
    LAS unsigned char* lds = (LAS unsigned char*)lds_raw;
    const int lo = args.ph_lo, hi = args.ph_hi;
#ifndef ONLY_PHASE
#define ONLY_PHASE -1
#endif
#define IN(k) ((ONLY_PHASE < 0 || ONLY_PHASE == (k)) && lo <= (k) && (k) < hi)
    volatile LAS unsigned* xb_st = (volatile LAS unsigned*)(lds + LDS_BYTES - 64);
    if (threadIdx.x == 0) { xb_st[0] = 0u; xb_st[1] = 0u; }
    __syncthreads();
    const XcdBarrier xbar = xcd_barrier_post((unsigned*)args.ws + CW_XB, xb_st);
    if (args.ph_hi > 64) { __syncthreads(); cg::this_grid().sync(); }
#define SEAM(k) do { if (IN(k) && IN((k) + 1)) { xcd_barrier(xbar); } } while (0)
    if (IN(0)) { phase_prologue(args, lds); if (PROBE_DUP == 0) { __syncthreads(); phase_prologue(args, lds); } }
    SEAM(0);
    if (IN(1)) { phase_gemm(args, lds, 0, 3); if (PROBE_DUP == 1) { __syncthreads(); phase_gemm(args, lds, 0, 3); } }
    SEAM(1);
    if (IN(2)) { phase_scan(args, lds); if (PROBE_DUP == 2) { __syncthreads(); phase_scan(args, lds); } }
    SEAM(2);
    if (IN(4)) { if (gridDim.x == 256) phase_outproj<0>(args, lds); else { phase_gemm(args, lds, 3, 1); } }
    if (gridDim.x != 256) { SEAM(4); if (IN(5)) phase_rows<0>(args); }
    SEAM(5);
    if (IN(6)) { phase_gemm(args, lds, 4, 2); if (PROBE_DUP == 6) { __syncthreads(); phase_gemm(args, lds, 4, 2); } }
    SEAM(6);
    if (IN(7)) { phase_attn1(args, lds); if (PROBE_DUP == 7) { __syncthreads(); phase_attn1(args, lds); } }
    SEAM(7);
    if (IN(8)) { if (gridDim.x == 256) phase_outproj<1>(args, lds); else { phase_gemm(args, lds, 6, 1); } }
    if (gridDim.x != 256) { SEAM(8); if (IN(9)) phase_rows<1>(args); }
#undef IN
#undef SEAM
}

extern "C" void kernel_launch(void* const* d_in, const int* in_sizes, int n_in, void* d_out, int out_size, void* d_ws, size_t ws_size, hipStream_t stream) {
    static int ready = 0;
    if (ready == 0) {
        if (n_in != 26 || out_size != MTOK * DM || ws_size < WS_END) { fprintf(stderr, "kernel_launch: unexpected problem shape (n_in %d out %d ws %zu)\n", n_in, out_size, ws_size); ready = -1; return; }
        if (hipFuncSetAttribute((const void*)yoco_fwd, hipFuncAttributeMaxDynamicSharedMemorySize, LDS_BYTES) != hipSuccess) { fprintf(stderr, "kernel_launch: hipFuncSetAttribute failed\n"); ready = -1; return; }
        int per_cu = 0;
        if (hipOccupancyMaxActiveBlocksPerMultiprocessor(&per_cu, (const void*)yoco_fwd, 512, LDS_BYTES) != hipSuccess || per_cu < 1) fprintf(stderr, "kernel_launch: occupancy query says %d\n", per_cu);
        (void)hipGetLastError();
        ready = 1;
    }
    if (ready < 0) return;
    Args a{};
    for (int i = 0; i < 26; ++i) a.in[i] = (const float*)d_in[i];
    a.out = (float*)d_out; a.ws = (unsigned char*)d_ws;
#if MK_COOP
    (void)hipMemsetAsync(d_ws, 0, 65536, stream);
    a.ph_lo = 0; a.ph_hi = N_PHASES;
    void* params[] = {&a};
    hipError_t e = hipLaunchCooperativeKernel((const void*)yoco_fwd, dim3(256), dim3(512), params, LDS_BYTES, stream);
    if (e != hipSuccess) fprintf(stderr, "kernel_launch: cooperative launch failed: %s\n", hipGetErrorString(e));
#else
    for (int ph = 0; ph < N_PHASES; ++ph) { a.ph_lo = ph; a.ph_hi = ph + 1; hipLaunchKernelGGL(yoco_fwd, dim3(256), dim3(512), LDS_BYTES, stream, a); }
#endif
}
```

```cpp
#include <hip/hip_runtime.h>
#include <hip/hip_cooperative_groups.h>
#include <cstdio>
#include <cstdint>
namespace cg = cooperative_groups;

#ifndef PROBE_DUP
#define PROBE_DUP -1
#endif
#ifndef MK_COOP
#define MK_COOP 1
#endif

#define LAS __attribute__((address_space(3)))
typedef unsigned short bf16;
typedef short bf16x8 __attribute__((ext_vector_type(8)));
typedef float f32x4 __attribute__((ext_vector_type(4)));
typedef float f32x2 __attribute__((ext_vector_type(2)));
typedef unsigned u32x4 __attribute__((ext_vector_type(4)));
typedef unsigned u32x2 __attribute__((ext_vector_type(2)));

constexpr int DM = 1024, NBATCH = 8, SEQ = 2048, MTOK = NBATCH * SEQ;
constexpr int MEML = 256, MROWS = NBATCH * MEML;
constexpr int BRW = 768, AH = 12, BH = 6;
constexpr int LDP0 = 3840;
constexpr int LDP1 = 2816;
constexpr int C_R = 0, C_K = 768, C_V = 1536, C_WD = 2304, C_AD = 2368, C_GATE0 = 2432, C_QM0 = 3200, C_GM0 = 3456;
constexpr int C_Q1 = 0, C_GATE1 = 768, C_QM1 = 1536, C_GM1 = 1792, C_KSH = 2048;
constexpr float NORM_EPS = 1e-6f, LNX_EPS = 64e-5f;
constexpr float LOG2E = 1.4426950408889634f;

constexpr size_t MiB = 1u << 20;
constexpr size_t WS_WA = 1 * MiB;
constexpr size_t WS_WB = 9 * MiB;
constexpr size_t WS_WO = 16 * MiB;
constexpr size_t WS_WM = 20 * MiB;
constexpr size_t WS_MEMN = 22 * MiB;
constexpr size_t WS_MK = 26 * MiB;
constexpr size_t WS_MVT = 28 * MiB;
constexpr size_t WS_XN = 30 * MiB;
constexpr size_t WS_CAT = 62 * MiB;
constexpr size_t WS_VT = 94 * MiB;
constexpr size_t WS_PROJ = 118 * MiB;
constexpr size_t WS_Y = 118 * MiB;
constexpr size_t WS_W2T = 0 * MiB + 65536;
constexpr size_t WS_KM = 6144;
constexpr size_t WS_XCNT = 16384;
constexpr size_t WS_XCH = 254 * MiB;
constexpr size_t WS_LD16 = WS_XN;
constexpr size_t WS_A16 = WS_VT;
constexpr int CW_LORA = 1280;
constexpr size_t WS_X1B = 210 * MiB;
constexpr size_t WS_BS = 238 * MiB;
constexpr size_t WS_END = 256 * MiB;

__device__ __forceinline__ unsigned f2bf(float f) { unsigned u = __builtin_bit_cast(unsigned, f); return (u + 0x7fffu + ((u >> 16) & 1u)) >> 16; }
typedef __bf16 bf16x2_t __attribute__((ext_vector_type(2)));
__device__ __forceinline__ unsigned pk2(float lo, float hi) { f32x2 v = {lo, hi}; bf16x2_t b = __builtin_convertvector(v, bf16x2_t); return __builtin_bit_cast(unsigned, b); }
__device__ __forceinline__ float bflo(unsigned u) { return __builtin_bit_cast(float, u << 16); }
__device__ __forceinline__ float bfhi(unsigned u) { return __builtin_bit_cast(float, u & 0xffff0000u); }
__device__ __forceinline__ float wave_sum(float v) {
#pragma unroll
    for (int o = 1; o < 64; o <<= 1) v += __shfl_xor(v, o);
    return v;
}
template <int CTRL> __device__ __forceinline__ float dppf(float x) { return __builtin_bit_cast(float, __builtin_amdgcn_update_dpp(0, __builtin_bit_cast(int, x), CTRL, 0xf, 0xf, false)); }
__device__ __forceinline__ float sum8(float x) { x += dppf<0xB1>(x); x += dppf<0x4E>(x); x += dppf<0x141>(x); return x; }
__device__ __forceinline__ float sum16(float x) { x += dppf<0xB1>(x); x += dppf<0x4E>(x); x += dppf<0x141>(x); x += dppf<0x140>(x); return x; }
__device__ __forceinline__ float rows_max(float m) { m = fmaxf(m, __shfl_xor(m, 16)); return fmaxf(m, __shfl_xor(m, 32)); }
__device__ __forceinline__ float rows_sum(float m) { m += __shfl_xor(m, 16); return m + __shfl_xor(m, 32); }
__device__ __forceinline__ float sigmoidf_(float x) { return __builtin_amdgcn_rcpf(1.f + __builtin_amdgcn_exp2f(-1.4426950408889634f * x)); }
__device__ __forceinline__ float siluf_(float x) { return x * __builtin_amdgcn_rcpf(1.f + __builtin_amdgcn_exp2f(-1.4426950408889634f * x)); }

namespace pg8 {
constexpr int BM = 256, BK = 64, HALF = 128, HTB = HALF * BK * 2, STAGE_BYTES = 8 * HTB, NXCD = 8, WGM = 8;
__device__ __forceinline__ int lds_byte(int r, int c) { const int st = (r >> 4) * 2 + (c >> 5), rr = r & 15, cc = c & 31, ob = rr * 64 + cc * 2; return st * 1024 + (ob ^ (((ob >> 9) & 1) << 5)); }
__device__ __forceinline__ void stage_rc(int b, int& R, int& C) { const int st = b / 1024, sb = b % 1024, swz = sb ^ (((sb >> 9) & 1) << 5); R = (st >> 1) * 16 + swz / 64; C = (st & 1) * 32 + (swz % 64) / 2; }
__device__ __forceinline__ int perm32(int rho) { const int n = rho >> 4, i = rho & 15; return 8 * (i >> 2) + 4 * n + (i & 3); }
struct Unit { int pm, pn; };
struct Gemm { const bf16* A; const bf16* Bt; int M, N, K; };
struct StaticOrder {
    int nM, nN, nwg, G, c;
    __device__ void init(int M, int N, int G_, int c_) { nM = M / BM; nN = N / BM; nwg = nM * nN; G = G_; c = c_; }
    __device__ bool next(int i, Unit& u) const {
        const long L = (long)i * G + c; if (L >= nwg) return false;
        int wgid = (int)L; { const int q = nwg / NXCD, r = nwg % NXCD, xcd = wgid % NXCD, off = wgid / NXCD; wgid = (xcd < r ? xcd * (q + 1) : r * (q + 1) + (xcd - r) * q) + off; }
        const int nig = WGM * nN, gid = wgid / nig, fm = gid * WGM, gsz = (nM - fm) < WGM ? (nM - fm) : WGM;
        u.pm = fm + ((wgid % nig) % gsz); u.pn = (wgid % nig) / gsz; return true;
    }
};
__device__ __forceinline__ unsigned cvt_pk_bf16(float lo, float hi) { unsigned r; asm volatile("v_cvt_pk_bf16_f32 %0, %1, %2" : "=v"(r) : "v"(lo), "v"(hi)); return r; }

struct EpiStore {
    void* O; int ldc; int f32out; unsigned* km;
    __device__ __forceinline__ void operator()(const f32x4 (&acc)[2][2][4][2], const Unit& u, int wr, int wc, int fr, int fq) const {
        const int row0 = u.pm * BM + wr * 64 + fr, col0 = u.pn * BM + wc * 32 + 8 * fq;
        if (f32out) {
#pragma unroll
            for (int ai = 0; ai < 2; ++ai)
#pragma unroll
                for (int m = 0; m < 4; ++m) { float* rowp = (float*)O + (size_t)(row0 + ai * HALF + m * 16) * ldc + col0;
#pragma unroll
                    for (int bj = 0; bj < 2; ++bj) { *(f32x4*)(rowp + bj * HALF) = acc[ai][bj][m][0]; *(f32x4*)(rowp + bj * HALF + 4) = acc[ai][bj][m][1]; } }
        } else {
#pragma unroll
            for (int ai = 0; ai < 2; ++ai)
#pragma unroll
                for (int m = 0; m < 4; ++m) { bf16* rowp = (bf16*)O + (size_t)(row0 + ai * HALF + m * 16) * ldc + col0;
#pragma unroll
                    for (int bj = 0; bj < 2; ++bj) { const f32x4 v0 = acc[ai][bj][m][0], v1 = acc[ai][bj][m][1];
                        u32x4 w; w.x = cvt_pk_bf16(v0[0], v0[1]); w.y = cvt_pk_bf16(v0[2], v0[3]); w.z = cvt_pk_bf16(v1[0], v1[1]); w.w = cvt_pk_bf16(v1[2], v1[3]);
                        *(u32x4*)(rowp + bj * HALF) = w; } }
            if (km && u.pn >= 8) {
#pragma unroll
                for (int bj = 0; bj < 2; ++bj) {
                    float pmax = 0.f;
#pragma unroll
                    for (int ai = 0; ai < 2; ++ai)
#pragma unroll
                        for (int m = 0; m < 4; ++m) { const f32x4 v0 = acc[ai][bj][m][0], v1 = acc[ai][bj][m][1];
                            const unsigned w0 = cvt_pk_bf16(v0[0], v0[1]), w1 = cvt_pk_bf16(v0[2], v0[3]), w2 = cvt_pk_bf16(v1[0], v1[1]), w3 = cvt_pk_bf16(v1[2], v1[3]);
                            const float a0 = bflo(w0), a1 = bfhi(w0), a2 = bflo(w1), a3 = bfhi(w1), a4 = bflo(w2), a5 = bfhi(w2), a6 = bflo(w3), a7 = bfhi(w3);
                            pmax = fmaxf(pmax, ((a0 * a0 + a1 * a1) + (a2 * a2 + a3 * a3)) + ((a4 * a4 + a5 * a5) + (a6 * a6 + a7 * a7))); }
                    pmax = fmaxf(pmax, dppf<0xB1>(pmax)); pmax = fmaxf(pmax, dppf<0x4E>(pmax)); pmax = fmaxf(pmax, dppf<0x141>(pmax)); pmax = fmaxf(pmax, dppf<0x140>(pmax));
                    if (fr == 0) { const int ck = u.pn * BM + bj * HALF + wc * 32 + 8 * fq - 2048;
                        atomicMax(km + (((u.pm >> 3) * 6 + (ck >> 7)) * 2 + ((ck >> 6) & 1)) * 8 + ((ck >> 3) & 7), __builtin_bit_cast(unsigned, pmax)); }
                }
            }
        }
    }
};

struct EpiFused {
    const float* xin; const bf16* xin16; float* out; bf16* out16; bf16* XN; const float* gpost; float* xch; unsigned* cnt;
    __device__ __forceinline__ void exchange(int ex, int pm, int pn, LAS float* P, LAS float* RS, int tid) const {
        __syncthreads();
        unsigned* mine = (unsigned*)(xch + ((size_t)(ex * 64 + pm) * 4) * 256);
        if (tid < 256) { const f32x4 p4 = *(const LAS f32x4*)(P + tid * 4);
            __hip_atomic_store(mine + pn * 256 + tid, __builtin_bit_cast(unsigned, (p4.x + p4.y) + (p4.z + p4.w)), __ATOMIC_RELAXED, __HIP_MEMORY_SCOPE_AGENT); }
        asm volatile("s_waitcnt vmcnt(0)" ::: "memory");
        __syncthreads();
        if (tid == 0) {
            unsigned* c = cnt + (ex * 64 + pm) * 16;
            (void)__hip_atomic_fetch_add(c, 1u, __ATOMIC_RELAXED, __HIP_MEMORY_SCOPE_AGENT);
            while (__hip_atomic_load(c, __ATOMIC_RELAXED, __HIP_MEMORY_SCOPE_AGENT) < 4u) __builtin_amdgcn_s_sleep(1);
        }
        __syncthreads();
        if (tid < 256) {
            const float t0 = __builtin_bit_cast(float, __hip_atomic_load(mine + tid, __ATOMIC_RELAXED, __HIP_MEMORY_SCOPE_AGENT)), t1 = __builtin_bit_cast(float, __hip_atomic_load(mine + 256 + tid, __ATOMIC_RELAXED, __HIP_MEMORY_SCOPE_AGENT)),
                        t2 = __builtin_bit_cast(float, __hip_atomic_load(mine + 512 + tid, __ATOMIC_RELAXED, __HIP_MEMORY_SCOPE_AGENT)), t3 = __builtin_bit_cast(float, __hip_atomic_load(mine + 768 + tid, __ATOMIC_RELAXED, __HIP_MEMORY_SCOPE_AGENT));
            RS[tid] = __builtin_amdgcn_rsqf(((t0 + t1) + (t2 + t3)) * (1.f / 1024.f) + 1e-6f); }
        __syncthreads();
    }
    __device__ __forceinline__ void fused(f32x4 (&acc)[2][2][4][2], const Unit& u, int wr, int wc, int fr, int fq, LAS unsigned char* lds) const {
        const int tid = threadIdx.x;
        LAS float* P = (LAS float*)lds;
        LAS float* RS = (LAS float*)(lds + 4096);
#pragma unroll
        for (int ai = 0; ai < 2; ++ai)
#pragma unroll
            for (int m = 0; m < 4; ++m) {
                float p = 0.f;
#pragma unroll
                for (int bj = 0; bj < 2; ++bj)
#pragma unroll
                    for (int n = 0; n < 2; ++n) { const f32x4 v = acc[ai][bj][m][n]; p += (v.x * v.x + v.y * v.y) + (v.z * v.z + v.w * v.w); }
                p += __shfl_xor(p, 16); p += __shfl_xor(p, 32);
                if (fq == 0) P[(ai * HALF + wr * 64 + m * 16 + fr) * 4 + wc] = p;
            }
        exchange(0, u.pm, u.pn, P, RS, tid);
        const int col0 = u.pn * BM + wc * 32 + 8 * fq;
        f32x4 gp[2][2];
#pragma unroll
        for (int bj = 0; bj < 2; ++bj)
#pragma unroll
            for (int n = 0; n < 2; ++n) gp[bj][n] = *(const f32x4*)(gpost + col0 + bj * HALF + 4 * n);
#pragma unroll
        for (int ai = 0; ai < 2; ++ai)
#pragma unroll
            for (int m = 0; m < 4; ++m) {
                const int rl = ai * HALF + wr * 64 + m * 16 + fr; const float rs = RS[rl];
                const size_t off = (size_t)(u.pm * BM + rl) * 1024 + col0;
                float p = 0.f;
#pragma unroll
                for (int bj = 0; bj < 2; ++bj) {
                    f32x4 xv[2];
                    if (xin16) { const u32x4 xb = *(const u32x4*)(xin16 + off + bj * HALF); xv[0] = (f32x4){bflo(xb.x), bfhi(xb.x), bflo(xb.y), bfhi(xb.y)}; xv[1] = (f32x4){bflo(xb.z), bfhi(xb.z), bflo(xb.w), bfhi(xb.w)}; }
                    else { xv[0] = *(const f32x4*)(xin + off + bj * HALF); xv[1] = *(const f32x4*)(xin + off + bj * HALF + 4); }
#pragma unroll
                    for (int n = 0; n < 2; ++n) {
                        const f32x4 x1 = xv[n] + acc[ai][bj][m][n] * rs * gp[bj][n];
                        acc[ai][bj][m][n] = x1;
                        p += (x1.x * x1.x + x1.y * x1.y) + (x1.z * x1.z + x1.w * x1.w);
                    }
                    if (out16) { const f32x4 v0 = acc[ai][bj][m][0], v1 = acc[ai][bj][m][1];
                        u32x4 w; w.x = cvt_pk_bf16(v0[0], v0[1]); w.y = cvt_pk_bf16(v0[2], v0[3]); w.z = cvt_pk_bf16(v1[0], v1[1]); w.w = cvt_pk_bf16(v1[2], v1[3]);
                        *(u32x4*)(out16 + off + bj * HALF) = w; }
                    else { *(f32x4*)(out + off + bj * HALF) = acc[ai][bj][m][0]; *(f32x4*)(out + off + bj * HALF + 4) = acc[ai][bj][m][1]; }
                }
                if (XN) { p += __shfl_xor(p, 16); p += __shfl_xor(p, 32); if (fq == 0) P[rl * 4 + wc] = p; }
            }
        if (XN) {
            exchange(1, u.pm, u.pn, P, RS, tid);
#pragma unroll
            for (int ai = 0; ai < 2; ++ai)
#pragma unroll
                for (int m = 0; m < 4; ++m) {
                    const int rl = ai * HALF + wr * 64 + m * 16 + fr; const float r1 = RS[rl];
                    bf16* rowp = XN + (size_t)(u.pm * BM + rl) * 1024 + col0;
#pragma unroll
                    for (int bj = 0; bj < 2; ++bj) { const f32x4 v0 = acc[ai][bj][m][0] * r1, v1 = acc[ai][bj][m][1] * r1;
                        u32x4 w; w.x = cvt_pk_bf16(v0[0], v0[1]); w.y = cvt_pk_bf16(v0[2], v0[3]); w.z = cvt_pk_bf16(v1[0], v1[1]); w.w = cvt_pk_bf16(v1[2], v1[3]);
                        *(u32x4*)(rowp + bj * HALF) = w; }
                }
        }
        __syncthreads();
    }
};

template <class Epi, class Sched, bool FUSED = false>
__device__ __forceinline__ void gemm_phase(LAS unsigned char* lds, const Gemm g, const Sched& S, const Epi& E) {
    const int tid = threadIdx.x, wid = __builtin_amdgcn_readfirstlane(tid >> 6), lane = tid & 63, wr = wid >> 2, wc = wid & 3, fr = lane & 15, fq = lane >> 4;
    const int K = g.K, nt = K / BK;
    unsigned voffA[2], voffB[2];
#pragma unroll
    for (int i = 0; i < 2; ++i) { int R, C; stage_rc(tid * 16 + i * 8192, R, C); const int Rb = (R & ~31) + perm32(R & 31);
        voffA[i] = (unsigned)(R * K + C) * 2u; voffB[i] = (unsigned)(Rb * K + C) * 2u; }
    const size_t kstep = (size_t)(BK * 2);
    const size_t hstep = (size_t)HALF * K * 2;
    const size_t tstep = 2 * hstep;
    const unsigned ldsw = (unsigned)wid * 1024u;
    const int aoff = lds_byte(wr * 64 + fr, fq * 8), boff = lds_byte(wc * 32 + fr, fq * 8);
#define PG8_SA(b, h) (((b) * 2 + (h)) * HTB)
#define PG8_SB(b, h) ((4 + (b) * 2 + (h)) * HTB)
#define PG8_STAGE(bufoff, gbase, voff) do { _Pragma("unroll") for (int _i = 0; _i < 2; ++_i) \
        __builtin_amdgcn_global_load_lds((const unsigned*)((const char*)(gbase) + (voff)[_i]), (LAS unsigned*)(lds + (bufoff) + ldsw + _i * 8192), 16, 0, 0); } while (0)
#define PG8_LDA(dst, b, h) do { _Pragma("unroll") for (int m = 0; m < 4; ++m) _Pragma("unroll") for (int k = 0; k < 2; ++k) dst[m][k] = *(const LAS bf16x8*)(lds + PG8_SA(b, h) + aoff + m * 2048 + k * 1024); } while (0)
#define PG8_LDB(dst, b, h) do { _Pragma("unroll") for (int n = 0; n < 2; ++n) _Pragma("unroll") for (int k = 0; k < 2; ++k) dst[n][k] = *(const LAS bf16x8*)(lds + PG8_SB(b, h) + boff + n * 2048 + k * 1024); } while (0)
#define PG8_MMA(ai, bj, At, Bt) do { __builtin_amdgcn_s_setprio(1); _Pragma("unroll") for (int m = 0; m < 4; ++m) _Pragma("unroll") for (int n = 0; n < 2; ++n) _Pragma("unroll") for (int k = 0; k < 2; ++k) \
        acc[ai][bj][m][n] = __builtin_amdgcn_mfma_f32_16x16x32_bf16(Bt[n][k], At[m][k], acc[ai][bj][m][n], 0, 0, 0); __builtin_amdgcn_s_setprio(0); } while (0)
#define PG8_WAIT_V(n) asm volatile("s_waitcnt vmcnt(" #n ")" ::: "memory")
#define PG8_WAIT_L(n) asm volatile("s_waitcnt lgkmcnt(" #n ")" ::: "memory")
#define PG8_BAR __builtin_amdgcn_s_barrier()
#define PG8_SCHED __builtin_amdgcn_sched_barrier(0)
    Unit cur, nxt; int ui = 0;
    if (!S.next(0, cur)) return;
    f32x4 acc[2][2][4][2];
#pragma unroll
    for (int a = 0; a < 2; ++a)
#pragma unroll
        for (int b = 0; b < 2; ++b)
#pragma unroll
            for (int m = 0; m < 4; ++m)
#pragma unroll
                for (int n = 0; n < 2; ++n) acc[a][b][m][n] = (f32x4){0.f, 0.f, 0.f, 0.f};
    bf16x8 At[4][2], B0[2][2], B1[2][2];
    const char* cA = (const char*)g.A + (size_t)cur.pm * tstep; const char* cB = (const char*)g.Bt + (size_t)cur.pn * tstep;
    PG8_STAGE(PG8_SB(0, 0), cB, voffB); PG8_STAGE(PG8_SB(0, 1), cB + hstep, voffB); PG8_STAGE(PG8_SA(0, 0), cA, voffA); PG8_STAGE(PG8_SA(0, 1), cA + hstep, voffA);
    if (wr == 1) PG8_BAR;
    PG8_WAIT_V(2); PG8_BAR;
    PG8_STAGE(PG8_SB(1, 0), cB + kstep, voffB); PG8_STAGE(PG8_SA(1, 0), cA + kstep, voffA); PG8_STAGE(PG8_SB(1, 1), cB + hstep + kstep, voffB);
    PG8_WAIT_V(6); PG8_BAR;
    for (;;) {
        const bool has_next = S.next(ui + 1, nxt);
        const char* nA = has_next ? (const char*)g.A + (size_t)nxt.pm * tstep : cA; const char* nB = has_next ? (const char*)g.Bt + (size_t)nxt.pn * tstep : cB;
        for (int t = 0; t < nt; t += 2) {
            const bool last = (t == nt - 2);
            const char* a1 = cA + (size_t)(t + 1) * kstep;
            const char* a2 = last ? nA : cA + (size_t)(t + 2) * kstep; const char* b2 = last ? nB : cB + (size_t)(t + 2) * kstep;
            const char* a3 = a2 + kstep; const char* b3 = b2 + kstep;
            PG8_LDB(B0, 0, 0); PG8_LDB(B1, 0, 1); PG8_SCHED; PG8_LDA(At, 0, 0); PG8_STAGE(PG8_SA(1, 1), a1 + hstep, voffA);
            PG8_WAIT_V(8); PG8_WAIT_L(0); PG8_BAR; PG8_MMA(0, 0, At, B0); PG8_MMA(0, 1, At, B1); PG8_BAR; PG8_SCHED;
            PG8_LDA(At, 0, 1); PG8_STAGE(PG8_SB(0, 0), b2, voffB); PG8_STAGE(PG8_SB(0, 1), b2 + hstep, voffB); PG8_STAGE(PG8_SA(0, 0), a2, voffA);
            PG8_WAIT_V(8); PG8_WAIT_L(0); PG8_BAR; PG8_MMA(1, 0, At, B0); PG8_MMA(1, 1, At, B1); PG8_BAR; PG8_SCHED;
            PG8_LDB(B0, 1, 0); PG8_LDB(B1, 1, 1); PG8_SCHED; PG8_LDA(At, 1, 0); PG8_STAGE(PG8_SA(0, 1), a2 + hstep, voffA);
            PG8_WAIT_V(8); PG8_WAIT_L(0); PG8_BAR; PG8_MMA(0, 0, At, B0); PG8_MMA(0, 1, At, B1); PG8_BAR; PG8_SCHED;
            PG8_LDA(At, 1, 1); PG8_STAGE(PG8_SB(1, 0), b3, voffB); PG8_STAGE(PG8_SB(1, 1), b3 + hstep, voffB); PG8_STAGE(PG8_SA(1, 0), a3, voffA);
            PG8_WAIT_V(8); PG8_WAIT_L(0); PG8_BAR; PG8_MMA(1, 0, At, B0); PG8_MMA(1, 1, At, B1); PG8_BAR; PG8_SCHED;
        }
        if (wr == 0) PG8_BAR;
        if constexpr (!FUSED) E(acc, cur, wr, wc, fr, fq);
        if (!has_next) break;
#pragma unroll
        for (int a = 0; a < 2; ++a)
#pragma unroll
            for (int b = 0; b < 2; ++b)
#pragma unroll
                for (int m = 0; m < 4; ++m)
#pragma unroll
                    for (int n = 0; n < 2; ++n) acc[a][b][m][n] = (f32x4){0.f, 0.f, 0.f, 0.f};
        cur = nxt; cA = nA; cB = nB; ++ui;
        if (wr == 1) PG8_BAR;
    }
    PG8_WAIT_V(0);
    PG8_BAR;
    if constexpr (FUSED) E.fused(acc, cur, wr, wc, fr, fq, lds);
#undef PG8_SA
#undef PG8_SB
#undef PG8_STAGE
#undef PG8_LDA
#undef PG8_LDB
#undef PG8_MMA
#undef PG8_WAIT_V
#undef PG8_WAIT_L
#undef PG8_BAR
#undef PG8_SCHED
}
}

struct Args { const float* in[26]; float* out; unsigned char* ws; int ph_lo, ph_hi; };
enum { I_X = 0, I_MEM, I_PRE, I_POST, I_WOUT, I_MEMNORM, I_WMEMKV, I_AWIN, I_AMU, I_AW0, I_AW2, I_AA0, I_AA2, I_AKK, I_AKA, I_ARK, I_ALNW, I_ALNB,
       I_KVNORM, I_WKV, I_BWIN, I_LQ1, I_LK1, I_LQ2, I_LK2, I_SUBLN };

constexpr int LDS_BYTES = 147456;

__device__ __forceinline__ void p0_transpose_item(const float* W, int ldw, int c0, int nc, const float* gain, bf16* WT, int row0, LAS float* scr, int item, int lane, int ldo = 1024) {
    const int nblk = nc / 32, kb = item / nblk, nb = item % nblk, k0 = 64 * kb, n0 = 32 * nb;
#pragma unroll
    for (int i = 0; i < 8; ++i) { const int kk = 8 * i + (lane >> 3), n4 = 4 * (lane & 7);
        f32x4 v = *(const f32x4*)(W + (size_t)(k0 + kk) * ldw + c0 + n0 + n4); if (gain) v = v * gain[k0 + kk];
        LAS float* d = scr + kk * 33 + n4; d[0] = v.x; d[1] = v.y; d[2] = v.z; d[3] = v.w; }
    asm volatile("s_waitcnt lgkmcnt(0)" ::: "memory");
    const int c = lane & 7;
#pragma unroll
    for (int j = 0; j < 4; ++j) { const int n = (lane >> 3) + 8 * j; const LAS float* s = scr + (8 * c) * 33 + n;
        u32x4 o; o.x = pk2(s[0 * 33], s[1 * 33]); o.y = pk2(s[2 * 33], s[3 * 33]); o.z = pk2(s[4 * 33], s[5 * 33]); o.w = pk2(s[6 * 33], s[7 * 33]);
        *(u32x4*)(WT + (size_t)(row0 + n0 + n) * ldo + k0 + 8 * c) = o; }
    asm volatile("s_waitcnt lgkmcnt(0)" ::: "memory");
}
__device__ __forceinline__ void rms_row_to_bf16(const float* xrow, bf16* orow, int lane) {
    const f32x4* xr = (const f32x4*)xrow + lane;
    f32x4 v[4]; float s = 0.f;
#pragma unroll
    for (int j = 0; j < 4; ++j) { v[j] = xr[64 * j]; s += (v[j].x * v[j].x + v[j].y * v[j].y) + (v[j].z * v[j].z + v[j].w * v[j].w); }
    const float rs = 1.f / sqrtf(wave_sum(s) * (1.f / DM) + NORM_EPS);
    unsigned long long* o8 = (unsigned long long*)orow + lane;
#pragma unroll
    for (int j = 0; j < 4; ++j) o8[64 * j] = (unsigned long long)pk2(v[j].x * rs, v[j].y * rs) | ((unsigned long long)pk2(v[j].z * rs, v[j].w * rs) << 32);
}
template <int GROUP>
__device__ __forceinline__ void transpose_group(const Args& a, LAS unsigned char* lds, int gw, int NGW) {
    const int lane = threadIdx.x & 63, wave = __builtin_amdgcn_readfirstlane(threadIdx.x >> 6);
    unsigned char* ws = a.ws;
    LAS float* scr = (LAS float*)(lds + wave * 16384);
    bf16* WA = (bf16*)(ws + WS_WA); bf16* WB = (bf16*)(ws + WS_WB); bf16* WO = (bf16*)(ws + WS_WO); bf16* WM = (bf16*)(ws + WS_WM);
    constexpr int I0 = 16 * (3712 / 32), I1 = 16 * (2048 / 32), I2 = 16 * (1536 / 32), I3 = 16 * (1024 / 32), I5 = 16 * (256 / 32), I6 = 768 / 32;
    bf16* W2T = (bf16*)(ws + WS_W2T); bf16* A2T = W2T + 768 * 64;
    if (GROUP == 0) {
        constexpr int NITEMS = I0 + 4 * I5 + 2 * I6;
        for (int it = gw; it < NITEMS; it += NGW) {
            int r = it;
            if (r < I0) { p0_transpose_item(a.in[I_AWIN], 3712, 0, 3712, a.in[I_PRE], WA, 0, scr, r, lane); continue; } r -= I0;
            if (r < I5) { p0_transpose_item(a.in[I_WMEMKV], 512, 0, 256, a.in[I_MEMNORM], WM, 0, scr, r, lane); continue; } r -= I5;
            if (r < I5) { p0_transpose_item(a.in[I_WMEMKV], 512, 256, 256, a.in[I_MEMNORM], WM, 512, scr, r, lane); continue; } r -= I5;
            if (r < I5) { p0_transpose_item(a.in[I_WMEMKV] + 1024 * 512, 512, 0, 256, a.in[I_MEMNORM] + 1024, WM, 256, scr, r, lane); continue; } r -= I5;
            if (r < I5) { p0_transpose_item(a.in[I_WMEMKV] + 1024 * 512, 512, 256, 256, a.in[I_MEMNORM] + 1024, WM, 768, scr, r, lane); continue; } r -= I5;
            if (r < I6) { p0_transpose_item(a.in[I_AW2], 768, 0, 768, nullptr, W2T, 0, scr, r, lane, 64); continue; } r -= I6;
            p0_transpose_item(a.in[I_AA2], 768, 0, 768, nullptr, A2T, 0, scr, r, lane, 64);
        }
    } else {
        constexpr int NITEMS = I1 + I2 + 2 * I3;
        for (int it = gw; it < NITEMS; it += NGW) {
            int r = it;
            if (r < I1) { p0_transpose_item(a.in[I_BWIN], 2048, 0, 2048, a.in[I_PRE] + 1024, WB, 0, scr, r, lane); continue; } r -= I1;
            if (r < I2) { p0_transpose_item(a.in[I_WKV], 1536, 0, 1536, a.in[I_KVNORM], WB, 2048, scr, r, lane); continue; } r -= I2;
            if (r < I3) { p0_transpose_item(a.in[I_WOUT], 1024, 0, 1024, nullptr, WO, 0, scr, r, lane); continue; } r -= I3;
            p0_transpose_item(a.in[I_WOUT] + 1024 * 1024, 1024, 0, 1024, nullptr, WO + 1024 * 1024, 0, scr, r, lane);
        }
    }
}
__device__ __forceinline__ void phase_prologue(const Args& a, LAS unsigned char* lds) {
    const int tid = threadIdx.x, lane = tid & 63, wave = __builtin_amdgcn_readfirstlane(tid >> 6);
    const int G = gridDim.x, gw = blockIdx.x * 8 + wave, NGW = G * 8;
    unsigned char* ws = a.ws;
    bf16* WA = (bf16*)(ws + WS_WA);
    transpose_group<0>(a, lds, gw, NGW);
    { u32x4* z = (u32x4*)(WA + (size_t)3712 * 1024); const int nz = 128 * 1024 * 2 / 16;
      for (int i = blockIdx.x * 512 + tid; i < nz; i += G * 512) z[i] = (u32x4){0u, 0u, 0u, 0u}; }
    bf16* XN = (bf16*)(ws + WS_XN); bf16* MEMN = (bf16*)(ws + WS_MEMN);
    for (int m = gw; m < MTOK + MROWS; m += NGW) {
        if (m < MTOK) rms_row_to_bf16(a.in[I_X] + (size_t)m * DM, XN + (size_t)m * DM, lane);
        else rms_row_to_bf16(a.in[I_MEM] + (size_t)(m - MTOK) * DM, MEMN + (size_t)(m - MTOK) * DM, lane);
    }
}

__device__ __forceinline__ void run_gemm(LAS unsigned char* lds, const bf16* A, const bf16* Bt, int M, int N, void* O, int ldc, int f32out, int shift, unsigned* km) {
    const int G = gridDim.x;
    pg8::Gemm g{A, Bt, M, N, 1024};
    pg8::StaticOrder S; S.init(M, N, G, (int)((blockIdx.x + G - shift) % G));
    pg8::EpiStore E{O, ldc, f32out, km};
    pg8::gemm_phase<pg8::EpiStore, pg8::StaticOrder>(lds, g, S, E);
}
template <int LAYER>
__device__ __forceinline__ void phase_outproj(const Args& a, LAS unsigned char* lds) {
    unsigned char* ws = a.ws; const int G = gridDim.x;
    pg8::Gemm g{(const bf16*)(ws + WS_CAT), (const bf16*)(ws + WS_WO) + (size_t)LAYER * 1024 * 1024, MTOK, 1024, 1024};
    pg8::StaticOrder S; S.init(MTOK, 1024, G, (int)blockIdx.x);
    pg8::EpiFused E{a.in[I_X], LAYER ? (const bf16*)(ws + WS_X1B) : nullptr, a.out, LAYER ? nullptr : (bf16*)(ws + WS_X1B), LAYER ? nullptr : (bf16*)(ws + WS_XN), a.in[I_POST] + LAYER * DM,
                    (float*)(ws + WS_XCH) + (size_t)LAYER * 2 * 64 * 4 * 256, (unsigned*)(ws + WS_XCNT) + LAYER * 2 * 64 * 16};
    pg8::gemm_phase<pg8::EpiFused, pg8::StaticOrder, true>(lds, g, S, E);
}
__device__ __forceinline__ void phase_gemm(const Args& a, LAS unsigned char* lds, int first, int count) {
    unsigned char* ws = a.ws;
    for (int j = first; j < first + count; ++j) {
        const bf16* A; const bf16* Bt; int M, N, ldc, f32o, shift; void* O;
        switch (j) {
        case 0: A = (const bf16*)(ws + WS_XN); Bt = (const bf16*)(ws + WS_WA); M = MTOK; N = 3840; O = ws + WS_PROJ; ldc = LDP0; f32o = 0; shift = 0; break;
        case 1: A = (const bf16*)(ws + WS_MEMN); Bt = (const bf16*)(ws + WS_WM); M = MROWS; N = 512; O = ws + WS_MK; ldc = 512; f32o = 0; shift = 192; break;
        case 2: A = (const bf16*)(ws + WS_WM) + 512 * 1024; Bt = (const bf16*)(ws + WS_MEMN); M = 512; N = MROWS; O = ws + WS_MVT; ldc = MROWS; f32o = 0; shift = 208; break;
        case 3: A = (const bf16*)(ws + WS_CAT); Bt = (const bf16*)(ws + WS_WO); M = MTOK; N = 1024; O = ws + WS_Y; ldc = 1024; f32o = 0; shift = 0; break;
        case 4: A = (const bf16*)(ws + WS_XN); Bt = (const bf16*)(ws + WS_WB); M = MTOK; N = 2816; O = ws + WS_PROJ; ldc = LDP1; f32o = 0; shift = 0; break;
        case 5: A = (const bf16*)(ws + WS_WB) + 2816 * 1024; Bt = (const bf16*)(ws + WS_XN); M = 768; N = MTOK; O = ws + WS_VT; ldc = MTOK; f32o = 0; shift = 192; break;
        default: A = (const bf16*)(ws + WS_CAT); Bt = (const bf16*)(ws + WS_WO) + 1024 * 1024; M = MTOK; N = 1024; O = ws + WS_Y; ldc = 1024; f32o = 0; shift = 0; break;
        }
        run_gemm(lds, A, Bt, M, N, O, ldc, f32o, shift, (j == 4) ? (unsigned*)(ws + WS_KM) : nullptr);
    }
}

constexpr int AT_PITCH = 72;
template <int NMAP>
__device__ __forceinline__ void attn_unit(LAS unsigned char* lds, const bf16* Qp, int ldq, const bf16* Kp, int ldk, const bf16* VTp, int ldvt,
                                          int nkt_lo, int nkt_hi, float slope2, int tq0,
                                          const bf16* Gp, int ldg, bf16* Op, int ldo, const float* subln, float lam, float oscale, const unsigned* kmp = nullptr) {
    constexpr int EV = 64 * NMAP, NET = EV / 16;
    const int tid = threadIdx.x, lane = tid & 63, wave = __builtin_amdgcn_readfirstlane(tid >> 6), g = lane >> 4, c = lane & 15;
    constexpr int AT_BUF = NMAP * 64 * AT_PITCH * 2 + EV * AT_PITCH * 2;
    const int nkt = (wave < 4) ? nkt_lo : nkt_hi;
    const int qrow = 16 * wave + c;
    bf16x8 qf[NMAP][2];
#pragma unroll
    for (int mp = 0; mp < NMAP; ++mp)
#pragma unroll
        for (int ks = 0; ks < 2; ++ks) qf[mp][ks] = *(const bf16x8*)(Qp + (size_t)qrow * ldq + mp * 64 + 32 * ks + 8 * g);
    f32x4 o[NMAP][NET];
#pragma unroll
    for (int mp = 0; mp < NMAP; ++mp)
#pragma unroll
        for (int et = 0; et < NET; ++et) o[mp][et] = (f32x4){0.f, 0.f, 0.f, 0.f};
    float mrun[NMAP], lrun[NMAP];
#pragma unroll
    for (int mp = 0; mp < NMAP; ++mp) { mrun[mp] = -1e30f; lrun[mp] = 0.f; }
    const float sc2 = 0.125f * LOG2E;
    const float tq = (float)(tq0 + qrow);
    float ubq[NMAP];
    LAS unsigned* votes = (LAS unsigned*)(lds + 2 * AT_BUF);
    if (NMAP == 2) {
#pragma unroll
        for (int mp = 0; mp < NMAP; ++mp) {
            float k2 = 0.f;
#pragma unroll
            for (int pc = 0; pc < 8; ++pc) k2 += __builtin_bit_cast(float, kmp[mp * 8 + pc]);
            float q2 = 0.f;
#pragma unroll
            for (int ks = 0; ks < 2; ++ks) { const u32x4 qq = __builtin_bit_cast(u32x4, qf[mp][ks]);
#pragma unroll
                for (int e = 0; e < 4; ++e) { const float a0 = bflo(qq[e]), a1 = bfhi(qq[e]); q2 += a0 * a0 + a1 * a1; } }
            q2 = rows_sum(q2);
            ubq[mp] = sqrtf(q2 * k2) * sc2 * 1.001f + 1e-3f;
        }
    }
    u32x4 kreg[2][NMAP], vreg[2][NMAP];
#define AT_LOAD(SET, kt) do { _Pragma("unroll") for (int i = 0; i < NMAP; ++i) { const int id = tid + 512 * i; \
        { const int mp = id >> 9, n = (id >> 3) & 63, ch = id & 7; kreg[SET][i] = *(const u32x4*)(Kp + (size_t)((kt) * 64 + n) * ldk + mp * 64 + 8 * ch); } \
        { const int e = id >> 3, ch = id & 7; vreg[SET][i] = *(const u32x4*)(VTp + (size_t)e * ldvt + (kt) * 64 + 8 * ch); } } } while (0)
#define AT_STORE(SET) do { LAS bf16* Ks = (LAS bf16*)(lds + (SET) * AT_BUF); LAS bf16* Vs = (LAS bf16*)(lds + (SET) * AT_BUF + NMAP * 64 * AT_PITCH * 2); \
        _Pragma("unroll") for (int i = 0; i < NMAP; ++i) { const int id = tid + 512 * i; \
        { const int mp = id >> 9, n = (id >> 3) & 63, ch = id & 7; *(LAS u32x4*)(Ks + (mp * 64 + n) * AT_PITCH + 8 * ch) = kreg[SET][i]; } \
        { const int e = id >> 3, ch = id & 7; *(LAS u32x4*)(Vs + e * AT_PITCH + 8 * ch) = vreg[SET][i]; } } } while (0)
    u32x2 gpre[NET];
#pragma unroll
    for (int et = 0; et < NET; ++et) gpre[et] = *(const u32x2*)(Gp + (size_t)qrow * ldg + 16 * et + 4 * g);
    AT_LOAD(0, nkt_hi - 1);
    if (nkt_hi > 1) AT_LOAD(1, nkt_hi - 2);
    __syncthreads();
    AT_STORE(0);
    if (nkt_hi > 2) AT_LOAD(0, nkt_hi - 3);
    __syncthreads();
    for (int it = 0; it < nkt_hi; ++it) {
        const int kt = nkt_hi - 1 - it;
        if (NMAP == 2 && it > 0) {
            const LAS unsigned* vv = votes + ((it - 1) & 1) * 8;
            if ((vv[0] & vv[1] & vv[2] & vv[3] & vv[4] & vv[5] & vv[6] & vv[7]) != 0u) break;
        }
        if (kt > 0) { if (it & 1) { AT_STORE(0); if (kt > 2) AT_LOAD(0, kt - 3); } else { AT_STORE(1); if (kt > 2) AT_LOAD(1, kt - 3); } }
        const LAS bf16* Ks = (const LAS bf16*)(lds + (it & 1) * AT_BUF); const LAS bf16* Vs = (const LAS bf16*)(lds + (it & 1) * AT_BUF + NMAP * 64 * AT_PITCH * 2);
        if (kt < nkt) {
            f32x4 bias[4];
#pragma unroll
            for (int k16 = 0; k16 < 4; ++k16)
#pragma unroll
                for (int j = 0; j < 4; ++j) bias[k16][j] = -slope2 * fabsf(tq - (float)(kt * 64 + 16 * k16 + 4 * g + j));
            bf16x8 pf[NMAP][2]; bool any = false;
#pragma unroll
            for (int mp = 0; mp < NMAP; ++mp) {
                f32x4 st[4];
#pragma unroll
                for (int k16 = 0; k16 < 4; ++k16) {
                    f32x4 acc = (f32x4){0.f, 0.f, 0.f, 0.f};
#pragma unroll
                    for (int ks = 0; ks < 2; ++ks) { const bf16x8 ka = *(const LAS bf16x8*)(Ks + (mp * 64 + 16 * k16 + c) * AT_PITCH + 32 * ks + 8 * g);
                        acc = __builtin_amdgcn_mfma_f32_16x16x32_bf16(ka, qf[mp][ks], acc, 0, 0, 0); }
                    st[k16] = acc * sc2 + bias[k16];
                }
                float m4[4];
#pragma unroll
                for (int k16 = 0; k16 < 4; ++k16) m4[k16] = fmaxf(fmaxf(st[k16].x, st[k16].y), fmaxf(st[k16].z, st[k16].w));
                float mx = fmaxf(fmaxf(m4[0], m4[1]), fmaxf(m4[2], m4[3]));
                mx = rows_max(mx);
                if (__builtin_amdgcn_ballot_w64(mx > mrun[mp] - 40.f) != 0ull) {
                    any = true;
                    const float mnew = fmaxf(mrun[mp], mx), alpha = __builtin_amdgcn_exp2f(mrun[mp] - mnew);
                    mrun[mp] = mnew;
                    float ps = 0.f;
#pragma unroll
                    for (int k16 = 0; k16 < 4; ++k16)
#pragma unroll
                        for (int j = 0; j < 4; ++j) { const float p = __builtin_amdgcn_exp2f(st[k16][j] - mnew); st[k16][j] = p; ps += p; }
                    lrun[mp] = lrun[mp] * alpha + ps;
                    if (__builtin_amdgcn_ballot_w64(alpha != 1.f) != 0ull) {
#pragma unroll
                        for (int et = 0; et < NET; ++et) o[mp][et] = o[mp][et] * alpha;
                    }
#pragma unroll
                    for (int i = 0; i < 2; ++i) { u32x4 w; w.x = pk2(st[2 * i][0], st[2 * i][1]); w.y = pk2(st[2 * i][2], st[2 * i][3]); w.z = pk2(st[2 * i + 1][0], st[2 * i + 1][1]); w.w = pk2(st[2 * i + 1][2], st[2 * i + 1][3]);
                        pf[mp][i] = __builtin_bit_cast(bf16x8, w); }
                } else {
                    pf[mp][0] = (bf16x8){0, 0, 0, 0, 0, 0, 0, 0}; pf[mp][1] = (bf16x8){0, 0, 0, 0, 0, 0, 0, 0};
                }
            }
            if (any) {
#pragma unroll
                for (int et = 0; et < NET; ++et)
#pragma unroll
                    for (int i = 0; i < 2; ++i) {
                        const u32x2 lo = *(const LAS u32x2*)(Vs + (16 * et + c) * AT_PITCH + 32 * i + 4 * g);
                        const u32x2 hi = *(const LAS u32x2*)(Vs + (16 * et + c) * AT_PITCH + 32 * i + 16 + 4 * g);
                        const bf16x8 va = __builtin_bit_cast(bf16x8, (u32x4){lo.x, lo.y, hi.x, hi.y});
#pragma unroll
                        for (int mp = 0; mp < NMAP; ++mp) o[mp][et] = __builtin_amdgcn_mfma_f32_16x16x32_bf16(va, pf[mp][i], o[mp][et], 0, 0, 0);
                    }
            }
        }
        if (NMAP == 2) {
            const float dmin = fmaxf(tq - (float)(64 * kt - 1), 0.f);
            bool neg = true;
#pragma unroll
            for (int mp = 0; mp < NMAP; ++mp) neg = neg && (ubq[mp] - slope2 * dmin < mrun[mp] - 40.f);
            const bool all = (__builtin_amdgcn_ballot_w64(neg) == ~0ull);
            if (lane == 0) votes[(it & 1) * 8 + wave] = all ? 1u : 0u;
        }
        __syncthreads();
    }
#undef AT_LOAD
#undef AT_STORE
    float inv[NMAP];
#pragma unroll
    for (int mp = 0; mp < NMAP; ++mp) { const float l = rows_sum(lrun[mp]); inv[mp] = 1.f / l; }
    f32x4 r[NET]; float ss = 0.f;
#pragma unroll
    for (int et = 0; et < NET; ++et) {
        if (NMAP == 2) r[et] = o[0][et] * inv[0] - o[NMAP - 1][et] * (lam * inv[NMAP - 1]);
        else r[et] = o[0][et] * inv[0];
        ss += (r[et].x * r[et].x + r[et].y * r[et].y) + (r[et].z * r[et].z + r[et].w * r[et].w);
    }
    float rs = 1.f;
    if (NMAP == 2) { ss = rows_sum(ss); rs = oscale / sqrtf(ss * (1.f / EV) + NORM_EPS); }
#pragma unroll
    for (int et = 0; et < NET; ++et) {
        const int e = 16 * et + 4 * g;
        const u32x2 gv = gpre[et];
        f32x4 v = r[et] * rs;
        if (NMAP == 2) v = v * *(const f32x4*)(subln + e);
        v.x *= siluf_(bflo(gv.x)); v.y *= siluf_(bfhi(gv.x)); v.z *= siluf_(bflo(gv.y)); v.w *= siluf_(bfhi(gv.y));
        u32x2 w; w.x = pk2(v.x, v.y); w.y = pk2(v.z, v.w);
        *(u32x2*)(Op + (size_t)qrow * ldo + e) = w;
    }
    __syncthreads();
}

__device__ __forceinline__ void mem_attn_unit(const Args& a, LAS unsigned char* lds, int l, int u) {
    unsigned char* ws = a.ws;
    const int b = u >> 6, h = (u >> 4) & 3, qb = u & 15;
    const bf16* PROJ = (const bf16*)(ws + WS_PROJ);
    const int ldp = l ? LDP1 : LDP0, cq = l ? C_QM1 : C_QM0, cg_ = l ? C_GM1 : C_GM0;
    const size_t row0 = (size_t)b * SEQ + qb * 128;
    attn_unit<1>(lds, PROJ + row0 * ldp + cq + h * 64, ldp,
                 (const bf16*)(ws + WS_MK) + (size_t)b * MEML * 512 + l * 256 + h * 64, 512,
                 (const bf16*)(ws + WS_MVT) + (size_t)(l * 256 + h * 64) * MROWS + b * MEML, MROWS,
                 4, 4, 0.f, 0,
                 PROJ + row0 * ldp + cg_ + h * 64, ldp, (bf16*)(ws + WS_CAT) + row0 * DM + BRW + h * 64, DM, nullptr, 0.f, 1.f);
}

typedef _Float16 f16x4_t __attribute__((ext_vector_type(4)));
__device__ __forceinline__ void lora_item(const Args& a, LAS unsigned char* lds, int b, int cgp) {
    const int tid = threadIdx.x, lane = tid & 63, wave = __builtin_amdgcn_readfirstlane(tid >> 6), g = lane >> 4, c = lane & 15;
    unsigned char* ws = a.ws;
    const bf16* PROJ = (const bf16*)(ws + WS_PROJ);
    const size_t mb = (size_t)b * SEQ; const int t0 = 64 * cgp;
    LAS bf16* AW = (LAS bf16*)lds; LAS bf16* AA = AW + 64 * 72;
    const float* mu = a.in[I_AMU];
#pragma unroll
    for (int r = 0; r < 2; ++r) {
        const int i = tid + 512 * r, tok = i >> 4, ch = i & 15;
        const bf16* cur = PROJ + (mb + t0 + tok) * LDP0 + C_WD + 8 * ch; const bf16* prv = (t0 + tok == 0) ? cur : cur - LDP0; const float pz = (t0 + tok == 0) ? 0.f : 1.f;
        const u32x4 zc = *(const u32x4*)cur, zp = *(const u32x4*)prv;
        const f32x4 m0 = *(const f32x4*)(mu + C_WD + 8 * ch), m1 = *(const f32x4*)(mu + C_WD + 8 * ch + 4);
        float x[8];
#pragma unroll
        for (int e = 0; e < 4; ++e) {
            const float ma = (e < 2) ? m0[2 * e] : m1[2 * e - 4], mb_ = (e < 2) ? m0[2 * e + 1] : m1[2 * e - 3];
            float z0 = bflo(zc[e]), z1 = bfhi(zc[e]);
            z0 = z0 + (bflo(zp[e]) * pz - z0) * ma; z1 = z1 + (bfhi(zp[e]) * pz - z1) * mb_;
            if (ch < 8) { z0 = 1.f - 2.f * __builtin_amdgcn_rcpf(1.f + __builtin_amdgcn_exp2f(2.8853900817779268f * z0)); z1 = 1.f - 2.f * __builtin_amdgcn_rcpf(1.f + __builtin_amdgcn_exp2f(2.8853900817779268f * z1)); }
            x[2 * e] = z0; x[2 * e + 1] = z1;
        }
        u32x4 w; w.x = pk2(x[0], x[1]); w.y = pk2(x[2], x[3]); w.z = pk2(x[4], x[5]); w.w = pk2(x[6], x[7]);
        *(LAS u32x4*)(((ch < 8) ? AW : AA) + tok * 72 + 8 * (ch & 7)) = w;
    }
    __syncthreads();
    const int mtp = wave & 1, gq = wave >> 1;
    const bf16* W2T = (const bf16*)(ws + WS_W2T); const bf16* A2T = W2T + 768 * 64;
    _Float16* LD16 = (_Float16*)(ws + WS_LD16); bf16* A16 = (bf16*)(ws + WS_A16);
    bf16x8 Aw[2][2], Aa[2][2];
#pragma unroll
    for (int mt = 0; mt < 2; ++mt)
#pragma unroll
        for (int ks = 0; ks < 2; ++ks) { Aw[mt][ks] = *(const LAS bf16x8*)(AW + (32 * mtp + 16 * mt + c) * 72 + 32 * ks + 8 * g); Aa[mt][ks] = *(const LAS bf16x8*)(AA + (32 * mtp + 16 * mt + c) * 72 + 32 * ks + 8 * g); }
    const f32x4 Z4 = {0.f, 0.f, 0.f, 0.f};
    for (int gi = 0; gi < 3; ++gi) {
        const int colb = 64 * (3 * gq + gi) + 4 * c;
        const f32x4 w0v = *(const f32x4*)(a.in[I_AW0] + colb), a0v = *(const f32x4*)(a.in[I_AA0] + colb);
        f32x4 accw[2][4], acca[2][4];
#pragma unroll
        for (int q = 0; q < 4; ++q) {
            const bf16x8 bw0 = *(const bf16x8*)(W2T + (size_t)(colb + q) * 64 + 8 * g), bw1 = *(const bf16x8*)(W2T + (size_t)(colb + q) * 64 + 32 + 8 * g);
            const bf16x8 ba0 = *(const bf16x8*)(A2T + (size_t)(colb + q) * 64 + 8 * g), ba1 = *(const bf16x8*)(A2T + (size_t)(colb + q) * 64 + 32 + 8 * g);
#pragma unroll
            for (int mt = 0; mt < 2; ++mt) {
                accw[mt][q] = __builtin_amdgcn_mfma_f32_16x16x32_bf16(Aw[mt][0], bw0, Z4, 0, 0, 0); accw[mt][q] = __builtin_amdgcn_mfma_f32_16x16x32_bf16(Aw[mt][1], bw1, accw[mt][q], 0, 0, 0);
                acca[mt][q] = __builtin_amdgcn_mfma_f32_16x16x32_bf16(Aa[mt][0], ba0, Z4, 0, 0, 0); acca[mt][q] = __builtin_amdgcn_mfma_f32_16x16x32_bf16(Aa[mt][1], ba1, acca[mt][q], 0, 0, 0);
            }
        }
#pragma unroll
        for (int mt = 0; mt < 2; ++mt)
#pragma unroll
            for (int j = 0; j < 4; ++j) {
                const size_t m = mb + t0 + 32 * mtp + 16 * mt + 4 * g + j;
                f16x4_t ld; float av[4];
#pragma unroll
                for (int q = 0; q < 4; ++q) { ld[q] = (_Float16)(-0.8750322163622201f * sigmoidf_(w0v[q] + accw[mt][q][j])); av[q] = sigmoidf_(a0v[q] + acca[mt][q][j]); }
                *(f16x4_t*)(LD16 + m * 768 + colb) = ld;
                *(u32x2*)(A16 + m * 768 + colb) = (u32x2){pk2(av[0], av[1]), pk2(av[2], av[3])};
            }
    }
    asm volatile("s_waitcnt vmcnt(0)" ::: "memory");
    __syncthreads();
    if (tid == 0) { __builtin_amdgcn_fence(__ATOMIC_RELEASE, "agent"); asm volatile("s_waitcnt vmcnt(0)" ::: "memory");
        (void)__hip_atomic_fetch_add((unsigned*)ws + CW_LORA, 1u, __ATOMIC_RELAXED, __HIP_MEMORY_SCOPE_AGENT); }
}

constexpr int SK_SLOT = 15360, SK_NT = 0, SK_RT = 2304, SK_BP = 4608, SK_KP = 7168, SK_VT = 9728, SK_PC = 12288, SK_LK = 12544, SK_TT = 13184, SK_MB = 13824, SK_MK = 14464;
constexpr int SK_SCR = 3 * SK_SLOT, SK_SCRW = 7680, SK_BS = 0, SK_KS = 2304, SK_LB = 4608, SK_VM = 5632;
constexpr int SK_P72 = 72, SK_P20 = 20;
constexpr int SK_PRM = SK_SCR + 4 * SK_SCRW, SK_W2L = SK_PRM, SK_A2L = SK_PRM + 9216, SK_PF = SK_PRM + 18432;
enum { PF_W0 = 0, PF_A0, PF_KK, PF_KA, PF_RK, PF_MUR, PF_MUK, PF_MUWD, PF_MUAD, PF_MUV };
__device__ __forceinline__ bf16x8 lds2x8(const LAS bf16* p, int offa, int offb) { const u32x2 a = *(const LAS u32x2*)(p + offa), b = *(const LAS u32x2*)(p + offb); return __builtin_bit_cast(bf16x8, (u32x4){a.x, a.y, b.x, b.y}); }
__device__ __forceinline__ bf16x8 lds8z(const LAS bf16* p, int offa) { const u32x2 a = *(const LAS u32x2*)(p + offa); return __builtin_bit_cast(bf16x8, (u32x4){a.x, a.y, 0u, 0u}); }
__device__ __forceinline__ void scan_unit(const Args& a, LAS unsigned char* lds, int b, int h) {
    const int tid = threadIdx.x, lane = tid & 63, wave = __builtin_amdgcn_readfirstlane(tid >> 6), g = lane >> 4, c = lane & 15;
    unsigned char* ws = a.ws;
    const bf16* PROJ = (const bf16*)(ws + WS_PROJ);
    bf16* CAT = (bf16*)(ws + WS_CAT);
    const size_t mb = (size_t)b * SEQ;
    constexpr int NBLK = SEQ / 16;
    const f32x4 Z4 = {0.f, 0.f, 0.f, 0.f};
    {
        const bf16* W2T = (const bf16*)(ws + WS_W2T);
        for (int i = tid; i < 2 * 64 * 8; i += 512) { const int m = i >> 9, key = (i >> 3) & 63, ch = i & 7;
            const u32x4 v = *(const u32x4*)(W2T + (size_t)m * 768 * 64 + (size_t)(h * 64 + key) * 64 + 8 * ch);
            *(LAS u32x4*)(lds + (m ? SK_A2L : SK_W2L) + (((key & 3) * 16 + (key >> 2)) * SK_P72 + 8 * ch) * 2) = v; }
        for (int i = tid; i < 10 * 64; i += 512) { const int w = i >> 6, k = i & 63; float v;
            switch (w) { case PF_W0: v = a.in[I_AW0][h * 64 + k]; break; case PF_A0: v = a.in[I_AA0][h * 64 + k]; break; case PF_KK: v = a.in[I_AKK][h * 64 + k]; break;
                         case PF_KA: v = a.in[I_AKA][h * 64 + k]; break; case PF_RK: v = a.in[I_ARK][h * 64 + k]; break; case PF_MUR: v = a.in[I_AMU][C_R + h * 64 + k]; break;
                         case PF_MUK: v = a.in[I_AMU][C_K + h * 64 + k]; break; case PF_MUWD: v = a.in[I_AMU][C_WD + k]; break; case PF_MUAD: v = a.in[I_AMU][C_AD + k]; break;
                         default: v = a.in[I_AMU][C_V + h * 64 + k]; break; }
            ((LAS float*)(lds + SK_PF))[i] = v; }
        if (tid == 0) { unsigned* cw = (unsigned*)ws + CW_LORA;
            while (__hip_atomic_load(cw, __ATOMIC_RELAXED, __HIP_MEMORY_SCOPE_AGENT) < gridDim.x) __builtin_amdgcn_s_sleep(2);
            __builtin_amdgcn_fence(__ATOMIC_ACQUIRE, "agent"); asm volatile("s_waitcnt vmcnt(0)" ::: "memory"); }
        __syncthreads();
    }
    if (wave < 4) {
        f32x4 St[4] = {Z4, Z4, Z4, Z4};
        for (int q = 0; q < 4; ++q) __syncthreads();
        for (int blk = 0; blk < NBLK; ++blk) {
            const LAS unsigned char* sl = lds + (blk % 3) * SK_SLOT;
            const LAS bf16* NT = (const LAS bf16*)(sl + SK_NT); const LAS bf16* RT = (const LAS bf16*)(sl + SK_RT);
            const LAS bf16* BP = (const LAS bf16*)(sl + SK_BP); const LAS bf16* KP = (const LAS bf16*)(sl + SK_KP);
            const LAS bf16* VT = (const LAS bf16*)(sl + SK_VT); const LAS float* PC = (const LAS float*)(sl + SK_PC);
            const LAS bf16* LK = (const LAS bf16*)(sl + SK_LK); const LAS bf16* TT = (const LAS bf16*)(sl + SK_TT);
            const LAS bf16* MB = (const LAS bf16*)(sl + SK_MB); const LAS bf16* MK = (const LAS bf16*)(sl + SK_MK);
            bf16x8 sbh[2];
#pragma unroll
            for (int ks = 0; ks < 2; ++ks) {
                const f32x4 x = St[2 * ks], y = St[2 * ks + 1];
                u32x4 hh; hh.x = pk2(x.x, x.y); hh.y = pk2(x.z, x.w); hh.z = pk2(y.x, y.y); hh.w = pk2(y.z, y.w);
                sbh[ks] = __builtin_bit_cast(bf16x8, hh);
            }
            const bf16x8 An0 = lds2x8(NT, c * SK_P72 + 4 * g, c * SK_P72 + 16 + 4 * g), An1 = lds2x8(NT, c * SK_P72 + 32 + 4 * g, c * SK_P72 + 48 + 4 * g);
            const bf16x8 Ar0 = lds2x8(RT, c * SK_P72 + 4 * g, c * SK_P72 + 16 + 4 * g), Ar1 = lds2x8(RT, c * SK_P72 + 32 + 4 * g, c * SK_P72 + 48 + 4 * g);
            const u32x2 vq = *(const LAS u32x2*)(VT + (16 * wave + c) * SK_P20 + 4 * g);
            const bf16x8 vlo = __builtin_bit_cast(bf16x8, (u32x4){vq.x, vq.y, 0u, 0u});
            const bf16x8 Alk = lds8z(LK, c * SK_P20 + 4 * g), At = lds8z(TT, c * SK_P20 + 4 * g);
            const bf16x8 Amk = lds2x8(MB, c * SK_P20 + 4 * g, (int)((SK_MK - SK_MB) / 2) + c * SK_P20 + 4 * g);
            f32x4 X = __builtin_amdgcn_mfma_f32_16x16x32_bf16(An0, sbh[0], Z4, 0, 0, 0);
            X = __builtin_amdgcn_mfma_f32_16x16x32_bf16(An1, sbh[1], X, 0, 0, 0);
            X = __builtin_amdgcn_mfma_f32_16x16x32_bf16(Alk, vlo, X, 0, 0, 0);
            f32x4 Y = __builtin_amdgcn_mfma_f32_16x16x32_bf16(Ar0, sbh[0], Z4, 0, 0, 0);
            Y = __builtin_amdgcn_mfma_f32_16x16x32_bf16(Ar1, sbh[1], Y, 0, 0, 0);
            const bf16x8 xb = __builtin_bit_cast(bf16x8, (u32x4){pk2(X.x, X.y), pk2(X.z, X.w), 0u, 0u});
            const f32x4 U = __builtin_amdgcn_mfma_f32_16x16x32_bf16(At, xb, Z4, 0, 0, 0);
            const bf16x8 ub = __builtin_bit_cast(bf16x8, (u32x4){pk2(U.x, U.y), pk2(U.z, U.w), vq.x, vq.y});
            Y = __builtin_amdgcn_mfma_f32_16x16x32_bf16(Amk, ub, Y, 0, 0, 0);
#pragma unroll
            for (int kt = 0; kt < 4; ++kt) {
                const f32x4 pc4 = *(const LAS f32x4*)(PC + 16 * kt + 4 * g);
                const bf16x8 Abk = lds2x8(BP, (16 * kt + c) * SK_P20 + 4 * g, (int)((SK_KP - SK_BP) / 2) + (16 * kt + c) * SK_P20 + 4 * g);
                St[kt] = __builtin_amdgcn_mfma_f32_16x16x32_bf16(Abk, ub, St[kt] * pc4, 0, 0, 0);
            }
            bf16* yp = CAT + (mb + (size_t)blk * 16 + 4 * g) * DM + h * 64 + 16 * wave + c;
            yp[0] = (bf16)f2bf(Y.x); yp[DM] = (bf16)f2bf(Y.y); yp[2 * DM] = (bf16)f2bf(Y.z); yp[3 * DM] = (bf16)f2bf(Y.w);
            __syncthreads();
        }
    } else {
        const int pw = wave - 4;
        const int kc = h * 64 + 4 * c;
        const LAS float* PF = (const LAS float*)(lds + SK_PF); const LAS bf16* W2L = (const LAS bf16*)(lds + SK_W2L); const LAS bf16* A2L = (const LAS bf16*)(lds + SK_A2L);
        LAS unsigned char* scr = lds + SK_SCR + pw * SK_SCRW;
        LAS bf16* BSs = (LAS bf16*)(scr + SK_BS); LAS bf16* KSs = (LAS bf16*)(scr + SK_KS); LAS float* LBs = (LAS float*)(scr + SK_LB);
        u32x4 zv[2], zvp[2]; u32x2 zr[4], zrp[4], zk[4], zkp[4], zl[4], za[4];
        const _Float16* LD16 = (const _Float16*)(ws + WS_LD16); const bf16* A16 = (const bf16*)(ws + WS_A16);
#define SK_LOAD_V(T0) do { \
        { const int sv_ = lane >> 2, cv_ = lane & 3; const bf16* cs = PROJ + (mb + (T0) + sv_) * LDP0; const bf16* ps = ((T0) + sv_ == 0) ? cs : cs - LDP0; \
          _Pragma("unroll") for (int i = 0; i < 2; ++i) { zv[i] = *(const u32x4*)(cs + C_V + h * 64 + 16 * cv_ + 8 * i); zvp[i] = *(const u32x4*)(ps + C_V + h * 64 + 16 * cv_ + 8 * i); } } } while (0)
#define SK_LOAD_S(T0, jj) do { const int s_ = 4 * g + (jj); const bf16* cs = PROJ + (mb + (T0) + s_) * LDP0; const bf16* ps = ((T0) + s_ == 0) ? cs : cs - LDP0; \
            zr[jj] = *(const u32x2*)(cs + C_R + kc); zrp[jj] = *(const u32x2*)(ps + C_R + kc); zk[jj] = *(const u32x2*)(cs + C_K + kc); zkp[jj] = *(const u32x2*)(ps + C_K + kc); \
            za[jj] = *(const u32x2*)(A16 + (mb + (T0) + s_) * 768 + kc); } while (0)
#define SK_LOAD_L(T0) do { _Pragma("unroll") for (int jj = 0; jj < 4; ++jj) zl[jj] = *(const u32x2*)(LD16 + (mb + (T0) + 4 * g + jj) * 768 + kc); } while (0)
        SK_LOAD_L(pw * 16); SK_LOAD_V(pw * 16);
#pragma unroll
        for (int jj = 0; jj < 4; ++jj) SK_LOAD_S(pw * 16, jj);
        for (int q = 0; q < pw; ++q) __syncthreads();
        for (int n = 0; n < NBLK / 4; ++n) {
            const int blk = 4 * n + pw, t0 = blk * 16, t0n = (blk + 4 < NBLK) ? t0 + 64 : t0;
            LAS unsigned char* sl = lds + (blk % 3) * SK_SLOT;
            int c_o = c; asm volatile("" : "+v"(c_o));
            {
                unsigned vm[8];
                const int sv = lane >> 2, cv = lane & 3; const float pz = (t0 + sv == 0) ? 0.f : 1.f;
#pragma unroll
                for (int i = 0; i < 2; ++i) {
                    const LAS float* mv = PF + PF_MUV * 64 + 16 * cv + 8 * i;
                    const f32x4 m0 = *(const LAS f32x4*)mv, m1 = *(const LAS f32x4*)(mv + 4);
#pragma unroll
                    for (int e = 0; e < 4; ++e) {
                        const unsigned uc = zv[i][e], up = zvp[i][e];
                        const float ma = (e < 2) ? m0[2 * e] : m1[2 * e - 4], mb_ = (e < 2) ? m0[2 * e + 1] : m1[2 * e - 3];
                        float z0 = bflo(uc), z1 = bfhi(uc);
                        z0 = z0 + (bflo(up) * pz - z0) * ma; z1 = z1 + (bfhi(up) * pz - z1) * mb_;
                        vm[4 * i + e] = pk2(z0, z1);
                    }
                }
                *(LAS u32x4*)(scr + SK_VM + lane * 32) = (u32x4){vm[0], vm[1], vm[2], vm[3]}; *(LAS u32x4*)(scr + SK_VM + lane * 32 + 16) = (u32x4){vm[4], vm[5], vm[6], vm[7]};
                SK_LOAD_V(t0n);
            }
            u32x2 ntp[4], rtp[4], bpp[4], kpp[4]; f32x4 pcv;
            {
                f32x4 dec[4], E4;
#pragma unroll
                for (int jj = 0; jj < 4; ++jj) { const f16x4_t l4 = __builtin_bit_cast(f16x4_t, zl[jj]);
#pragma unroll
                    for (int nt = 0; nt < 4; ++nt) dec[jj][nt] = __builtin_amdgcn_exp2f((float)l4[nt]); }
                SK_LOAD_L(t0n);
#pragma unroll
                for (int nt = 0; nt < 4; ++nt) {
                    const float p3 = (dec[0][nt] * dec[1][nt]) * (dec[2][nt] * dec[3][nt]);
                    const float q0 = __shfl(p3, c), q1 = __shfl(p3, c + 16), q2 = __shfl(p3, c + 32), q3 = __shfl(p3, c + 48);
                    E4[nt] = ((g > 0) ? q0 : 1.f) * ((g > 1) ? q1 : 1.f) * ((g > 2) ? q2 : 1.f);
                    pcv[nt] = (q0 * q1) * (q2 * q3);
                }
                const f32x4 p_kk = *(const LAS f32x4*)(PF + PF_KK * 64 + 4 * c), p_ka = *(const LAS f32x4*)(PF + PF_KA * 64 + 4 * c),
                            p_rk = *(const LAS f32x4*)(PF + PF_RK * 64 + 4 * c), mu_r = *(const LAS f32x4*)(PF + PF_MUR * 64 + 4 * c), mu_k = *(const LAS f32x4*)(PF + PF_MUK * 64 + 4 * c);
                f32x4 pex = E4, bprev, kprev;
#pragma unroll
                for (int jj = 0; jj < 4; ++jj) {
                    if (jj == 1 || jj == 3) __syncthreads();
                    const int s = 4 * g + jj;
                    const float pz = (t0 + s == 0) ? 0.f : 1.f;
                    const f32x4 pin = pex * dec[jj];
                    f32x4 rr, kp4, ku, aa;
                    const unsigned ur[2] = {zr[jj].x, zr[jj].y}, urp[2] = {zrp[jj].x, zrp[jj].y}, uk[2] = {zk[jj].x, zk[jj].y}, ukp[2] = {zkp[jj].x, zkp[jj].y}, ua[2] = {za[jj].x, za[jj].y};
                    SK_LOAD_S(t0n, jj);
                    float ssq = 0.f, bs = 0.f;
#pragma unroll
                    for (int nt = 0; nt < 4; ++nt) {
                        const float zc = (nt & 1) ? bfhi(ur[nt >> 1]) : bflo(ur[nt >> 1]), zp = ((nt & 1) ? bfhi(urp[nt >> 1]) : bflo(urp[nt >> 1])) * pz;
                        const float kc_ = (nt & 1) ? bfhi(uk[nt >> 1]) : bflo(uk[nt >> 1]), kp_ = ((nt & 1) ? bfhi(ukp[nt >> 1]) : bflo(ukp[nt >> 1])) * pz;
                        rr[nt] = zc + (zp - zc) * mu_r[nt];
                        const float kk = kc_ + (kp_ - kc_) * mu_k[nt];
                        aa[nt] = (nt & 1) ? bfhi(ua[nt >> 1]) : bflo(ua[nt >> 1]);
                        ku[nt] = kk * p_kk[nt];
                        ssq += ku[nt] * ku[nt];
                        kp4[nt] = kk * (1.f + (aa[nt] - 1.f) * p_ka[nt]);
                        bs += rr[nt] * kp4[nt] * p_rk[nt];
                    }
                    ssq = sum16(ssq); bs = sum16(bs);
                    if (c == 0) ((float*)(ws + WS_BS))[(mb + t0 + s) * AH + h] = bs;
                    const float rn = __builtin_amdgcn_rsqf(fmaxf(ssq, 1e-12f));
                    f32x4 rp; rp.x = __builtin_amdgcn_rcpf(pin.x); rp.y = __builtin_amdgcn_rcpf(pin.y); rp.z = __builtin_amdgcn_rcpf(pin.z); rp.w = __builtin_amdgcn_rcpf(pin.w);
                    const f32x4 kn = ku * rn;
                    const f32x4 nt_ = pex * (-kn), bt = kn * aa * rp, kt_ = kp4 * rp, rt = pin * rr;
                    const f32x4 bpc = bt * pcv, kpc = kt_ * pcv;
                    ntp[jj] = (u32x2){pk2(nt_.x, nt_.y), pk2(nt_.z, nt_.w)};
                    rtp[jj] = (u32x2){pk2(rt.x, rt.y), pk2(rt.z, rt.w)};
                    *(LAS u32x2*)(BSs + s * SK_P72 + 4 * c) = (u32x2){pk2(bt.x, bt.y), pk2(bt.z, bt.w)};
                    *(LAS u32x2*)(KSs + s * SK_P72 + 4 * c) = (u32x2){pk2(kt_.x, kt_.y), pk2(kt_.z, kt_.w)};
                    if (jj & 1) {
#pragma unroll
                        for (int nt = 0; nt < 4; ++nt) { if (jj == 1) { bpp[nt].x = pk2(bprev[nt], bpc[nt]); kpp[nt].x = pk2(kprev[nt], kpc[nt]); } else { bpp[nt].y = pk2(bprev[nt], bpc[nt]); kpp[nt].y = pk2(kprev[nt], kpc[nt]); } }
                    } else { bprev = bpc; kprev = kpc; }
                    pex = pin;
                }
            }
            {
                LAS bf16* NT = (LAS bf16*)(sl + SK_NT); LAS bf16* RT = (LAS bf16*)(sl + SK_RT);
                LAS bf16* BP = (LAS bf16*)(sl + SK_BP); LAS bf16* KP = (LAS bf16*)(sl + SK_KP);
#pragma unroll
                for (int jj = 0; jj < 4; ++jj) { const int s = 4 * g + jj;
                    *(LAS u32x2*)(NT + s * SK_P72 + 4 * c) = ntp[jj]; *(LAS u32x2*)(RT + s * SK_P72 + 4 * c) = rtp[jj]; }
#pragma unroll
                for (int nt = 0; nt < 4; ++nt) { *(LAS u32x2*)(BP + (4 * c + nt) * SK_P20 + 4 * g) = bpp[nt]; *(LAS u32x2*)(KP + (4 * c + nt) * SK_P20 + 4 * g) = kpp[nt]; }
                if (g == 0) *(LAS f32x4*)((LAS float*)(sl + SK_PC) + 4 * c) = pcv;
                { const int sv = lane >> 2, cv = lane & 3; LAS bf16* VT = (LAS bf16*)(sl + SK_VT);
                  const u32x4 va_ = *(const LAS u32x4*)(scr + SK_VM + lane * 32), vb_ = *(const LAS u32x4*)(scr + SK_VM + lane * 32 + 16);
                  const unsigned vm[8] = {va_.x, va_.y, va_.z, va_.w, vb_.x, vb_.y, vb_.z, vb_.w};
#pragma unroll
                  for (int i = 0; i < 8; ++i) { VT[(16 * cv + 2 * i) * SK_P20 + sv] = (bf16)(vm[i] & 0xffffu); VT[(16 * cv + 2 * i + 1) * SK_P20 + sv] = (bf16)(vm[i] >> 16); } }
                asm volatile("s_waitcnt lgkmcnt(0)" ::: "memory");
                f32x4 Lb = Z4, Lk = Z4, Mb = Z4, Mk = Z4;
#pragma unroll
                for (int ks = 0; ks < 2; ++ks) {
                    const bf16x8 ab = *(const LAS bf16x8*)(BSs + c * SK_P72 + 32 * ks + 8 * g), ak = *(const LAS bf16x8*)(KSs + c * SK_P72 + 32 * ks + 8 * g);
                    const bf16x8 bn = *(const LAS bf16x8*)(NT + c * SK_P72 + 32 * ks + 8 * g), br = *(const LAS bf16x8*)(RT + c * SK_P72 + 32 * ks + 8 * g);
                    Lb = __builtin_amdgcn_mfma_f32_16x16x32_bf16(ab, bn, Lb, 0, 0, 0);
                    Lk = __builtin_amdgcn_mfma_f32_16x16x32_bf16(ak, bn, Lk, 0, 0, 0);
                    Mb = __builtin_amdgcn_mfma_f32_16x16x32_bf16(ab, br, Mb, 0, 0, 0);
                    Mk = __builtin_amdgcn_mfma_f32_16x16x32_bf16(ak, br, Mk, 0, 0, 0);
                }
#pragma unroll
                for (int j = 0; j < 4; ++j) { const int s = 4 * g + j; if (!(s < c)) { Lb[j] = 0.f; Lk[j] = 0.f; } if (!(s <= c)) { Mb[j] = 0.f; Mk[j] = 0.f; } }
                *(LAS u32x2*)((LAS bf16*)(sl + SK_LK) + c * SK_P20 + 4 * g) = (u32x2){pk2(Lk[0], Lk[1]), pk2(Lk[2], Lk[3])};
                *(LAS u32x2*)((LAS bf16*)(sl + SK_MB) + c * SK_P20 + 4 * g) = (u32x2){pk2(Mb[0], Mb[1]), pk2(Mb[2], Mb[3])};
                *(LAS u32x2*)((LAS bf16*)(sl + SK_MK) + c * SK_P20 + 4 * g) = (u32x2){pk2(Mk[0], Mk[1]), pk2(Mk[2], Mk[3])};
                *(LAS f32x4*)(LBs + c * 16 + 4 * g) = Lb;
            }
            __syncthreads();
            {
                float Ti[16];
#pragma unroll
                for (int t = 0; t < 16; ++t) {
                    float acc = (c_o == t) ? 1.f : 0.f;
                    if ((t & 3) == 0) asm volatile("" ::: "memory");
#pragma unroll
                    for (int s4 = 0; s4 < (t + 3) / 4; ++s4) {
                        const f32x4 l4 = *(const LAS f32x4*)(LBs + t * 16 + 4 * s4);
#pragma unroll
                        for (int e = 0; e < 4; ++e) if (4 * s4 + e < t) acc += Ti[4 * s4 + e] * l4[e];
                    }
                    Ti[t] = acc;
                }
                if (g == 0) {
                    LAS bf16* TT = (LAS bf16*)(sl + SK_TT);
#pragma unroll
                    for (int t = 0; t < 16; ++t) TT[t * SK_P20 + c] = (bf16)f2bf(Ti[t]);
                }
            }
            __syncthreads();
        }
#undef SK_LOAD_S
#undef SK_LOAD_L
#undef SK_LOAD_V
        for (int q = 0; q < 4 - pw; ++q) __syncthreads();
    }
}

constexpr int CW_HEAD = 12288;
__device__ __forceinline__ void head_publish(const Args& a, int u) {
    asm volatile("s_waitcnt vmcnt(0)" ::: "memory");
    __syncthreads();
    if (threadIdx.x == 0) {
        __builtin_amdgcn_fence(__ATOMIC_RELEASE, "agent");
        asm volatile("s_waitcnt vmcnt(0)" ::: "memory");
        __hip_atomic_store((unsigned*)a.ws + CW_HEAD + 16 * u, 1u, __ATOMIC_RELAXED, __HIP_MEMORY_SCOPE_AGENT);
    }
}
__device__ __forceinline__ void head_wait(const Args& a, int u) {
    if (threadIdx.x == 0) {
        unsigned* f = (unsigned*)a.ws + CW_HEAD + 16 * u;
        while (__hip_atomic_load(f, __ATOMIC_RELAXED, __HIP_MEMORY_SCOPE_AGENT) == 0u) __builtin_amdgcn_s_sleep(8);
        __builtin_amdgcn_fence(__ATOMIC_ACQUIRE, "agent");
        asm volatile("s_waitcnt vmcnt(0)" ::: "memory");
    }
    __syncthreads();
}
__device__ __forceinline__ void rwkv_post_item(const Args& a, int u, int sl) {
    const int tid = threadIdx.x, lane = tid & 63, wave = tid >> 6, tsub = lane >> 4, col = (u % 12) * 64 + 4 * (lane & 15);
    const int b = u / 12, h = u % 12;
    unsigned char* ws = a.ws;
    const bf16* PROJ = (const bf16*)(ws + WS_PROJ); bf16* CAT = (bf16*)(ws + WS_CAT); const float* BS = (const float*)(ws + WS_BS);
    const f32x4 lw = *(const f32x4*)(a.in[I_ALNW] + col), lb = *(const f32x4*)(a.in[I_ALNB] + col), mv = *(const f32x4*)(a.in[I_AMU] + C_V + col);
    for (int p0 = 0; p0 < 8; p0 += 2) {
        u32x2 yv[2], vc[2], vp[2], gt[2]; float bsv[2], pzv[2]; size_t mrow[2];
#pragma unroll
        for (int r = 0; r < 2; ++r) {
            const int t = 256 * sl + 32 * wave + 4 * (p0 + r) + tsub; const size_t m = (size_t)b * SEQ + t; mrow[r] = m;
            const bf16* pc = PROJ + m * LDP0; const bf16* pp = (t == 0) ? pc : pc - LDP0; pzv[r] = (t == 0) ? 0.f : 1.f;
            yv[r] = *(const u32x2*)(CAT + m * DM + col); vc[r] = *(const u32x2*)(pc + C_V + col); vp[r] = *(const u32x2*)(pp + C_V + col); gt[r] = *(const u32x2*)(pc + C_GATE0 + col);
            bsv[r] = BS[m * AH + h];
        }
#pragma unroll
        for (int r = 0; r < 2; ++r) {
            const float pz = pzv[r];
            float y[4] = {bflo(yv[r].x), bfhi(yv[r].x), bflo(yv[r].y), bfhi(yv[r].y)};
            const float mean = sum16((y[0] + y[1]) + (y[2] + y[3])) * (1.f / 64.f);
            float d[4], vs = 0.f;
#pragma unroll
            for (int j = 0; j < 4; ++j) { d[j] = y[j] - mean; vs += d[j] * d[j]; }
            const float rstd = 1.f / sqrtf(sum16(vs) * (1.f / 64.f) + LNX_EPS);
            const float vcur[4] = {bflo(vc[r].x), bfhi(vc[r].x), bflo(vc[r].y), bfhi(vc[r].y)};
            const float vprv[4] = {bflo(vp[r].x) * pz, bfhi(vp[r].x) * pz, bflo(vp[r].y) * pz, bfhi(vp[r].y) * pz};
            const float gg[4] = {bflo(gt[r].x), bfhi(gt[r].x), bflo(gt[r].y), bfhi(gt[r].y)};
            float o[4];
#pragma unroll
            for (int j = 0; j < 4; ++j) { const float v = vcur[j] + (vprv[j] - vcur[j]) * mv[j];
                o[j] = (d[j] * rstd * lw[j] + lb[j] + bsv[r] * v) * siluf_(gg[j]); }
            *(u32x2*)(CAT + mrow[r] * DM + col) = (u32x2){pk2(o[0], o[1]), pk2(o[2], o[3])};
        }
    }
}

__device__ __forceinline__ void phase_scan(const Args& a, LAS unsigned char* lds) {
    const int G = gridDim.x, bx = blockIdx.x;
    for (int it = bx; it < 256; it += G) lora_item(a, lds, it & 7, it >> 3);
    __syncthreads();
    if (bx < 96) { scan_unit(a, lds, bx / 12, bx % 12); head_publish(a, bx); }
    else { for (int u = bx - 96; u < 512; u += G - 96) mem_attn_unit(a, lds, 0, u);
           const int wave = __builtin_amdgcn_readfirstlane(threadIdx.x >> 6);
           transpose_group<1>(a, lds, (bx - 96) * 8 + wave, (G - 96) * 8); }
    for (int i = bx; i < 768; i += G) { const int u = i % 96; head_wait(a, u); rwkv_post_item(a, u, i / 96); }
}

__device__ __forceinline__ void phase_rwkv_post(const Args& a) {
    const int tid = threadIdx.x, lane = tid & 63, wave = tid >> 6, G = gridDim.x;
    unsigned char* ws = a.ws;
    const bf16* PROJ = (const bf16*)(ws + WS_PROJ); bf16* CAT = (bf16*)(ws + WS_CAT); const float* BS = (const float*)(ws + WS_BS);
    const float* mu = a.in[I_AMU];
    for (int m = blockIdx.x * 8 + wave; m < MTOK; m += G * 8) {
        const int t = m & (SEQ - 1);
        const bf16* pc = PROJ + (size_t)m * LDP0; const bf16* pp = (t == 0) ? pc : pc - LDP0; const float pz = (t == 0) ? 0.f : 1.f;
#pragma unroll
        for (int i = 0; i < 3; ++i) {
            const int col = 256 * i + 4 * lane, hh = col >> 6;
            const u32x2 yv = *(const u32x2*)(CAT + (size_t)m * DM + col);
            float y[4] = {bflo(yv.x), bfhi(yv.x), bflo(yv.y), bfhi(yv.y)};
            const float mean = sum16((y[0] + y[1]) + (y[2] + y[3])) * (1.f / 64.f);
            float d[4], vs = 0.f;
#pragma unroll
            for (int j = 0; j < 4; ++j) { d[j] = y[j] - mean; vs += d[j] * d[j]; }
            const float rstd = 1.f / sqrtf(sum16(vs) * (1.f / 64.f) + LNX_EPS);
            const f32x4 lw = *(const f32x4*)(a.in[I_ALNW] + col), lb = *(const f32x4*)(a.in[I_ALNB] + col), mv = *(const f32x4*)(mu + C_V + col);
            const u32x2 vc = *(const u32x2*)(pc + C_V + col), vp = *(const u32x2*)(pp + C_V + col), gt = *(const u32x2*)(pc + C_GATE0 + col);
            const float vcur[4] = {bflo(vc.x), bfhi(vc.x), bflo(vc.y), bfhi(vc.y)}, vprv[4] = {bflo(vp.x) * pz, bfhi(vp.x) * pz, bflo(vp.y) * pz, bfhi(vp.y) * pz};
            const float gg[4] = {bflo(gt.x), bfhi(gt.x), bflo(gt.y), bfhi(gt.y)};
            const float bs = BS[(size_t)m * AH + hh];
            float o[4];
#pragma unroll
            for (int j = 0; j < 4; ++j) { const float v = vcur[j] + (vprv[j] - vcur[j]) * mv[j];
                o[j] = (d[j] * rstd * lw[j] + lb[j] + bs * v) * siluf_(gg[j]); }
            u32x2 w; w.x = pk2(o[0], o[1]); w.y = pk2(o[2], o[3]);
            *(u32x2*)(CAT + (size_t)m * DM + col) = w;
        }
    }
}

template <int LAYER>
__device__ __forceinline__ void phase_rows(const Args& a) {
    const int tid = threadIdx.x, lane = tid & 63, wave = tid >> 6, G = gridDim.x;
    unsigned char* ws = a.ws;
    const bf16* Y = (const bf16*)(ws + WS_Y); const float* gpost = a.in[I_POST] + LAYER * DM;
    const float* xin = LAYER ? (const float*)a.out : a.in[I_X];
    bf16* XN = (bf16*)(ws + WS_XN);
    for (int m = blockIdx.x * 8 + wave; m < MTOK; m += G * 8) {
        const u32x2* yr = (const u32x2*)(Y + (size_t)m * DM) + lane; const f32x4* xr = (const f32x4*)(xin + (size_t)m * DM) + lane;
        f32x4 y[4], x[4]; float s = 0.f;
#pragma unroll
        for (int j = 0; j < 4; ++j) { const u32x2 yy = yr[64 * j]; y[j] = (f32x4){bflo(yy.x), bfhi(yy.x), bflo(yy.y), bfhi(yy.y)}; x[j] = xr[64 * j]; s += (y[j].x * y[j].x + y[j].y * y[j].y) + (y[j].z * y[j].z + y[j].w * y[j].w); }
        const float rs = 1.f / sqrtf(wave_sum(s) * (1.f / DM) + NORM_EPS);
        float s1 = 0.f;
        f32x4* orow = (f32x4*)(a.out + (size_t)m * DM) + lane;
#pragma unroll
        for (int j = 0; j < 4; ++j) { const f32x4 gp = *((const f32x4*)gpost + lane + 64 * j);
            x[j] = x[j] + y[j] * rs * gp; orow[64 * j] = x[j];
            s1 += (x[j].x * x[j].x + x[j].y * x[j].y) + (x[j].z * x[j].z + x[j].w * x[j].w); }
        if (LAYER == 0) {
            const float r1 = 1.f / sqrtf(wave_sum(s1) * (1.f / DM) + NORM_EPS);
            unsigned long long* o8 = (unsigned long long*)(XN + (size_t)m * DM) + lane;
#pragma unroll
            for (int j = 0; j < 4; ++j) o8[64 * j] = (unsigned long long)pk2(x[j].x * r1, x[j].y * r1) | ((unsigned long long)pk2(x[j].z * r1, x[j].w * r1) << 32);
        }
    }
}

constexpr int ATT_MAXU = 4;
__device__ const unsigned char att_deal[32][4] = {{32,31,94,8},{48,30,93,7},{33,29,90,81},{49,28,89,79},{34,27,86,74},{50,26,85,73},{35,25,82,66},{51,24,18,65},{36,23,12,1},{52,22,11,80},{37,21,2,255},{53,20,10,64},{38,19,9,16},{54,95,13,17},{39,92,4,255},{55,91,3,255},{40,88,76,255},{56,87,75,255},{41,84,70,255},{57,83,69,255},{42,15,68,255},{58,14,67,255},{43,6,255,255},{59,5,255,255},{44,78,255,255},{60,77,255,255},{45,72,255,255},{61,71,255,255},{46,0,255,255},{62,255,255,255},{47,255,255,255},{63,255,255,255}};
__device__ __forceinline__ void phase_attn1(const Args& a, LAS unsigned char* lds) {
    const int G = gridDim.x, bx = blockIdx.x, lane = threadIdx.x & 63;
    unsigned char* ws = a.ws;
    const float s1 = wave_sum(a.in[I_LQ1][lane] * a.in[I_LK1][lane]), s2 = wave_sum(a.in[I_LQ2][lane] * a.in[I_LK2][lane]);
    const float lam_init = 0.8f - 0.6f * 0.7408182206817179f;
    const float lam = __expf(s1) - __expf(s2) + lam_init;
    const bf16* PROJ = (const bf16*)(ws + WS_PROJ); const bf16* VT = (const bf16*)(ws + WS_VT); bf16* CAT = (bf16*)(ws + WS_CAT);
    const float slopes[6] = {0.25f, 0.0625f, 0.015625f, 0.00390625f, 0.5f, 0.125f};
    for (int i = 0; i < ATT_MAXU; ++i) {
        int qb, b, h;
        if (G == 256) { const int code = att_deal[bx >> 3][i]; if (code == 255) break; b = bx & 7; h = code >> 4; qb = code & 15; }
        else { const int n = i * G + bx; if (n >= 768) break; qb = 15 - n / 48; b = (n % 48) / 6; h = (n % 48) % 6; }
        const size_t row0 = (size_t)b * SEQ + qb * 128;
        float slope = slopes[0];
#pragma unroll
        for (int k = 1; k < 6; ++k) slope = (h == k) ? slopes[k] : slope;
        attn_unit<2>(lds, PROJ + row0 * LDP1 + C_Q1 + h * 128, LDP1,
                     PROJ + (size_t)b * SEQ * LDP1 + C_KSH + h * 128, LDP1,
                     VT + (size_t)(h * 128) * MTOK + (size_t)b * SEQ, MTOK,
                     2 * qb + 1, 2 * qb + 2, slope * LOG2E, qb * 128,
                     PROJ + row0 * LDP1 + C_GATE1 + h * 128, LDP1, CAT + row0 * DM + h * 128, DM, a.in[I_SUBLN], lam, 1.f - lam_init, (const unsigned*)(ws + WS_KM) + (b * 6 + h) * 16);
    }
    for (int u = bx; u < 512; u += G) mem_attn_unit(a, lds, 1, u);
}

constexpr int CW_XB = 8192;
#define XB_TMO      128
#define XB_XCNT(j)  (256  + 64 * (j))
#define XB_XSUB(j)  (1280 + 64 * (j))
#define XB_XGEN(j)  (2304 + 64 * (j))
#define XB_TOP      3328
#define XB_TOPGEN   3392
#define XB_SPIN_CAP (1u << 22)
__device__ __forceinline__ unsigned xb_ld(unsigned* p)              { return __hip_atomic_load(p, __ATOMIC_RELAXED, __HIP_MEMORY_SCOPE_AGENT); }
__device__ __forceinline__ unsigned xb_add(unsigned* p, unsigned v) { return __hip_atomic_fetch_add(p, v, __ATOMIC_RELAXED, __HIP_MEMORY_SCOPE_AGENT); }
__device__ __forceinline__ unsigned xb_xcc_id() { return (unsigned)__builtin_amdgcn_s_getreg((3 << 11) | 20) & 0xFu; }
#define XB_SPIN(cond, bar) do { unsigned _sp = 0; while (cond) { __builtin_amdgcn_s_sleep(1); \
    if ((++_sp & 255u) == 0u) { if (xb_ld(&(bar)[XB_TMO])) break; if (_sp > XB_SPIN_CAP) { atomicAdd(&(bar)[XB_TMO], 1u); break; } } } } while (0)
struct XcdBarrier { unsigned* bar; unsigned x; volatile LAS unsigned* st; };
__device__ __forceinline__ XcdBarrier xcd_barrier_post(unsigned* bar, volatile LAS unsigned* st) {
    XcdBarrier b; b.bar = bar; b.x = xb_xcc_id(); b.st = st;
    if (threadIdx.x == 0) (void)xb_add(&bar[XB_XCNT(b.x)], 1u);
    return b;
}
__device__ __forceinline__ void xcd_barrier_complete(unsigned* bar, unsigned x, unsigned& nloc, unsigned& nx) {
    const unsigned G = gridDim.x * gridDim.y * gridDim.z;
    unsigned sum, cnt, mine, sp = 0u;
    for (;;) {
        sum = 0u; cnt = 0u; mine = 0u;
#pragma unroll
        for (unsigned j = 0; j < 16; ++j) { const unsigned c = xb_ld(&bar[XB_XCNT(j)]); sum += c; cnt += (c > 0u) ? 1u : 0u; mine = (j == x) ? c : mine; }
        if (sum == G) break;
        __builtin_amdgcn_s_sleep(1);
        if ((++sp & 255u) == 0u) { if (xb_ld(&bar[XB_TMO])) break; if (sp > XB_SPIN_CAP) { atomicAdd(&bar[XB_TMO], 1u); break; } }
    }
    nloc = mine > 0u ? mine : 1u; nx = cnt > 0u ? cnt : 1u;
}
__device__ __forceinline__ void xcd_barrier(const XcdBarrier& b) {
    asm volatile("s_waitcnt vmcnt(0)" ::: "memory");
    __syncthreads();
    if (threadIdx.x == 0) {
        unsigned* bar = b.bar;
        __builtin_amdgcn_s_waitcnt(0);
        unsigned nloc = b.st[0], nx = b.st[1];
        if (nloc == 0u) { xcd_barrier_complete(bar, b.x, nloc, nx); b.st[0] = nloc; b.st[1] = nx; }
        const unsigned old = xb_add(&bar[XB_XSUB(b.x)], 1u);
        const unsigned gen = old / nloc;
        if (old + 1u == (gen + 1u) * nloc) {
            __builtin_amdgcn_fence(__ATOMIC_RELEASE, "agent");
            asm volatile("s_waitcnt vmcnt(0)" ::: "memory");
            const unsigned og = xb_add(&bar[XB_TOP], 1u);
            const unsigned tg = og / nx;
            if (og + 1u == (tg + 1u) * nx) xb_add(&bar[XB_TOPGEN], 1u);
            else XB_SPIN(xb_ld(&bar[XB_TOPGEN]) == tg, bar);
            __builtin_amdgcn_fence(__ATOMIC_ACQUIRE, "agent");
            xb_add(&bar[XB_XGEN(b.x)], 1u);
            asm volatile("s_waitcnt vmcnt(0)" ::: "memory");
        } else {
            XB_SPIN(xb_ld(&bar[XB_XGEN(b.x)]) == gen, bar);
            __builtin_amdgcn_fence(__ATOMIC_ACQUIRE, "agent");
            asm volatile("s_waitcnt vmcnt(0)" ::: "memory");
        }
    }
    __syncthreads();
}

constexpr int N_PHASES = 10;
__global__ void __launch_bounds__(512, 2) yoco_fwd(Args args) {
    extern __shared__ __attribute__((aligned(16))) unsigned char lds_raw[];
    LAS unsigned char* lds = (LAS unsigned char*)lds_raw;
    const int lo = args.ph_lo, hi = args.ph_hi;
#ifndef ONLY_PHASE
#define ONLY_PHASE -1
#endif
#define IN(k) ((ONLY_PHASE < 0 || ONLY_PHASE == (k)) && lo <= (k) && (k) < hi)
    volatile LAS unsigned* xb_st = (volatile LAS unsigned*)(lds + LDS_BYTES - 64);
    if (threadIdx.x == 0) { xb_st[0] = 0u; xb_st[1] = 0u; }
    __syncthreads();
    const XcdBarrier xbar = xcd_barrier_post((unsigned*)args.ws + CW_XB, xb_st);
    if (args.ph_hi > 64) { __syncthreads(); cg::this_grid().sync(); }
#define SEAM(k) do { if (IN(k) && IN((k) + 1)) { xcd_barrier(xbar); } } while (0)
    if (IN(0)) { phase_prologue(args, lds); if (PROBE_DUP == 0) { __syncthreads(); phase_prologue(args, lds); } }
    SEAM(0);
    if (IN(1)) { phase_gemm(args, lds, 0, 3); if (PROBE_DUP == 1) { __syncthreads(); phase_gemm(args, lds, 0, 3); } }
    SEAM(1);
    if (IN(2)) { phase_scan(args, lds); if (PROBE_DUP == 2) { __syncthreads(); phase_scan(args, lds); } }
    SEAM(2);
    if (IN(4)) { if (gridDim.x == 256) phase_outproj<0>(args, lds); else { phase_gemm(args, lds, 3, 1); } }
    if (gridDim.x != 256) { SEAM(4); if (IN(5)) phase_rows<0>(args); }
    SEAM(5);
    if (IN(6)) { phase_gemm(args, lds, 4, 2); if (PROBE_DUP == 6) { __syncthreads(); phase_gemm(args, lds, 4, 2); } }
    SEAM(6);
    if (IN(7)) { phase_attn1(args, lds); if (PROBE_DUP == 7) { __syncthreads(); phase_attn1(args, lds); } }
    SEAM(7);
    if (IN(8)) { if (gridDim.x == 256) phase_outproj<1>(args, lds); else { phase_gemm(args, lds, 6, 1); } }
    if (gridDim.x != 256) { SEAM(8); if (IN(9)) phase_rows<1>(args); }
#undef IN
#undef SEAM
}

extern "C" void kernel_launch(void* const* d_in, const int* in_sizes, int n_in, void* d_out, int out_size, void* d_ws, size_t ws_size, hipStream_t stream) {
    static int ready = 0;
    if (ready == 0) {
        if (n_in != 26 || out_size != MTOK * DM || ws_size < WS_END) { fprintf(stderr, "kernel_launch: unexpected problem shape (n_in %d out %d ws %zu)\n", n_in, out_size, ws_size); ready = -1; return; }
        if (hipFuncSetAttribute((const void*)yoco_fwd, hipFuncAttributeMaxDynamicSharedMemorySize, LDS_BYTES) != hipSuccess) { fprintf(stderr, "kernel_launch: hipFuncSetAttribute failed\n"); ready = -1; return; }
        int per_cu = 0;
        if (hipOccupancyMaxActiveBlocksPerMultiprocessor(&per_cu, (const void*)yoco_fwd, 512, LDS_BYTES) != hipSuccess || per_cu < 1) fprintf(stderr, "kernel_launch: occupancy query says %d\n", per_cu);
        (void)hipGetLastError();
        ready = 1;
    }
    if (ready < 0) return;
    Args a{};
    for (int i = 0; i < 26; ++i) a.in[i] = (const float*)d_in[i];
    a.out = (float*)d_out; a.ws = (unsigned char*)d_ws;
#if MK_COOP
    (void)hipMemsetAsync(d_ws, 0, 65536, stream);
    a.ph_lo = 0; a.ph_hi = N_PHASES;
    void* params[] = {&a};
    hipError_t e = hipLaunchCooperativeKernel((const void*)yoco_fwd, dim3(256), dim3(512), params, LDS_BYTES, stream);
    if (e != hipSuccess) fprintf(stderr, "kernel_launch: cooperative launch failed: %s\n", hipGetErrorString(e));
#else
    for (int ph = 0; ph < N_PHASES; ++ph) { a.ph_lo = ph; a.ph_hi = ph + 1; hipLaunchKernelGGL(yoco_fwd, dim3(256), dim3(512), LDS_BYTES, stream, a); }
#endif
}
```

```cpp
#include <hip/hip_runtime.h>
#include <hip/hip_cooperative_groups.h>
#include <cstdio>
#include <cstdint>
namespace cg = cooperative_groups;

#ifndef PROBE_DUP
#define PROBE_DUP -1
#endif
#ifndef MK_COOP
#define MK_COOP 1
#endif

#define LAS __attribute__((address_space(3)))
typedef unsigned short bf16;
typedef short bf16x8 __attribute__((ext_vector_type(8)));
typedef float f32x4 __attribute__((ext_vector_type(4)));
typedef float f32x2 __attribute__((ext_vector_type(2)));
typedef unsigned u32x4 __attribute__((ext_vector_type(4)));
typedef unsigned u32x2 __attribute__((ext_vector_type(2)));

constexpr int DM = 1024, NBATCH = 8, SEQ = 2048, MTOK = NBATCH * SEQ;
constexpr int MEML = 256, MROWS = NBATCH * MEML;
constexpr int BRW = 768, AH = 12, BH = 6;
constexpr int LDP0 = 3840;
constexpr int LDP1 = 2816;
constexpr int C_R = 0, C_K = 768, C_V = 1536, C_WD = 2304, C_AD = 2368, C_GATE0 = 2432, C_QM0 = 3200, C_GM0 = 3456;
constexpr int C_Q1 = 0, C_GATE1 = 768, C_QM1 = 1536, C_GM1 = 1792, C_KSH = 2048;
constexpr float NORM_EPS = 1e-6f, LNX_EPS = 64e-5f;
constexpr float LOG2E = 1.4426950408889634f;

constexpr size_t MiB = 1u << 20;
constexpr size_t WS_WA = 1 * MiB;
constexpr size_t WS_WB = 9 * MiB;
constexpr size_t WS_WO = 16 * MiB;
constexpr size_t WS_WM = 20 * MiB;
constexpr size_t WS_MEMN = 22 * MiB;
constexpr size_t WS_MK = 26 * MiB;
constexpr size_t WS_MVT = 28 * MiB;
constexpr size_t WS_XN = 30 * MiB;
constexpr size_t WS_CAT = 62 * MiB;
constexpr size_t WS_VT = 94 * MiB;
constexpr size_t WS_PROJ = 118 * MiB;
constexpr size_t WS_Y = 118 * MiB;
constexpr size_t WS_W2T = 0 * MiB + 65536;
constexpr size_t WS_KM = 6144;
constexpr size_t WS_XCNT = 16384;
constexpr size_t WS_XCH = 254 * MiB;
constexpr size_t WS_LD16 = WS_XN;
constexpr size_t WS_A16 = WS_VT;
constexpr int CW_LX = 14336;
constexpr int CW_LORA = 1280;
constexpr size_t WS_X1B = 210 * MiB;
constexpr size_t WS_BS = 238 * MiB;
constexpr size_t WS_END = 256 * MiB;

__device__ __forceinline__ unsigned f2bf(float f) { unsigned u = __builtin_bit_cast(unsigned, f); return (u + 0x7fffu + ((u >> 16) & 1u)) >> 16; }
typedef __bf16 bf16x2_t __attribute__((ext_vector_type(2)));
__device__ __forceinline__ unsigned pk2(float lo, float hi) { f32x2 v = {lo, hi}; bf16x2_t b = __builtin_convertvector(v, bf16x2_t); return __builtin_bit_cast(unsigned, b); }
__device__ __forceinline__ float bflo(unsigned u) { return __builtin_bit_cast(float, u << 16); }
__device__ __forceinline__ float bfhi(unsigned u) { return __builtin_bit_cast(float, u & 0xffff0000u); }
__device__ __forceinline__ float wave_sum(float v) {
#pragma unroll
    for (int o = 1; o < 64; o <<= 1) v += __shfl_xor(v, o);
    return v;
}
template <int CTRL> __device__ __forceinline__ float dppf(float x) { return __builtin_bit_cast(float, __builtin_amdgcn_update_dpp(0, __builtin_bit_cast(int, x), CTRL, 0xf, 0xf, false)); }
__device__ __forceinline__ float sum8(float x) { x += dppf<0xB1>(x); x += dppf<0x4E>(x); x += dppf<0x141>(x); return x; }
__device__ __forceinline__ float sum16(float x) { x += dppf<0xB1>(x); x += dppf<0x4E>(x); x += dppf<0x141>(x); x += dppf<0x140>(x); return x; }
__device__ __forceinline__ float rows_max(float m) { m = fmaxf(m, __shfl_xor(m, 16)); return fmaxf(m, __shfl_xor(m, 32)); }
__device__ __forceinline__ float rows_sum(float m) { m += __shfl_xor(m, 16); return m + __shfl_xor(m, 32); }
__device__ __forceinline__ float sigmoidf_(float x) { return __builtin_amdgcn_rcpf(1.f + __builtin_amdgcn_exp2f(-1.4426950408889634f * x)); }
__device__ __forceinline__ float siluf_(float x) { return x * __builtin_amdgcn_rcpf(1.f + __builtin_amdgcn_exp2f(-1.4426950408889634f * x)); }

namespace pg8 {
constexpr int BM = 256, BK = 64, HALF = 128, HTB = HALF * BK * 2, STAGE_BYTES = 8 * HTB, NXCD = 8, WGM = 8;
__device__ __forceinline__ int lds_byte(int r, int c) { const int st = (r >> 4) * 2 + (c >> 5), rr = r & 15, cc = c & 31, ob = rr * 64 + cc * 2; return st * 1024 + (ob ^ (((ob >> 9) & 1) << 5)); }
__device__ __forceinline__ void stage_rc(int b, int& R, int& C) { const int st = b / 1024, sb = b % 1024, swz = sb ^ (((sb >> 9) & 1) << 5); R = (st >> 1) * 16 + swz / 64; C = (st & 1) * 32 + (swz % 64) / 2; }
__device__ __forceinline__ int perm32(int rho) { const int n = rho >> 4, i = rho & 15; return 8 * (i >> 2) + 4 * n + (i & 3); }
struct Unit { int pm, pn; };
struct Gemm { const bf16* A; const bf16* Bt; int M, N, K; };
struct StaticOrder {
    int nM, nN, nwg, G, c;
    __device__ void init(int M, int N, int G_, int c_) { nM = M / BM; nN = N / BM; nwg = nM * nN; G = G_; c = c_; }
    __device__ bool next(int i, Unit& u) const {
        const long L = (long)i * G + c; if (L >= nwg) return false;
        int wgid = (int)L; { const int q = nwg / NXCD, r = nwg % NXCD, xcd = wgid % NXCD, off = wgid / NXCD; wgid = (xcd < r ? xcd * (q + 1) : r * (q + 1) + (xcd - r) * q) + off; }
        const int nig = WGM * nN, gid = wgid / nig, fm = gid * WGM, gsz = (nM - fm) < WGM ? (nM - fm) : WGM;
        u.pm = fm + ((wgid % nig) % gsz); u.pn = (wgid % nig) / gsz; return true;
    }
};
__device__ __forceinline__ unsigned cvt_pk_bf16(float lo, float hi) { unsigned r; asm volatile("v_cvt_pk_bf16_f32 %0, %1, %2" : "=v"(r) : "v"(lo), "v"(hi)); return r; }

struct EpiStore {
    void* O; int ldc; int f32out; unsigned* km;
    __device__ __forceinline__ void operator()(const f32x4 (&acc)[2][2][4][2], const Unit& u, int wr, int wc, int fr, int fq) const {
        const int row0 = u.pm * BM + wr * 64 + fr, col0 = u.pn * BM + wc * 32 + 8 * fq;
        if (f32out) {
#pragma unroll
            for (int ai = 0; ai < 2; ++ai)
#pragma unroll
                for (int m = 0; m < 4; ++m) { float* rowp = (float*)O + (size_t)(row0 + ai * HALF + m * 16) * ldc + col0;
#pragma unroll
                    for (int bj = 0; bj < 2; ++bj) { *(f32x4*)(rowp + bj * HALF) = acc[ai][bj][m][0]; *(f32x4*)(rowp + bj * HALF + 4) = acc[ai][bj][m][1]; } }
        } else {
#pragma unroll
            for (int ai = 0; ai < 2; ++ai)
#pragma unroll
                for (int m = 0; m < 4; ++m) { bf16* rowp = (bf16*)O + (size_t)(row0 + ai * HALF + m * 16) * ldc + col0;
#pragma unroll
                    for (int bj = 0; bj < 2; ++bj) { const f32x4 v0 = acc[ai][bj][m][0], v1 = acc[ai][bj][m][1];
                        u32x4 w; w.x = cvt_pk_bf16(v0[0], v0[1]); w.y = cvt_pk_bf16(v0[2], v0[3]); w.z = cvt_pk_bf16(v1[0], v1[1]); w.w = cvt_pk_bf16(v1[2], v1[3]);
                        *(u32x4*)(rowp + bj * HALF) = w; } }
            if (km && u.pn >= 8) {
#pragma unroll
                for (int bj = 0; bj < 2; ++bj) {
                    float pmax = 0.f;
#pragma unroll
                    for (int ai = 0; ai < 2; ++ai)
#pragma unroll
                        for (int m = 0; m < 4; ++m) { const f32x4 v0 = acc[ai][bj][m][0], v1 = acc[ai][bj][m][1];
                            const unsigned w0 = cvt_pk_bf16(v0[0], v0[1]), w1 = cvt_pk_bf16(v0[2], v0[3]), w2 = cvt_pk_bf16(v1[0], v1[1]), w3 = cvt_pk_bf16(v1[2], v1[3]);
                            const float a0 = bflo(w0), a1 = bfhi(w0), a2 = bflo(w1), a3 = bfhi(w1), a4 = bflo(w2), a5 = bfhi(w2), a6 = bflo(w3), a7 = bfhi(w3);
                            pmax = fmaxf(pmax, ((a0 * a0 + a1 * a1) + (a2 * a2 + a3 * a3)) + ((a4 * a4 + a5 * a5) + (a6 * a6 + a7 * a7))); }
                    pmax = fmaxf(pmax, dppf<0xB1>(pmax)); pmax = fmaxf(pmax, dppf<0x4E>(pmax)); pmax = fmaxf(pmax, dppf<0x141>(pmax)); pmax = fmaxf(pmax, dppf<0x140>(pmax));
                    if (fr == 0) { const int ck = u.pn * BM + bj * HALF + wc * 32 + 8 * fq - 2048;
                        atomicMax(km + (((u.pm >> 3) * 6 + (ck >> 7)) * 2 + ((ck >> 6) & 1)) * 8 + ((ck >> 3) & 7), __builtin_bit_cast(unsigned, pmax)); }
                }
            }
        }
    }
};

struct EpiFused {
    const float* xin; const bf16* xin16; float* out; bf16* out16; bf16* XN; const float* gpost; float* xch; unsigned* cnt;
    __device__ __forceinline__ void exchange(int ex, int pm, int pn, LAS float* P, LAS float* RS, int tid) const {
        __syncthreads();
        unsigned* mine = (unsigned*)(xch + ((size_t)(ex * 64 + pm) * 4) * 256);
        if (tid < 256) { const f32x4 p4 = *(const LAS f32x4*)(P + tid * 4);
            __hip_atomic_store(mine + pn * 256 + tid, __builtin_bit_cast(unsigned, (p4.x + p4.y) + (p4.z + p4.w)), __ATOMIC_RELAXED, __HIP_MEMORY_SCOPE_AGENT); }
        asm volatile("s_waitcnt vmcnt(0)" ::: "memory");
        __syncthreads();
        if (tid == 0) {
            unsigned* c = cnt + (ex * 64 + pm) * 16;
            (void)__hip_atomic_fetch_add(c, 1u, __ATOMIC_RELAXED, __HIP_MEMORY_SCOPE_AGENT);
            while (__hip_atomic_load(c, __ATOMIC_RELAXED, __HIP_MEMORY_SCOPE_AGENT) < 4u) __builtin_amdgcn_s_sleep(1);
        }
        __syncthreads();
        if (tid < 256) {
            const float t0 = __builtin_bit_cast(float, __hip_atomic_load(mine + tid, __ATOMIC_RELAXED, __HIP_MEMORY_SCOPE_AGENT)), t1 = __builtin_bit_cast(float, __hip_atomic_load(mine + 256 + tid, __ATOMIC_RELAXED, __HIP_MEMORY_SCOPE_AGENT)),
                        t2 = __builtin_bit_cast(float, __hip_atomic_load(mine + 512 + tid, __ATOMIC_RELAXED, __HIP_MEMORY_SCOPE_AGENT)), t3 = __builtin_bit_cast(float, __hip_atomic_load(mine + 768 + tid, __ATOMIC_RELAXED, __HIP_MEMORY_SCOPE_AGENT));
            RS[tid] = __builtin_amdgcn_rsqf(((t0 + t1) + (t2 + t3)) * (1.f / 1024.f) + 1e-6f); }
        __syncthreads();
    }
    __device__ __forceinline__ void fused(f32x4 (&acc)[2][2][4][2], const Unit& u, int wr, int wc, int fr, int fq, LAS unsigned char* lds) const {
        const int tid = threadIdx.x;
        LAS float* P = (LAS float*)lds;
        LAS float* RS = (LAS float*)(lds + 4096);
#pragma unroll
        for (int ai = 0; ai < 2; ++ai)
#pragma unroll
            for (int m = 0; m < 4; ++m) {
                float p = 0.f;
#pragma unroll
                for (int bj = 0; bj < 2; ++bj)
#pragma unroll
                    for (int n = 0; n < 2; ++n) { const f32x4 v = acc[ai][bj][m][n]; p += (v.x * v.x + v.y * v.y) + (v.z * v.z + v.w * v.w); }
                p += __shfl_xor(p, 16); p += __shfl_xor(p, 32);
                if (fq == 0) P[(ai * HALF + wr * 64 + m * 16 + fr) * 4 + wc] = p;
            }
        exchange(0, u.pm, u.pn, P, RS, tid);
        const int col0 = u.pn * BM + wc * 32 + 8 * fq;
        f32x4 gp[2][2];
#pragma unroll
        for (int bj = 0; bj < 2; ++bj)
#pragma unroll
            for (int n = 0; n < 2; ++n) gp[bj][n] = *(const f32x4*)(gpost + col0 + bj * HALF + 4 * n);
#pragma unroll
        for (int ai = 0; ai < 2; ++ai)
#pragma unroll
            for (int m = 0; m < 4; ++m) {
                const int rl = ai * HALF + wr * 64 + m * 16 + fr; const float rs = RS[rl];
                const size_t off = (size_t)(u.pm * BM + rl) * 1024 + col0;
                float p = 0.f;
#pragma unroll
                for (int bj = 0; bj < 2; ++bj) {
                    f32x4 xv[2];
                    if (xin16) { const u32x4 xb = *(const u32x4*)(xin16 + off + bj * HALF); xv[0] = (f32x4){bflo(xb.x), bfhi(xb.x), bflo(xb.y), bfhi(xb.y)}; xv[1] = (f32x4){bflo(xb.z), bfhi(xb.z), bflo(xb.w), bfhi(xb.w)}; }
                    else { xv[0] = *(const f32x4*)(xin + off + bj * HALF); xv[1] = *(const f32x4*)(xin + off + bj * HALF + 4); }
#pragma unroll
                    for (int n = 0; n < 2; ++n) {
                        const f32x4 x1 = xv[n] + acc[ai][bj][m][n] * rs * gp[bj][n];
                        acc[ai][bj][m][n] = x1;
                        p += (x1.x * x1.x + x1.y * x1.y) + (x1.z * x1.z + x1.w * x1.w);
                    }
                    if (out16) { const f32x4 v0 = acc[ai][bj][m][0], v1 = acc[ai][bj][m][1];
                        u32x4 w; w.x = cvt_pk_bf16(v0[0], v0[1]); w.y = cvt_pk_bf16(v0[2], v0[3]); w.z = cvt_pk_bf16(v1[0], v1[1]); w.w = cvt_pk_bf16(v1[2], v1[3]);
                        *(u32x4*)(out16 + off + bj * HALF) = w; }
                    else { *(f32x4*)(out + off + bj * HALF) = acc[ai][bj][m][0]; *(f32x4*)(out + off + bj * HALF + 4) = acc[ai][bj][m][1]; }
                }
                if (XN) { p += __shfl_xor(p, 16); p += __shfl_xor(p, 32); if (fq == 0) P[rl * 4 + wc] = p; }
            }
        if (XN) {
            exchange(1, u.pm, u.pn, P, RS, tid);
#pragma unroll
            for (int ai = 0; ai < 2; ++ai)
#pragma unroll
                for (int m = 0; m < 4; ++m) {
                    const int rl = ai * HALF + wr * 64 + m * 16 + fr; const float r1 = RS[rl];
                    bf16* rowp = XN + (size_t)(u.pm * BM + rl) * 1024 + col0;
#pragma unroll
                    for (int bj = 0; bj < 2; ++bj) { const f32x4 v0 = acc[ai][bj][m][0] * r1, v1 = acc[ai][bj][m][1] * r1;
                        u32x4 w; w.x = cvt_pk_bf16(v0[0], v0[1]); w.y = cvt_pk_bf16(v0[2], v0[3]); w.z = cvt_pk_bf16(v1[0], v1[1]); w.w = cvt_pk_bf16(v1[2], v1[3]);
                        *(u32x4*)(rowp + bj * HALF) = w; }
                }
        }
        __syncthreads();
    }
};

template <class Epi, class Sched, bool FUSED = false>
__device__ __forceinline__ void gemm_phase(LAS unsigned char* lds, const Gemm g, const Sched& S, const Epi& E) {
    const int tid = threadIdx.x, wid = __builtin_amdgcn_readfirstlane(tid >> 6), lane = tid & 63, wr = wid >> 2, wc = wid & 3, fr = lane & 15, fq = lane >> 4;
    const int K = g.K, nt = K / BK;
    unsigned voffA[2], voffB[2];
#pragma unroll
    for (int i = 0; i < 2; ++i) { int R, C; stage_rc(tid * 16 + i * 8192, R, C); const int Rb = (R & ~31) + perm32(R & 31);
        voffA[i] = (unsigned)(R * K + C) * 2u; voffB[i] = (unsigned)(Rb * K + C) * 2u; }
    const size_t kstep = (size_t)(BK * 2);
    const size_t hstep = (size_t)HALF * K * 2;
    const size_t tstep = 2 * hstep;
    const unsigned ldsw = (unsigned)wid * 1024u;
    const int aoff = lds_byte(wr * 64 + fr, fq * 8), boff = lds_byte(wc * 32 + fr, fq * 8);
#define PG8_SA(b, h) (((b) * 2 + (h)) * HTB)
#define PG8_SB(b, h) ((4 + (b) * 2 + (h)) * HTB)
#define PG8_STAGE(bufoff, gbase, voff) do { _Pragma("unroll") for (int _i = 0; _i < 2; ++_i) \
        __builtin_amdgcn_global_load_lds((const unsigned*)((const char*)(gbase) + (voff)[_i]), (LAS unsigned*)(lds + (bufoff) + ldsw + _i * 8192), 16, 0, 0); } while (0)
#define PG8_LDA(dst, b, h) do { _Pragma("unroll") for (int m = 0; m < 4; ++m) _Pragma("unroll") for (int k = 0; k < 2; ++k) dst[m][k] = *(const LAS bf16x8*)(lds + PG8_SA(b, h) + aoff + m * 2048 + k * 1024); } while (0)
#define PG8_LDB(dst, b, h) do { _Pragma("unroll") for (int n = 0; n < 2; ++n) _Pragma("unroll") for (int k = 0; k < 2; ++k) dst[n][k] = *(const LAS bf16x8*)(lds + PG8_SB(b, h) + boff + n * 2048 + k * 1024); } while (0)
#define PG8_MMA(ai, bj, At, Bt) do { __builtin_amdgcn_s_setprio(1); _Pragma("unroll") for (int m = 0; m < 4; ++m) _Pragma("unroll") for (int n = 0; n < 2; ++n) _Pragma("unroll") for (int k = 0; k < 2; ++k) \
        acc[ai][bj][m][n] = __builtin_amdgcn_mfma_f32_16x16x32_bf16(Bt[n][k], At[m][k], acc[ai][bj][m][n], 0, 0, 0); __builtin_amdgcn_s_setprio(0); } while (0)
#define PG8_WAIT_V(n) asm volatile("s_waitcnt vmcnt(" #n ")" ::: "memory")
#define PG8_WAIT_L(n) asm volatile("s_waitcnt lgkmcnt(" #n ")" ::: "memory")
#define PG8_BAR __builtin_amdgcn_s_barrier()
#define PG8_SCHED __builtin_amdgcn_sched_barrier(0)
    Unit cur, nxt; int ui = 0;
    if (!S.next(0, cur)) return;
    f32x4 acc[2][2][4][2];
#pragma unroll
    for (int a = 0; a < 2; ++a)
#pragma unroll
        for (int b = 0; b < 2; ++b)
#pragma unroll
            for (int m = 0; m < 4; ++m)
#pragma unroll
                for (int n = 0; n < 2; ++n) acc[a][b][m][n] = (f32x4){0.f, 0.f, 0.f, 0.f};
    bf16x8 At[4][2], B0[2][2], B1[2][2];
    const char* cA = (const char*)g.A + (size_t)cur.pm * tstep; const char* cB = (const char*)g.Bt + (size_t)cur.pn * tstep;
    PG8_STAGE(PG8_SB(0, 0), cB, voffB); PG8_STAGE(PG8_SB(0, 1), cB + hstep, voffB); PG8_STAGE(PG8_SA(0, 0), cA, voffA); PG8_STAGE(PG8_SA(0, 1), cA + hstep, voffA);
    if (wr == 1) PG8_BAR;
    PG8_WAIT_V(2); PG8_BAR;
    PG8_STAGE(PG8_SB(1, 0), cB + kstep, voffB); PG8_STAGE(PG8_SA(1, 0), cA + kstep, voffA); PG8_STAGE(PG8_SB(1, 1), cB + hstep + kstep, voffB);
    PG8_WAIT_V(6); PG8_BAR;
    for (;;) {
        const bool has_next = S.next(ui + 1, nxt);
        const char* nA = has_next ? (const char*)g.A + (size_t)nxt.pm * tstep : cA; const char* nB = has_next ? (const char*)g.Bt + (size_t)nxt.pn * tstep : cB;
        for (int t = 0; t < nt; t += 2) {
            const bool last = (t == nt - 2);
            const char* a1 = cA + (size_t)(t + 1) * kstep;
            const char* a2 = last ? nA : cA + (size_t)(t + 2) * kstep; const char* b2 = last ? nB : cB + (size_t)(t + 2) * kstep;
            const char* a3 = a2 + kstep; const char* b3 = b2 + kstep;
            PG8_LDB(B0, 0, 0); PG8_LDB(B1, 0, 1); PG8_SCHED; PG8_LDA(At, 0, 0); PG8_STAGE(PG8_SA(1, 1), a1 + hstep, voffA);
            PG8_WAIT_V(8); PG8_WAIT_L(0); PG8_BAR; PG8_MMA(0, 0, At, B0); PG8_MMA(0, 1, At, B1); PG8_BAR; PG8_SCHED;
            PG8_LDA(At, 0, 1); PG8_STAGE(PG8_SB(0, 0), b2, voffB); PG8_STAGE(PG8_SB(0, 1), b2 + hstep, voffB); PG8_STAGE(PG8_SA(0, 0), a2, voffA);
            PG8_WAIT_V(8); PG8_WAIT_L(0); PG8_BAR; PG8_MMA(1, 0, At, B0); PG8_MMA(1, 1, At, B1); PG8_BAR; PG8_SCHED;
            PG8_LDB(B0, 1, 0); PG8_LDB(B1, 1, 1); PG8_SCHED; PG8_LDA(At, 1, 0); PG8_STAGE(PG8_SA(0, 1), a2 + hstep, voffA);
            PG8_WAIT_V(8); PG8_WAIT_L(0); PG8_BAR; PG8_MMA(0, 0, At, B0); PG8_MMA(0, 1, At, B1); PG8_BAR; PG8_SCHED;
            PG8_LDA(At, 1, 1); PG8_STAGE(PG8_SB(1, 0), b3, voffB); PG8_STAGE(PG8_SB(1, 1), b3 + hstep, voffB); PG8_STAGE(PG8_SA(1, 0), a3, voffA);
            PG8_WAIT_V(8); PG8_WAIT_L(0); PG8_BAR; PG8_MMA(1, 0, At, B0); PG8_MMA(1, 1, At, B1); PG8_BAR; PG8_SCHED;
        }
        if (wr == 0) PG8_BAR;
        if constexpr (!FUSED) E(acc, cur, wr, wc, fr, fq);
        if (!has_next) break;
#pragma unroll
        for (int a = 0; a < 2; ++a)
#pragma unroll
            for (int b = 0; b < 2; ++b)
#pragma unroll
                for (int m = 0; m < 4; ++m)
#pragma unroll
                    for (int n = 0; n < 2; ++n) acc[a][b][m][n] = (f32x4){0.f, 0.f, 0.f, 0.f};
        cur = nxt; cA = nA; cB = nB; ++ui;
        if (wr == 1) PG8_BAR;
    }
    PG8_WAIT_V(0);
    PG8_BAR;
    if constexpr (FUSED) E.fused(acc, cur, wr, wc, fr, fq, lds);
#undef PG8_SA
#undef PG8_SB
#undef PG8_STAGE
#undef PG8_LDA
#undef PG8_LDB
#undef PG8_MMA
#undef PG8_WAIT_V
#undef PG8_WAIT_L
#undef PG8_BAR
#undef PG8_SCHED
}
}

struct Args { const float* in[26]; float* out; unsigned char* ws; int ph_lo, ph_hi; };
enum { I_X = 0, I_MEM, I_PRE, I_POST, I_WOUT, I_MEMNORM, I_WMEMKV, I_AWIN, I_AMU, I_AW0, I_AW2, I_AA0, I_AA2, I_AKK, I_AKA, I_ARK, I_ALNW, I_ALNB,
       I_KVNORM, I_WKV, I_BWIN, I_LQ1, I_LK1, I_LQ2, I_LK2, I_SUBLN };

constexpr int LDS_BYTES = 147456;

__device__ __forceinline__ void p0_transpose_item(const float* W, int ldw, int c0, int nc, const float* gain, bf16* WT, int row0, LAS float* scr, int item, int lane, int ldo = 1024) {
    const int nblk = nc / 32, kb = item / nblk, nb = item % nblk, k0 = 64 * kb, n0 = 32 * nb;
#pragma unroll
    for (int i = 0; i < 8; ++i) { const int kk = 8 * i + (lane >> 3), n4 = 4 * (lane & 7);
        f32x4 v = *(const f32x4*)(W + (size_t)(k0 + kk) * ldw + c0 + n0 + n4); if (gain) v = v * gain[k0 + kk];
        LAS float* d = scr + kk * 33 + n4; d[0] = v.x; d[1] = v.y; d[2] = v.z; d[3] = v.w; }
    asm volatile("s_waitcnt lgkmcnt(0)" ::: "memory");
    const int c = lane & 7;
#pragma unroll
    for (int j = 0; j < 4; ++j) { const int n = (lane >> 3) + 8 * j; const LAS float* s = scr + (8 * c) * 33 + n;
        u32x4 o; o.x = pk2(s[0 * 33], s[1 * 33]); o.y = pk2(s[2 * 33], s[3 * 33]); o.z = pk2(s[4 * 33], s[5 * 33]); o.w = pk2(s[6 * 33], s[7 * 33]);
        *(u32x4*)(WT + (size_t)(row0 + n0 + n) * ldo + k0 + 8 * c) = o; }
    asm volatile("s_waitcnt lgkmcnt(0)" ::: "memory");
}
__device__ __forceinline__ void rms_row_to_bf16(const float* xrow, bf16* orow, int lane) {
    const f32x4* xr = (const f32x4*)xrow + lane;
    f32x4 v[4]; float s = 0.f;
#pragma unroll
    for (int j = 0; j < 4; ++j) { v[j] = xr[64 * j]; s += (v[j].x * v[j].x + v[j].y * v[j].y) + (v[j].z * v[j].z + v[j].w * v[j].w); }
    const float rs = 1.f / sqrtf(wave_sum(s) * (1.f / DM) + NORM_EPS);
    unsigned long long* o8 = (unsigned long long*)orow + lane;
#pragma unroll
    for (int j = 0; j < 4; ++j) o8[64 * j] = (unsigned long long)pk2(v[j].x * rs, v[j].y * rs) | ((unsigned long long)pk2(v[j].z * rs, v[j].w * rs) << 32);
}
template <int GROUP>
__device__ __forceinline__ void transpose_group(const Args& a, LAS unsigned char* lds, int gw, int NGW) {
    const int lane = threadIdx.x & 63, wave = __builtin_amdgcn_readfirstlane(threadIdx.x >> 6);
    unsigned char* ws = a.ws;
    LAS float* scr = (LAS float*)(lds + wave * 16384);
    bf16* WA = (bf16*)(ws + WS_WA); bf16* WB = (bf16*)(ws + WS_WB); bf16* WO = (bf16*)(ws + WS_WO); bf16* WM = (bf16*)(ws + WS_WM);
    constexpr int I0 = 16 * (3712 / 32), I1 = 16 * (2048 / 32), I2 = 16 * (1536 / 32), I3 = 16 * (1024 / 32), I5 = 16 * (256 / 32), I6 = 768 / 32;
    bf16* W2T = (bf16*)(ws + WS_W2T); bf16* A2T = W2T + 768 * 64;
    if (GROUP == 0) {
        constexpr int NITEMS = I0 + 4 * I5 + 2 * I6;
        for (int it = gw; it < NITEMS; it += NGW) {
            int r = it;
            if (r < I0) { p0_transpose_item(a.in[I_AWIN], 3712, 0, 3712, a.in[I_PRE], WA, 0, scr, r, lane); continue; } r -= I0;
            if (r < I5) { p0_transpose_item(a.in[I_WMEMKV], 512, 0, 256, a.in[I_MEMNORM], WM, 0, scr, r, lane); continue; } r -= I5;
            if (r < I5) { p0_transpose_item(a.in[I_WMEMKV], 512, 256, 256, a.in[I_MEMNORM], WM, 512, scr, r, lane); continue; } r -= I5;
            if (r < I5) { p0_transpose_item(a.in[I_WMEMKV] + 1024 * 512, 512, 0, 256, a.in[I_MEMNORM] + 1024, WM, 256, scr, r, lane); continue; } r -= I5;
            if (r < I5) { p0_transpose_item(a.in[I_WMEMKV] + 1024 * 512, 512, 256, 256, a.in[I_MEMNORM] + 1024, WM, 768, scr, r, lane); continue; } r -= I5;
            if (r < I6) { p0_transpose_item(a.in[I_AW2], 768, 0, 768, nullptr, W2T, 0, scr, r, lane, 64); continue; } r -= I6;
            p0_transpose_item(a.in[I_AA2], 768, 0, 768, nullptr, A2T, 0, scr, r, lane, 64);
        }
    } else {
        constexpr int NITEMS = I1 + I2 + 2 * I3;
        for (int it = gw; it < NITEMS; it += NGW) {
            int r = it;
            if (r < I1) { p0_transpose_item(a.in[I_BWIN], 2048, 0, 2048, a.in[I_PRE] + 1024, WB, 0, scr, r, lane); continue; } r -= I1;
            if (r < I2) { p0_transpose_item(a.in[I_WKV], 1536, 0, 1536, a.in[I_KVNORM], WB, 2048, scr, r, lane); continue; } r -= I2;
            if (r < I3) { p0_transpose_item(a.in[I_WOUT], 1024, 0, 1024, nullptr, WO, 0, scr, r, lane); continue; } r -= I3;
            p0_transpose_item(a.in[I_WOUT] + 1024 * 1024, 1024, 0, 1024, nullptr, WO + 1024 * 1024, 0, scr, r, lane);
        }
    }
}
__device__ __forceinline__ void phase_prologue(const Args& a, LAS unsigned char* lds) {
    const int tid = threadIdx.x, lane = tid & 63, wave = __builtin_amdgcn_readfirstlane(tid >> 6);
    const int G = gridDim.x, gw = blockIdx.x * 8 + wave, NGW = G * 8;
    unsigned char* ws = a.ws;
    bf16* WA = (bf16*)(ws + WS_WA);
    transpose_group<0>(a, lds, gw, NGW);
    { u32x4* z = (u32x4*)(WA + (size_t)3712 * 1024); const int nz = 128 * 1024 * 2 / 16;
      for (int i = blockIdx.x * 512 + tid; i < nz; i += G * 512) z[i] = (u32x4){0u, 0u, 0u, 0u}; }
    bf16* XN = (bf16*)(ws + WS_XN); bf16* MEMN = (bf16*)(ws + WS_MEMN);
    for (int m = gw; m < MTOK + MROWS; m += NGW) {
        if (m < MTOK) rms_row_to_bf16(a.in[I_X] + (size_t)m * DM, XN + (size_t)m * DM, lane);
        else rms_row_to_bf16(a.in[I_MEM] + (size_t)(m - MTOK) * DM, MEMN + (size_t)(m - MTOK) * DM, lane);
    }
}

__device__ __forceinline__ void run_gemm(LAS unsigned char* lds, const bf16* A, const bf16* Bt, int M, int N, void* O, int ldc, int f32out, int shift, unsigned* km) {
    const int G = gridDim.x;
    pg8::Gemm g{A, Bt, M, N, 1024};
    pg8::StaticOrder S; S.init(M, N, G, (int)((blockIdx.x + G - shift) % G));
    pg8::EpiStore E{O, ldc, f32out, km};
    pg8::gemm_phase<pg8::EpiStore, pg8::StaticOrder>(lds, g, S, E);
}
template <int LAYER>
__device__ __forceinline__ void phase_outproj(const Args& a, LAS unsigned char* lds) {
    unsigned char* ws = a.ws; const int G = gridDim.x;
    pg8::Gemm g{(const bf16*)(ws + WS_CAT), (const bf16*)(ws + WS_WO) + (size_t)LAYER * 1024 * 1024, MTOK, 1024, 1024};
    pg8::StaticOrder S; S.init(MTOK, 1024, G, (int)blockIdx.x);
    pg8::EpiFused E{a.in[I_X], LAYER ? (const bf16*)(ws + WS_X1B) : nullptr, a.out, LAYER ? nullptr : (bf16*)(ws + WS_X1B), LAYER ? nullptr : (bf16*)(ws + WS_XN), a.in[I_POST] + LAYER * DM,
                    (float*)(ws + WS_XCH) + (size_t)LAYER * 2 * 64 * 4 * 256, (unsigned*)(ws + WS_XCNT) + LAYER * 2 * 64 * 16};
    pg8::gemm_phase<pg8::EpiFused, pg8::StaticOrder, true>(lds, g, S, E);
}
__device__ __forceinline__ void phase_gemm(const Args& a, LAS unsigned char* lds, int first, int count) {
    unsigned char* ws = a.ws;
    for (int j = first; j < first + count; ++j) {
        const bf16* A; const bf16* Bt; int M, N, ldc, f32o, shift; void* O;
        switch (j) {
        case 0: A = (const bf16*)(ws + WS_XN); Bt = (const bf16*)(ws + WS_WA); M = MTOK; N = 3840; O = ws + WS_PROJ; ldc = LDP0; f32o = 0; shift = 0; break;
        case 1: A = (const bf16*)(ws + WS_MEMN); Bt = (const bf16*)(ws + WS_WM); M = MROWS; N = 512; O = ws + WS_MK; ldc = 512; f32o = 0; shift = 192; break;
        case 2: A = (const bf16*)(ws + WS_WM) + 512 * 1024; Bt = (const bf16*)(ws + WS_MEMN); M = 512; N = MROWS; O = ws + WS_MVT; ldc = MROWS; f32o = 0; shift = 208; break;
        case 3: A = (const bf16*)(ws + WS_CAT); Bt = (const bf16*)(ws + WS_WO); M = MTOK; N = 1024; O = ws + WS_Y; ldc = 1024; f32o = 0; shift = 0; break;
        case 4: A = (const bf16*)(ws + WS_XN); Bt = (const bf16*)(ws + WS_WB); M = MTOK; N = 2816; O = ws + WS_PROJ; ldc = LDP1; f32o = 0; shift = 0; break;
        case 5: A = (const bf16*)(ws + WS_WB) + 2816 * 1024; Bt = (const bf16*)(ws + WS_XN); M = 768; N = MTOK; O = ws + WS_VT; ldc = MTOK; f32o = 0; shift = 192; break;
        default: A = (const bf16*)(ws + WS_CAT); Bt = (const bf16*)(ws + WS_WO) + 1024 * 1024; M = MTOK; N = 1024; O = ws + WS_Y; ldc = 1024; f32o = 0; shift = 0; break;
        }
        run_gemm(lds, A, Bt, M, N, O, ldc, f32o, shift, (j == 4) ? (unsigned*)(ws + WS_KM) : nullptr);
    }
}

constexpr int AT_PITCH = 72;
template <int NMAP>
__device__ __forceinline__ void attn_unit(LAS unsigned char* lds, const bf16* Qp, int ldq, const bf16* Kp, int ldk, const bf16* VTp, int ldvt,
                                          int nkt_lo, int nkt_hi, float slope2, int tq0,
                                          const bf16* Gp, int ldg, bf16* Op, int ldo, const float* subln, float lam, float oscale, const unsigned* kmp = nullptr) {
    constexpr int EV = 64 * NMAP, NET = EV / 16;
    const int tid = threadIdx.x, lane = tid & 63, wave = __builtin_amdgcn_readfirstlane(tid >> 6), g = lane >> 4, c = lane & 15;
    constexpr int AT_BUF = NMAP * 64 * AT_PITCH * 2 + EV * AT_PITCH * 2;
    const int nkt = (wave < 4) ? nkt_lo : nkt_hi;
    const int qrow = 16 * wave + c;
    bf16x8 qf[NMAP][2];
#pragma unroll
    for (int mp = 0; mp < NMAP; ++mp)
#pragma unroll
        for (int ks = 0; ks < 2; ++ks) qf[mp][ks] = *(const bf16x8*)(Qp + (size_t)qrow * ldq + mp * 64 + 32 * ks + 8 * g);
    f32x4 o[NMAP][NET];
#pragma unroll
    for (int mp = 0; mp < NMAP; ++mp)
#pragma unroll
        for (int et = 0; et < NET; ++et) o[mp][et] = (f32x4){0.f, 0.f, 0.f, 0.f};
    float mrun[NMAP], lrun[NMAP];
#pragma unroll
    for (int mp = 0; mp < NMAP; ++mp) { mrun[mp] = -1e30f; lrun[mp] = 0.f; }
    const float sc2 = 0.125f * LOG2E;
    const float tq = (float)(tq0 + qrow);
    float ubq[NMAP];
    LAS unsigned* votes = (LAS unsigned*)(lds + 2 * AT_BUF);
    if (NMAP == 2) {
#pragma unroll
        for (int mp = 0; mp < NMAP; ++mp) {
            float k2 = 0.f;
#pragma unroll
            for (int pc = 0; pc < 8; ++pc) k2 += __builtin_bit_cast(float, kmp[mp * 8 + pc]);
            float q2 = 0.f;
#pragma unroll
            for (int ks = 0; ks < 2; ++ks) { const u32x4 qq = __builtin_bit_cast(u32x4, qf[mp][ks]);
#pragma unroll
                for (int e = 0; e < 4; ++e) { const float a0 = bflo(qq[e]), a1 = bfhi(qq[e]); q2 += a0 * a0 + a1 * a1; } }
            q2 = rows_sum(q2);
            ubq[mp] = sqrtf(q2 * k2) * sc2 * 1.001f + 1e-3f;
        }
    }
    u32x4 kreg[2][NMAP], vreg[2][NMAP];
#define AT_LOAD(SET, kt) do { _Pragma("unroll") for (int i = 0; i < NMAP; ++i) { const int id = tid + 512 * i; \
        { const int mp = id >> 9, n = (id >> 3) & 63, ch = id & 7; kreg[SET][i] = *(const u32x4*)(Kp + (size_t)((kt) * 64 + n) * ldk + mp * 64 + 8 * ch); } \
        { const int e = id >> 3, ch = id & 7; vreg[SET][i] = *(const u32x4*)(VTp + (size_t)e * ldvt + (kt) * 64 + 8 * ch); } } } while (0)
#define AT_STORE(SET) do { LAS bf16* Ks = (LAS bf16*)(lds + (SET) * AT_BUF); LAS bf16* Vs = (LAS bf16*)(lds + (SET) * AT_BUF + NMAP * 64 * AT_PITCH * 2); \
        _Pragma("unroll") for (int i = 0; i < NMAP; ++i) { const int id = tid + 512 * i; \
        { const int mp = id >> 9, n = (id >> 3) & 63, ch = id & 7; *(LAS u32x4*)(Ks + (mp * 64 + n) * AT_PITCH + 8 * ch) = kreg[SET][i]; } \
        { const int e = id >> 3, ch = id & 7; *(LAS u32x4*)(Vs + e * AT_PITCH + 8 * ch) = vreg[SET][i]; } } } while (0)
    u32x2 gpre[NET];
#pragma unroll
    for (int et = 0; et < NET; ++et) gpre[et] = *(const u32x2*)(Gp + (size_t)qrow * ldg + 16 * et + 4 * g);
    AT_LOAD(0, nkt_hi - 1);
    if (nkt_hi > 1) AT_LOAD(1, nkt_hi - 2);
    __syncthreads();
    AT_STORE(0);
    if (nkt_hi > 2) AT_LOAD(0, nkt_hi - 3);
    __syncthreads();
    for (int it = 0; it < nkt_hi; ++it) {
        const int kt = nkt_hi - 1 - it;
        if (NMAP == 2 && it > 0) {
            const LAS unsigned* vv = votes + ((it - 1) & 1) * 8;
            if ((vv[0] & vv[1] & vv[2] & vv[3] & vv[4] & vv[5] & vv[6] & vv[7]) != 0u) break;
        }
        if (kt > 0) { if (it & 1) { AT_STORE(0); if (kt > 2) AT_LOAD(0, kt - 3); } else { AT_STORE(1); if (kt > 2) AT_LOAD(1, kt - 3); } }
        const LAS bf16* Ks = (const LAS bf16*)(lds + (it & 1) * AT_BUF); const LAS bf16* Vs = (const LAS bf16*)(lds + (it & 1) * AT_BUF + NMAP * 64 * AT_PITCH * 2);
        if (kt < nkt) {
            f32x4 bias[4];
#pragma unroll
            for (int k16 = 0; k16 < 4; ++k16)
#pragma unroll
                for (int j = 0; j < 4; ++j) bias[k16][j] = -slope2 * fabsf(tq - (float)(kt * 64 + 16 * k16 + 4 * g + j));
            bf16x8 pf[NMAP][2]; bool any = false;
#pragma unroll
            for (int mp = 0; mp < NMAP; ++mp) {
                f32x4 st[4];
#pragma unroll
                for (int k16 = 0; k16 < 4; ++k16) {
                    f32x4 acc = (f32x4){0.f, 0.f, 0.f, 0.f};
#pragma unroll
                    for (int ks = 0; ks < 2; ++ks) { const bf16x8 ka = *(const LAS bf16x8*)(Ks + (mp * 64 + 16 * k16 + c) * AT_PITCH + 32 * ks + 8 * g);
                        acc = __builtin_amdgcn_mfma_f32_16x16x32_bf16(ka, qf[mp][ks], acc, 0, 0, 0); }
                    st[k16] = acc * sc2 + bias[k16];
                }
                float m4[4];
#pragma unroll
                for (int k16 = 0; k16 < 4; ++k16) m4[k16] = fmaxf(fmaxf(st[k16].x, st[k16].y), fmaxf(st[k16].z, st[k16].w));
                float mx = fmaxf(fmaxf(m4[0], m4[1]), fmaxf(m4[2], m4[3]));
                mx = rows_max(mx);
                if (__builtin_amdgcn_ballot_w64(mx > mrun[mp] - 40.f) != 0ull) {
                    any = true;
                    const float mnew = fmaxf(mrun[mp], mx), alpha = __builtin_amdgcn_exp2f(mrun[mp] - mnew);
                    mrun[mp] = mnew;
                    float ps = 0.f;
#pragma unroll
                    for (int k16 = 0; k16 < 4; ++k16)
#pragma unroll
                        for (int j = 0; j < 4; ++j) { const float p = __builtin_amdgcn_exp2f(st[k16][j] - mnew); st[k16][j] = p; ps += p; }
                    lrun[mp] = lrun[mp] * alpha + ps;
                    if (__builtin_amdgcn_ballot_w64(alpha != 1.f) != 0ull) {
#pragma unroll
                        for (int et = 0; et < NET; ++et) o[mp][et] = o[mp][et] * alpha;
                    }
#pragma unroll
                    for (int i = 0; i < 2; ++i) { u32x4 w; w.x = pk2(st[2 * i][0], st[2 * i][1]); w.y = pk2(st[2 * i][2], st[2 * i][3]); w.z = pk2(st[2 * i + 1][0], st[2 * i + 1][1]); w.w = pk2(st[2 * i + 1][2], st[2 * i + 1][3]);
                        pf[mp][i] = __builtin_bit_cast(bf16x8, w); }
                } else {
                    pf[mp][0] = (bf16x8){0, 0, 0, 0, 0, 0, 0, 0}; pf[mp][1] = (bf16x8){0, 0, 0, 0, 0, 0, 0, 0};
                }
            }
            if (any) {
#pragma unroll
                for (int et = 0; et < NET; ++et)
#pragma unroll
                    for (int i = 0; i < 2; ++i) {
                        const u32x2 lo = *(const LAS u32x2*)(Vs + (16 * et + c) * AT_PITCH + 32 * i + 4 * g);
                        const u32x2 hi = *(const LAS u32x2*)(Vs + (16 * et + c) * AT_PITCH + 32 * i + 16 + 4 * g);
                        const bf16x8 va = __builtin_bit_cast(bf16x8, (u32x4){lo.x, lo.y, hi.x, hi.y});
#pragma unroll
                        for (int mp = 0; mp < NMAP; ++mp) o[mp][et] = __builtin_amdgcn_mfma_f32_16x16x32_bf16(va, pf[mp][i], o[mp][et], 0, 0, 0);
                    }
            }
        }
        if (NMAP == 2) {
            const float dmin = fmaxf(tq - (float)(64 * kt - 1), 0.f);
            bool neg = true;
#pragma unroll
            for (int mp = 0; mp < NMAP; ++mp) neg = neg && (ubq[mp] - slope2 * dmin < mrun[mp] - 40.f);
            const bool all = (__builtin_amdgcn_ballot_w64(neg) == ~0ull);
            if (lane == 0) votes[(it & 1) * 8 + wave] = all ? 1u : 0u;
        }
        __syncthreads();
    }
#undef AT_LOAD
#undef AT_STORE
    float inv[NMAP];
#pragma unroll
    for (int mp = 0; mp < NMAP; ++mp) { const float l = rows_sum(lrun[mp]); inv[mp] = 1.f / l; }
    f32x4 r[NET]; float ss = 0.f;
#pragma unroll
    for (int et = 0; et < NET; ++et) {
        if (NMAP == 2) r[et] = o[0][et] * inv[0] - o[NMAP - 1][et] * (lam * inv[NMAP - 1]);
        else r[et] = o[0][et] * inv[0];
        ss += (r[et].x * r[et].x + r[et].y * r[et].y) + (r[et].z * r[et].z + r[et].w * r[et].w);
    }
    float rs = 1.f;
    if (NMAP == 2) { ss = rows_sum(ss); rs = oscale / sqrtf(ss * (1.f / EV) + NORM_EPS); }
#pragma unroll
    for (int et = 0; et < NET; ++et) {
        const int e = 16 * et + 4 * g;
        const u32x2 gv = gpre[et];
        f32x4 v = r[et] * rs;
        if (NMAP == 2) v = v * *(const f32x4*)(subln + e);
        v.x *= siluf_(bflo(gv.x)); v.y *= siluf_(bfhi(gv.x)); v.z *= siluf_(bflo(gv.y)); v.w *= siluf_(bfhi(gv.y));
        u32x2 w; w.x = pk2(v.x, v.y); w.y = pk2(v.z, v.w);
        *(u32x2*)(Op + (size_t)qrow * ldo + e) = w;
    }
    __syncthreads();
}

__device__ __forceinline__ void mem_attn_unit(const Args& a, LAS unsigned char* lds, int l, int u) {
    unsigned char* ws = a.ws;
    const int b = u >> 6, h = (u >> 4) & 3, qb = u & 15;
    const bf16* PROJ = (const bf16*)(ws + WS_PROJ);
    const int ldp = l ? LDP1 : LDP0, cq = l ? C_QM1 : C_QM0, cg_ = l ? C_GM1 : C_GM0;
    const size_t row0 = (size_t)b * SEQ + qb * 128;
    attn_unit<1>(lds, PROJ + row0 * ldp + cq + h * 64, ldp,
                 (const bf16*)(ws + WS_MK) + (size_t)b * MEML * 512 + l * 256 + h * 64, 512,
                 (const bf16*)(ws + WS_MVT) + (size_t)(l * 256 + h * 64) * MROWS + b * MEML, MROWS,
                 4, 4, 0.f, 0,
                 PROJ + row0 * ldp + cg_ + h * 64, ldp, (bf16*)(ws + WS_CAT) + row0 * DM + BRW + h * 64, DM, nullptr, 0.f, 1.f);
}

typedef _Float16 f16x4_t __attribute__((ext_vector_type(4)));
__device__ __forceinline__ void lora_item(const Args& a, LAS unsigned char* lds, int b, int cgp) {
    const int tid = threadIdx.x, lane = tid & 63, wave = __builtin_amdgcn_readfirstlane(tid >> 6), g = lane >> 4, c = lane & 15;
    unsigned char* ws = a.ws;
    const bf16* PROJ = (const bf16*)(ws + WS_PROJ);
    const size_t mb = (size_t)b * SEQ; const int t0 = 64 * cgp;
    LAS bf16* AW = (LAS bf16*)lds; LAS bf16* AA = AW + 64 * 72;
    const float* mu = a.in[I_AMU];
#pragma unroll
    for (int r = 0; r < 2; ++r) {
        const int i = tid + 512 * r, tok = i >> 4, ch = i & 15;
        const bf16* cur = PROJ + (mb + t0 + tok) * LDP0 + C_WD + 8 * ch; const bf16* prv = (t0 + tok == 0) ? cur : cur - LDP0; const float pz = (t0 + tok == 0) ? 0.f : 1.f;
        const u32x4 zc = *(const u32x4*)cur, zp = *(const u32x4*)prv;
        const f32x4 m0 = *(const f32x4*)(mu + C_WD + 8 * ch), m1 = *(const f32x4*)(mu + C_WD + 8 * ch + 4);
        float x[8];
#pragma unroll
        for (int e = 0; e < 4; ++e) {
            const float ma = (e < 2) ? m0[2 * e] : m1[2 * e - 4], mb_ = (e < 2) ? m0[2 * e + 1] : m1[2 * e - 3];
            float z0 = bflo(zc[e]), z1 = bfhi(zc[e]);
            z0 = z0 + (bflo(zp[e]) * pz - z0) * ma; z1 = z1 + (bfhi(zp[e]) * pz - z1) * mb_;
            if (ch < 8) { z0 = 1.f - 2.f * __builtin_amdgcn_rcpf(1.f + __builtin_amdgcn_exp2f(2.8853900817779268f * z0)); z1 = 1.f - 2.f * __builtin_amdgcn_rcpf(1.f + __builtin_amdgcn_exp2f(2.8853900817779268f * z1)); }
            x[2 * e] = z0; x[2 * e + 1] = z1;
        }
        u32x4 w; w.x = pk2(x[0], x[1]); w.y = pk2(x[2], x[3]); w.z = pk2(x[4], x[5]); w.w = pk2(x[6], x[7]);
        *(LAS u32x4*)(((ch < 8) ? AW : AA) + tok * 72 + 8 * (ch & 7)) = w;
    }
    __syncthreads();
    const int mtp = wave & 1, gq = wave >> 1;
    const bf16* W2T = (const bf16*)(ws + WS_W2T); const bf16* A2T = W2T + 768 * 64;
    _Float16* LD16 = (_Float16*)(ws + WS_LD16); bf16* A16 = (bf16*)(ws + WS_A16);
    bf16x8 Aw[2][2], Aa[2][2];
#pragma unroll
    for (int mt = 0; mt < 2; ++mt)
#pragma unroll
        for (int ks = 0; ks < 2; ++ks) { Aw[mt][ks] = *(const LAS bf16x8*)(AW + (32 * mtp + 16 * mt + c) * 72 + 32 * ks + 8 * g); Aa[mt][ks] = *(const LAS bf16x8*)(AA + (32 * mtp + 16 * mt + c) * 72 + 32 * ks + 8 * g); }
    const f32x4 Z4 = {0.f, 0.f, 0.f, 0.f};
    for (int gi = 0; gi < 3; ++gi) {
        const int colb = 64 * (3 * gq + gi) + 4 * c;
        const f32x4 w0v = *(const f32x4*)(a.in[I_AW0] + colb), a0v = *(const f32x4*)(a.in[I_AA0] + colb);
        f32x4 accw[2][4], acca[2][4];
#pragma unroll
        for (int q = 0; q < 4; ++q) {
            const bf16x8 bw0 = *(const bf16x8*)(W2T + (size_t)(colb + q) * 64 + 8 * g), bw1 = *(const bf16x8*)(W2T + (size_t)(colb + q) * 64 + 32 + 8 * g);
            const bf16x8 ba0 = *(const bf16x8*)(A2T + (size_t)(colb + q) * 64 + 8 * g), ba1 = *(const bf16x8*)(A2T + (size_t)(colb + q) * 64 + 32 + 8 * g);
#pragma unroll
            for (int mt = 0; mt < 2; ++mt) {
                accw[mt][q] = __builtin_amdgcn_mfma_f32_16x16x32_bf16(Aw[mt][0], bw0, Z4, 0, 0, 0); accw[mt][q] = __builtin_amdgcn_mfma_f32_16x16x32_bf16(Aw[mt][1], bw1, accw[mt][q], 0, 0, 0);
                acca[mt][q] = __builtin_amdgcn_mfma_f32_16x16x32_bf16(Aa[mt][0], ba0, Z4, 0, 0, 0); acca[mt][q] = __builtin_amdgcn_mfma_f32_16x16x32_bf16(Aa[mt][1], ba1, acca[mt][q], 0, 0, 0);
            }
        }
#pragma unroll
        for (int mt = 0; mt < 2; ++mt)
#pragma unroll
            for (int j = 0; j < 4; ++j) {
                const size_t m = mb + t0 + 32 * mtp + 16 * mt + 4 * g + j;
                f16x4_t ld; float av[4];
#pragma unroll
                for (int q = 0; q < 4; ++q) { ld[q] = (_Float16)(-0.8750322163622201f * sigmoidf_(w0v[q] + accw[mt][q][j])); av[q] = sigmoidf_(a0v[q] + acca[mt][q][j]); }
                *(f16x4_t*)(LD16 + m * 768 + colb) = ld;
                *(u32x2*)(A16 + m * 768 + colb) = (u32x2){pk2(av[0], av[1]), pk2(av[2], av[3])};
            }
    }
    asm volatile("s_waitcnt vmcnt(0)" ::: "memory");
    __syncthreads();
    if (tid == 0) {
        const unsigned x = (unsigned)__builtin_amdgcn_s_getreg((3 << 11) | 20) & 0xFu, nloc = ((volatile LAS unsigned*)(lds + LDS_BYTES - 64))[0];
        if (__hip_atomic_fetch_add((unsigned*)ws + CW_LX + 16 * x, 1u, __ATOMIC_RELAXED, __HIP_MEMORY_SCOPE_AGENT) + 1u == nloc) {
            __builtin_amdgcn_fence(__ATOMIC_RELEASE, "agent"); asm volatile("s_waitcnt vmcnt(0)" ::: "memory");
            (void)__hip_atomic_fetch_add((unsigned*)ws + CW_LORA, 1u, __ATOMIC_RELAXED, __HIP_MEMORY_SCOPE_AGENT); }
    }
}

constexpr int SK_SLOT = 15360, SK_NT = 0, SK_RT = 2304, SK_BP = 4608, SK_KP = 7168, SK_VT = 9728, SK_PC = 12288, SK_LK = 12544, SK_TT = 13184, SK_MB = 13824, SK_MK = 14464;
constexpr int SK_SCR = 3 * SK_SLOT, SK_SCRW = 7680, SK_BS = 0, SK_KS = 2304, SK_LB = 4608, SK_VM = 5632;
constexpr int SK_P72 = 72, SK_P20 = 20;
constexpr int SK_PRM = SK_SCR + 4 * SK_SCRW, SK_W2L = SK_PRM, SK_A2L = SK_PRM + 9216, SK_PF = SK_PRM + 18432;
enum { PF_W0 = 0, PF_A0, PF_KK, PF_KA, PF_RK, PF_MUR, PF_MUK, PF_MUWD, PF_MUAD, PF_MUV };
__device__ __forceinline__ bf16x8 lds2x8(const LAS bf16* p, int offa, int offb) { const u32x2 a = *(const LAS u32x2*)(p + offa), b = *(const LAS u32x2*)(p + offb); return __builtin_bit_cast(bf16x8, (u32x4){a.x, a.y, b.x, b.y}); }
__device__ __forceinline__ bf16x8 lds8z(const LAS bf16* p, int offa) { const u32x2 a = *(const LAS u32x2*)(p + offa); return __builtin_bit_cast(bf16x8, (u32x4){a.x, a.y, 0u, 0u}); }
__device__ __forceinline__ void scan_unit(const Args& a, LAS unsigned char* lds, int b, int h) {
    const int tid = threadIdx.x, lane = tid & 63, wave = __builtin_amdgcn_readfirstlane(tid >> 6), g = lane >> 4, c = lane & 15;
    unsigned char* ws = a.ws;
    const bf16* PROJ = (const bf16*)(ws + WS_PROJ);
    bf16* CAT = (bf16*)(ws + WS_CAT);
    const size_t mb = (size_t)b * SEQ;
    constexpr int NBLK = SEQ / 16;
    const f32x4 Z4 = {0.f, 0.f, 0.f, 0.f};
    {
        const bf16* W2T = (const bf16*)(ws + WS_W2T);
        for (int i = tid; i < 2 * 64 * 8; i += 512) { const int m = i >> 9, key = (i >> 3) & 63, ch = i & 7;
            const u32x4 v = *(const u32x4*)(W2T + (size_t)m * 768 * 64 + (size_t)(h * 64 + key) * 64 + 8 * ch);
            *(LAS u32x4*)(lds + (m ? SK_A2L : SK_W2L) + (((key & 3) * 16 + (key >> 2)) * SK_P72 + 8 * ch) * 2) = v; }
        for (int i = tid; i < 10 * 64; i += 512) { const int w = i >> 6, k = i & 63; float v;
            switch (w) { case PF_W0: v = a.in[I_AW0][h * 64 + k]; break; case PF_A0: v = a.in[I_AA0][h * 64 + k]; break; case PF_KK: v = a.in[I_AKK][h * 64 + k]; break;
                         case PF_KA: v = a.in[I_AKA][h * 64 + k]; break; case PF_RK: v = a.in[I_ARK][h * 64 + k]; break; case PF_MUR: v = a.in[I_AMU][C_R + h * 64 + k]; break;
                         case PF_MUK: v = a.in[I_AMU][C_K + h * 64 + k]; break; case PF_MUWD: v = a.in[I_AMU][C_WD + k]; break; case PF_MUAD: v = a.in[I_AMU][C_AD + k]; break;
                         default: v = a.in[I_AMU][C_V + h * 64 + k]; break; }
            ((LAS float*)(lds + SK_PF))[i] = v; }
        if (tid == 0) { unsigned* cw = (unsigned*)ws + CW_LORA;
            const unsigned nx = ((volatile LAS unsigned*)(lds + LDS_BYTES - 64))[1];
            while (__hip_atomic_load(cw, __ATOMIC_RELAXED, __HIP_MEMORY_SCOPE_AGENT) < nx) __builtin_amdgcn_s_sleep(2);
            __builtin_amdgcn_fence(__ATOMIC_ACQUIRE, "agent"); asm volatile("s_waitcnt vmcnt(0)" ::: "memory"); }
        __syncthreads();
    }
    if (wave < 4) {
        f32x4 St[4] = {Z4, Z4, Z4, Z4};
        for (int q = 0; q < 4; ++q) __syncthreads();
        for (int blk = 0; blk < NBLK; ++blk) {
            const LAS unsigned char* sl = lds + (blk % 3) * SK_SLOT;
            const LAS bf16* NT = (const LAS bf16*)(sl + SK_NT); const LAS bf16* RT = (const LAS bf16*)(sl + SK_RT);
            const LAS bf16* BP = (const LAS bf16*)(sl + SK_BP); const LAS bf16* KP = (const LAS bf16*)(sl + SK_KP);
            const LAS bf16* VT = (const LAS bf16*)(sl + SK_VT); const LAS float* PC = (const LAS float*)(sl + SK_PC);
            const LAS bf16* LK = (const LAS bf16*)(sl + SK_LK); const LAS bf16* TT = (const LAS bf16*)(sl + SK_TT);
            const LAS bf16* MB = (const LAS bf16*)(sl + SK_MB); const LAS bf16* MK = (const LAS bf16*)(sl + SK_MK);
            bf16x8 sbh[2];
#pragma unroll
            for (int ks = 0; ks < 2; ++ks) {
                const f32x4 x = St[2 * ks], y = St[2 * ks + 1];
                u32x4 hh; hh.x = pk2(x.x, x.y); hh.y = pk2(x.z, x.w); hh.z = pk2(y.x, y.y); hh.w = pk2(y.z, y.w);
                sbh[ks] = __builtin_bit_cast(bf16x8, hh);
            }
            const bf16x8 An0 = lds2x8(NT, c * SK_P72 + 4 * g, c * SK_P72 + 16 + 4 * g), An1 = lds2x8(NT, c * SK_P72 + 32 + 4 * g, c * SK_P72 + 48 + 4 * g);
            const bf16x8 Ar0 = lds2x8(RT, c * SK_P72 + 4 * g, c * SK_P72 + 16 + 4 * g), Ar1 = lds2x8(RT, c * SK_P72 + 32 + 4 * g, c * SK_P72 + 48 + 4 * g);
            const u32x2 vq = *(const LAS u32x2*)(VT + (16 * wave + c) * SK_P20 + 4 * g);
            const bf16x8 vlo = __builtin_bit_cast(bf16x8, (u32x4){vq.x, vq.y, 0u, 0u});
            const bf16x8 Alk = lds8z(LK, c * SK_P20 + 4 * g), At = lds8z(TT, c * SK_P20 + 4 * g);
            const bf16x8 Amk = lds2x8(MB, c * SK_P20 + 4 * g, (int)((SK_MK - SK_MB) / 2) + c * SK_P20 + 4 * g);
            f32x4 X = __builtin_amdgcn_mfma_f32_16x16x32_bf16(An0, sbh[0], Z4, 0, 0, 0);
            X = __builtin_amdgcn_mfma_f32_16x16x32_bf16(An1, sbh[1], X, 0, 0, 0);
            X = __builtin_amdgcn_mfma_f32_16x16x32_bf16(Alk, vlo, X, 0, 0, 0);
            f32x4 Y = __builtin_amdgcn_mfma_f32_16x16x32_bf16(Ar0, sbh[0], Z4, 0, 0, 0);
            Y = __builtin_amdgcn_mfma_f32_16x16x32_bf16(Ar1, sbh[1], Y, 0, 0, 0);
            const bf16x8 xb = __builtin_bit_cast(bf16x8, (u32x4){pk2(X.x, X.y), pk2(X.z, X.w), 0u, 0u});
            const f32x4 U = __builtin_amdgcn_mfma_f32_16x16x32_bf16(At, xb, Z4, 0, 0, 0);
            const bf16x8 ub = __builtin_bit_cast(bf16x8, (u32x4){pk2(U.x, U.y), pk2(U.z, U.w), vq.x, vq.y});
            Y = __builtin_amdgcn_mfma_f32_16x16x32_bf16(Amk, ub, Y, 0, 0, 0);
#pragma unroll
            for (int kt = 0; kt < 4; ++kt) {
                const f32x4 pc4 = *(const LAS f32x4*)(PC + 16 * kt + 4 * g);
                const bf16x8 Abk = lds2x8(BP, (16 * kt + c) * SK_P20 + 4 * g, (int)((SK_KP - SK_BP) / 2) + (16 * kt + c) * SK_P20 + 4 * g);
                St[kt] = __builtin_amdgcn_mfma_f32_16x16x32_bf16(Abk, ub, St[kt] * pc4, 0, 0, 0);
            }
            bf16* yp = CAT + (mb + (size_t)blk * 16 + 4 * g) * DM + h * 64 + 16 * wave + c;
            yp[0] = (bf16)f2bf(Y.x); yp[DM] = (bf16)f2bf(Y.y); yp[2 * DM] = (bf16)f2bf(Y.z); yp[3 * DM] = (bf16)f2bf(Y.w);
            __syncthreads();
        }
    } else {
        const int pw = wave - 4;
        const int kc = h * 64 + 4 * c;
        const LAS float* PF = (const LAS float*)(lds + SK_PF); const LAS bf16* W2L = (const LAS bf16*)(lds + SK_W2L); const LAS bf16* A2L = (const LAS bf16*)(lds + SK_A2L);
        LAS unsigned char* scr = lds + SK_SCR + pw * SK_SCRW;
        LAS bf16* BSs = (LAS bf16*)(scr + SK_BS); LAS bf16* KSs = (LAS bf16*)(scr + SK_KS); LAS float* LBs = (LAS float*)(scr + SK_LB);
        u32x4 zv[2], zvp[2]; u32x2 zr[4], zrp[4], zk[4], zkp[4], zl[4], za[4];
        const _Float16* LD16 = (const _Float16*)(ws + WS_LD16); const bf16* A16 = (const bf16*)(ws + WS_A16);
#define SK_LOAD_V(T0) do { \
        { const int sv_ = lane >> 2, cv_ = lane & 3; const bf16* cs = PROJ + (mb + (T0) + sv_) * LDP0; const bf16* ps = ((T0) + sv_ == 0) ? cs : cs - LDP0; \
          _Pragma("unroll") for (int i = 0; i < 2; ++i) { zv[i] = *(const u32x4*)(cs + C_V + h * 64 + 16 * cv_ + 8 * i); zvp[i] = *(const u32x4*)(ps + C_V + h * 64 + 16 * cv_ + 8 * i); } } } while (0)
#define SK_LOAD_S(T0, jj) do { const int s_ = 4 * g + (jj); const bf16* cs = PROJ + (mb + (T0) + s_) * LDP0; const bf16* ps = ((T0) + s_ == 0) ? cs : cs - LDP0; \
            zr[jj] = *(const u32x2*)(cs + C_R + kc); zrp[jj] = *(const u32x2*)(ps + C_R + kc); zk[jj] = *(const u32x2*)(cs + C_K + kc); zkp[jj] = *(const u32x2*)(ps + C_K + kc); \
            za[jj] = *(const u32x2*)(A16 + (mb + (T0) + s_) * 768 + kc); } while (0)
#define SK_LOAD_L(T0) do { _Pragma("unroll") for (int jj = 0; jj < 4; ++jj) zl[jj] = *(const u32x2*)(LD16 + (mb + (T0) + 4 * g + jj) * 768 + kc); } while (0)
        SK_LOAD_L(pw * 16); SK_LOAD_V(pw * 16);
#pragma unroll
        for (int jj = 0; jj < 4; ++jj) SK_LOAD_S(pw * 16, jj);
        for (int q = 0; q < pw; ++q) __syncthreads();
        for (int n = 0; n < NBLK / 4; ++n) {
            const int blk = 4 * n + pw, t0 = blk * 16, t0n = (blk + 4 < NBLK) ? t0 + 64 : t0;
            LAS unsigned char* sl = lds + (blk % 3) * SK_SLOT;
            int c_o = c; asm volatile("" : "+v"(c_o));
            {
                unsigned vm[8];
                const int sv = lane >> 2, cv = lane & 3; const float pz = (t0 + sv == 0) ? 0.f : 1.f;
#pragma unroll
                for (int i = 0; i < 2; ++i) {
                    const LAS float* mv = PF + PF_MUV * 64 + 16 * cv + 8 * i;
                    const f32x4 m0 = *(const LAS f32x4*)mv, m1 = *(const LAS f32x4*)(mv + 4);
#pragma unroll
                    for (int e = 0; e < 4; ++e) {
                        const unsigned uc = zv[i][e], up = zvp[i][e];
                        const float ma = (e < 2) ? m0[2 * e] : m1[2 * e - 4], mb_ = (e < 2) ? m0[2 * e + 1] : m1[2 * e - 3];
                        float z0 = bflo(uc), z1 = bfhi(uc);
                        z0 = z0 + (bflo(up) * pz - z0) * ma; z1 = z1 + (bfhi(up) * pz - z1) * mb_;
                        vm[4 * i + e] = pk2(z0, z1);
                    }
                }
                *(LAS u32x4*)(scr + SK_VM + lane * 32) = (u32x4){vm[0], vm[1], vm[2], vm[3]}; *(LAS u32x4*)(scr + SK_VM + lane * 32 + 16) = (u32x4){vm[4], vm[5], vm[6], vm[7]};
                SK_LOAD_V(t0n);
            }
            u32x2 ntp[4], rtp[4], bpp[4], kpp[4]; f32x4 pcv;
            {
                f32x4 dec[4], E4;
#pragma unroll
                for (int jj = 0; jj < 4; ++jj) { const f16x4_t l4 = __builtin_bit_cast(f16x4_t, zl[jj]);
#pragma unroll
                    for (int nt = 0; nt < 4; ++nt) dec[jj][nt] = __builtin_amdgcn_exp2f((float)l4[nt]); }
                SK_LOAD_L(t0n);
#pragma unroll
                for (int nt = 0; nt < 4; ++nt) {
                    const float p3 = (dec[0][nt] * dec[1][nt]) * (dec[2][nt] * dec[3][nt]);
                    const float q0 = __shfl(p3, c), q1 = __shfl(p3, c + 16), q2 = __shfl(p3, c + 32), q3 = __shfl(p3, c + 48);
                    E4[nt] = ((g > 0) ? q0 : 1.f) * ((g > 1) ? q1 : 1.f) * ((g > 2) ? q2 : 1.f);
                    pcv[nt] = (q0 * q1) * (q2 * q3);
                }
                const f32x4 p_kk = *(const LAS f32x4*)(PF + PF_KK * 64 + 4 * c), p_ka = *(const LAS f32x4*)(PF + PF_KA * 64 + 4 * c),
                            p_rk = *(const LAS f32x4*)(PF + PF_RK * 64 + 4 * c), mu_r = *(const LAS f32x4*)(PF + PF_MUR * 64 + 4 * c), mu_k = *(const LAS f32x4*)(PF + PF_MUK * 64 + 4 * c);
                f32x4 pex = E4, bprev, kprev;
#pragma unroll
                for (int jj = 0; jj < 4; ++jj) {
                    if (jj == 1 || jj == 3) __syncthreads();
                    const int s = 4 * g + jj;
                    const float pz = (t0 + s == 0) ? 0.f : 1.f;
                    const f32x4 pin = pex * dec[jj];
                    f32x4 rr, kp4, ku, aa;
                    const unsigned ur[2] = {zr[jj].x, zr[jj].y}, urp[2] = {zrp[jj].x, zrp[jj].y}, uk[2] = {zk[jj].x, zk[jj].y}, ukp[2] = {zkp[jj].x, zkp[jj].y}, ua[2] = {za[jj].x, za[jj].y};
                    SK_LOAD_S(t0n, jj);
                    float ssq = 0.f, bs = 0.f;
#pragma unroll
                    for (int nt = 0; nt < 4; ++nt) {
                        const float zc = (nt & 1) ? bfhi(ur[nt >> 1]) : bflo(ur[nt >> 1]), zp = ((nt & 1) ? bfhi(urp[nt >> 1]) : bflo(urp[nt >> 1])) * pz;
                        const float kc_ = (nt & 1) ? bfhi(uk[nt >> 1]) : bflo(uk[nt >> 1]), kp_ = ((nt & 1) ? bfhi(ukp[nt >> 1]) : bflo(ukp[nt >> 1])) * pz;
                        rr[nt] = zc + (zp - zc) * mu_r[nt];
                        const float kk = kc_ + (kp_ - kc_) * mu_k[nt];
                        aa[nt] = (nt & 1) ? bfhi(ua[nt >> 1]) : bflo(ua[nt >> 1]);
                        ku[nt] = kk * p_kk[nt];
                        ssq += ku[nt] * ku[nt];
                        kp4[nt] = kk * (1.f + (aa[nt] - 1.f) * p_ka[nt]);
                        bs += rr[nt] * kp4[nt] * p_rk[nt];
                    }
                    ssq = sum16(ssq); bs = sum16(bs);
                    if (c == 0) ((float*)(ws + WS_BS))[(mb + t0 + s) * AH + h] = bs;
                    const float rn = __builtin_amdgcn_rsqf(fmaxf(ssq, 1e-12f));
                    f32x4 rp; rp.x = __builtin_amdgcn_rcpf(pin.x); rp.y = __builtin_amdgcn_rcpf(pin.y); rp.z = __builtin_amdgcn_rcpf(pin.z); rp.w = __builtin_amdgcn_rcpf(pin.w);
                    const f32x4 kn = ku * rn;
                    const f32x4 nt_ = pex * (-kn), bt = kn * aa * rp, kt_ = kp4 * rp, rt = pin * rr;
                    const f32x4 bpc = bt * pcv, kpc = kt_ * pcv;
                    ntp[jj] = (u32x2){pk2(nt_.x, nt_.y), pk2(nt_.z, nt_.w)};
                    rtp[jj] = (u32x2){pk2(rt.x, rt.y), pk2(rt.z, rt.w)};
                    *(LAS u32x2*)(BSs + s * SK_P72 + 4 * c) = (u32x2){pk2(bt.x, bt.y), pk2(bt.z, bt.w)};
                    *(LAS u32x2*)(KSs + s * SK_P72 + 4 * c) = (u32x2){pk2(kt_.x, kt_.y), pk2(kt_.z, kt_.w)};
                    if (jj & 1) {
#pragma unroll
                        for (int nt = 0; nt < 4; ++nt) { if (jj == 1) { bpp[nt].x = pk2(bprev[nt], bpc[nt]); kpp[nt].x = pk2(kprev[nt], kpc[nt]); } else { bpp[nt].y = pk2(bprev[nt], bpc[nt]); kpp[nt].y = pk2(kprev[nt], kpc[nt]); } }
                    } else { bprev = bpc; kprev = kpc; }
                    pex = pin;
                }
            }
            {
                LAS bf16* NT = (LAS bf16*)(sl + SK_NT); LAS bf16* RT = (LAS bf16*)(sl + SK_RT);
                LAS bf16* BP = (LAS bf16*)(sl + SK_BP); LAS bf16* KP = (LAS bf16*)(sl + SK_KP);
#pragma unroll
                for (int jj = 0; jj < 4; ++jj) { const int s = 4 * g + jj;
                    *(LAS u32x2*)(NT + s * SK_P72 + 4 * c) = ntp[jj]; *(LAS u32x2*)(RT + s * SK_P72 + 4 * c) = rtp[jj]; }
#pragma unroll
                for (int nt = 0; nt < 4; ++nt) { *(LAS u32x2*)(BP + (4 * c + nt) * SK_P20 + 4 * g) = bpp[nt]; *(LAS u32x2*)(KP + (4 * c + nt) * SK_P20 + 4 * g) = kpp[nt]; }
                if (g == 0) *(LAS f32x4*)((LAS float*)(sl + SK_PC) + 4 * c) = pcv;
                { const int sv = lane >> 2, cv = lane & 3; LAS bf16* VT = (LAS bf16*)(sl + SK_VT);
                  const u32x4 va_ = *(const LAS u32x4*)(scr + SK_VM + lane * 32), vb_ = *(const LAS u32x4*)(scr + SK_VM + lane * 32 + 16);
                  const unsigned vm[8] = {va_.x, va_.y, va_.z, va_.w, vb_.x, vb_.y, vb_.z, vb_.w};
#pragma unroll
                  for (int i = 0; i < 8; ++i) { VT[(16 * cv + 2 * i) * SK_P20 + sv] = (bf16)(vm[i] & 0xffffu); VT[(16 * cv + 2 * i + 1) * SK_P20 + sv] = (bf16)(vm[i] >> 16); } }
                asm volatile("s_waitcnt lgkmcnt(0)" ::: "memory");
                f32x4 Lb = Z4, Lk = Z4, Mb = Z4, Mk = Z4;
#pragma unroll
                for (int ks = 0; ks < 2; ++ks) {
                    const bf16x8 ab = *(const LAS bf16x8*)(BSs + c * SK_P72 + 32 * ks + 8 * g), ak = *(const LAS bf16x8*)(KSs + c * SK_P72 + 32 * ks + 8 * g);
                    const bf16x8 bn = *(const LAS bf16x8*)(NT + c * SK_P72 + 32 * ks + 8 * g), br = *(const LAS bf16x8*)(RT + c * SK_P72 + 32 * ks + 8 * g);
                    Lb = __builtin_amdgcn_mfma_f32_16x16x32_bf16(ab, bn, Lb, 0, 0, 0);
                    Lk = __builtin_amdgcn_mfma_f32_16x16x32_bf16(ak, bn, Lk, 0, 0, 0);
                    Mb = __builtin_amdgcn_mfma_f32_16x16x32_bf16(ab, br, Mb, 0, 0, 0);
                    Mk = __builtin_amdgcn_mfma_f32_16x16x32_bf16(ak, br, Mk, 0, 0, 0);
                }
#pragma unroll
                for (int j = 0; j < 4; ++j) { const int s = 4 * g + j; if (!(s < c)) { Lb[j] = 0.f; Lk[j] = 0.f; } if (!(s <= c)) { Mb[j] = 0.f; Mk[j] = 0.f; } }
                *(LAS u32x2*)((LAS bf16*)(sl + SK_LK) + c * SK_P20 + 4 * g) = (u32x2){pk2(Lk[0], Lk[1]), pk2(Lk[2], Lk[3])};
                *(LAS u32x2*)((LAS bf16*)(sl + SK_MB) + c * SK_P20 + 4 * g) = (u32x2){pk2(Mb[0], Mb[1]), pk2(Mb[2], Mb[3])};
                *(LAS u32x2*)((LAS bf16*)(sl + SK_MK) + c * SK_P20 + 4 * g) = (u32x2){pk2(Mk[0], Mk[1]), pk2(Mk[2], Mk[3])};
                *(LAS f32x4*)(LBs + c * 16 + 4 * g) = Lb;
            }
            __syncthreads();
            {
                float Ti[16];
#pragma unroll
                for (int t = 0; t < 16; ++t) {
                    float acc = (c_o == t) ? 1.f : 0.f;
                    if ((t & 3) == 0) asm volatile("" ::: "memory");
#pragma unroll
                    for (int s4 = 0; s4 < (t + 3) / 4; ++s4) {
                        const f32x4 l4 = *(const LAS f32x4*)(LBs + t * 16 + 4 * s4);
#pragma unroll
                        for (int e = 0; e < 4; ++e) if (4 * s4 + e < t) acc += Ti[4 * s4 + e] * l4[e];
                    }
                    Ti[t] = acc;
                }
                if (g == 0) {
                    LAS bf16* TT = (LAS bf16*)(sl + SK_TT);
#pragma unroll
                    for (int t = 0; t < 16; ++t) TT[t * SK_P20 + c] = (bf16)f2bf(Ti[t]);
                }
            }
            __syncthreads();
        }
#undef SK_LOAD_S
#undef SK_LOAD_L
#undef SK_LOAD_V
        for (int q = 0; q < 4 - pw; ++q) __syncthreads();
    }
}

constexpr int CW_HEAD = 12288;
__device__ __forceinline__ void head_publish(const Args& a, int u) {
    asm volatile("s_waitcnt vmcnt(0)" ::: "memory");
    __syncthreads();
    if (threadIdx.x == 0) {
        __builtin_amdgcn_fence(__ATOMIC_RELEASE, "agent");
        asm volatile("s_waitcnt vmcnt(0)" ::: "memory");
        __hip_atomic_store((unsigned*)a.ws + CW_HEAD + 16 * u, 1u, __ATOMIC_RELAXED, __HIP_MEMORY_SCOPE_AGENT);
    }
}
__device__ __forceinline__ void head_wait(const Args& a, int u) {
    if (threadIdx.x == 0) {
        unsigned* f = (unsigned*)a.ws + CW_HEAD + 16 * u;
        while (__hip_atomic_load(f, __ATOMIC_RELAXED, __HIP_MEMORY_SCOPE_AGENT) == 0u) __builtin_amdgcn_s_sleep(8);
        __builtin_amdgcn_fence(__ATOMIC_ACQUIRE, "agent");
        asm volatile("s_waitcnt vmcnt(0)" ::: "memory");
    }
    __syncthreads();
}
__device__ __forceinline__ void rwkv_post_item(const Args& a, int u, int sl) {
    const int tid = threadIdx.x, lane = tid & 63, wave = tid >> 6, tsub = lane >> 4, col = (u % 12) * 64 + 4 * (lane & 15);
    const int b = u / 12, h = u % 12;
    unsigned char* ws = a.ws;
    const bf16* PROJ = (const bf16*)(ws + WS_PROJ); bf16* CAT = (bf16*)(ws + WS_CAT); const float* BS = (const float*)(ws + WS_BS);
    const f32x4 lw = *(const f32x4*)(a.in[I_ALNW] + col), lb = *(const f32x4*)(a.in[I_ALNB] + col), mv = *(const f32x4*)(a.in[I_AMU] + C_V + col);
    for (int p0 = 0; p0 < 8; p0 += 2) {
        u32x2 yv[2], vc[2], vp[2], gt[2]; float bsv[2], pzv[2]; size_t mrow[2];
#pragma unroll
        for (int r = 0; r < 2; ++r) {
            const int t = 256 * sl + 32 * wave + 4 * (p0 + r) + tsub; const size_t m = (size_t)b * SEQ + t; mrow[r] = m;
            const bf16* pc = PROJ + m * LDP0; const bf16* pp = (t == 0) ? pc : pc - LDP0; pzv[r] = (t == 0) ? 0.f : 1.f;
            yv[r] = *(const u32x2*)(CAT + m * DM + col); vc[r] = *(const u32x2*)(pc + C_V + col); vp[r] = *(const u32x2*)(pp + C_V + col); gt[r] = *(const u32x2*)(pc + C_GATE0 + col);
            bsv[r] = BS[m * AH + h];
        }
#pragma unroll
        for (int r = 0; r < 2; ++r) {
            const float pz = pzv[r];
            float y[4] = {bflo(yv[r].x), bfhi(yv[r].x), bflo(yv[r].y), bfhi(yv[r].y)};
            const float mean = sum16((y[0] + y[1]) + (y[2] + y[3])) * (1.f / 64.f);
            float d[4], vs = 0.f;
#pragma unroll
            for (int j = 0; j < 4; ++j) { d[j] = y[j] - mean; vs += d[j] * d[j]; }
            const float rstd = 1.f / sqrtf(sum16(vs) * (1.f / 64.f) + LNX_EPS);
            const float vcur[4] = {bflo(vc[r].x), bfhi(vc[r].x), bflo(vc[r].y), bfhi(vc[r].y)};
            const float vprv[4] = {bflo(vp[r].x) * pz, bfhi(vp[r].x) * pz, bflo(vp[r].y) * pz, bfhi(vp[r].y) * pz};
            const float gg[4] = {bflo(gt[r].x), bfhi(gt[r].x), bflo(gt[r].y), bfhi(gt[r].y)};
            float o[4];
#pragma unroll
            for (int j = 0; j < 4; ++j) { const float v = vcur[j] + (vprv[j] - vcur[j]) * mv[j];
                o[j] = (d[j] * rstd * lw[j] + lb[j] + bsv[r] * v) * siluf_(gg[j]); }
            *(u32x2*)(CAT + mrow[r] * DM + col) = (u32x2){pk2(o[0], o[1]), pk2(o[2], o[3])};
        }
    }
}

__device__ __forceinline__ void phase_scan(const Args& a, LAS unsigned char* lds) {
    const int G = gridDim.x, bx = blockIdx.x;
    for (int it = bx; it < 256; it += G) lora_item(a, lds, it & 7, it >> 3);
    __syncthreads();
    if (bx < 96) { scan_unit(a, lds, bx / 12, bx % 12); head_publish(a, bx); }
    else { for (int u = bx - 96; u < 512; u += G - 96) mem_attn_unit(a, lds, 0, u);
           const int wave = __builtin_amdgcn_readfirstlane(threadIdx.x >> 6);
           transpose_group<1>(a, lds, (bx - 96) * 8 + wave, (G - 96) * 8); }
    for (int i = bx; i < 768; i += G) { const int u = i % 96; head_wait(a, u); rwkv_post_item(a, u, i / 96); }
}

__device__ __forceinline__ void phase_rwkv_post(const Args& a) {
    const int tid = threadIdx.x, lane = tid & 63, wave = tid >> 6, G = gridDim.x;
    unsigned char* ws = a.ws;
    const bf16* PROJ = (const bf16*)(ws + WS_PROJ); bf16* CAT = (bf16*)(ws + WS_CAT); const float* BS = (const float*)(ws + WS_BS);
    const float* mu = a.in[I_AMU];
    for (int m = blockIdx.x * 8 + wave; m < MTOK; m += G * 8) {
        const int t = m & (SEQ - 1);
        const bf16* pc = PROJ + (size_t)m * LDP0; const bf16* pp = (t == 0) ? pc : pc - LDP0; const float pz = (t == 0) ? 0.f : 1.f;
#pragma unroll
        for (int i = 0; i < 3; ++i) {
            const int col = 256 * i + 4 * lane, hh = col >> 6;
            const u32x2 yv = *(const u32x2*)(CAT + (size_t)m * DM + col);
            float y[4] = {bflo(yv.x), bfhi(yv.x), bflo(yv.y), bfhi(yv.y)};
            const float mean = sum16((y[0] + y[1]) + (y[2] + y[3])) * (1.f / 64.f);
            float d[4], vs = 0.f;
#pragma unroll
            for (int j = 0; j < 4; ++j) { d[j] = y[j] - mean; vs += d[j] * d[j]; }
            const float rstd = 1.f / sqrtf(sum16(vs) * (1.f / 64.f) + LNX_EPS);
            const f32x4 lw = *(const f32x4*)(a.in[I_ALNW] + col), lb = *(const f32x4*)(a.in[I_ALNB] + col), mv = *(const f32x4*)(mu + C_V + col);
            const u32x2 vc = *(const u32x2*)(pc + C_V + col), vp = *(const u32x2*)(pp + C_V + col), gt = *(const u32x2*)(pc + C_GATE0 + col);
            const float vcur[4] = {bflo(vc.x), bfhi(vc.x), bflo(vc.y), bfhi(vc.y)}, vprv[4] = {bflo(vp.x) * pz, bfhi(vp.x) * pz, bflo(vp.y) * pz, bfhi(vp.y) * pz};
            const float gg[4] = {bflo(gt.x), bfhi(gt.x), bflo(gt.y), bfhi(gt.y)};
            const float bs = BS[(size_t)m * AH + hh];
            float o[4];
#pragma unroll
            for (int j = 0; j < 4; ++j) { const float v = vcur[j] + (vprv[j] - vcur[j]) * mv[j];
                o[j] = (d[j] * rstd * lw[j] + lb[j] + bs * v) * siluf_(gg[j]); }
            u32x2 w; w.x = pk2(o[0], o[1]); w.y = pk2(o[2], o[3]);
            *(u32x2*)(CAT + (size_t)m * DM + col) = w;
        }
    }
}

template <int LAYER>
__device__ __forceinline__ void phase_rows(const Args& a) {
    const int tid = threadIdx.x, lane = tid & 63, wave = tid >> 6, G = gridDim.x;
    unsigned char* ws = a.ws;
    const bf16* Y = (const bf16*)(ws + WS_Y); const float* gpost = a.in[I_POST] + LAYER * DM;
    const float* xin = LAYER ? (const float*)a.out : a.in[I_X];
    bf16* XN = (bf16*)(ws + WS_XN);
    for (int m = blockIdx.x * 8 + wave; m < MTOK; m += G * 8) {
        const u32x2* yr = (const u32x2*)(Y + (size_t)m * DM) + lane; const f32x4* xr = (const f32x4*)(xin + (size_t)m * DM) + lane;
        f32x4 y[4], x[4]; float s = 0.f;
#pragma unroll
        for (int j = 0; j < 4; ++j) { const u32x2 yy = yr[64 * j]; y[j] = (f32x4){bflo(yy.x), bfhi(yy.x), bflo(yy.y), bfhi(yy.y)}; x[j] = xr[64 * j]; s += (y[j].x * y[j].x + y[j].y * y[j].y) + (y[j].z * y[j].z + y[j].w * y[j].w); }
        const float rs = 1.f / sqrtf(wave_sum(s) * (1.f / DM) + NORM_EPS);
        float s1 = 0.f;
        f32x4* orow = (f32x4*)(a.out + (size_t)m * DM) + lane;
#pragma unroll
        for (int j = 0; j < 4; ++j) { const f32x4 gp = *((const f32x4*)gpost + lane + 64 * j);
            x[j] = x[j] + y[j] * rs * gp; orow[64 * j] = x[j];
            s1 += (x[j].x * x[j].x + x[j].y * x[j].y) + (x[j].z * x[j].z + x[j].w * x[j].w); }
        if (LAYER == 0) {
            const float r1 = 1.f / sqrtf(wave_sum(s1) * (1.f / DM) + NORM_EPS);
            unsigned long long* o8 = (unsigned long long*)(XN + (size_t)m * DM) + lane;
#pragma unroll
            for (int j = 0; j < 4; ++j) o8[64 * j] = (unsigned long long)pk2(x[j].x * r1, x[j].y * r1) | ((unsigned long long)pk2(x[j].z * r1, x[j].w * r1) << 32);
        }
    }
}

constexpr int ATT_MAXU = 4;
__device__ const unsigned char att_deal[32][4] = {{32,31,94,8},{48,30,93,7},{33,29,90,81},{49,28,89,79},{34,27,86,74},{50,26,85,73},{35,25,82,66},{51,24,18,65},{36,23,12,1},{52,22,11,80},{37,21,2,255},{53,20,10,64},{38,19,9,16},{54,95,13,17},{39,92,4,255},{55,91,3,255},{40,88,76,255},{56,87,75,255},{41,84,70,255},{57,83,69,255},{42,15,68,255},{58,14,67,255},{43,6,255,255},{59,5,255,255},{44,78,255,255},{60,77,255,255},{45,72,255,255},{61,71,255,255},{46,0,255,255},{62,255,255,255},{47,255,255,255},{63,255,255,255}};
__device__ __forceinline__ void phase_attn1(const Args& a, LAS unsigned char* lds) {
    const int G = gridDim.x, bx = blockIdx.x, lane = threadIdx.x & 63;
    unsigned char* ws = a.ws;
    const float s1 = wave_sum(a.in[I_LQ1][lane] * a.in[I_LK1][lane]), s2 = wave_sum(a.in[I_LQ2][lane] * a.in[I_LK2][lane]);
    const float lam_init = 0.8f - 0.6f * 0.7408182206817179f;
    const float lam = __expf(s1) - __expf(s2) + lam_init;
    const bf16* PROJ = (const bf16*)(ws + WS_PROJ); const bf16* VT = (const bf16*)(ws + WS_VT); bf16* CAT = (bf16*)(ws + WS_CAT);
    const float slopes[6] = {0.25f, 0.0625f, 0.015625f, 0.00390625f, 0.5f, 0.125f};
    for (int i = 0; i < ATT_MAXU; ++i) {
        int qb, b, h;
        if (G == 256) { const int code = att_deal[bx >> 3][i]; if (code == 255) break; b = bx & 7; h = code >> 4; qb = code & 15; }
        else { const int n = i * G + bx; if (n >= 768) break; qb = 15 - n / 48; b = (n % 48) / 6; h = (n % 48) % 6; }
        const size_t row0 = (size_t)b * SEQ + qb * 128;
        float slope = slopes[0];
#pragma unroll
        for (int k = 1; k < 6; ++k) slope = (h == k) ? slopes[k] : slope;
        attn_unit<2>(lds, PROJ + row0 * LDP1 + C_Q1 + h * 128, LDP1,
                     PROJ + (size_t)b * SEQ * LDP1 + C_KSH + h * 128, LDP1,
                     VT + (size_t)(h * 128) * MTOK + (size_t)b * SEQ, MTOK,
                     2 * qb + 1, 2 * qb + 2, slope * LOG2E, qb * 128,
                     PROJ + row0 * LDP1 + C_GATE1 + h * 128, LDP1, CAT + row0 * DM + h * 128, DM, a.in[I_SUBLN], lam, 1.f - lam_init, (const unsigned*)(ws + WS_KM) + (b * 6 + h) * 16);
    }
    for (int u = bx; u < 512; u += G) mem_attn_unit(a, lds, 1, u);
}

constexpr int CW_XB = 8192;
#define XB_TMO      128
#define XB_XCNT(j)  (256  + 64 * (j))
#define XB_XSUB(j)  (1280 + 64 * (j))
#define XB_XGEN(j)  (2304 + 64 * (j))
#define XB_TOP      3328
#define XB_TOPGEN   3392
#define XB_SPIN_CAP (1u << 22)
__device__ __forceinline__ unsigned xb_ld(unsigned* p)              { return __hip_atomic_load(p, __ATOMIC_RELAXED, __HIP_MEMORY_SCOPE_AGENT); }
__device__ __forceinline__ unsigned xb_add(unsigned* p, unsigned v) { return __hip_atomic_fetch_add(p, v, __ATOMIC_RELAXED, __HIP_MEMORY_SCOPE_AGENT); }
__device__ __forceinline__ unsigned xb_xcc_id() { return (unsigned)__builtin_amdgcn_s_getreg((3 << 11) | 20) & 0xFu; }
#define XB_SPIN(cond, bar) do { unsigned _sp = 0; while (cond) { __builtin_amdgcn_s_sleep(1); \
    if ((++_sp & 255u) == 0u) { if (xb_ld(&(bar)[XB_TMO])) break; if (_sp > XB_SPIN_CAP) { atomicAdd(&(bar)[XB_TMO], 1u); break; } } } } while (0)
struct XcdBarrier { unsigned* bar; unsigned x; volatile LAS unsigned* st; };
__device__ __forceinline__ XcdBarrier xcd_barrier_post(unsigned* bar, volatile LAS unsigned* st) {
    XcdBarrier b; b.bar = bar; b.x = xb_xcc_id(); b.st = st;
    if (threadIdx.x == 0) (void)xb_add(&bar[XB_XCNT(b.x)], 1u);
    return b;
}
__device__ __forceinline__ void xcd_barrier_complete(unsigned* bar, unsigned x, unsigned& nloc, unsigned& nx) {
    const unsigned G = gridDim.x * gridDim.y * gridDim.z;
    unsigned sum, cnt, mine, sp = 0u;
    for (;;) {
        sum = 0u; cnt = 0u; mine = 0u;
#pragma unroll
        for (unsigned j = 0; j < 16; ++j) { const unsigned c = xb_ld(&bar[XB_XCNT(j)]); sum += c; cnt += (c > 0u) ? 1u : 0u; mine = (j == x) ? c : mine; }
        if (sum == G) break;
        __builtin_amdgcn_s_sleep(1);
        if ((++sp & 255u) == 0u) { if (xb_ld(&bar[XB_TMO])) break; if (sp > XB_SPIN_CAP) { atomicAdd(&bar[XB_TMO], 1u); break; } }
    }
    nloc = mine > 0u ? mine : 1u; nx = cnt > 0u ? cnt : 1u;
}
__device__ __forceinline__ void xcd_barrier(const XcdBarrier& b) {
    asm volatile("s_waitcnt vmcnt(0)" ::: "memory");
    __syncthreads();
    if (threadIdx.x == 0) {
        unsigned* bar = b.bar;
        __builtin_amdgcn_s_waitcnt(0);
        unsigned nloc = b.st[0], nx = b.st[1];
        if (nloc == 0u) { xcd_barrier_complete(bar, b.x, nloc, nx); b.st[0] = nloc; b.st[1] = nx; }
        const unsigned old = xb_add(&bar[XB_XSUB(b.x)], 1u);
        const unsigned gen = old / nloc;
        if (old + 1u == (gen + 1u) * nloc) {
            __builtin_amdgcn_fence(__ATOMIC_RELEASE, "agent");
            asm volatile("s_waitcnt vmcnt(0)" ::: "memory");
            const unsigned og = xb_add(&bar[XB_TOP], 1u);
            const unsigned tg = og / nx;
            if (og + 1u == (tg + 1u) * nx) xb_add(&bar[XB_TOPGEN], 1u);
            else XB_SPIN(xb_ld(&bar[XB_TOPGEN]) == tg, bar);
            __builtin_amdgcn_fence(__ATOMIC_ACQUIRE, "agent");
            xb_add(&bar[XB_XGEN(b.x)], 1u);
            asm volatile("s_waitcnt vmcnt(0)" ::: "memory");
        } else {
            XB_SPIN(xb_ld(&bar[XB_XGEN(b.x)]) == gen, bar);
            __builtin_amdgcn_fence(__ATOMIC_ACQUIRE, "agent");
            asm volatile("s_waitcnt vmcnt(0)" ::: "memory");
        }
    }
    __syncthreads();
}

constexpr int N_PHASES = 10;
__global__ void __launch_bounds__(512, 2) yoco_fwd(Args args) {
    extern __shared__ __attribute__((aligned(16))) unsigned char lds_raw[];
    LAS unsigned char* lds = (LAS unsigned char*)lds_raw;
    const int lo = args.ph_lo, hi = args.ph_hi;
#ifndef ONLY_PHASE
#define ONLY_PHASE -1
#endif
#define IN(k) ((ONLY_PHASE < 0 || ONLY_PHASE == (k)) && lo <= (k) && (k) < hi)
    volatile LAS unsigned* xb_st = (volatile LAS unsigned*)(lds + LDS_BYTES - 64);
    if (threadIdx.x == 0) { xb_st[0] = 0u; xb_st[1] = 0u; }
    __syncthreads();
    const XcdBarrier xbar = xcd_barrier_post((unsigned*)args.ws + CW_XB, xb_st);
    if (args.ph_hi > 64) { __syncthreads(); cg::this_grid().sync(); }
#define SEAM(k) do { if (IN(k) && IN((k) + 1)) { xcd_barrier(xbar); } } while (0)
    if (IN(0)) { phase_prologue(args, lds); if (PROBE_DUP == 0) { __syncthreads(); phase_prologue(args, lds); } }
    SEAM(0);
    if (IN(1)) { phase_gemm(args, lds, 0, 3); if (PROBE_DUP == 1) { __syncthreads(); phase_gemm(args, lds, 0, 3); } }
    SEAM(1);
    if (IN(2)) { phase_scan(args, lds); if (PROBE_DUP == 2) { __syncthreads(); phase_scan(args, lds); } }
    SEAM(2);
    if (IN(4)) { if (gridDim.x == 256) phase_outproj<0>(args, lds); else { phase_gemm(args, lds, 3, 1); } }
    if (gridDim.x != 256) { SEAM(4); if (IN(5)) phase_rows<0>(args); }
    SEAM(5);
    if (IN(6)) { phase_gemm(args, lds, 4, 2); if (PROBE_DUP == 6) { __syncthreads(); phase_gemm(args, lds, 4, 2); } }
    SEAM(6);
    if (IN(7)) { phase_attn1(args, lds); if (PROBE_DUP == 7) { __syncthreads(); phase_attn1(args, lds); } }
    SEAM(7);
    if (IN(8)) { if (gridDim.x == 256) phase_outproj<1>(args, lds); else { phase_gemm(args, lds, 6, 1); } }
    if (gridDim.x != 256) { SEAM(8); if (IN(9)) phase_rows<1>(args); }
#undef IN
#undef SEAM
}

extern "C" void kernel_launch(void* const* d_in, const int* in_sizes, int n_in, void* d_out, int out_size, void* d_ws, size_t ws_size, hipStream_t stream) {
    static int ready = 0;
    if (ready == 0) {
        if (n_in != 26 || out_size != MTOK * DM || ws_size < WS_END) { fprintf(stderr, "kernel_launch: unexpected problem shape (n_in %d out %d ws %zu)\n", n_in, out_size, ws_size); ready = -1; return; }
        if (hipFuncSetAttribute((const void*)yoco_fwd, hipFuncAttributeMaxDynamicSharedMemorySize, LDS_BYTES) != hipSuccess) { fprintf(stderr, "kernel_launch: hipFuncSetAttribute failed\n"); ready = -1; return; }
        int per_cu = 0;
        if (hipOccupancyMaxActiveBlocksPerMultiprocessor(&per_cu, (const void*)yoco_fwd, 512, LDS_BYTES) != hipSuccess || per_cu < 1) fprintf(stderr, "kernel_launch: occupancy query says %d\n", per_cu);
        (void)hipGetLastError();
        ready = 1;
    }
    if (ready < 0) return;
    Args a{};
    for (int i = 0; i < 26; ++i) a.in[i] = (const float*)d_in[i];
    a.out = (float*)d_out; a.ws = (unsigned char*)d_ws;
#if MK_COOP
    (void)hipMemsetAsync(d_ws, 0, 65536, stream);
    a.ph_lo = 0; a.ph_hi = N_PHASES;
    void* params[] = {&a};
    hipError_t e = hipLaunchCooperativeKernel((const void*)yoco_fwd, dim3(256), dim3(512), params, LDS_BYTES, stream);
    if (e != hipSuccess) fprintf(stderr, "kernel_launch: cooperative launch failed: %s\n", hipGetErrorString(e));
#else
    for (int ph = 0; ph < N_PHASES; ++ph) { a.ph_lo = ph; a.ph_hi = ph + 1; hipLaunchKernelGGL(yoco_fwd, dim3(256), dim3(512), LDS_BYTES, stream, a); }
#endif
}
```

```cpp
#include <hip/hip_runtime.h>
#include <hip/hip_cooperative_groups.h>
#include <cstdio>
#include <cstdint>
namespace cg = cooperative_groups;

#ifndef PROBE_DUP
#define PROBE_DUP -1
#endif
#ifndef MK_COOP
#define MK_COOP 1
#endif

#define LAS __attribute__((address_space(3)))
typedef unsigned short bf16;
typedef short bf16x8 __attribute__((ext_vector_type(8)));
typedef float f32x4 __attribute__((ext_vector_type(4)));
typedef float f32x2 __attribute__((ext_vector_type(2)));
typedef unsigned u32x4 __attribute__((ext_vector_type(4)));
typedef unsigned u32x2 __attribute__((ext_vector_type(2)));

constexpr int DM = 1024, NBATCH = 8, SEQ = 2048, MTOK = NBATCH * SEQ;
constexpr int MEML = 256, MROWS = NBATCH * MEML;
constexpr int BRW = 768, AH = 12, BH = 6;
constexpr int LDP0 = 3840;
constexpr int LDP1 = 2816;
constexpr int C_R = 0, C_K = 768, C_V = 1536, C_WD = 2304, C_AD = 2368, C_GATE0 = 2432, C_QM0 = 3200, C_GM0 = 3456;
constexpr int C_Q1 = 0, C_GATE1 = 768, C_QM1 = 1536, C_GM1 = 1792, C_KSH = 2048;
constexpr float NORM_EPS = 1e-6f, LNX_EPS = 64e-5f;
constexpr float LOG2E = 1.4426950408889634f;

constexpr size_t MiB = 1u << 20;
constexpr size_t WS_WA = 1 * MiB;
constexpr size_t WS_WB = 9 * MiB;
constexpr size_t WS_WO = 16 * MiB;
constexpr size_t WS_WM = 20 * MiB;
constexpr size_t WS_MEMN = 22 * MiB;
constexpr size_t WS_MK = 26 * MiB;
constexpr size_t WS_MVT = 28 * MiB;
constexpr size_t WS_XN = 30 * MiB;
constexpr size_t WS_CAT = 62 * MiB;
constexpr size_t WS_VT = 94 * MiB;
constexpr size_t WS_PROJ = 118 * MiB;
constexpr size_t WS_Y = 118 * MiB;
constexpr size_t WS_W2T = 0 * MiB + 65536;
constexpr size_t WS_KM = 6144;
constexpr size_t WS_XCNT = 16384;
constexpr size_t WS_XCH = 254 * MiB;
constexpr size_t WS_LD16 = WS_XN;
constexpr size_t WS_A16 = WS_VT;
constexpr int CW_LX = 14336;
constexpr int CW_HEAD = 12288;
constexpr int CW_LORA = 1280;
constexpr size_t WS_X1B = 210 * MiB;
constexpr size_t WS_BS = 238 * MiB;
constexpr size_t WS_END = 256 * MiB;

__device__ __forceinline__ unsigned f2bf(float f) { unsigned u = __builtin_bit_cast(unsigned, f); return (u + 0x7fffu + ((u >> 16) & 1u)) >> 16; }
typedef __bf16 bf16x2_t __attribute__((ext_vector_type(2)));
__device__ __forceinline__ unsigned pk2(float lo, float hi) { f32x2 v = {lo, hi}; bf16x2_t b = __builtin_convertvector(v, bf16x2_t); return __builtin_bit_cast(unsigned, b); }
__device__ __forceinline__ float bflo(unsigned u) { return __builtin_bit_cast(float, u << 16); }
__device__ __forceinline__ float bfhi(unsigned u) { return __builtin_bit_cast(float, u & 0xffff0000u); }
__device__ __forceinline__ float wave_sum(float v) {
#pragma unroll
    for (int o = 1; o < 64; o <<= 1) v += __shfl_xor(v, o);
    return v;
}
template <int CTRL> __device__ __forceinline__ float dppf(float x) { return __builtin_bit_cast(float, __builtin_amdgcn_update_dpp(0, __builtin_bit_cast(int, x), CTRL, 0xf, 0xf, false)); }
__device__ __forceinline__ float sum8(float x) { x += dppf<0xB1>(x); x += dppf<0x4E>(x); x += dppf<0x141>(x); return x; }
__device__ __forceinline__ float sum16(float x) { x += dppf<0xB1>(x); x += dppf<0x4E>(x); x += dppf<0x141>(x); x += dppf<0x140>(x); return x; }
__device__ __forceinline__ float rows_max(float m) { m = fmaxf(m, __shfl_xor(m, 16)); return fmaxf(m, __shfl_xor(m, 32)); }
__device__ __forceinline__ float rows_sum(float m) { m += __shfl_xor(m, 16); return m + __shfl_xor(m, 32); }
__device__ __forceinline__ float sigmoidf_(float x) { return __builtin_amdgcn_rcpf(1.f + __builtin_amdgcn_exp2f(-1.4426950408889634f * x)); }
__device__ __forceinline__ float siluf_(float x) { return x * __builtin_amdgcn_rcpf(1.f + __builtin_amdgcn_exp2f(-1.4426950408889634f * x)); }

namespace pg8 {
constexpr int BM = 256, BK = 64, HALF = 128, HTB = HALF * BK * 2, STAGE_BYTES = 8 * HTB, NXCD = 8, WGM = 8;
__device__ __forceinline__ int lds_byte(int r, int c) { const int st = (r >> 4) * 2 + (c >> 5), rr = r & 15, cc = c & 31, ob = rr * 64 + cc * 2; return st * 1024 + (ob ^ (((ob >> 9) & 1) << 5)); }
__device__ __forceinline__ void stage_rc(int b, int& R, int& C) { const int st = b / 1024, sb = b % 1024, swz = sb ^ (((sb >> 9) & 1) << 5); R = (st >> 1) * 16 + swz / 64; C = (st & 1) * 32 + (swz % 64) / 2; }
__device__ __forceinline__ int perm32(int rho) { const int n = rho >> 4, i = rho & 15; return 8 * (i >> 2) + 4 * n + (i & 3); }
struct Unit { int pm, pn; };
struct Gemm { const bf16* A; const bf16* Bt; int M, N, K; };
struct StaticOrder {
    int nM, nN, nwg, G, c;
    __device__ void init(int M, int N, int G_, int c_) { nM = M / BM; nN = N / BM; nwg = nM * nN; G = G_; c = c_; }
    __device__ bool next(int i, Unit& u) const {
        const long L = (long)i * G + c; if (L >= nwg) return false;
        int wgid = (int)L; { const int q = nwg / NXCD, r = nwg % NXCD, xcd = wgid % NXCD, off = wgid / NXCD; wgid = (xcd < r ? xcd * (q + 1) : r * (q + 1) + (xcd - r) * q) + off; }
        const int nig = WGM * nN, gid = wgid / nig, fm = gid * WGM, gsz = (nM - fm) < WGM ? (nM - fm) : WGM;
        u.pm = fm + ((wgid % nig) % gsz); u.pn = (wgid % nig) / gsz; return true;
    }
};
__device__ __forceinline__ unsigned cvt_pk_bf16(float lo, float hi) { unsigned r; asm volatile("v_cvt_pk_bf16_f32 %0, %1, %2" : "=v"(r) : "v"(lo), "v"(hi)); return r; }

struct EpiStore {
    void* O; int ldc; int f32out; unsigned* km;
    __device__ __forceinline__ void operator()(const f32x4 (&acc)[2][2][4][2], const Unit& u, int wr, int wc, int fr, int fq) const {
        const int row0 = u.pm * BM + wr * 64 + fr, col0 = u.pn * BM + wc * 32 + 8 * fq;
        if (f32out) {
#pragma unroll
            for (int ai = 0; ai < 2; ++ai)
#pragma unroll
                for (int m = 0; m < 4; ++m) { float* rowp = (float*)O + (size_t)(row0 + ai * HALF + m * 16) * ldc + col0;
#pragma unroll
                    for (int bj = 0; bj < 2; ++bj) { *(f32x4*)(rowp + bj * HALF) = acc[ai][bj][m][0]; *(f32x4*)(rowp + bj * HALF + 4) = acc[ai][bj][m][1]; } }
        } else {
#pragma unroll
            for (int ai = 0; ai < 2; ++ai)
#pragma unroll
                for (int m = 0; m < 4; ++m) { bf16* rowp = (bf16*)O + (size_t)(row0 + ai * HALF + m * 16) * ldc + col0;
#pragma unroll
                    for (int bj = 0; bj < 2; ++bj) { const f32x4 v0 = acc[ai][bj][m][0], v1 = acc[ai][bj][m][1];
                        u32x4 w; w.x = cvt_pk_bf16(v0[0], v0[1]); w.y = cvt_pk_bf16(v0[2], v0[3]); w.z = cvt_pk_bf16(v1[0], v1[1]); w.w = cvt_pk_bf16(v1[2], v1[3]);
                        *(u32x4*)(rowp + bj * HALF) = w; } }
            if (km && u.pn >= 8) {
#pragma unroll
                for (int bj = 0; bj < 2; ++bj) {
                    float pmax = 0.f;
#pragma unroll
                    for (int ai = 0; ai < 2; ++ai)
#pragma unroll
                        for (int m = 0; m < 4; ++m) { const f32x4 v0 = acc[ai][bj][m][0], v1 = acc[ai][bj][m][1];
                            const unsigned w0 = cvt_pk_bf16(v0[0], v0[1]), w1 = cvt_pk_bf16(v0[2], v0[3]), w2 = cvt_pk_bf16(v1[0], v1[1]), w3 = cvt_pk_bf16(v1[2], v1[3]);
                            const float a0 = bflo(w0), a1 = bfhi(w0), a2 = bflo(w1), a3 = bfhi(w1), a4 = bflo(w2), a5 = bfhi(w2), a6 = bflo(w3), a7 = bfhi(w3);
                            pmax = fmaxf(pmax, ((a0 * a0 + a1 * a1) + (a2 * a2 + a3 * a3)) + ((a4 * a4 + a5 * a5) + (a6 * a6 + a7 * a7))); }
                    pmax = fmaxf(pmax, dppf<0xB1>(pmax)); pmax = fmaxf(pmax, dppf<0x4E>(pmax)); pmax = fmaxf(pmax, dppf<0x141>(pmax)); pmax = fmaxf(pmax, dppf<0x140>(pmax));
                    if (fr == 0) { const int ck = u.pn * BM + bj * HALF + wc * 32 + 8 * fq - 2048;
                        atomicMax(km + (((u.pm >> 3) * 6 + (ck >> 7)) * 2 + ((ck >> 6) & 1)) * 8 + ((ck >> 3) & 7), __builtin_bit_cast(unsigned, pmax)); }
                }
            }
        }
    }
};

struct EpiFused {
    const float* xin; const bf16* xin16; float* out; bf16* out16; bf16* XN; const float* gpost; float* xch; unsigned* cnt;
    __device__ __forceinline__ void exchange(int ex, int pm, int pn, LAS float* P, LAS float* RS, int tid) const {
        __syncthreads();
        unsigned* mine = (unsigned*)(xch + ((size_t)(ex * 64 + pm) * 4) * 256);
        if (tid < 256) { const f32x4 p4 = *(const LAS f32x4*)(P + tid * 4);
            __hip_atomic_store(mine + pn * 256 + tid, __builtin_bit_cast(unsigned, (p4.x + p4.y) + (p4.z + p4.w)), __ATOMIC_RELAXED, __HIP_MEMORY_SCOPE_AGENT); }
        asm volatile("s_waitcnt vmcnt(0)" ::: "memory");
        __syncthreads();
        if (tid == 0) {
            unsigned* c = cnt + (ex * 64 + pm) * 16;
            (void)__hip_atomic_fetch_add(c, 1u, __ATOMIC_RELAXED, __HIP_MEMORY_SCOPE_AGENT);
            while (__hip_atomic_load(c, __ATOMIC_RELAXED, __HIP_MEMORY_SCOPE_AGENT) < 4u) __builtin_amdgcn_s_sleep(1);
        }
        __syncthreads();
        if (tid < 256) {
            const float t0 = __builtin_bit_cast(float, __hip_atomic_load(mine + tid, __ATOMIC_RELAXED, __HIP_MEMORY_SCOPE_AGENT)), t1 = __builtin_bit_cast(float, __hip_atomic_load(mine + 256 + tid, __ATOMIC_RELAXED, __HIP_MEMORY_SCOPE_AGENT)),
                        t2 = __builtin_bit_cast(float, __hip_atomic_load(mine + 512 + tid, __ATOMIC_RELAXED, __HIP_MEMORY_SCOPE_AGENT)), t3 = __builtin_bit_cast(float, __hip_atomic_load(mine + 768 + tid, __ATOMIC_RELAXED, __HIP_MEMORY_SCOPE_AGENT));
            RS[tid] = __builtin_amdgcn_rsqf(((t0 + t1) + (t2 + t3)) * (1.f / 1024.f) + 1e-6f); }
        __syncthreads();
    }
    __device__ __forceinline__ void fused(f32x4 (&acc)[2][2][4][2], const Unit& u, int wr, int wc, int fr, int fq, LAS unsigned char* lds) const {
        const int tid = threadIdx.x;
        LAS float* P = (LAS float*)lds;
        LAS float* RS = (LAS float*)(lds + 4096);
#pragma unroll
        for (int ai = 0; ai < 2; ++ai)
#pragma unroll
            for (int m = 0; m < 4; ++m) {
                float p = 0.f;
#pragma unroll
                for (int bj = 0; bj < 2; ++bj)
#pragma unroll
                    for (int n = 0; n < 2; ++n) { const f32x4 v = acc[ai][bj][m][n]; p += (v.x * v.x + v.y * v.y) + (v.z * v.z + v.w * v.w); }
                p += __shfl_xor(p, 16); p += __shfl_xor(p, 32);
                if (fq == 0) P[(ai * HALF + wr * 64 + m * 16 + fr) * 4 + wc] = p;
            }
        exchange(0, u.pm, u.pn, P, RS, tid);
        const int col0 = u.pn * BM + wc * 32 + 8 * fq;
        f32x4 gp[2][2];
#pragma unroll
        for (int bj = 0; bj < 2; ++bj)
#pragma unroll
            for (int n = 0; n < 2; ++n) gp[bj][n] = *(const f32x4*)(gpost + col0 + bj * HALF + 4 * n);
#pragma unroll
        for (int ai = 0; ai < 2; ++ai)
#pragma unroll
            for (int m = 0; m < 4; ++m) {
                const int rl = ai * HALF + wr * 64 + m * 16 + fr; const float rs = RS[rl];
                const size_t off = (size_t)(u.pm * BM + rl) * 1024 + col0;
                float p = 0.f;
#pragma unroll
                for (int bj = 0; bj < 2; ++bj) {
                    f32x4 xv[2];
                    if (xin16) { const u32x4 xb = *(const u32x4*)(xin16 + off + bj * HALF); xv[0] = (f32x4){bflo(xb.x), bfhi(xb.x), bflo(xb.y), bfhi(xb.y)}; xv[1] = (f32x4){bflo(xb.z), bfhi(xb.z), bflo(xb.w), bfhi(xb.w)}; }
                    else { xv[0] = *(const f32x4*)(xin + off + bj * HALF); xv[1] = *(const f32x4*)(xin + off + bj * HALF + 4); }
#pragma unroll
                    for (int n = 0; n < 2; ++n) {
                        const f32x4 x1 = xv[n] + acc[ai][bj][m][n] * rs * gp[bj][n];
                        acc[ai][bj][m][n] = x1;
                        p += (x1.x * x1.x + x1.y * x1.y) + (x1.z * x1.z + x1.w * x1.w);
                    }
                    if (out16) { const f32x4 v0 = acc[ai][bj][m][0], v1 = acc[ai][bj][m][1];
                        u32x4 w; w.x = cvt_pk_bf16(v0[0], v0[1]); w.y = cvt_pk_bf16(v0[2], v0[3]); w.z = cvt_pk_bf16(v1[0], v1[1]); w.w = cvt_pk_bf16(v1[2], v1[3]);
                        *(u32x4*)(out16 + off + bj * HALF) = w; }
                    else { *(f32x4*)(out + off + bj * HALF) = acc[ai][bj][m][0]; *(f32x4*)(out + off + bj * HALF + 4) = acc[ai][bj][m][1]; }
                }
                if (XN) { p += __shfl_xor(p, 16); p += __shfl_xor(p, 32); if (fq == 0) P[rl * 4 + wc] = p; }
            }
        if (XN) {
            exchange(1, u.pm, u.pn, P, RS, tid);
#pragma unroll
            for (int ai = 0; ai < 2; ++ai)
#pragma unroll
                for (int m = 0; m < 4; ++m) {
                    const int rl = ai * HALF + wr * 64 + m * 16 + fr; const float r1 = RS[rl];
                    bf16* rowp = XN + (size_t)(u.pm * BM + rl) * 1024 + col0;
#pragma unroll
                    for (int bj = 0; bj < 2; ++bj) { const f32x4 v0 = acc[ai][bj][m][0] * r1, v1 = acc[ai][bj][m][1] * r1;
                        u32x4 w; w.x = cvt_pk_bf16(v0[0], v0[1]); w.y = cvt_pk_bf16(v0[2], v0[3]); w.z = cvt_pk_bf16(v1[0], v1[1]); w.w = cvt_pk_bf16(v1[2], v1[3]);
                        *(u32x4*)(rowp + bj * HALF) = w; }
                }
        }
        __syncthreads();
    }
};

template <class Epi, class Sched, bool FUSED = false>
__device__ __forceinline__ void gemm_phase(LAS unsigned char* lds, const Gemm g, const Sched& S, const Epi& E) {
    const int tid = threadIdx.x, wid = __builtin_amdgcn_readfirstlane(tid >> 6), lane = tid & 63, wr = wid >> 2, wc = wid & 3, fr = lane & 15, fq = lane >> 4;
    const int K = g.K, nt = K / BK;
    unsigned voffA[2], voffB[2];
#pragma unroll
    for (int i = 0; i < 2; ++i) { int R, C; stage_rc(tid * 16 + i * 8192, R, C); const int Rb = (R & ~31) + perm32(R & 31);
        voffA[i] = (unsigned)(R * K + C) * 2u; voffB[i] = (unsigned)(Rb * K + C) * 2u; }
    const size_t kstep = (size_t)(BK * 2);
    const size_t hstep = (size_t)HALF * K * 2;
    const size_t tstep = 2 * hstep;
    const unsigned ldsw = (unsigned)wid * 1024u;
    const int aoff = lds_byte(wr * 64 + fr, fq * 8), boff = lds_byte(wc * 32 + fr, fq * 8);
#define PG8_SA(b, h) (((b) * 2 + (h)) * HTB)
#define PG8_SB(b, h) ((4 + (b) * 2 + (h)) * HTB)
#define PG8_STAGE(bufoff, gbase, voff) do { _Pragma("unroll") for (int _i = 0; _i < 2; ++_i) \
        __builtin_amdgcn_global_load_lds((const unsigned*)((const char*)(gbase) + (voff)[_i]), (LAS unsigned*)(lds + (bufoff) + ldsw + _i * 8192), 16, 0, 0); } while (0)
#define PG8_LDA(dst, b, h) do { _Pragma("unroll") for (int m = 0; m < 4; ++m) _Pragma("unroll") for (int k = 0; k < 2; ++k) dst[m][k] = *(const LAS bf16x8*)(lds + PG8_SA(b, h) + aoff + m * 2048 + k * 1024); } while (0)
#define PG8_LDB(dst, b, h) do { _Pragma("unroll") for (int n = 0; n < 2; ++n) _Pragma("unroll") for (int k = 0; k < 2; ++k) dst[n][k] = *(const LAS bf16x8*)(lds + PG8_SB(b, h) + boff + n * 2048 + k * 1024); } while (0)
#define PG8_MMA(ai, bj, At, Bt) do { __builtin_amdgcn_s_setprio(1); _Pragma("unroll") for (int m = 0; m < 4; ++m) _Pragma("unroll") for (int n = 0; n < 2; ++n) _Pragma("unroll") for (int k = 0; k < 2; ++k) \
        acc[ai][bj][m][n] = __builtin_amdgcn_mfma_f32_16x16x32_bf16(Bt[n][k], At[m][k], acc[ai][bj][m][n], 0, 0, 0); __builtin_amdgcn_s_setprio(0); } while (0)
#define PG8_WAIT_V(n) asm volatile("s_waitcnt vmcnt(" #n ")" ::: "memory")
#define PG8_WAIT_L(n) asm volatile("s_waitcnt lgkmcnt(" #n ")" ::: "memory")
#define PG8_BAR __builtin_amdgcn_s_barrier()
#define PG8_SCHED __builtin_amdgcn_sched_barrier(0)
    Unit cur, nxt; int ui = 0;
    if (!S.next(0, cur)) return;
    f32x4 acc[2][2][4][2];
#pragma unroll
    for (int a = 0; a < 2; ++a)
#pragma unroll
        for (int b = 0; b < 2; ++b)
#pragma unroll
            for (int m = 0; m < 4; ++m)
#pragma unroll
                for (int n = 0; n < 2; ++n) acc[a][b][m][n] = (f32x4){0.f, 0.f, 0.f, 0.f};
    bf16x8 At[4][2], B0[2][2], B1[2][2];
    const char* cA = (const char*)g.A + (size_t)cur.pm * tstep; const char* cB = (const char*)g.Bt + (size_t)cur.pn * tstep;
    PG8_STAGE(PG8_SB(0, 0), cB, voffB); PG8_STAGE(PG8_SB(0, 1), cB + hstep, voffB); PG8_STAGE(PG8_SA(0, 0), cA, voffA); PG8_STAGE(PG8_SA(0, 1), cA + hstep, voffA);
    if (wr == 1) PG8_BAR;
    PG8_WAIT_V(2); PG8_BAR;
    PG8_STAGE(PG8_SB(1, 0), cB + kstep, voffB); PG8_STAGE(PG8_SA(1, 0), cA + kstep, voffA); PG8_STAGE(PG8_SB(1, 1), cB + hstep + kstep, voffB);
    PG8_WAIT_V(6); PG8_BAR;
    for (;;) {
        const bool has_next = S.next(ui + 1, nxt);
        const char* nA = has_next ? (const char*)g.A + (size_t)nxt.pm * tstep : cA; const char* nB = has_next ? (const char*)g.Bt + (size_t)nxt.pn * tstep : cB;
        for (int t = 0; t < nt; t += 2) {
            const bool last = (t == nt - 2);
            const char* a1 = cA + (size_t)(t + 1) * kstep;
            const char* a2 = last ? nA : cA + (size_t)(t + 2) * kstep; const char* b2 = last ? nB : cB + (size_t)(t + 2) * kstep;
            const char* a3 = a2 + kstep; const char* b3 = b2 + kstep;
            PG8_LDB(B0, 0, 0); PG8_LDB(B1, 0, 1); PG8_SCHED; PG8_LDA(At, 0, 0); PG8_STAGE(PG8_SA(1, 1), a1 + hstep, voffA);
            PG8_WAIT_V(8); PG8_WAIT_L(0); PG8_BAR; PG8_MMA(0, 0, At, B0); PG8_MMA(0, 1, At, B1); PG8_BAR; PG8_SCHED;
            PG8_LDA(At, 0, 1); PG8_STAGE(PG8_SB(0, 0), b2, voffB); PG8_STAGE(PG8_SB(0, 1), b2 + hstep, voffB); PG8_STAGE(PG8_SA(0, 0), a2, voffA);
            PG8_WAIT_V(8); PG8_WAIT_L(0); PG8_BAR; PG8_MMA(1, 0, At, B0); PG8_MMA(1, 1, At, B1); PG8_BAR; PG8_SCHED;
            PG8_LDB(B0, 1, 0); PG8_LDB(B1, 1, 1); PG8_SCHED; PG8_LDA(At, 1, 0); PG8_STAGE(PG8_SA(0, 1), a2 + hstep, voffA);
            PG8_WAIT_V(8); PG8_WAIT_L(0); PG8_BAR; PG8_MMA(0, 0, At, B0); PG8_MMA(0, 1, At, B1); PG8_BAR; PG8_SCHED;
            PG8_LDA(At, 1, 1); PG8_STAGE(PG8_SB(1, 0), b3, voffB); PG8_STAGE(PG8_SB(1, 1), b3 + hstep, voffB); PG8_STAGE(PG8_SA(1, 0), a3, voffA);
            PG8_WAIT_V(8); PG8_WAIT_L(0); PG8_BAR; PG8_MMA(1, 0, At, B0); PG8_MMA(1, 1, At, B1); PG8_BAR; PG8_SCHED;
        }
        if (wr == 0) PG8_BAR;
        if constexpr (!FUSED) E(acc, cur, wr, wc, fr, fq);
        if (!has_next) break;
#pragma unroll
        for (int a = 0; a < 2; ++a)
#pragma unroll
            for (int b = 0; b < 2; ++b)
#pragma unroll
                for (int m = 0; m < 4; ++m)
#pragma unroll
                    for (int n = 0; n < 2; ++n) acc[a][b][m][n] = (f32x4){0.f, 0.f, 0.f, 0.f};
        cur = nxt; cA = nA; cB = nB; ++ui;
        if (wr == 1) PG8_BAR;
    }
    PG8_WAIT_V(0);
    PG8_BAR;
    if constexpr (FUSED) E.fused(acc, cur, wr, wc, fr, fq, lds);
#undef PG8_SA
#undef PG8_SB
#undef PG8_STAGE
#undef PG8_LDA
#undef PG8_LDB
#undef PG8_MMA
#undef PG8_WAIT_V
#undef PG8_WAIT_L
#undef PG8_BAR
#undef PG8_SCHED
}
}

struct Args { const float* in[26]; float* out; unsigned char* ws; int ph_lo, ph_hi; };
enum { I_X = 0, I_MEM, I_PRE, I_POST, I_WOUT, I_MEMNORM, I_WMEMKV, I_AWIN, I_AMU, I_AW0, I_AW2, I_AA0, I_AA2, I_AKK, I_AKA, I_ARK, I_ALNW, I_ALNB,
       I_KVNORM, I_WKV, I_BWIN, I_LQ1, I_LK1, I_LQ2, I_LK2, I_SUBLN };

constexpr int LDS_BYTES = 147456;

__device__ __forceinline__ void p0_transpose_item(const float* W, int ldw, int c0, int nc, const float* gain, bf16* WT, int row0, LAS float* scr, int item, int lane, int ldo = 1024) {
    const int nblk = nc / 32, kb = item / nblk, nb = item % nblk, k0 = 64 * kb, n0 = 32 * nb;
#pragma unroll
    for (int i = 0; i < 8; ++i) { const int kk = 8 * i + (lane >> 3), n4 = 4 * (lane & 7);
        f32x4 v = *(const f32x4*)(W + (size_t)(k0 + kk) * ldw + c0 + n0 + n4); if (gain) v = v * gain[k0 + kk];
        LAS float* d = scr + kk * 33 + n4; d[0] = v.x; d[1] = v.y; d[2] = v.z; d[3] = v.w; }
    asm volatile("s_waitcnt lgkmcnt(0)" ::: "memory");
    const int c = lane & 7;
#pragma unroll
    for (int j = 0; j < 4; ++j) { const int n = (lane >> 3) + 8 * j; const LAS float* s = scr + (8 * c) * 33 + n;
        u32x4 o; o.x = pk2(s[0 * 33], s[1 * 33]); o.y = pk2(s[2 * 33], s[3 * 33]); o.z = pk2(s[4 * 33], s[5 * 33]); o.w = pk2(s[6 * 33], s[7 * 33]);
        *(u32x4*)(WT + (size_t)(row0 + n0 + n) * ldo + k0 + 8 * c) = o; }
    asm volatile("s_waitcnt lgkmcnt(0)" ::: "memory");
}
__device__ __forceinline__ void rms_row_to_bf16(const float* xrow, bf16* orow, int lane) {
    const f32x4* xr = (const f32x4*)xrow + lane;
    f32x4 v[4]; float s = 0.f;
#pragma unroll
    for (int j = 0; j < 4; ++j) { v[j] = xr[64 * j]; s += (v[j].x * v[j].x + v[j].y * v[j].y) + (v[j].z * v[j].z + v[j].w * v[j].w); }
    const float rs = 1.f / sqrtf(wave_sum(s) * (1.f / DM) + NORM_EPS);
    unsigned long long* o8 = (unsigned long long*)orow + lane;
#pragma unroll
    for (int j = 0; j < 4; ++j) o8[64 * j] = (unsigned long long)pk2(v[j].x * rs, v[j].y * rs) | ((unsigned long long)pk2(v[j].z * rs, v[j].w * rs) << 32);
}
template <int GROUP>
__device__ __forceinline__ void transpose_group(const Args& a, LAS unsigned char* lds, int gw, int NGW) {
    const int lane = threadIdx.x & 63, wave = __builtin_amdgcn_readfirstlane(threadIdx.x >> 6);
    unsigned char* ws = a.ws;
    LAS float* scr = (LAS float*)(lds + wave * 16384);
    bf16* WA = (bf16*)(ws + WS_WA); bf16* WB = (bf16*)(ws + WS_WB); bf16* WO = (bf16*)(ws + WS_WO); bf16* WM = (bf16*)(ws + WS_WM);
    constexpr int I0 = 16 * (3712 / 32), I1 = 16 * (2048 / 32), I2 = 16 * (1536 / 32), I3 = 16 * (1024 / 32), I5 = 16 * (256 / 32), I6 = 768 / 32;
    bf16* W2T = (bf16*)(ws + WS_W2T); bf16* A2T = W2T + 768 * 64;
    if (GROUP == 0) {
        constexpr int NITEMS = I0 + 4 * I5 + 2 * I6;
        for (int it = gw; it < NITEMS; it += NGW) {
            int r = it;
            if (r < I0) { p0_transpose_item(a.in[I_AWIN], 3712, 0, 3712, a.in[I_PRE], WA, 0, scr, r, lane); continue; } r -= I0;
            if (r < I5) { p0_transpose_item(a.in[I_WMEMKV], 512, 0, 256, a.in[I_MEMNORM], WM, 0, scr, r, lane); continue; } r -= I5;
            if (r < I5) { p0_transpose_item(a.in[I_WMEMKV], 512, 256, 256, a.in[I_MEMNORM], WM, 512, scr, r, lane); continue; } r -= I5;
            if (r < I5) { p0_transpose_item(a.in[I_WMEMKV] + 1024 * 512, 512, 0, 256, a.in[I_MEMNORM] + 1024, WM, 256, scr, r, lane); continue; } r -= I5;
            if (r < I5) { p0_transpose_item(a.in[I_WMEMKV] + 1024 * 512, 512, 256, 256, a.in[I_MEMNORM] + 1024, WM, 768, scr, r, lane); continue; } r -= I5;
            if (r < I6) { p0_transpose_item(a.in[I_AW2], 768, 0, 768, nullptr, W2T, 0, scr, r, lane, 64); continue; } r -= I6;
            p0_transpose_item(a.in[I_AA2], 768, 0, 768, nullptr, A2T, 0, scr, r, lane, 64);
        }
    } else {
        constexpr int NITEMS = I1 + I2 + 2 * I3;
        for (int it = gw; it < NITEMS; it += NGW) {
            int r = it;
            if (r < I1) { p0_transpose_item(a.in[I_BWIN], 2048, 0, 2048, a.in[I_PRE] + 1024, WB, 0, scr, r, lane); continue; } r -= I1;
            if (r < I2) { p0_transpose_item(a.in[I_WKV], 1536, 0, 1536, a.in[I_KVNORM], WB, 2048, scr, r, lane); continue; } r -= I2;
            if (r < I3) { p0_transpose_item(a.in[I_WOUT], 1024, 0, 1024, nullptr, WO, 0, scr, r, lane); continue; } r -= I3;
            p0_transpose_item(a.in[I_WOUT] + 1024 * 1024, 1024, 0, 1024, nullptr, WO + 1024 * 1024, 0, scr, r, lane);
        }
    }
}
__device__ __forceinline__ void phase_prologue(const Args& a, LAS unsigned char* lds) {
    const int tid = threadIdx.x, lane = tid & 63, wave = __builtin_amdgcn_readfirstlane(tid >> 6);
    const int G = gridDim.x, gw = blockIdx.x * 8 + wave, NGW = G * 8;
    unsigned char* ws = a.ws;
    bf16* WA = (bf16*)(ws + WS_WA);
    transpose_group<0>(a, lds, gw, NGW);
    { u32x4* z = (u32x4*)(WA + (size_t)3712 * 1024); const int nz = 128 * 1024 * 2 / 16;
      for (int i = blockIdx.x * 512 + tid; i < nz; i += G * 512) z[i] = (u32x4){0u, 0u, 0u, 0u}; }
    bf16* XN = (bf16*)(ws + WS_XN); bf16* MEMN = (bf16*)(ws + WS_MEMN);
    for (int m = gw; m < MTOK + MROWS; m += NGW) {
        if (m < MTOK) rms_row_to_bf16(a.in[I_X] + (size_t)m * DM, XN + (size_t)m * DM, lane);
        else rms_row_to_bf16(a.in[I_MEM] + (size_t)(m - MTOK) * DM, MEMN + (size_t)(m - MTOK) * DM, lane);
    }
}

__device__ __forceinline__ void run_gemm(LAS unsigned char* lds, const bf16* A, const bf16* Bt, int M, int N, void* O, int ldc, int f32out, int shift, unsigned* km) {
    const int G = gridDim.x;
    pg8::Gemm g{A, Bt, M, N, 1024};
    pg8::StaticOrder S; S.init(M, N, G, (int)((blockIdx.x + G - shift) % G));
    pg8::EpiStore E{O, ldc, f32out, km};
    pg8::gemm_phase<pg8::EpiStore, pg8::StaticOrder>(lds, g, S, E);
}
template <int LAYER>
__device__ __forceinline__ void phase_outproj(const Args& a, LAS unsigned char* lds) {
    unsigned char* ws = a.ws; const int G = gridDim.x;
    pg8::Gemm g{(const bf16*)(ws + WS_CAT), (const bf16*)(ws + WS_WO) + (size_t)LAYER * 1024 * 1024, MTOK, 1024, 1024};
    pg8::StaticOrder S; S.init(MTOK, 1024, G, (int)blockIdx.x);
    pg8::EpiFused E{a.in[I_X], LAYER ? (const bf16*)(ws + WS_X1B) : nullptr, a.out, LAYER ? nullptr : (bf16*)(ws + WS_X1B), LAYER ? nullptr : (bf16*)(ws + WS_XN), a.in[I_POST] + LAYER * DM,
                    (float*)(ws + WS_XCH) + (size_t)LAYER * 2 * 64 * 4 * 256, (unsigned*)(ws + WS_XCNT) + LAYER * 2 * 64 * 16};
    pg8::gemm_phase<pg8::EpiFused, pg8::StaticOrder, true>(lds, g, S, E);
}
__device__ __forceinline__ void phase_gemm(const Args& a, LAS unsigned char* lds, int first, int count) {
    unsigned char* ws = a.ws;
    for (int j = first; j < first + count; ++j) {
        const bf16* A; const bf16* Bt; int M, N, ldc, f32o, shift; void* O;
        switch (j) {
        case 0: A = (const bf16*)(ws + WS_XN); Bt = (const bf16*)(ws + WS_WA); M = MTOK; N = 3840; O = ws + WS_PROJ; ldc = LDP0; f32o = 0; shift = 0; break;
        case 1: A = (const bf16*)(ws + WS_MEMN); Bt = (const bf16*)(ws + WS_WM); M = MROWS; N = 512; O = ws + WS_MK; ldc = 512; f32o = 0; shift = 192; break;
        case 2: A = (const bf16*)(ws + WS_WM) + 512 * 1024; Bt = (const bf16*)(ws + WS_MEMN); M = 512; N = MROWS; O = ws + WS_MVT; ldc = MROWS; f32o = 0; shift = 208; break;
        case 3: A = (const bf16*)(ws + WS_CAT); Bt = (const bf16*)(ws + WS_WO); M = MTOK; N = 1024; O = ws + WS_Y; ldc = 1024; f32o = 0; shift = 0; break;
        case 4: A = (const bf16*)(ws + WS_XN); Bt = (const bf16*)(ws + WS_WB); M = MTOK; N = 2816; O = ws + WS_PROJ; ldc = LDP1; f32o = 0; shift = 0; break;
        case 5: A = (const bf16*)(ws + WS_WB) + 2816 * 1024; Bt = (const bf16*)(ws + WS_XN); M = 768; N = MTOK; O = ws + WS_VT; ldc = MTOK; f32o = 0; shift = 192; break;
        default: A = (const bf16*)(ws + WS_CAT); Bt = (const bf16*)(ws + WS_WO) + 1024 * 1024; M = MTOK; N = 1024; O = ws + WS_Y; ldc = 1024; f32o = 0; shift = 0; break;
        }
        run_gemm(lds, A, Bt, M, N, O, ldc, f32o, shift, (j == 4) ? (unsigned*)(ws + WS_KM) : nullptr);
    }
}

constexpr int AT_PITCH = 72;
template <int NMAP>
__device__ __forceinline__ void attn_unit(LAS unsigned char* lds, const bf16* Qp, int ldq, const bf16* Kp, int ldk, const bf16* VTp, int ldvt,
                                          int nkt_lo, int nkt_hi, float slope2, int tq0,
                                          const bf16* Gp, int ldg, bf16* Op, int ldo, const float* subln, float lam, float oscale, const unsigned* kmp = nullptr) {
    constexpr int EV = 64 * NMAP, NET = EV / 16;
    const int tid = threadIdx.x, lane = tid & 63, wave = __builtin_amdgcn_readfirstlane(tid >> 6), g = lane >> 4, c = lane & 15;
    constexpr int AT_BUF = NMAP * 64 * AT_PITCH * 2 + EV * AT_PITCH * 2;
    const int nkt = (wave < 4) ? nkt_lo : nkt_hi;
    const int qrow = 16 * wave + c;
    bf16x8 qf[NMAP][2];
#pragma unroll
    for (int mp = 0; mp < NMAP; ++mp)
#pragma unroll
        for (int ks = 0; ks < 2; ++ks) qf[mp][ks] = *(const bf16x8*)(Qp + (size_t)qrow * ldq + mp * 64 + 32 * ks + 8 * g);
    f32x4 o[NMAP][NET];
#pragma unroll
    for (int mp = 0; mp < NMAP; ++mp)
#pragma unroll
        for (int et = 0; et < NET; ++et) o[mp][et] = (f32x4){0.f, 0.f, 0.f, 0.f};
    float mrun[NMAP], lrun[NMAP];
#pragma unroll
    for (int mp = 0; mp < NMAP; ++mp) { mrun[mp] = -1e30f; lrun[mp] = 0.f; }
    const float sc2 = 0.125f * LOG2E;
    const float tq = (float)(tq0 + qrow);
    float ubq[NMAP];
    LAS unsigned* votes = (LAS unsigned*)(lds + 2 * AT_BUF);
    if (NMAP == 2) {
#pragma unroll
        for (int mp = 0; mp < NMAP; ++mp) {
            float k2 = 0.f;
#pragma unroll
            for (int pc = 0; pc < 8; ++pc) k2 += __builtin_bit_cast(float, kmp[mp * 8 + pc]);
            float q2 = 0.f;
#pragma unroll
            for (int ks = 0; ks < 2; ++ks) { const u32x4 qq = __builtin_bit_cast(u32x4, qf[mp][ks]);
#pragma unroll
                for (int e = 0; e < 4; ++e) { const float a0 = bflo(qq[e]), a1 = bfhi(qq[e]); q2 += a0 * a0 + a1 * a1; } }
            q2 = rows_sum(q2);
            ubq[mp] = sqrtf(q2 * k2) * sc2 * 1.001f + 1e-3f;
        }
    }
    u32x4 kreg[2][NMAP], vreg[2][NMAP];
#define AT_LOAD(SET, kt) do { _Pragma("unroll") for (int i = 0; i < NMAP; ++i) { const int id = tid + 512 * i; \
        { const int mp = id >> 9, n = (id >> 3) & 63, ch = id & 7; kreg[SET][i] = *(const u32x4*)(Kp + (size_t)((kt) * 64 + n) * ldk + mp * 64 + 8 * ch); } \
        { const int e = id >> 3, ch = id & 7; vreg[SET][i] = *(const u32x4*)(VTp + (size_t)e * ldvt + (kt) * 64 + 8 * ch); } } } while (0)
#define AT_STORE(SET) do { LAS bf16* Ks = (LAS bf16*)(lds + (SET) * AT_BUF); LAS bf16* Vs = (LAS bf16*)(lds + (SET) * AT_BUF + NMAP * 64 * AT_PITCH * 2); \
        _Pragma("unroll") for (int i = 0; i < NMAP; ++i) { const int id = tid + 512 * i; \
        { const int mp = id >> 9, n = (id >> 3) & 63, ch = id & 7; *(LAS u32x4*)(Ks + (mp * 64 + n) * AT_PITCH + 8 * ch) = kreg[SET][i]; } \
        { const int e = id >> 3, ch = id & 7; *(LAS u32x4*)(Vs + e * AT_PITCH + 8 * ch) = vreg[SET][i]; } } } while (0)
    u32x2 gpre[NET];
#pragma unroll
    for (int et = 0; et < NET; ++et) gpre[et] = *(const u32x2*)(Gp + (size_t)qrow * ldg + 16 * et + 4 * g);
    AT_LOAD(0, nkt_hi - 1);
    if (nkt_hi > 1) AT_LOAD(1, nkt_hi - 2);
    __syncthreads();
    AT_STORE(0);
    if (nkt_hi > 2) AT_LOAD(0, nkt_hi - 3);
    __syncthreads();
    for (int it = 0; it < nkt_hi; ++it) {
        const int kt = nkt_hi - 1 - it;
        if (NMAP == 2 && it > 0) {
            const LAS unsigned* vv = votes + ((it - 1) & 1) * 8;
            if ((vv[0] & vv[1] & vv[2] & vv[3] & vv[4] & vv[5] & vv[6] & vv[7]) != 0u) break;
        }
        if (kt > 0) { if (it & 1) { AT_STORE(0); if (kt > 2) AT_LOAD(0, kt - 3); } else { AT_STORE(1); if (kt > 2) AT_LOAD(1, kt - 3); } }
        const LAS bf16* Ks = (const LAS bf16*)(lds + (it & 1) * AT_BUF); const LAS bf16* Vs = (const LAS bf16*)(lds + (it & 1) * AT_BUF + NMAP * 64 * AT_PITCH * 2);
        if (kt < nkt) {
            f32x4 bias[4];
#pragma unroll
            for (int k16 = 0; k16 < 4; ++k16)
#pragma unroll
                for (int j = 0; j < 4; ++j) bias[k16][j] = -slope2 * fabsf(tq - (float)(kt * 64 + 16 * k16 + 4 * g + j));
            bf16x8 pf[NMAP][2]; bool any = false;
#pragma unroll
            for (int mp = 0; mp < NMAP; ++mp) {
                f32x4 st[4];
#pragma unroll
                for (int k16 = 0; k16 < 4; ++k16) {
                    f32x4 acc = (f32x4){0.f, 0.f, 0.f, 0.f};
#pragma unroll
                    for (int ks = 0; ks < 2; ++ks) { const bf16x8 ka = *(const LAS bf16x8*)(Ks + (mp * 64 + 16 * k16 + c) * AT_PITCH + 32 * ks + 8 * g);
                        acc = __builtin_amdgcn_mfma_f32_16x16x32_bf16(ka, qf[mp][ks], acc, 0, 0, 0); }
                    st[k16] = acc * sc2 + bias[k16];
                }
                float m4[4];
#pragma unroll
                for (int k16 = 0; k16 < 4; ++k16) m4[k16] = fmaxf(fmaxf(st[k16].x, st[k16].y), fmaxf(st[k16].z, st[k16].w));
                float mx = fmaxf(fmaxf(m4[0], m4[1]), fmaxf(m4[2], m4[3]));
                mx = rows_max(mx);
                if (__builtin_amdgcn_ballot_w64(mx > mrun[mp] - 40.f) != 0ull) {
                    any = true;
                    const float mnew = fmaxf(mrun[mp], mx), alpha = __builtin_amdgcn_exp2f(mrun[mp] - mnew);
                    mrun[mp] = mnew;
                    float ps = 0.f;
#pragma unroll
                    for (int k16 = 0; k16 < 4; ++k16)
#pragma unroll
                        for (int j = 0; j < 4; ++j) { const float p = __builtin_amdgcn_exp2f(st[k16][j] - mnew); st[k16][j] = p; ps += p; }
                    lrun[mp] = lrun[mp] * alpha + ps;
                    if (__builtin_amdgcn_ballot_w64(alpha != 1.f) != 0ull) {
#pragma unroll
                        for (int et = 0; et < NET; ++et) o[mp][et] = o[mp][et] * alpha;
                    }
#pragma unroll
                    for (int i = 0; i < 2; ++i) { u32x4 w; w.x = pk2(st[2 * i][0], st[2 * i][1]); w.y = pk2(st[2 * i][2], st[2 * i][3]); w.z = pk2(st[2 * i + 1][0], st[2 * i + 1][1]); w.w = pk2(st[2 * i + 1][2], st[2 * i + 1][3]);
                        pf[mp][i] = __builtin_bit_cast(bf16x8, w); }
                } else {
                    pf[mp][0] = (bf16x8){0, 0, 0, 0, 0, 0, 0, 0}; pf[mp][1] = (bf16x8){0, 0, 0, 0, 0, 0, 0, 0};
                }
            }
            if (any) {
#pragma unroll
                for (int et = 0; et < NET; ++et)
#pragma unroll
                    for (int i = 0; i < 2; ++i) {
                        const u32x2 lo = *(const LAS u32x2*)(Vs + (16 * et + c) * AT_PITCH + 32 * i + 4 * g);
                        const u32x2 hi = *(const LAS u32x2*)(Vs + (16 * et + c) * AT_PITCH + 32 * i + 16 + 4 * g);
                        const bf16x8 va = __builtin_bit_cast(bf16x8, (u32x4){lo.x, lo.y, hi.x, hi.y});
#pragma unroll
                        for (int mp = 0; mp < NMAP; ++mp) o[mp][et] = __builtin_amdgcn_mfma_f32_16x16x32_bf16(va, pf[mp][i], o[mp][et], 0, 0, 0);
                    }
            }
        }
        if (NMAP == 2) {
            const float dmin = fmaxf(tq - (float)(64 * kt - 1), 0.f);
            bool neg = true;
#pragma unroll
            for (int mp = 0; mp < NMAP; ++mp) neg = neg && (ubq[mp] - slope2 * dmin < mrun[mp] - 40.f);
            const bool all = (__builtin_amdgcn_ballot_w64(neg) == ~0ull);
            if (lane == 0) votes[(it & 1) * 8 + wave] = all ? 1u : 0u;
        }
        __syncthreads();
    }
#undef AT_LOAD
#undef AT_STORE
    float inv[NMAP];
#pragma unroll
    for (int mp = 0; mp < NMAP; ++mp) { const float l = rows_sum(lrun[mp]); inv[mp] = 1.f / l; }
    f32x4 r[NET]; float ss = 0.f;
#pragma unroll
    for (int et = 0; et < NET; ++et) {
        if (NMAP == 2) r[et] = o[0][et] * inv[0] - o[NMAP - 1][et] * (lam * inv[NMAP - 1]);
        else r[et] = o[0][et] * inv[0];
        ss += (r[et].x * r[et].x + r[et].y * r[et].y) + (r[et].z * r[et].z + r[et].w * r[et].w);
    }
    float rs = 1.f;
    if (NMAP == 2) { ss = rows_sum(ss); rs = oscale / sqrtf(ss * (1.f / EV) + NORM_EPS); }
#pragma unroll
    for (int et = 0; et < NET; ++et) {
        const int e = 16 * et + 4 * g;
        const u32x2 gv = gpre[et];
        f32x4 v = r[et] * rs;
        if (NMAP == 2) v = v * *(const f32x4*)(subln + e);
        v.x *= siluf_(bflo(gv.x)); v.y *= siluf_(bfhi(gv.x)); v.z *= siluf_(bflo(gv.y)); v.w *= siluf_(bfhi(gv.y));
        u32x2 w; w.x = pk2(v.x, v.y); w.y = pk2(v.z, v.w);
        *(u32x2*)(Op + (size_t)qrow * ldo + e) = w;
    }
    __syncthreads();
}

__device__ __forceinline__ void mem_attn_unit(const Args& a, LAS unsigned char* lds, int l, int u) {
    unsigned char* ws = a.ws;
    const int b = u >> 6, h = (u >> 4) & 3, qb = u & 15;
    const bf16* PROJ = (const bf16*)(ws + WS_PROJ);
    const int ldp = l ? LDP1 : LDP0, cq = l ? C_QM1 : C_QM0, cg_ = l ? C_GM1 : C_GM0;
    const size_t row0 = (size_t)b * SEQ + qb * 128;
    attn_unit<1>(lds, PROJ + row0 * ldp + cq + h * 64, ldp,
                 (const bf16*)(ws + WS_MK) + (size_t)b * MEML * 512 + l * 256 + h * 64, 512,
                 (const bf16*)(ws + WS_MVT) + (size_t)(l * 256 + h * 64) * MROWS + b * MEML, MROWS,
                 4, 4, 0.f, 0,
                 PROJ + row0 * ldp + cg_ + h * 64, ldp, (bf16*)(ws + WS_CAT) + row0 * DM + BRW + h * 64, DM, nullptr, 0.f, 1.f);
}

typedef _Float16 f16x4_t __attribute__((ext_vector_type(4)));
__device__ __forceinline__ void lora_item(const Args& a, LAS unsigned char* lds, int b, int cgp) {
    const int tid = threadIdx.x, lane = tid & 63, wave = __builtin_amdgcn_readfirstlane(tid >> 6), g = lane >> 4, c = lane & 15;
    unsigned char* ws = a.ws;
    const bf16* PROJ = (const bf16*)(ws + WS_PROJ);
    const size_t mb = (size_t)b * SEQ; const int t0 = 64 * cgp;
    LAS bf16* AW = (LAS bf16*)lds; LAS bf16* AA = AW + 64 * 72;
    const float* mu = a.in[I_AMU];
#pragma unroll
    for (int r = 0; r < 2; ++r) {
        const int i = tid + 512 * r, tok = i >> 4, ch = i & 15;
        const bf16* cur = PROJ + (mb + t0 + tok) * LDP0 + C_WD + 8 * ch; const bf16* prv = (t0 + tok == 0) ? cur : cur - LDP0; const float pz = (t0 + tok == 0) ? 0.f : 1.f;
        const u32x4 zc = *(const u32x4*)cur, zp = *(const u32x4*)prv;
        const f32x4 m0 = *(const f32x4*)(mu + C_WD + 8 * ch), m1 = *(const f32x4*)(mu + C_WD + 8 * ch + 4);
        float x[8];
#pragma unroll
        for (int e = 0; e < 4; ++e) {
            const float ma = (e < 2) ? m0[2 * e] : m1[2 * e - 4], mb_ = (e < 2) ? m0[2 * e + 1] : m1[2 * e - 3];
            float z0 = bflo(zc[e]), z1 = bfhi(zc[e]);
            z0 = z0 + (bflo(zp[e]) * pz - z0) * ma; z1 = z1 + (bfhi(zp[e]) * pz - z1) * mb_;
            if (ch < 8) { z0 = 1.f - 2.f * __builtin_amdgcn_rcpf(1.f + __builtin_amdgcn_exp2f(2.8853900817779268f * z0)); z1 = 1.f - 2.f * __builtin_amdgcn_rcpf(1.f + __builtin_amdgcn_exp2f(2.8853900817779268f * z1)); }
            x[2 * e] = z0; x[2 * e + 1] = z1;
        }
        u32x4 w; w.x = pk2(x[0], x[1]); w.y = pk2(x[2], x[3]); w.z = pk2(x[4], x[5]); w.w = pk2(x[6], x[7]);
        *(LAS u32x4*)(((ch < 8) ? AW : AA) + tok * 72 + 8 * (ch & 7)) = w;
    }
    __syncthreads();
    const int mtp = wave & 1, gq = wave >> 1;
    const bf16* W2T = (const bf16*)(ws + WS_W2T); const bf16* A2T = W2T + 768 * 64;
    _Float16* LD16 = (_Float16*)(ws + WS_LD16); bf16* A16 = (bf16*)(ws + WS_A16);
    bf16x8 Aw[2][2], Aa[2][2];
#pragma unroll
    for (int mt = 0; mt < 2; ++mt)
#pragma unroll
        for (int ks = 0; ks < 2; ++ks) { Aw[mt][ks] = *(const LAS bf16x8*)(AW + (32 * mtp + 16 * mt + c) * 72 + 32 * ks + 8 * g); Aa[mt][ks] = *(const LAS bf16x8*)(AA + (32 * mtp + 16 * mt + c) * 72 + 32 * ks + 8 * g); }
    const f32x4 Z4 = {0.f, 0.f, 0.f, 0.f};
    for (int gi = 0; gi < 3; ++gi) {
        const int colb = 64 * (3 * gq + gi) + 4 * c;
        const f32x4 w0v = *(const f32x4*)(a.in[I_AW0] + colb), a0v = *(const f32x4*)(a.in[I_AA0] + colb);
        f32x4 accw[2][4], acca[2][4];
#pragma unroll
        for (int q = 0; q < 4; ++q) {
            const bf16x8 bw0 = *(const bf16x8*)(W2T + (size_t)(colb + q) * 64 + 8 * g), bw1 = *(const bf16x8*)(W2T + (size_t)(colb + q) * 64 + 32 + 8 * g);
            const bf16x8 ba0 = *(const bf16x8*)(A2T + (size_t)(colb + q) * 64 + 8 * g), ba1 = *(const bf16x8*)(A2T + (size_t)(colb + q) * 64 + 32 + 8 * g);
#pragma unroll
            for (int mt = 0; mt < 2; ++mt) {
                accw[mt][q] = __builtin_amdgcn_mfma_f32_16x16x32_bf16(Aw[mt][0], bw0, Z4, 0, 0, 0); accw[mt][q] = __builtin_amdgcn_mfma_f32_16x16x32_bf16(Aw[mt][1], bw1, accw[mt][q], 0, 0, 0);
                acca[mt][q] = __builtin_amdgcn_mfma_f32_16x16x32_bf16(Aa[mt][0], ba0, Z4, 0, 0, 0); acca[mt][q] = __builtin_amdgcn_mfma_f32_16x16x32_bf16(Aa[mt][1], ba1, acca[mt][q], 0, 0, 0);
            }
        }
#pragma unroll
        for (int mt = 0; mt < 2; ++mt)
#pragma unroll
            for (int j = 0; j < 4; ++j) {
                const size_t m = mb + t0 + 32 * mtp + 16 * mt + 4 * g + j;
                f16x4_t ld; float av[4];
#pragma unroll
                for (int q = 0; q < 4; ++q) { ld[q] = (_Float16)(-0.8750322163622201f * sigmoidf_(w0v[q] + accw[mt][q][j])); av[q] = sigmoidf_(a0v[q] + acca[mt][q][j]); }
                *(f16x4_t*)(LD16 + m * 768 + colb) = ld;
                *(u32x2*)(A16 + m * 768 + colb) = (u32x2){pk2(av[0], av[1]), pk2(av[2], av[3])};
            }
    }
    asm volatile("s_waitcnt vmcnt(0)" ::: "memory");
    __syncthreads();
    if (tid == 0) {
        const unsigned x = (unsigned)__builtin_amdgcn_s_getreg((3 << 11) | 20) & 0xFu, nloc = ((volatile LAS unsigned*)(lds + LDS_BYTES - 64))[0];
        if (__hip_atomic_fetch_add((unsigned*)ws + CW_LX + 16 * x, 1u, __ATOMIC_RELAXED, __HIP_MEMORY_SCOPE_AGENT) + 1u == nloc) {
            __builtin_amdgcn_fence(__ATOMIC_RELEASE, "agent"); asm volatile("s_waitcnt vmcnt(0)" ::: "memory");
            (void)__hip_atomic_fetch_add((unsigned*)ws + CW_LORA, 1u, __ATOMIC_RELAXED, __HIP_MEMORY_SCOPE_AGENT); }
    }
}

constexpr int SK_SLOT = 15360, SK_NT = 0, SK_RT = 2304, SK_BP = 4608, SK_KP = 7168, SK_VT = 9728, SK_PC = 12288, SK_LK = 12544, SK_TT = 13184, SK_MB = 13824, SK_MK = 14464;
constexpr int SK_SCR = 3 * SK_SLOT, SK_SCRW = 7680, SK_BS = 0, SK_KS = 2304, SK_LB = 4608, SK_VM = 5632;
constexpr int SK_P72 = 72, SK_P20 = 20;
constexpr int SK_PRM = SK_SCR + 4 * SK_SCRW, SK_W2L = SK_PRM, SK_A2L = SK_PRM + 9216, SK_PF = SK_PRM + 18432;
enum { PF_W0 = 0, PF_A0, PF_KK, PF_KA, PF_RK, PF_MUR, PF_MUK, PF_MUWD, PF_MUAD, PF_MUV };
__device__ __forceinline__ bf16x8 lds2x8(const LAS bf16* p, int offa, int offb) { const u32x2 a = *(const LAS u32x2*)(p + offa), b = *(const LAS u32x2*)(p + offb); return __builtin_bit_cast(bf16x8, (u32x4){a.x, a.y, b.x, b.y}); }
__device__ __forceinline__ bf16x8 lds8z(const LAS bf16* p, int offa) { const u32x2 a = *(const LAS u32x2*)(p + offa); return __builtin_bit_cast(bf16x8, (u32x4){a.x, a.y, 0u, 0u}); }
__device__ __forceinline__ void scan_unit(const Args& a, LAS unsigned char* lds, int b, int h) {
    const int tid = threadIdx.x, lane = tid & 63, wave = __builtin_amdgcn_readfirstlane(tid >> 6), g = lane >> 4, c = lane & 15;
    unsigned char* ws = a.ws;
    const bf16* PROJ = (const bf16*)(ws + WS_PROJ);
    bf16* CAT = (bf16*)(ws + WS_CAT);
    const size_t mb = (size_t)b * SEQ;
    constexpr int NBLK = SEQ / 16;
    const f32x4 Z4 = {0.f, 0.f, 0.f, 0.f};
    {
        const bf16* W2T = (const bf16*)(ws + WS_W2T);
        for (int i = tid; i < 2 * 64 * 8; i += 512) { const int m = i >> 9, key = (i >> 3) & 63, ch = i & 7;
            const u32x4 v = *(const u32x4*)(W2T + (size_t)m * 768 * 64 + (size_t)(h * 64 + key) * 64 + 8 * ch);
            *(LAS u32x4*)(lds + (m ? SK_A2L : SK_W2L) + (((key & 3) * 16 + (key >> 2)) * SK_P72 + 8 * ch) * 2) = v; }
        for (int i = tid; i < 10 * 64; i += 512) { const int w = i >> 6, k = i & 63; float v;
            switch (w) { case PF_W0: v = a.in[I_AW0][h * 64 + k]; break; case PF_A0: v = a.in[I_AA0][h * 64 + k]; break; case PF_KK: v = a.in[I_AKK][h * 64 + k]; break;
                         case PF_KA: v = a.in[I_AKA][h * 64 + k]; break; case PF_RK: v = a.in[I_ARK][h * 64 + k]; break; case PF_MUR: v = a.in[I_AMU][C_R + h * 64 + k]; break;
                         case PF_MUK: v = a.in[I_AMU][C_K + h * 64 + k]; break; case PF_MUWD: v = a.in[I_AMU][C_WD + k]; break; case PF_MUAD: v = a.in[I_AMU][C_AD + k]; break;
                         default: v = a.in[I_AMU][C_V + h * 64 + k]; break; }
            ((LAS float*)(lds + SK_PF))[i] = v; }
        if (tid == 0) { unsigned* cw = (unsigned*)ws + CW_LORA;
            const unsigned nx = ((volatile LAS unsigned*)(lds + LDS_BYTES - 64))[1];
            while (__hip_atomic_load(cw, __ATOMIC_RELAXED, __HIP_MEMORY_SCOPE_AGENT) < nx) __builtin_amdgcn_s_sleep(2);
            __builtin_amdgcn_fence(__ATOMIC_ACQUIRE, "agent"); asm volatile("s_waitcnt vmcnt(0)" ::: "memory"); }
        __syncthreads();
    }
    if (wave < 4) {
        f32x4 St[4] = {Z4, Z4, Z4, Z4};
        for (int q = 0; q < 4; ++q) __syncthreads();
        for (int blk = 0; blk < NBLK; ++blk) {
            const LAS unsigned char* sl = lds + (blk % 3) * SK_SLOT;
            const LAS bf16* NT = (const LAS bf16*)(sl + SK_NT); const LAS bf16* RT = (const LAS bf16*)(sl + SK_RT);
            const LAS bf16* BP = (const LAS bf16*)(sl + SK_BP); const LAS bf16* KP = (const LAS bf16*)(sl + SK_KP);
            const LAS bf16* VT = (const LAS bf16*)(sl + SK_VT); const LAS float* PC = (const LAS float*)(sl + SK_PC);
            const LAS bf16* LK = (const LAS bf16*)(sl + SK_LK); const LAS bf16* TT = (const LAS bf16*)(sl + SK_TT);
            const LAS bf16* MB = (const LAS bf16*)(sl + SK_MB); const LAS bf16* MK = (const LAS bf16*)(sl + SK_MK);
            bf16x8 sbh[2];
#pragma unroll
            for (int ks = 0; ks < 2; ++ks) {
                const f32x4 x = St[2 * ks], y = St[2 * ks + 1];
                u32x4 hh; hh.x = pk2(x.x, x.y); hh.y = pk2(x.z, x.w); hh.z = pk2(y.x, y.y); hh.w = pk2(y.z, y.w);
                sbh[ks] = __builtin_bit_cast(bf16x8, hh);
            }
            const bf16x8 An0 = lds2x8(NT, c * SK_P72 + 4 * g, c * SK_P72 + 16 + 4 * g), An1 = lds2x8(NT, c * SK_P72 + 32 + 4 * g, c * SK_P72 + 48 + 4 * g);
            const bf16x8 Ar0 = lds2x8(RT, c * SK_P72 + 4 * g, c * SK_P72 + 16 + 4 * g), Ar1 = lds2x8(RT, c * SK_P72 + 32 + 4 * g, c * SK_P72 + 48 + 4 * g);
            const u32x2 vq = *(const LAS u32x2*)(VT + (16 * wave + c) * SK_P20 + 4 * g);
            const bf16x8 vlo = __builtin_bit_cast(bf16x8, (u32x4){vq.x, vq.y, 0u, 0u});
            const bf16x8 Alk = lds8z(LK, c * SK_P20 + 4 * g), At = lds8z(TT, c * SK_P20 + 4 * g);
            const bf16x8 Amk = lds2x8(MB, c * SK_P20 + 4 * g, (int)((SK_MK - SK_MB) / 2) + c * SK_P20 + 4 * g);
            f32x4 X = __builtin_amdgcn_mfma_f32_16x16x32_bf16(An0, sbh[0], Z4, 0, 0, 0);
            X = __builtin_amdgcn_mfma_f32_16x16x32_bf16(An1, sbh[1], X, 0, 0, 0);
            X = __builtin_amdgcn_mfma_f32_16x16x32_bf16(Alk, vlo, X, 0, 0, 0);
            f32x4 Y = __builtin_amdgcn_mfma_f32_16x16x32_bf16(Ar0, sbh[0], Z4, 0, 0, 0);
            Y = __builtin_amdgcn_mfma_f32_16x16x32_bf16(Ar1, sbh[1], Y, 0, 0, 0);
            const bf16x8 xb = __builtin_bit_cast(bf16x8, (u32x4){pk2(X.x, X.y), pk2(X.z, X.w), 0u, 0u});
            const f32x4 U = __builtin_amdgcn_mfma_f32_16x16x32_bf16(At, xb, Z4, 0, 0, 0);
            const bf16x8 ub = __builtin_bit_cast(bf16x8, (u32x4){pk2(U.x, U.y), pk2(U.z, U.w), vq.x, vq.y});
            Y = __builtin_amdgcn_mfma_f32_16x16x32_bf16(Amk, ub, Y, 0, 0, 0);
#pragma unroll
            for (int kt = 0; kt < 4; ++kt) {
                const f32x4 pc4 = *(const LAS f32x4*)(PC + 16 * kt + 4 * g);
                const bf16x8 Abk = lds2x8(BP, (16 * kt + c) * SK_P20 + 4 * g, (int)((SK_KP - SK_BP) / 2) + (16 * kt + c) * SK_P20 + 4 * g);
                St[kt] = __builtin_amdgcn_mfma_f32_16x16x32_bf16(Abk, ub, St[kt] * pc4, 0, 0, 0);
            }
            bf16* yp = CAT + (mb + (size_t)blk * 16 + 4 * g) * DM + h * 64 + 16 * wave + c;
            yp[0] = (bf16)f2bf(Y.x); yp[DM] = (bf16)f2bf(Y.y); yp[2 * DM] = (bf16)f2bf(Y.z); yp[3 * DM] = (bf16)f2bf(Y.w);
            if ((blk & 31) == 31) asm volatile("s_waitcnt vmcnt(0)" ::: "memory");
            __syncthreads();
        }
    } else {
        const int pw = wave - 4;
        const int kc = h * 64 + 4 * c;
        const LAS float* PF = (const LAS float*)(lds + SK_PF); const LAS bf16* W2L = (const LAS bf16*)(lds + SK_W2L); const LAS bf16* A2L = (const LAS bf16*)(lds + SK_A2L);
        LAS unsigned char* scr = lds + SK_SCR + pw * SK_SCRW;
        LAS bf16* BSs = (LAS bf16*)(scr + SK_BS); LAS bf16* KSs = (LAS bf16*)(scr + SK_KS); LAS float* LBs = (LAS float*)(scr + SK_LB);
        u32x4 zv[2], zvp[2]; u32x2 zr[4], zrp[4], zk[4], zkp[4], zl[4], za[4];
        const _Float16* LD16 = (const _Float16*)(ws + WS_LD16); const bf16* A16 = (const bf16*)(ws + WS_A16);
#define SK_LOAD_V(T0) do { \
        { const int sv_ = lane >> 2, cv_ = lane & 3; const bf16* cs = PROJ + (mb + (T0) + sv_) * LDP0; const bf16* ps = ((T0) + sv_ == 0) ? cs : cs - LDP0; \
          _Pragma("unroll") for (int i = 0; i < 2; ++i) { zv[i] = *(const u32x4*)(cs + C_V + h * 64 + 16 * cv_ + 8 * i); zvp[i] = *(const u32x4*)(ps + C_V + h * 64 + 16 * cv_ + 8 * i); } } } while (0)
#define SK_LOAD_S(T0, jj) do { const int s_ = 4 * g + (jj); const bf16* cs = PROJ + (mb + (T0) + s_) * LDP0; const bf16* ps = ((T0) + s_ == 0) ? cs : cs - LDP0; \
            zr[jj] = *(const u32x2*)(cs + C_R + kc); zrp[jj] = *(const u32x2*)(ps + C_R + kc); zk[jj] = *(const u32x2*)(cs + C_K + kc); zkp[jj] = *(const u32x2*)(ps + C_K + kc); \
            za[jj] = *(const u32x2*)(A16 + (mb + (T0) + s_) * 768 + kc); } while (0)
#define SK_LOAD_L(T0) do { _Pragma("unroll") for (int jj = 0; jj < 4; ++jj) zl[jj] = *(const u32x2*)(LD16 + (mb + (T0) + 4 * g + jj) * 768 + kc); } while (0)
        SK_LOAD_L(pw * 16); SK_LOAD_V(pw * 16);
#pragma unroll
        for (int jj = 0; jj < 4; ++jj) SK_LOAD_S(pw * 16, jj);
        for (int q = 0; q < pw; ++q) __syncthreads();
        for (int n = 0; n < NBLK / 4; ++n) {
            if (pw == 0 && n >= 10 && ((n - 10) & 7) == 0 && lane == 0) {
                __builtin_amdgcn_fence(__ATOMIC_RELEASE, "agent"); asm volatile("s_waitcnt vmcnt(0)" ::: "memory");
                __hip_atomic_store((unsigned*)ws + CW_HEAD + 16 * (b * 12 + h) + ((n - 10) >> 3), 1u, __ATOMIC_RELAXED, __HIP_MEMORY_SCOPE_AGENT);
            }
            const int blk = 4 * n + pw, t0 = blk * 16, t0n = (blk + 4 < NBLK) ? t0 + 64 : t0;
            LAS unsigned char* sl = lds + (blk % 3) * SK_SLOT;
            int c_o = c; asm volatile("" : "+v"(c_o));
            {
                unsigned vm[8];
                const int sv = lane >> 2, cv = lane & 3; const float pz = (t0 + sv == 0) ? 0.f : 1.f;
#pragma unroll
                for (int i = 0; i < 2; ++i) {
                    const LAS float* mv = PF + PF_MUV * 64 + 16 * cv + 8 * i;
                    const f32x4 m0 = *(const LAS f32x4*)mv, m1 = *(const LAS f32x4*)(mv + 4);
#pragma unroll
                    for (int e = 0; e < 4; ++e) {
                        const unsigned uc = zv[i][e], up = zvp[i][e];
                        const float ma = (e < 2) ? m0[2 * e] : m1[2 * e - 4], mb_ = (e < 2) ? m0[2 * e + 1] : m1[2 * e - 3];
                        float z0 = bflo(uc), z1 = bfhi(uc);
                        z0 = z0 + (bflo(up) * pz - z0) * ma; z1 = z1 + (bfhi(up) * pz - z1) * mb_;
                        vm[4 * i + e] = pk2(z0, z1);
                    }
                }
                *(LAS u32x4*)(scr + SK_VM + lane * 32) = (u32x4){vm[0], vm[1], vm[2], vm[3]}; *(LAS u32x4*)(scr + SK_VM + lane * 32 + 16) = (u32x4){vm[4], vm[5], vm[6], vm[7]};
                SK_LOAD_V(t0n);
            }
            u32x2 ntp[4], rtp[4], bpp[4], kpp[4]; f32x4 pcv;
            {
                f32x4 dec[4], E4;
#pragma unroll
                for (int jj = 0; jj < 4; ++jj) { const f16x4_t l4 = __builtin_bit_cast(f16x4_t, zl[jj]);
#pragma unroll
                    for (int nt = 0; nt < 4; ++nt) dec[jj][nt] = __builtin_amdgcn_exp2f((float)l4[nt]); }
                SK_LOAD_L(t0n);
#pragma unroll
                for (int nt = 0; nt < 4; ++nt) {
                    const float p3 = (dec[0][nt] * dec[1][nt]) * (dec[2][nt] * dec[3][nt]);
                    const float q0 = __shfl(p3, c), q1 = __shfl(p3, c + 16), q2 = __shfl(p3, c + 32), q3 = __shfl(p3, c + 48);
                    E4[nt] = ((g > 0) ? q0 : 1.f) * ((g > 1) ? q1 : 1.f) * ((g > 2) ? q2 : 1.f);
                    pcv[nt] = (q0 * q1) * (q2 * q3);
                }
                const f32x4 p_kk = *(const LAS f32x4*)(PF + PF_KK * 64 + 4 * c), p_ka = *(const LAS f32x4*)(PF + PF_KA * 64 + 4 * c),
                            p_rk = *(const LAS f32x4*)(PF + PF_RK * 64 + 4 * c), mu_r = *(const LAS f32x4*)(PF + PF_MUR * 64 + 4 * c), mu_k = *(const LAS f32x4*)(PF + PF_MUK * 64 + 4 * c);
                f32x4 pex = E4, bprev, kprev;
#pragma unroll
                for (int jj = 0; jj < 4; ++jj) {
                    if (jj == 1 || jj == 3) __syncthreads();
                    const int s = 4 * g + jj;
                    const float pz = (t0 + s == 0) ? 0.f : 1.f;
                    const f32x4 pin = pex * dec[jj];
                    f32x4 rr, kp4, ku, aa;
                    const unsigned ur[2] = {zr[jj].x, zr[jj].y}, urp[2] = {zrp[jj].x, zrp[jj].y}, uk[2] = {zk[jj].x, zk[jj].y}, ukp[2] = {zkp[jj].x, zkp[jj].y}, ua[2] = {za[jj].x, za[jj].y};
                    SK_LOAD_S(t0n, jj);
                    float ssq = 0.f, bs = 0.f;
#pragma unroll
                    for (int nt = 0; nt < 4; ++nt) {
                        const float zc = (nt & 1) ? bfhi(ur[nt >> 1]) : bflo(ur[nt >> 1]), zp = ((nt & 1) ? bfhi(urp[nt >> 1]) : bflo(urp[nt >> 1])) * pz;
                        const float kc_ = (nt & 1) ? bfhi(uk[nt >> 1]) : bflo(uk[nt >> 1]), kp_ = ((nt & 1) ? bfhi(ukp[nt >> 1]) : bflo(ukp[nt >> 1])) * pz;
                        rr[nt] = zc + (zp - zc) * mu_r[nt];
                        const float kk = kc_ + (kp_ - kc_) * mu_k[nt];
                        aa[nt] = (nt & 1) ? bfhi(ua[nt >> 1]) : bflo(ua[nt >> 1]);
                        ku[nt] = kk * p_kk[nt];
                        ssq += ku[nt] * ku[nt];
                        kp4[nt] = kk * (1.f + (aa[nt] - 1.f) * p_ka[nt]);
                        bs += rr[nt] * kp4[nt] * p_rk[nt];
                    }
                    ssq = sum16(ssq); bs = sum16(bs);
                    if (c == 0) ((float*)(ws + WS_BS))[(mb + t0 + s) * AH + h] = bs;
                    const float rn = __builtin_amdgcn_rsqf(fmaxf(ssq, 1e-12f));
                    f32x4 rp; rp.x = __builtin_amdgcn_rcpf(pin.x); rp.y = __builtin_amdgcn_rcpf(pin.y); rp.z = __builtin_amdgcn_rcpf(pin.z); rp.w = __builtin_amdgcn_rcpf(pin.w);
                    const f32x4 kn = ku * rn;
                    const f32x4 nt_ = pex * (-kn), bt = kn * aa * rp, kt_ = kp4 * rp, rt = pin * rr;
                    const f32x4 bpc = bt * pcv, kpc = kt_ * pcv;
                    ntp[jj] = (u32x2){pk2(nt_.x, nt_.y), pk2(nt_.z, nt_.w)};
                    rtp[jj] = (u32x2){pk2(rt.x, rt.y), pk2(rt.z, rt.w)};
                    *(LAS u32x2*)(BSs + s * SK_P72 + 4 * c) = (u32x2){pk2(bt.x, bt.y), pk2(bt.z, bt.w)};
                    *(LAS u32x2*)(KSs + s * SK_P72 + 4 * c) = (u32x2){pk2(kt_.x, kt_.y), pk2(kt_.z, kt_.w)};
                    if (jj & 1) {
#pragma unroll
                        for (int nt = 0; nt < 4; ++nt) { if (jj == 1) { bpp[nt].x = pk2(bprev[nt], bpc[nt]); kpp[nt].x = pk2(kprev[nt], kpc[nt]); } else { bpp[nt].y = pk2(bprev[nt], bpc[nt]); kpp[nt].y = pk2(kprev[nt], kpc[nt]); } }
                    } else { bprev = bpc; kprev = kpc; }
                    pex = pin;
                }
            }
            {
                LAS bf16* NT = (LAS bf16*)(sl + SK_NT); LAS bf16* RT = (LAS bf16*)(sl + SK_RT);
                LAS bf16* BP = (LAS bf16*)(sl + SK_BP); LAS bf16* KP = (LAS bf16*)(sl + SK_KP);
#pragma unroll
                for (int jj = 0; jj < 4; ++jj) { const int s = 4 * g + jj;
                    *(LAS u32x2*)(NT + s * SK_P72 + 4 * c) = ntp[jj]; *(LAS u32x2*)(RT + s * SK_P72 + 4 * c) = rtp[jj]; }
#pragma unroll
                for (int nt = 0; nt < 4; ++nt) { *(LAS u32x2*)(BP + (4 * c + nt) * SK_P20 + 4 * g) = bpp[nt]; *(LAS u32x2*)(KP + (4 * c + nt) * SK_P20 + 4 * g) = kpp[nt]; }
                if (g == 0) *(LAS f32x4*)((LAS float*)(sl + SK_PC) + 4 * c) = pcv;
                { const int sv = lane >> 2, cv = lane & 3; LAS bf16* VT = (LAS bf16*)(sl + SK_VT);
                  const u32x4 va_ = *(const LAS u32x4*)(scr + SK_VM + lane * 32), vb_ = *(const LAS u32x4*)(scr + SK_VM + lane * 32 + 16);
                  const unsigned vm[8] = {va_.x, va_.y, va_.z, va_.w, vb_.x, vb_.y, vb_.z, vb_.w};
#pragma unroll
                  for (int i = 0; i < 8; ++i) { VT[(16 * cv + 2 * i) * SK_P20 + sv] = (bf16)(vm[i] & 0xffffu); VT[(16 * cv + 2 * i + 1) * SK_P20 + sv] = (bf16)(vm[i] >> 16); } }
                asm volatile("s_waitcnt lgkmcnt(0)" ::: "memory");
                f32x4 Lb = Z4, Lk = Z4, Mb = Z4, Mk = Z4;
#pragma unroll
                for (int ks = 0; ks < 2; ++ks) {
                    const bf16x8 ab = *(const LAS bf16x8*)(BSs + c * SK_P72 + 32 * ks + 8 * g), ak = *(const LAS bf16x8*)(KSs + c * SK_P72 + 32 * ks + 8 * g);
                    const bf16x8 bn = *(const LAS bf16x8*)(NT + c * SK_P72 + 32 * ks + 8 * g), br = *(const LAS bf16x8*)(RT + c * SK_P72 + 32 * ks + 8 * g);
                    Lb = __builtin_amdgcn_mfma_f32_16x16x32_bf16(ab, bn, Lb, 0, 0, 0);
                    Lk = __builtin_amdgcn_mfma_f32_16x16x32_bf16(ak, bn, Lk, 0, 0, 0);
                    Mb = __builtin_amdgcn_mfma_f32_16x16x32_bf16(ab, br, Mb, 0, 0, 0);
                    Mk = __builtin_amdgcn_mfma_f32_16x16x32_bf16(ak, br, Mk, 0, 0, 0);
                }
#pragma unroll
                for (int j = 0; j < 4; ++j) { const int s = 4 * g + j; if (!(s < c)) { Lb[j] = 0.f; Lk[j] = 0.f; } if (!(s <= c)) { Mb[j] = 0.f; Mk[j] = 0.f; } }
                *(LAS u32x2*)((LAS bf16*)(sl + SK_LK) + c * SK_P20 + 4 * g) = (u32x2){pk2(Lk[0], Lk[1]), pk2(Lk[2], Lk[3])};
                *(LAS u32x2*)((LAS bf16*)(sl + SK_MB) + c * SK_P20 + 4 * g) = (u32x2){pk2(Mb[0], Mb[1]), pk2(Mb[2], Mb[3])};
                *(LAS u32x2*)((LAS bf16*)(sl + SK_MK) + c * SK_P20 + 4 * g) = (u32x2){pk2(Mk[0], Mk[1]), pk2(Mk[2], Mk[3])};
                *(LAS f32x4*)(LBs + c * 16 + 4 * g) = Lb;
            }
            __syncthreads();
            {
                float Ti[16];
#pragma unroll
                for (int t = 0; t < 16; ++t) {
                    float acc = (c_o == t) ? 1.f : 0.f;
                    if ((t & 3) == 0) asm volatile("" ::: "memory");
#pragma unroll
                    for (int s4 = 0; s4 < (t + 3) / 4; ++s4) {
                        const f32x4 l4 = *(const LAS f32x4*)(LBs + t * 16 + 4 * s4);
#pragma unroll
                        for (int e = 0; e < 4; ++e) if (4 * s4 + e < t) acc += Ti[4 * s4 + e] * l4[e];
                    }
                    Ti[t] = acc;
                }
                if (g == 0) {
                    LAS bf16* TT = (LAS bf16*)(sl + SK_TT);
#pragma unroll
                    for (int t = 0; t < 16; ++t) TT[t * SK_P20 + c] = (bf16)f2bf(Ti[t]);
                }
            }
            __syncthreads();
        }
#undef SK_LOAD_S
#undef SK_LOAD_L
#undef SK_LOAD_V
        for (int q = 0; q < 4 - pw; ++q) __syncthreads();
    }
}

__device__ __forceinline__ void head_publish(const Args& a, int u) {
    asm volatile("s_waitcnt vmcnt(0)" ::: "memory");
    __syncthreads();
    if (threadIdx.x == 0) {
        __builtin_amdgcn_fence(__ATOMIC_RELEASE, "agent");
        asm volatile("s_waitcnt vmcnt(0)" ::: "memory");
        __hip_atomic_store((unsigned*)a.ws + CW_HEAD + 16 * u + 3, 1u, __ATOMIC_RELAXED, __HIP_MEMORY_SCOPE_AGENT);
    }
}
__device__ __forceinline__ void head_wait(const Args& a, int u, int q) {
    if (threadIdx.x == 0) {
        unsigned* f = (unsigned*)a.ws + CW_HEAD + 16 * u + q;
        while (__hip_atomic_load(f, __ATOMIC_RELAXED, __HIP_MEMORY_SCOPE_AGENT) == 0u) __builtin_amdgcn_s_sleep(8);
        __builtin_amdgcn_fence(__ATOMIC_ACQUIRE, "agent");
        asm volatile("s_waitcnt vmcnt(0)" ::: "memory");
    }
    __syncthreads();
}
__device__ __forceinline__ void rwkv_post_item(const Args& a, int u, int sl) {
    const int tid = threadIdx.x, lane = tid & 63, wave = tid >> 6, tsub = lane >> 4, col = (u % 12) * 64 + 4 * (lane & 15);
    const int b = u / 12, h = u % 12;
    unsigned char* ws = a.ws;
    const bf16* PROJ = (const bf16*)(ws + WS_PROJ); bf16* CAT = (bf16*)(ws + WS_CAT); const float* BS = (const float*)(ws + WS_BS);
    const f32x4 lw = *(const f32x4*)(a.in[I_ALNW] + col), lb = *(const f32x4*)(a.in[I_ALNB] + col), mv = *(const f32x4*)(a.in[I_AMU] + C_V + col);
    for (int p0 = 0; p0 < 8; p0 += 2) {
        u32x2 yv[2], vc[2], vp[2], gt[2]; float bsv[2], pzv[2]; size_t mrow[2];
#pragma unroll
        for (int r = 0; r < 2; ++r) {
            const int t = 256 * sl + 32 * wave + 4 * (p0 + r) + tsub; const size_t m = (size_t)b * SEQ + t; mrow[r] = m;
            const bf16* pc = PROJ + m * LDP0; const bf16* pp = (t == 0) ? pc : pc - LDP0; pzv[r] = (t == 0) ? 0.f : 1.f;
            yv[r] = *(const u32x2*)(CAT + m * DM + col); vc[r] = *(const u32x2*)(pc + C_V + col); vp[r] = *(const u32x2*)(pp + C_V + col); gt[r] = *(const u32x2*)(pc + C_GATE0 + col);
            bsv[r] = BS[m * AH + h];
        }
#pragma unroll
        for (int r = 0; r < 2; ++r) {
            const float pz = pzv[r];
            float y[4] = {bflo(yv[r].x), bfhi(yv[r].x), bflo(yv[r].y), bfhi(yv[r].y)};
            const float mean = sum16((y[0] + y[1]) + (y[2] + y[3])) * (1.f / 64.f);
            float d[4], vs = 0.f;
#pragma unroll
            for (int j = 0; j < 4; ++j) { d[j] = y[j] - mean; vs += d[j] * d[j]; }
            const float rstd = 1.f / sqrtf(sum16(vs) * (1.f / 64.f) + LNX_EPS);
            const float vcur[4] = {bflo(vc[r].x), bfhi(vc[r].x), bflo(vc[r].y), bfhi(vc[r].y)};
            const float vprv[4] = {bflo(vp[r].x) * pz, bfhi(vp[r].x) * pz, bflo(vp[r].y) * pz, bfhi(vp[r].y) * pz};
            const float gg[4] = {bflo(gt[r].x), bfhi(gt[r].x), bflo(gt[r].y), bfhi(gt[r].y)};
            float o[4];
#pragma unroll
            for (int j = 0; j < 4; ++j) { const float v = vcur[j] + (vprv[j] - vcur[j]) * mv[j];
                o[j] = (d[j] * rstd * lw[j] + lb[j] + bsv[r] * v) * siluf_(gg[j]); }
            *(u32x2*)(CAT + mrow[r] * DM + col) = (u32x2){pk2(o[0], o[1]), pk2(o[2], o[3])};
        }
    }
}

__device__ __forceinline__ void phase_scan(const Args& a, LAS unsigned char* lds) {
    const int G = gridDim.x, bx = blockIdx.x;
    for (int it = bx; it < 256; it += G) lora_item(a, lds, it & 7, it >> 3);
    __syncthreads();
    if (bx < 96) { scan_unit(a, lds, bx / 12, bx % 12); head_publish(a, bx); }
    else { for (int u = bx - 96; u < 512; u += G - 96) mem_attn_unit(a, lds, 0, u);
           const int wave = __builtin_amdgcn_readfirstlane(threadIdx.x >> 6);
           transpose_group<1>(a, lds, (bx - 96) * 8 + wave, (G - 96) * 8); }
    if (bx >= 96) for (int j = bx - 96; j < 576; j += G - 96) { const int u = j % 96, sl = j / 96; head_wait(a, u, sl >> 1); rwkv_post_item(a, u, sl); }
    if (bx < 192) { const int u = bx % 96, sl = 6 + bx / 96; head_wait(a, u, 3); rwkv_post_item(a, u, sl); }
}

__device__ __forceinline__ void phase_rwkv_post(const Args& a) {
    const int tid = threadIdx.x, lane = tid & 63, wave = tid >> 6, G = gridDim.x;
    unsigned char* ws = a.ws;
    const bf16* PROJ = (const bf16*)(ws + WS_PROJ); bf16* CAT = (bf16*)(ws + WS_CAT); const float* BS = (const float*)(ws + WS_BS);
    const float* mu = a.in[I_AMU];
    for (int m = blockIdx.x * 8 + wave; m < MTOK; m += G * 8) {
        const int t = m & (SEQ - 1);
        const bf16* pc = PROJ + (size_t)m * LDP0; const bf16* pp = (t == 0) ? pc : pc - LDP0; const float pz = (t == 0) ? 0.f : 1.f;
#pragma unroll
        for (int i = 0; i < 3; ++i) {
            const int col = 256 * i + 4 * lane, hh = col >> 6;
            const u32x2 yv = *(const u32x2*)(CAT + (size_t)m * DM + col);
            float y[4] = {bflo(yv.x), bfhi(yv.x), bflo(yv.y), bfhi(yv.y)};
            const float mean = sum16((y[0] + y[1]) + (y[2] + y[3])) * (1.f / 64.f);
            float d[4], vs = 0.f;
#pragma unroll
            for (int j = 0; j < 4; ++j) { d[j] = y[j] - mean; vs += d[j] * d[j]; }
            const float rstd = 1.f / sqrtf(sum16(vs) * (1.f / 64.f) + LNX_EPS);
            const f32x4 lw = *(const f32x4*)(a.in[I_ALNW] + col), lb = *(const f32x4*)(a.in[I_ALNB] + col), mv = *(const f32x4*)(mu + C_V + col);
            const u32x2 vc = *(const u32x2*)(pc + C_V + col), vp = *(const u32x2*)(pp + C_V + col), gt = *(const u32x2*)(pc + C_GATE0 + col);
            const float vcur[4] = {bflo(vc.x), bfhi(vc.x), bflo(vc.y), bfhi(vc.y)}, vprv[4] = {bflo(vp.x) * pz, bfhi(vp.x) * pz, bflo(vp.y) * pz, bfhi(vp.y) * pz};
            const float gg[4] = {bflo(gt.x), bfhi(gt.x), bflo(gt.y), bfhi(gt.y)};
            const float bs = BS[(size_t)m * AH + hh];
            float o[4];
#pragma unroll
            for (int j = 0; j < 4; ++j) { const float v = vcur[j] + (vprv[j] - vcur[j]) * mv[j];
                o[j] = (d[j] * rstd * lw[j] + lb[j] + bs * v) * siluf_(gg[j]); }
            u32x2 w; w.x = pk2(o[0], o[1]); w.y = pk2(o[2], o[3]);
            *(u32x2*)(CAT + (size_t)m * DM + col) = w;
        }
    }
}

template <int LAYER>
__device__ __forceinline__ void phase_rows(const Args& a) {
    const int tid = threadIdx.x, lane = tid & 63, wave = tid >> 6, G = gridDim.x;
    unsigned char* ws = a.ws;
    const bf16* Y = (const bf16*)(ws + WS_Y); const float* gpost = a.in[I_POST] + LAYER * DM;
    const float* xin = LAYER ? (const float*)a.out : a.in[I_X];
    bf16* XN = (bf16*)(ws + WS_XN);
    for (int m = blockIdx.x * 8 + wave; m < MTOK; m += G * 8) {
        const u32x2* yr = (const u32x2*)(Y + (size_t)m * DM) + lane; const f32x4* xr = (const f32x4*)(xin + (size_t)m * DM) + lane;
        f32x4 y[4], x[4]; float s = 0.f;
#pragma unroll
        for (int j = 0; j < 4; ++j) { const u32x2 yy = yr[64 * j]; y[j] = (f32x4){bflo(yy.x), bfhi(yy.x), bflo(yy.y), bfhi(yy.y)}; x[j] = xr[64 * j]; s += (y[j].x * y[j].x + y[j].y * y[j].y) + (y[j].z * y[j].z + y[j].w * y[j].w); }
        const float rs = 1.f / sqrtf(wave_sum(s) * (1.f / DM) + NORM_EPS);
        float s1 = 0.f;
        f32x4* orow = (f32x4*)(a.out + (size_t)m * DM) + lane;
#pragma unroll
        for (int j = 0; j < 4; ++j) { const f32x4 gp = *((const f32x4*)gpost + lane + 64 * j);
            x[j] = x[j] + y[j] * rs * gp; orow[64 * j] = x[j];
            s1 += (x[j].x * x[j].x + x[j].y * x[j].y) + (x[j].z * x[j].z + x[j].w * x[j].w); }
        if (LAYER == 0) {
            const float r1 = 1.f / sqrtf(wave_sum(s1) * (1.f / DM) + NORM_EPS);
            unsigned long long* o8 = (unsigned long long*)(XN + (size_t)m * DM) + lane;
#pragma unroll
            for (int j = 0; j < 4; ++j) o8[64 * j] = (unsigned long long)pk2(x[j].x * r1, x[j].y * r1) | ((unsigned long long)pk2(x[j].z * r1, x[j].w * r1) << 32);
        }
    }
}

constexpr int ATT_MAXU = 4;
__device__ const unsigned char att_deal[32][4] = {{32,31,94,8},{48,30,93,7},{33,29,90,81},{49,28,89,79},{34,27,86,74},{50,26,85,73},{35,25,82,66},{51,24,18,65},{36,23,12,1},{52,22,11,80},{37,21,2,255},{53,20,10,64},{38,19,9,16},{54,95,13,17},{39,92,4,255},{55,91,3,255},{40,88,76,255},{56,87,75,255},{41,84,70,255},{57,83,69,255},{42,15,68,255},{58,14,67,255},{43,6,255,255},{59,5,255,255},{44,78,255,255},{60,77,255,255},{45,72,255,255},{61,71,255,255},{46,0,255,255},{62,255,255,255},{47,255,255,255},{63,255,255,255}};
__device__ __forceinline__ void phase_attn1(const Args& a, LAS unsigned char* lds) {
    const int G = gridDim.x, bx = blockIdx.x, lane = threadIdx.x & 63;
    unsigned char* ws = a.ws;
    const float s1 = wave_sum(a.in[I_LQ1][lane] * a.in[I_LK1][lane]), s2 = wave_sum(a.in[I_LQ2][lane] * a.in[I_LK2][lane]);
    const float lam_init = 0.8f - 0.6f * 0.7408182206817179f;
    const float lam = __expf(s1) - __expf(s2) + lam_init;
    const bf16* PROJ = (const bf16*)(ws + WS_PROJ); const bf16* VT = (const bf16*)(ws + WS_VT); bf16* CAT = (bf16*)(ws + WS_CAT);
    const float slopes[6] = {0.25f, 0.0625f, 0.015625f, 0.00390625f, 0.5f, 0.125f};
    for (int i = 0; i < ATT_MAXU; ++i) {
        int qb, b, h;
        if (G == 256) { const int code = att_deal[bx >> 3][i]; if (code == 255) break; b = bx & 7; h = code >> 4; qb = code & 15; }
        else { const int n = i * G + bx; if (n >= 768) break; qb = 15 - n / 48; b = (n % 48) / 6; h = (n % 48) % 6; }
        const size_t row0 = (size_t)b * SEQ + qb * 128;
        float slope = slopes[0];
#pragma unroll
        for (int k = 1; k < 6; ++k) slope = (h == k) ? slopes[k] : slope;
        attn_unit<2>(lds, PROJ + row0 * LDP1 + C_Q1 + h * 128, LDP1,
                     PROJ + (size_t)b * SEQ * LDP1 + C_KSH + h * 128, LDP1,
                     VT + (size_t)(h * 128) * MTOK + (size_t)b * SEQ, MTOK,
                     2 * qb + 1, 2 * qb + 2, slope * LOG2E, qb * 128,
                     PROJ + row0 * LDP1 + C_GATE1 + h * 128, LDP1, CAT + row0 * DM + h * 128, DM, a.in[I_SUBLN], lam, 1.f - lam_init, (const unsigned*)(ws + WS_KM) + (b * 6 + h) * 16);
    }
    for (int u = bx; u < 512; u += G) mem_attn_unit(a, lds, 1, u);
}

constexpr int CW_XB = 8192;
#define XB_TMO      128
#define XB_XCNT(j)  (256  + 64 * (j))
#define XB_XSUB(j)  (1280 + 64 * (j))
#define XB_XGEN(j)  (2304 + 64 * (j))
#define XB_TOP      3328
#define XB_TOPGEN   3392
#define XB_SPIN_CAP (1u << 22)
__device__ __forceinline__ unsigned xb_ld(unsigned* p)              { return __hip_atomic_load(p, __ATOMIC_RELAXED, __HIP_MEMORY_SCOPE_AGENT); }
__device__ __forceinline__ unsigned xb_add(unsigned* p, unsigned v) { return __hip_atomic_fetch_add(p, v, __ATOMIC_RELAXED, __HIP_MEMORY_SCOPE_AGENT); }
__device__ __forceinline__ unsigned xb_xcc_id() { return (unsigned)__builtin_amdgcn_s_getreg((3 << 11) | 20) & 0xFu; }
#define XB_SPIN(cond, bar) do { unsigned _sp = 0; while (cond) { __builtin_amdgcn_s_sleep(1); \
    if ((++_sp & 255u) == 0u) { if (xb_ld(&(bar)[XB_TMO])) break; if (_sp > XB_SPIN_CAP) { atomicAdd(&(bar)[XB_TMO], 1u); break; } } } } while (0)
struct XcdBarrier { unsigned* bar; unsigned x; volatile LAS unsigned* st; };
__device__ __forceinline__ XcdBarrier xcd_barrier_post(unsigned* bar, volatile LAS unsigned* st) {
    XcdBarrier b; b.bar = bar; b.x = xb_xcc_id(); b.st = st;
    if (threadIdx.x == 0) (void)xb_add(&bar[XB_XCNT(b.x)], 1u);
    return b;
}
__device__ __forceinline__ void xcd_barrier_complete(unsigned* bar, unsigned x, unsigned& nloc, unsigned& nx) {
    const unsigned G = gridDim.x * gridDim.y * gridDim.z;
    unsigned sum, cnt, mine, sp = 0u;
    for (;;) {
        sum = 0u; cnt = 0u; mine = 0u;
#pragma unroll
        for (unsigned j = 0; j < 16; ++j) { const unsigned c = xb_ld(&bar[XB_XCNT(j)]); sum += c; cnt += (c > 0u) ? 1u : 0u; mine = (j == x) ? c : mine; }
        if (sum == G) break;
        __builtin_amdgcn_s_sleep(1);
        if ((++sp & 255u) == 0u) { if (xb_ld(&bar[XB_TMO])) break; if (sp > XB_SPIN_CAP) { atomicAdd(&bar[XB_TMO], 1u); break; } }
    }
    nloc = mine > 0u ? mine : 1u; nx = cnt > 0u ? cnt : 1u;
}
__device__ __forceinline__ void xcd_barrier(const XcdBarrier& b) {
    asm volatile("s_waitcnt vmcnt(0)" ::: "memory");
    __syncthreads();
    if (threadIdx.x == 0) {
        unsigned* bar = b.bar;
        __builtin_amdgcn_s_waitcnt(0);
        unsigned nloc = b.st[0], nx = b.st[1];
        if (nloc == 0u) { xcd_barrier_complete(bar, b.x, nloc, nx); b.st[0] = nloc; b.st[1] = nx; }
        const unsigned old = xb_add(&bar[XB_XSUB(b.x)], 1u);
        const unsigned gen = old / nloc;
        if (old + 1u == (gen + 1u) * nloc) {
            __builtin_amdgcn_fence(__ATOMIC_RELEASE, "agent");
            asm volatile("s_waitcnt vmcnt(0)" ::: "memory");
            const unsigned og = xb_add(&bar[XB_TOP], 1u);
            const unsigned tg = og / nx;
            if (og + 1u == (tg + 1u) * nx) xb_add(&bar[XB_TOPGEN], 1u);
            else XB_SPIN(xb_ld(&bar[XB_TOPGEN]) == tg, bar);
            __builtin_amdgcn_fence(__ATOMIC_ACQUIRE, "agent");
            xb_add(&bar[XB_XGEN(b.x)], 1u);
            asm volatile("s_waitcnt vmcnt(0)" ::: "memory");
        } else {
            XB_SPIN(xb_ld(&bar[XB_XGEN(b.x)]) == gen, bar);
            __builtin_amdgcn_fence(__ATOMIC_ACQUIRE, "agent");
            asm volatile("s_waitcnt vmcnt(0)" ::: "memory");
        }
    }
    __syncthreads();
}

constexpr int N_PHASES = 10;
__global__ void __launch_bounds__(512, 2) yoco_fwd(Args args) {
    extern __shared__ __attribute__((aligned(16))) unsigned char lds_raw[];
    LAS unsigned char* lds = (LAS unsigned char*)lds_raw;
    const int lo = args.ph_lo, hi = args.ph_hi;
#ifndef ONLY_PHASE
#define ONLY_PHASE -1
#endif
#define IN(k) ((ONLY_PHASE < 0 || ONLY_PHASE == (k)) && lo <= (k) && (k) < hi)
    volatile LAS unsigned* xb_st = (volatile LAS unsigned*)(lds + LDS_BYTES - 64);
    if (threadIdx.x == 0) { xb_st[0] = 0u; xb_st[1] = 0u; }
    __syncthreads();
    const XcdBarrier xbar = xcd_barrier_post((unsigned*)args.ws + CW_XB, xb_st);
    if (args.ph_hi > 64) { __syncthreads(); cg::this_grid().sync(); }
#define SEAM(k) do { if (IN(k) && IN((k) + 1)) { xcd_barrier(xbar); } } while (0)
    if (IN(0)) { phase_prologue(args, lds); if (PROBE_DUP == 0) { __syncthreads(); phase_prologue(args, lds); } }
    SEAM(0);
    if (IN(1)) { phase_gemm(args, lds, 0, 3); if (PROBE_DUP == 1) { __syncthreads(); phase_gemm(args, lds, 0, 3); } }
    SEAM(1);
    if (IN(2)) { phase_scan(args, lds); if (PROBE_DUP == 2) { __syncthreads(); phase_scan(args, lds); } }
    SEAM(2);
    if (IN(4)) { if (gridDim.x == 256) phase_outproj<0>(args, lds); else { phase_gemm(args, lds, 3, 1); } }
    if (gridDim.x != 256) { SEAM(4); if (IN(5)) phase_rows<0>(args); }
    SEAM(5);
    if (IN(6)) { phase_gemm(args, lds, 4, 2); if (PROBE_DUP == 6) { __syncthreads(); phase_gemm(args, lds, 4, 2); } }
    SEAM(6);
    if (IN(7)) { phase_attn1(args, lds); if (PROBE_DUP == 7) { __syncthreads(); phase_attn1(args, lds); } }
    SEAM(7);
    if (IN(8)) { if (gridDim.x == 256) phase_outproj<1>(args, lds); else { phase_gemm(args, lds, 6, 1); } }
    if (gridDim.x != 256) { SEAM(8); if (IN(9)) phase_rows<1>(args); }
#undef IN
#undef SEAM
}

extern "C" void kernel_launch(void* const* d_in, const int* in_sizes, int n_in, void* d_out, int out_size, void* d_ws, size_t ws_size, hipStream_t stream) {
    static int ready = 0;
    if (ready == 0) {
        if (n_in != 26 || out_size != MTOK * DM || ws_size < WS_END) { fprintf(stderr, "kernel_launch: unexpected problem shape (n_in %d out %d ws %zu)\n", n_in, out_size, ws_size); ready = -1; return; }
        if (hipFuncSetAttribute((const void*)yoco_fwd, hipFuncAttributeMaxDynamicSharedMemorySize, LDS_BYTES) != hipSuccess) { fprintf(stderr, "kernel_launch: hipFuncSetAttribute failed\n"); ready = -1; return; }
        int per_cu = 0;
        if (hipOccupancyMaxActiveBlocksPerMultiprocessor(&per_cu, (const void*)yoco_fwd, 512, LDS_BYTES) != hipSuccess || per_cu < 1) fprintf(stderr, "kernel_launch: occupancy query says %d\n", per_cu);
        (void)hipGetLastError();
        ready = 1;
    }
    if (ready < 0) return;
    Args a{};
    for (int i = 0; i < 26; ++i) a.in[i] = (const float*)d_in[i];
    a.out = (float*)d_out; a.ws = (unsigned char*)d_ws;
#if MK_COOP
    (void)hipMemsetAsync(d_ws, 0, 65536, stream);
    a.ph_lo = 0; a.ph_hi = N_PHASES;
    void* params[] = {&a};
    hipError_t e = hipLaunchCooperativeKernel((const void*)yoco_fwd, dim3(256), dim3(512), params, LDS_BYTES, stream);
    if (e != hipSuccess) fprintf(stderr, "kernel_launch: cooperative launch failed: %s\n", hipGetErrorString(e));
#else
    for (int ph = 0; ph < N_PHASES; ++ph) { a.ph_lo = ph; a.ph_hi = ph + 1; hipLaunchKernelGGL(yoco_fwd, dim3(256), dim3(512), LDS_BYTES, stream, a); }
#endif
}
```
